# Optimizing an MI355X kernel written in HIP

```python
import math
import jax, jax.numpy as jnp
from jax import lax
import numpy as np

D_MODEL = 1024
BATCH = 16
SEQ = 4096
DEPTH = 1

CHUNK = 64
Q_BLOCK = 128
HEAD_DIM = 64
N_FOX_HEADS = 8
FOX_WIDTH = N_FOX_HEADS * HEAD_DIM
N_DIFF_HEADS = 4
DIFF_V_DIM = 2 * HEAD_DIM
DIFF_QK_WIDTH = N_DIFF_HEADS * 2 * HEAD_DIM
DIFF_WIDTH = N_DIFF_HEADS * DIFF_V_DIM
N_BRANCHES = 2
ROPE_THETA = 10000.0
COL_FQ = 0
COL_FK = COL_FQ + FOX_WIDTH
COL_FV = COL_FK + FOX_WIDTH
COL_FF = COL_FV + FOX_WIDTH
COL_DQ = COL_FF + N_FOX_HEADS
COL_DK = COL_DQ + DIFF_QK_WIDTH
COL_DV = COL_DK + DIFF_QK_WIDTH
COL_GATE = COL_DV + DIFF_WIDTH
IN_COLS = COL_GATE + N_BRANCHES * D_MODEL
N_GROUPS = 4
EXPERTS_PER_GROUP = 8
N_EXPERTS = N_GROUPS * EXPERTS_PER_GROUP
TOP_K = 2
D_EXPERT = D_MODEL // 2
MOE_BLOCK = 256
EPS = 1e-6
NEG_INF = -1e30

kernel_name = 'chunk_causal_fox_diffattn_hmoe_adaln_block'


def lambda_init(layer_idx):
    return 0.8 - 0.6 * math.exp(-0.3 * layer_idx)


def rms_norm(x, g):
    xf = x.astype(jnp.float32)
    y = xf * lax.rsqrt(jnp.mean(xf * xf, axis=-1, keepdims=True) + EPS)
    return (y * g.astype(jnp.float32)).astype(x.dtype)


def rope(x, cos, sin):
    x1, x2 = jnp.split(x, 2, axis=-1)
    cos = cos.astype(x.dtype)
    sin = sin.astype(x.dtype)
    return jnp.concatenate([x1 * cos - x2 * sin, x2 * cos + x1 * sin], axis=-1)


def split_heads(t, n, d):
    b, s, _ = t.shape
    return t.reshape(b, s, n, d).transpose(0, 2, 1, 3)


def forgetting_attention(q, k, v, log_f):
    s_len = q.shape[2]
    cum = jnp.cumsum(log_f, axis=-1)
    scale = HEAD_DIM ** -0.5
    outs = []
    for i in range(s_len // Q_BLOCK):
        q0, q1 = i * Q_BLOCK, (i + 1) * Q_BLOCK
        logits = jnp.einsum('bhqd,bhkd->bhqk', q[:, :, q0:q1], k[:, :, :q1]).astype(jnp.float32) * scale
        logits = logits + cum[:, :, q0:q1, None] - cum[:, :, None, :q1]
        t_idx = jnp.arange(q0, q1)[:, None]
        s_idx = jnp.arange(q1)[None, :]
        logits = jnp.where(s_idx <= t_idx, logits, NEG_INF)
        p = jax.nn.softmax(logits, axis=-1)
        outs.append(jnp.einsum('bhqk,bhkd->bhqd', p.astype(v.dtype), v[:, :, :q1]))
    return jnp.concatenate(outs, axis=2)


def differential_attention(q, k, v, lam):
    s_len = q.shape[3]
    scale = HEAD_DIM ** -0.5
    outs = []
    for i in range(s_len // Q_BLOCK):
        q0, q1 = i * Q_BLOCK, (i + 1) * Q_BLOCK
        logits = jnp.einsum('bhmqd,bhmkd->bhmqk', q[:, :, :, q0:q1], k[:, :, :, :q1]).astype(jnp.float32) * scale
        t_chunk = (jnp.arange(q0, q1) // CHUNK)[:, None]
        s_chunk = (jnp.arange(q1) // CHUNK)[None, :]
        logits = jnp.where(s_chunk <= t_chunk, logits, NEG_INF)
        p = jax.nn.softmax(logits, axis=-1)
        attn = p[:, :, 0] - lam * p[:, :, 1]
        outs.append(jnp.einsum('bhqk,bhkd->bhqd', attn.astype(v.dtype), v[:, :, :q1]))
    return jnp.concatenate(outs, axis=2)


def hierarchical_route(h, w_rg, b_rg, w_re, b_re):
    t = h.shape[0]
    hf = h.astype(jnp.float32)
    p_group = jax.nn.softmax(hf @ w_rg.astype(jnp.float32) + b_rg.astype(jnp.float32), axis=-1)
    g_w, g_idx = lax.top_k(p_group, 1)
    e_logits = (hf @ w_re.astype(jnp.float32) + b_re.astype(jnp.float32)).reshape(t, N_GROUPS, EXPERTS_PER_GROUP)
    e_logits = jnp.take_along_axis(e_logits, g_idx[:, :, None], axis=1)[:, 0]
    p_exp = jax.nn.softmax(e_logits, axis=-1)
    e_w, e_idx = lax.top_k(p_exp, TOP_K)
    e_w = e_w / jnp.sum(e_w, axis=-1, keepdims=True)
    weights = g_w * e_w
    expert_ids = (g_idx * EXPERTS_PER_GROUP + e_idx).astype(jnp.int32)
    return expert_ids, weights


def moe_forward(h, expert_ids, weights, w1, w3, w2):
    t, d = h.shape
    a = t * TOP_K
    n_blocks = -(-a // MOE_BLOCK) + N_EXPERTS
    p_rows = n_blocks * MOE_BLOCK
    flat_e = expert_ids.reshape(a)
    flat_tok = jnp.arange(a, dtype=jnp.int32) // TOP_K
    order = jnp.argsort(flat_e)
    sorted_e = flat_e[order]
    counts = jnp.bincount(flat_e, length=N_EXPERTS).astype(jnp.int32)
    padded = ((counts + MOE_BLOCK - 1) // MOE_BLOCK) * MOE_BLOCK
    pad_end = jnp.cumsum(padded)
    pad_start = pad_end - padded
    start = jnp.cumsum(counts) - counts
    dest = pad_start[sorted_e] + (jnp.arange(a, dtype=jnp.int32) - start[sorted_e])
    buf_tok = jnp.full((p_rows,), t, dtype=jnp.int32).at[dest].set(flat_tok[order])
    h_pad = jnp.concatenate([h, jnp.zeros((1, d), h.dtype)], axis=0)
    xb = h_pad[buf_tok].reshape(n_blocks, MOE_BLOCK, d)
    block_expert = jnp.minimum(
        jnp.searchsorted(pad_end, jnp.arange(n_blocks, dtype=jnp.int32) * MOE_BLOCK, side='right'),
        N_EXPERTS - 1).astype(jnp.int32)

    def expert_block(args):
        xblk, e = args
        return (jax.nn.silu(xblk @ w1[e]) * (xblk @ w3[e])) @ w2[e]

    yb = lax.map(expert_block, (xb, block_expert)).reshape(p_rows, d)
    dest_orig = jnp.zeros((a,), jnp.int32).at[order].set(dest)
    y_assign = yb[dest_orig].reshape(t, TOP_K, d)
    return jnp.einsum('tkd,tk->td', y_assign, weights.astype(h.dtype))


def setup_inputs(seed: int = 0) -> dict:
    key = jax.random.key(seed)
    ks = jax.random.split(key, 32)
    L, D = DEPTH, D_MODEL

    def nrm(k, shape, scale):
        return jax.random.normal(k, shape, jnp.float32) * scale

    offsets = jax.random.randint(ks[2], (BATCH, 1), 0, 64, dtype=jnp.int32) * CHUNK
    positions = (offsets + jnp.arange(SEQ, dtype=jnp.int32)[None, :]).astype(jnp.int32)
    return {
        'x': nrm(ks[0], (BATCH, SEQ, D), 1.0),
        'c': nrm(ks[1], (BATCH, D), 1.0),
        'positions': positions,
        'w_ada': nrm(ks[3], (L, D, 6 * D), D ** -0.5),
        'b_ada': nrm(ks[4], (L, 6 * D), 0.02),
        'g_norm1': 1.0 + nrm(ks[5], (L, D), 0.02),
        'w_in': nrm(ks[6], (L, D, IN_COLS), D ** -0.5),
        'b_f': 3.0 + nrm(ks[7], (L, N_FOX_HEADS), 0.5),
        'g_q_fox': 1.0 + nrm(ks[8], (L, HEAD_DIM), 0.02),
        'g_k_fox': 1.0 + nrm(ks[9], (L, HEAD_DIM), 0.02),
        'g_q_diff': 1.0 + nrm(ks[10], (L, HEAD_DIM), 0.02),
        'g_k_diff': 1.0 + nrm(ks[11], (L, HEAD_DIM), 0.02),
        'lam_q1': nrm(ks[12], (L, HEAD_DIM), 0.1),
        'lam_k1': nrm(ks[13], (L, HEAD_DIM), 0.1),
        'lam_q2': nrm(ks[14], (L, HEAD_DIM), 0.1),
        'lam_k2': nrm(ks[15], (L, HEAD_DIM), 0.1),
        'g_subln': 1.0 + nrm(ks[16], (L, DIFF_V_DIM), 0.02),
        'w_proj_fox': nrm(ks[17], (L, FOX_WIDTH, D), FOX_WIDTH ** -0.5),
        'w_proj_diff': nrm(ks[18], (L, DIFF_WIDTH, D), DIFF_WIDTH ** -0.5),
        'w_out': nrm(ks[19], (L, D, D), D ** -0.5),
        'g_norm2': 1.0 + nrm(ks[20], (L, D), 0.02),
        'w_router_group': nrm(ks[21], (L, D, N_GROUPS), D ** -0.5),
        'b_router_group': nrm(ks[22], (L, N_GROUPS), 0.01),
        'w_router_expert': nrm(ks[23], (L, D, N_EXPERTS), D ** -0.5),
        'b_router_expert': nrm(ks[24], (L, N_EXPERTS), 0.01),
        'w1': nrm(ks[25], (L, N_EXPERTS, D, D_EXPERT), D ** -0.5),
        'w3': nrm(ks[26], (L, N_EXPERTS, D, D_EXPERT), D ** -0.5),
        'w2': nrm(ks[27], (L, N_EXPERTS, D_EXPERT, D), D_EXPERT ** -0.5),
    }


def reference(x, c, positions, w_ada, b_ada, g_norm1, w_in, b_f, g_q_fox, g_k_fox,
              g_q_diff, g_k_diff, lam_q1, lam_k1, lam_q2, lam_k2, g_subln,
              w_proj_fox, w_proj_diff, w_out, g_norm2, w_router_group, b_router_group,
              w_router_expert, b_router_expert, w1, w3, w2):
    b, s, d = x.shape
    inv_freq = ROPE_THETA ** (-jnp.arange(0, HEAD_DIM, 2, dtype=jnp.float32) / HEAD_DIM)
    ang = positions.astype(jnp.float32)[..., None] * inv_freq
    cos = jnp.cos(ang)[:, None, None]
    sin = jnp.sin(ang)[:, None, None]
    c_act = jax.nn.silu(c)

    for l in range(DEPTH):
        lam0 = lambda_init(l)
        mod = c_act @ w_ada[l] + b_ada[l]
        sh1, sc1, gt1, sh2, sc2, gt2 = [m[:, None, :] for m in jnp.split(mod, 6, axis=-1)]

        h = rms_norm(x, g_norm1[l]) * (1.0 + sc1) + sh1
        z = h @ w_in[l]

        q_f = rms_norm(split_heads(z[..., COL_FQ:COL_FK], N_FOX_HEADS, HEAD_DIM), g_q_fox[l])
        k_f = rms_norm(split_heads(z[..., COL_FK:COL_FV], N_FOX_HEADS, HEAD_DIM), g_k_fox[l])
        v_f = split_heads(z[..., COL_FV:COL_FF], N_FOX_HEADS, HEAD_DIM)
        log_f = jax.nn.log_sigmoid((z[..., COL_FF:COL_DQ] + b_f[l]).astype(jnp.float32)).transpose(0, 2, 1)
        o_f = forgetting_attention(q_f, k_f, v_f, log_f)
        o_f = o_f.transpose(0, 2, 1, 3).reshape(b, s, FOX_WIDTH)

        q_d = z[..., COL_DQ:COL_DK].reshape(b, s, N_DIFF_HEADS, 2, HEAD_DIM).transpose(0, 2, 3, 1, 4)
        k_d = z[..., COL_DK:COL_DV].reshape(b, s, N_DIFF_HEADS, 2, HEAD_DIM).transpose(0, 2, 3, 1, 4)
        q_d = rope(rms_norm(q_d, g_q_diff[l]), cos, sin)
        k_d = rope(rms_norm(k_d, g_k_diff[l]), cos, sin)
        v_d = split_heads(z[..., COL_DV:COL_GATE], N_DIFF_HEADS, DIFF_V_DIM)
        lam = (jnp.exp(jnp.sum(lam_q1[l].astype(jnp.float32) * lam_k1[l].astype(jnp.float32)))
               - jnp.exp(jnp.sum(lam_q2[l].astype(jnp.float32) * lam_k2[l].astype(jnp.float32)))
               + lam0)
        o_d = differential_attention(q_d, k_d, v_d, lam)
        o_d = rms_norm(o_d, g_subln[l]) * (1.0 - lam0)
        o_d = o_d.transpose(0, 2, 1, 3).reshape(b, s, DIFF_WIDTH)

        gates = jax.nn.sigmoid(z[..., COL_GATE:]).reshape(b, s, N_BRANCHES, d)
        merged = gates[:, :, 0] * (o_f @ w_proj_fox[l]) + gates[:, :, 1] * (o_d @ w_proj_diff[l])
        x = x + gt1 * (merged @ w_out[l])

        h2 = (rms_norm(x, g_norm2[l]) * (1.0 + sc2) + sh2).reshape(b * s, d)
        expert_ids, weights = hierarchical_route(h2, w_router_group[l], b_router_group[l],
                                                 w_router_expert[l], b_router_expert[l])
        y_moe = moe_forward(h2, expert_ids, weights, w1[l], w3[l], w2[l]).reshape(b, s, d)
        x = x + gt2 * y_moe
    return x
```

```cpp
#include <hip/hip_runtime.h>
#include <cstdio>
#include <cstdint>
#include <cmath>

#ifndef MK_N_LAUNCHES
#define MK_N_LAUNCHES 1
#endif

#define LAS __attribute__((address_space(3)))
#define GAS __attribute__((address_space(1)))
typedef unsigned short bf16_t;
typedef short bf16x8 __attribute__((ext_vector_type(8)));
typedef short s16x4 __attribute__((ext_vector_type(4)));
typedef float f32x4 __attribute__((ext_vector_type(4)));
typedef float f32x2 __attribute__((ext_vector_type(2)));
typedef float f32x16 __attribute__((ext_vector_type(16)));
typedef unsigned u32x4 __attribute__((ext_vector_type(4)));
typedef unsigned u32x2 __attribute__((ext_vector_type(2)));
typedef __bf16 bf16x2_t __attribute__((ext_vector_type(2)));

constexpr int NB = 16, SEQ = 4096, DMODEL = 1024, NTOK = NB * SEQ;
constexpr int IN_COLS = 5128, COL_FQ = 0, COL_FK = 512, COL_FV = 1024, COL_FF = 1536, COL_DQ = 1544, COL_DK = 2056, COL_DV = 2568, COL_GATE = 3080;
constexpr int NEXP = 32, DEXP = 512;
constexpr int NASSIGN = NTOK * 2;
constexpr int PADROWS = NASSIGN + NEXP * 256;
constexpr float EPS = 1e-6f;
constexpr float LOG2E = 1.4426950408889634f;
constexpr float C2 = 0.125f * LOG2E;
constexpr float LAM0 = 0.2f;

constexpr size_t MiB = 1u << 20;
constexpr size_t WS_CTL = 0, CTL_ZERO_BYTES = 1 * MiB;
constexpr size_t WS_MOD = 1 * MiB;
constexpr size_t WS_MISC = 1 * MiB + 512 * 1024;
constexpr size_t WS_GALL = 1 * MiB + 768 * 1024;
constexpr size_t WS_EID = 2 * MiB;
constexpr size_t WS_RNK = 2 * MiB + 512 * 1024;
constexpr size_t WS_WGT = 3 * MiB;
constexpr size_t WS_POS = 3 * MiB + 512 * 1024;
constexpr size_t WS_HIST = 4 * MiB;
constexpr size_t WS_LOGF = 5 * MiB;
constexpr size_t WS_BIAS = 7 * MiB;
constexpr size_t WS_WR = 10 * MiB;
constexpr size_t WS_LOGIT = 11 * MiB;
constexpr size_t WS_ROPE = 27 * MiB;
constexpr size_t WS_WIN = 43 * MiB;
constexpr size_t WS_WPF = 53 * MiB, WS_WPD = 54 * MiB, WS_WOUT = 55 * MiB;
constexpr size_t WS_W13 = 57 * MiB;
constexpr size_t WS_W2 = 121 * MiB;
constexpr size_t WS_H1 = 160 * MiB;
constexpr size_t WS_QF = 288 * MiB, WS_KF = 352 * MiB, WS_VF = 416 * MiB, WS_QD = 480 * MiB, WS_KD = 544 * MiB, WS_VD = 608 * MiB;
constexpr size_t WS_G = 672 * MiB;
constexpr size_t WS_OD = 928 * MiB;
constexpr size_t WS_MERGED = WS_KF;
constexpr size_t WS_H2S = WS_QD;
constexpr size_t WS_HH = 752 * MiB;
constexpr size_t WS_END = 1024 * MiB;
static_assert(WS_KF - WS_QF == 67108864 && WS_VD - WS_QF == 5 * 67108864, "six q/k/v buffers 64 MiB apart");
static_assert(WS_H2S + (size_t)PADROWS * 2048 <= WS_HH && WS_HH + (size_t)PADROWS * 1024 <= WS_OD, "ws map");

constexpr int CW_TMO = 0, CW_BAR = 4096;

constexpr int RING_BYTES = 131072, LDSCTL_OFF = RING_BYTES, MISC_OFF = LDSCTL_OFF + 320, SCHED_OFF = LDSCTL_OFF + 1024;
constexpr int LDS_BYTES = 147456;
constexpr int NWAVES = 8, NTHREADS = 512;

#define RLX_AGENT __ATOMIC_RELAXED, __HIP_MEMORY_SCOPE_AGENT
#define LDS_WAIT() asm volatile("s_waitcnt lgkmcnt(0)" ::: "memory")
#define VM_WAIT() asm volatile("s_waitcnt vmcnt(0)" ::: "memory")
__device__ __forceinline__ unsigned f2bf(float f) { unsigned u = __builtin_bit_cast(unsigned, f); return (u + 0x7fffu + ((u >> 16) & 1u)) >> 16; }
__device__ __forceinline__ unsigned pk2(float lo, float hi) { return f2bf(lo) | (f2bf(hi) << 16); }
__device__ __forceinline__ float bf2f(unsigned b) { return __builtin_bit_cast(float, b << 16); }
__device__ __forceinline__ unsigned cvtpk(float lo, float hi) { f32x2 v = {lo, hi}; bf16x2_t b = __builtin_convertvector(v, bf16x2_t); return __builtin_bit_cast(unsigned, b); }
__device__ __forceinline__ float wave_sum(float v) {
#pragma unroll
    for (int o = 1; o < 64; o <<= 1) v += __shfl_xor(v, o);
    return v;
}
__device__ __forceinline__ float wave_max(float v) {
#pragma unroll
    for (int o = 1; o < 64; o <<= 1) v = fmaxf(v, __shfl_xor(v, o));
    return v;
}
__device__ __forceinline__ float sigmoidf_(float x) { return 1.0f / (1.0f + __expf(-x)); }

namespace pg8 {
constexpr int BM = 256, BK = 64, HALF = 128, HTB = HALF * BK * 2, STAGE_BYTES = 8 * HTB, NXCD = 8, WGM = 8;
__host__ __device__ __forceinline__ int lds_byte(int r, int c) { const int st = (r >> 4) * 2 + (c >> 5), rr = r & 15, cc = c & 31, ob = rr * 64 + cc * 2; return st * 1024 + (ob ^ (((ob >> 9) & 1) << 5)); }
__host__ __device__ __forceinline__ void stage_rc(int b, int& R, int& C) { const int st = b / 1024, sb = b % 1024, swz = sb ^ (((sb >> 9) & 1) << 5); R = (st >> 1) * 16 + swz / 64; C = (st & 1) * 32 + (swz % 64) / 2; }
__host__ __device__ __forceinline__ int perm32(int rho) { const int n = rho >> 4, i = rho & 15; return 8 * (i >> 2) + 4 * n + (i & 3); }

struct Unit { int row0, pn, seg, src; const char* A; const char* B; };

struct USched {
    int nM, nN, G, c, pair, K, nseg;
    const char *A0, *A1, *B0, *B1;
    size_t segB;
    const LAS int* tp;
    const LAS int* rowst;
    __device__ __forceinline__ bool next(int i, Unit& u) const {
        const int ii = pair ? (i >> 1) : i, src = pair ? (i & 1) : 0;
        const long L = (long)ii * G + c; const int nwg = nM * nN; if (L >= nwg) return false;
        int wgid = (int)L; { const int q = nwg / NXCD, r = nwg % NXCD, xcd = wgid % NXCD, off = wgid / NXCD; wgid = (xcd < r ? xcd * (q + 1) : r * (q + 1) + (xcd - r) * q) + off; }
        const int nig = WGM * nN, gid = wgid / nig, fm = gid * WGM, gsz = (nM - fm) < WGM ? (nM - fm) : WGM;
        const int pm = fm + ((wgid % nig) % gsz), pn = (wgid % nig) / gsz;
        int s = 0, row0 = pm * BM;
        if (nseg > 1) { for (int j = 1; j < nseg; ++j) if (pm >= tp[j]) s = j; row0 = rowst[s] + (pm - tp[s]) * BM; }
        u.row0 = row0; u.pn = pn; u.seg = s; u.src = src;
        u.A = (src ? A1 : A0) + (size_t)row0 * K * 2;
        u.B = (src ? B1 : B0) + (size_t)s * segB + (size_t)pn * BM * K * 2;
        return true;
    }
};

template <class Epi, class Sched>
__device__ __forceinline__ void gemm_phase(LAS unsigned char* lds, const int K, const Sched S, const Epi E) {
    const int tid = threadIdx.x, wid = __builtin_amdgcn_readfirstlane(tid >> 6), lane = tid & 63, wr = wid >> 2, wc = wid & 3, fr = lane & 15, fq = lane >> 4;
    const int nt = K / BK;
    unsigned voffA[2], voffB[2];
#pragma unroll
    for (int i = 0; i < 2; ++i) { int R, C; stage_rc(tid * 16 + i * 8192, R, C); const int Rb = (R & ~31) + perm32(R & 31);
        voffA[i] = (unsigned)(R * K + C) * 2u; voffB[i] = (unsigned)(Rb * K + C) * 2u; }
    const size_t kstep = (size_t)(BK * 2);
    const size_t hstep = (size_t)HALF * K * 2;
    const unsigned ldsw = (unsigned)wid * 1024u;
    const int aoff = lds_byte(wr * 64 + fr, fq * 8), boff = lds_byte(wc * 32 + fr, fq * 8);
#define PG8_SA(b, h) (((b) * 2 + (h)) * HTB)
#define PG8_SB(b, h) ((4 + (b) * 2 + (h)) * HTB)
#define PG8_STAGE(bufoff, gbase, voff) do { _Pragma("unroll") for (int _i = 0; _i < 2; ++_i) \
        __builtin_amdgcn_global_load_lds((const unsigned*)((const char*)(gbase) + (voff)[_i]), (LAS unsigned*)(lds + (bufoff) + ldsw + _i * 8192), 16, 0, 0); } while (0)
#define PG8_LDA(dst, b, h) do { _Pragma("unroll") for (int m = 0; m < 4; ++m) _Pragma("unroll") for (int k = 0; k < 2; ++k) dst[m][k] = *(const LAS bf16x8*)(lds + PG8_SA(b, h) + aoff + m * 2048 + k * 1024); } while (0)
#define PG8_LDB(dst, b, h) do { _Pragma("unroll") for (int n = 0; n < 2; ++n) _Pragma("unroll") for (int k = 0; k < 2; ++k) dst[n][k] = *(const LAS bf16x8*)(lds + PG8_SB(b, h) + boff + n * 2048 + k * 1024); } while (0)
#define PG8_MMA(ai, bj, At, Bt) do { __builtin_amdgcn_s_setprio(1); _Pragma("unroll") for (int m = 0; m < 4; ++m) _Pragma("unroll") for (int n = 0; n < 2; ++n) _Pragma("unroll") for (int k = 0; k < 2; ++k) \
        acc[ai][bj][m][n] = __builtin_amdgcn_mfma_f32_16x16x32_bf16(Bt[n][k], At[m][k], acc[ai][bj][m][n], 0, 0, 0); __builtin_amdgcn_s_setprio(0); } while (0)
#define PG8_WAIT_V(n) asm volatile("s_waitcnt vmcnt(" #n ")" ::: "memory")
#define PG8_WAIT_L(n) asm volatile("s_waitcnt lgkmcnt(" #n ")" ::: "memory")
#define PG8_BAR __builtin_amdgcn_s_barrier()
#define PG8_SCHED __builtin_amdgcn_sched_barrier(0)
    Unit cur, nxt; int ui = 0;
    if (!S.next(0, cur)) return;
    f32x4 acc[2][2][4][2];
#pragma unroll
    for (int a = 0; a < 2; ++a)
#pragma unroll
        for (int b = 0; b < 2; ++b)
#pragma unroll
            for (int m = 0; m < 4; ++m)
#pragma unroll
                for (int n = 0; n < 2; ++n) acc[a][b][m][n] = (f32x4){0.f, 0.f, 0.f, 0.f};
    bf16x8 At[4][2], B0[2][2], B1[2][2];
    const char* cA = cur.A; const char* cB = cur.B;
    PG8_STAGE(PG8_SB(0, 0), cB, voffB); PG8_STAGE(PG8_SB(0, 1), cB + hstep, voffB); PG8_STAGE(PG8_SA(0, 0), cA, voffA); PG8_STAGE(PG8_SA(0, 1), cA + hstep, voffA);
    if (wr == 1) PG8_BAR;
    PG8_WAIT_V(2); PG8_BAR;
    PG8_STAGE(PG8_SB(1, 0), cB + kstep, voffB); PG8_STAGE(PG8_SA(1, 0), cA + kstep, voffA); PG8_STAGE(PG8_SB(1, 1), cB + hstep + kstep, voffB);
    PG8_WAIT_V(6); PG8_BAR;
    for (;;) {
        const bool has_next = S.next(ui + 1, nxt);
        const char* nA = has_next ? nxt.A : cA; const char* nB = has_next ? nxt.B : cB;
        for (int t = 0; t < nt; t += 2) {
            const bool last = (t == nt - 2);
            const char* a1 = cA + (size_t)(t + 1) * kstep;
            const char* a2 = last ? nA : cA + (size_t)(t + 2) * kstep; const char* b2 = last ? nB : cB + (size_t)(t + 2) * kstep;
            const char* a3 = a2 + kstep; const char* b3 = b2 + kstep;
            PG8_LDB(B0, 0, 0); PG8_LDB(B1, 0, 1); PG8_SCHED; PG8_LDA(At, 0, 0); PG8_STAGE(PG8_SA(1, 1), a1 + hstep, voffA);
            PG8_WAIT_V(8); PG8_WAIT_L(0); PG8_BAR; PG8_MMA(0, 0, At, B0); PG8_MMA(0, 1, At, B1); PG8_BAR; PG8_SCHED;
            PG8_LDA(At, 0, 1); PG8_STAGE(PG8_SB(0, 0), b2, voffB); PG8_STAGE(PG8_SB(0, 1), b2 + hstep, voffB); PG8_STAGE(PG8_SA(0, 0), a2, voffA);
            PG8_WAIT_V(8); PG8_WAIT_L(0); PG8_BAR; PG8_MMA(1, 0, At, B0); PG8_MMA(1, 1, At, B1); PG8_BAR; PG8_SCHED;
            PG8_LDB(B0, 1, 0); PG8_LDB(B1, 1, 1); PG8_SCHED; PG8_LDA(At, 1, 0); PG8_STAGE(PG8_SA(0, 1), a2 + hstep, voffA);
            PG8_WAIT_V(8); PG8_WAIT_L(0); PG8_BAR; PG8_MMA(0, 0, At, B0); PG8_MMA(0, 1, At, B1); PG8_BAR; PG8_SCHED;
            PG8_LDA(At, 1, 1); PG8_STAGE(PG8_SB(1, 0), b3, voffB); PG8_STAGE(PG8_SB(1, 1), b3 + hstep, voffB); PG8_STAGE(PG8_SA(1, 0), a3, voffA);
            PG8_WAIT_V(8); PG8_WAIT_L(0); PG8_BAR; PG8_MMA(1, 0, At, B0); PG8_MMA(1, 1, At, B1); PG8_BAR; PG8_SCHED;
        }
        if (wr == 0) PG8_BAR;
        E(acc, cur, wr, wc, fr, fq);
        if (!has_next) break;
#pragma unroll
        for (int a = 0; a < 2; ++a)
#pragma unroll
            for (int b = 0; b < 2; ++b)
#pragma unroll
                for (int m = 0; m < 4; ++m)
#pragma unroll
                    for (int n = 0; n < 2; ++n) acc[a][b][m][n] = (f32x4){0.f, 0.f, 0.f, 0.f};
        cur = nxt; cA = nA; cB = nB; ++ui;
        if (wr == 1) PG8_BAR;
    }
    PG8_WAIT_V(0);
    PG8_BAR;
#undef PG8_SA
#undef PG8_SB
#undef PG8_STAGE
#undef PG8_LDA
#undef PG8_LDB
#undef PG8_MMA
#undef PG8_WAIT_V
#undef PG8_WAIT_L
#undef PG8_BAR
#undef PG8_SCHED
}
}

struct UEpi {
    int mode;
    bf16_t *qkv6, *gates; const float *gall, *rope;
    bf16_t* merged;
    const float* x; float* x1; const float* mod;
    float* logits;
    bf16_t* hh; bf16_t* y;
    __device__ __forceinline__ void operator()(const f32x4 (&acc)[2][2][4][2], const pg8::Unit& u, int wr, int wc, int fr, int fq) const {
        const int rbase = u.row0 + wr * 64 + fr;
        if (mode == 1) {
            const int pn = u.pn;
            if (pn >= 12 || pn == 4 || pn == 5 || pn == 10 || pn == 11) {
                const bool gate = pn >= 12;
                bf16_t* base; int ldc, colt;
                if (gate) { base = gates; ldc = 2048; colt = (pn - 12) * 256; }
                else { base = qkv6 + (size_t)(pn >> 1) * 33554432; ldc = 512; colt = (pn & 1) * 256; }
                const int col0 = colt + wc * 32 + 8 * fq;
#pragma unroll
                for (int ai = 0; ai < 2; ++ai)
#pragma unroll
                    for (int m = 0; m < 4; ++m) { bf16_t* rowp = base + (size_t)(rbase + ai * 128 + m * 16) * ldc + col0;
#pragma unroll
                        for (int bj = 0; bj < 2; ++bj) { f32x4 v0 = acc[ai][bj][m][0], v1 = acc[ai][bj][m][1];
                            if (gate) {
#pragma unroll
                                for (int e = 0; e < 4; ++e) { v0[e] = sigmoidf_(v0[e]); v1[e] = sigmoidf_(v1[e]); } }
                            u32x4 w; w.x = cvtpk(v0[0], v0[1]); w.y = cvtpk(v0[2], v0[3]); w.z = cvtpk(v1[0], v1[1]); w.w = cvtpk(v1[2], v1[3]);
                            *(u32x4*)(rowp + bj * 128) = w; } }
            } else {
                const int sec = pn >> 1;
                bf16_t* base = qkv6 + (size_t)sec * 33554432;
                const float* g = gall + (sec - (sec >= 3 ? 1 : 0)) * 64;
                const bool dorope = sec >= 3; const float sc = (sec == 0 || sec == 3) ? C2 : 1.0f;
                const int head = 4 * (pn & 1) + wc;
                f32x4 gv[2][2];
#pragma unroll
                for (int bj = 0; bj < 2; ++bj)
#pragma unroll
                    for (int n = 0; n < 2; ++n) { gv[bj][n] = *(const f32x4*)(g + 32 * bj + 8 * fq + 4 * n); gv[bj][n] = gv[bj][n] * sc; }
#pragma unroll
                for (int ai = 0; ai < 2; ++ai)
#pragma unroll
                    for (int m = 0; m < 4; ++m) {
                        const int row = rbase + ai * 128 + m * 16;
                        f32x4 v[2][2]; float ss = 0.f;
#pragma unroll
                        for (int bj = 0; bj < 2; ++bj)
#pragma unroll
                            for (int n = 0; n < 2; ++n) { v[bj][n] = acc[ai][bj][m][n]; const f32x4 q = v[bj][n] * v[bj][n]; ss += (q[0] + q[1]) + (q[2] + q[3]); }
                        ss += __shfl_xor(ss, 16); ss += __shfl_xor(ss, 32);
                        const float rstd = 1.0f / sqrtf(ss * (1.0f / 64.0f) + EPS);
#pragma unroll
                        for (int bj = 0; bj < 2; ++bj)
#pragma unroll
                            for (int n = 0; n < 2; ++n) v[bj][n] = v[bj][n] * rstd * gv[bj][n];
                        if (dorope) {
                            const float* rp = rope + (size_t)row * 64 + 8 * fq;
#pragma unroll
                            for (int n = 0; n < 2; ++n) { const f32x4 cs = *(const f32x4*)(rp + 4 * n), sn = *(const f32x4*)(rp + 32 + 4 * n);
                                const f32x4 x1 = v[0][n], x2 = v[1][n]; v[0][n] = x1 * cs - x2 * sn; v[1][n] = x2 * cs + x1 * sn; }
                        }
                        bf16_t* rowp = base + (size_t)row * 512 + head * 64 + 8 * fq;
#pragma unroll
                        for (int bj = 0; bj < 2; ++bj) { u32x4 w; w.x = cvtpk(v[bj][0][0], v[bj][0][1]); w.y = cvtpk(v[bj][0][2], v[bj][0][3]); w.z = cvtpk(v[bj][1][0], v[bj][1][1]); w.w = cvtpk(v[bj][1][2], v[bj][1][3]);
                            *(u32x4*)(rowp + bj * 32) = w; }
                    }
            }
        } else if (mode == 2) {
            const int col0 = u.pn * 256 + wc * 32 + 8 * fq; const int src = u.src;
#pragma unroll
            for (int ai = 0; ai < 2; ++ai)
#pragma unroll
                for (int m = 0; m < 4; ++m) { const size_t row = (size_t)(rbase + ai * 128 + m * 16);
#pragma unroll
                    for (int bj = 0; bj < 2; ++bj) { const int col = col0 + bj * 128;
                        const u32x4 gw = *(const u32x4*)(gates + row * 2048 + src * 1024 + col);
                        f32x4 v0 = acc[ai][bj][m][0], v1 = acc[ai][bj][m][1];
                        v0[0] *= bf2f(gw.x & 0xffffu); v0[1] *= bf2f(gw.x >> 16); v0[2] *= bf2f(gw.y & 0xffffu); v0[3] *= bf2f(gw.y >> 16);
                        v1[0] *= bf2f(gw.z & 0xffffu); v1[1] *= bf2f(gw.z >> 16); v1[2] *= bf2f(gw.w & 0xffffu); v1[3] *= bf2f(gw.w >> 16);
                        bf16_t* dp = merged + row * 1024 + col;
                        if (src) { const u32x4 t = *(const u32x4*)dp;
                            v0[0] += bf2f(t.x & 0xffffu); v0[1] += bf2f(t.x >> 16); v0[2] += bf2f(t.y & 0xffffu); v0[3] += bf2f(t.y >> 16);
                            v1[0] += bf2f(t.z & 0xffffu); v1[1] += bf2f(t.z >> 16); v1[2] += bf2f(t.w & 0xffffu); v1[3] += bf2f(t.w >> 16); }
                        u32x4 w; w.x = cvtpk(v0[0], v0[1]); w.y = cvtpk(v0[2], v0[3]); w.z = cvtpk(v1[0], v1[1]); w.w = cvtpk(v1[2], v1[3]);
                        *(u32x4*)dp = w; } }
        } else if (mode == 3) {
            const int col0 = u.pn * 256 + wc * 32 + 8 * fq; const int b = u.row0 >> 12;
            const float* gt = mod + (size_t)b * 6144 + 2048;
#pragma unroll
            for (int bj = 0; bj < 2; ++bj) { const int col = col0 + bj * 128; const f32x4 g0 = *(const f32x4*)(gt + col), g1 = *(const f32x4*)(gt + col + 4);
#pragma unroll
                for (int ai = 0; ai < 2; ++ai)
#pragma unroll
                    for (int m = 0; m < 4; ++m) { const size_t off = (size_t)(rbase + ai * 128 + m * 16) * 1024 + col;
                        const f32x4 x0 = *(const f32x4*)(x + off), xb = *(const f32x4*)(x + off + 4);
                        *(f32x4*)(x1 + off) = x0 + g0 * acc[ai][bj][m][0]; *(f32x4*)(x1 + off + 4) = xb + g1 * acc[ai][bj][m][1]; } }
        } else if (mode == 4) {
            if (wc < 2) { const int col = wc * 32 + 8 * fq;
#pragma unroll
                for (int ai = 0; ai < 2; ++ai)
#pragma unroll
                    for (int m = 0; m < 4; ++m) { float* dp = logits + (size_t)(rbase + ai * 128 + m * 16) * 64 + col;
                        *(f32x4*)dp = acc[ai][0][m][0]; *(f32x4*)(dp + 4) = acc[ai][0][m][1]; } }
        } else if (mode == 5) {
            const int col0 = u.pn * 128 + wc * 32 + 8 * fq;
#pragma unroll
            for (int ai = 0; ai < 2; ++ai)
#pragma unroll
                for (int m = 0; m < 4; ++m) { f32x4 h0, h1;
#pragma unroll
                    for (int e = 0; e < 4; ++e) { const float a0 = acc[ai][0][m][0][e], a1 = acc[ai][0][m][1][e];
                        h0[e] = a0 * sigmoidf_(a0) * acc[ai][1][m][0][e]; h1[e] = a1 * sigmoidf_(a1) * acc[ai][1][m][1][e]; }
                    u32x4 w; w.x = cvtpk(h0[0], h0[1]); w.y = cvtpk(h0[2], h0[3]); w.z = cvtpk(h1[0], h1[1]); w.w = cvtpk(h1[2], h1[3]);
                    *(u32x4*)(hh + (size_t)(rbase + ai * 128 + m * 16) * 512 + col0) = w; }
        } else {
            const int col0 = u.pn * 256 + wc * 32 + 8 * fq;
#pragma unroll
            for (int ai = 0; ai < 2; ++ai)
#pragma unroll
                for (int m = 0; m < 4; ++m) { bf16_t* rowp = y + (size_t)(rbase + ai * 128 + m * 16) * 1024 + col0;
#pragma unroll
                    for (int bj = 0; bj < 2; ++bj) { const f32x4 v0 = acc[ai][bj][m][0], v1 = acc[ai][bj][m][1];
                        u32x4 w; w.x = cvtpk(v0[0], v0[1]); w.y = cvtpk(v0[2], v0[3]); w.z = cvtpk(v1[0], v1[1]); w.w = cvtpk(v1[2], v1[3]);
                        *(u32x4*)(rowp + bj * 128) = w; } }
        }
    }
};

namespace attn_body {
constexpr int D = 64, DM = 512;
constexpr int NW = 8, QBLK = 32, QB = QBLK * NW, KVBLK = 64;
__device__ __forceinline__ int crow(int r, int hi) { return (r & 3) + 8 * (r >> 2) + 4 * hi; }
#define SBAR() __builtin_amdgcn_sched_barrier(0)
__device__ __forceinline__ void cmask(f32x16& p0, f32x16& p1, int jb, int qrel, int hi) {
    const float NEG = -INFINITY; int kb = 64 * jb + 4 * hi;
#pragma unroll
    for (int r = 0; r < 16; ++r) { int kv = kb + (r & 3) + 8 * (r >> 2); if (kv > qrel) p0[r] = NEG; if (kv + 32 > qrel) p1[r] = NEG; }
}
__device__ __forceinline__ void maskall(f32x16& p0, f32x16& p1) {
    const float NEG = -INFINITY;
#pragma unroll
    for (int r = 0; r < 16; ++r) { p0[r] = NEG; p1[r] = NEG; }
}
constexpr int NSLOT = 3, SLOTB = 8192;
constexpr int LDS_K = 0, LDS_V = NSLOT * SLOTB, LDS_WS = 2 * NSLOT * SLOTB, LDS_OST = LDS_WS + NW * 64 * 4, LDS_BYTES_A = LDS_OST + NW * 4096;
__device__ __forceinline__ void glds16(const void* gsrc, unsigned lds_dst) { unsigned keep;
    asm volatile("s_mov_b32 %0, m0\n\ts_mov_b32 m0, %2\n\ts_nop 0\n\tglobal_load_lds_dwordx4 %1, off\n\ts_mov_b32 m0, %0" : "=&s"(keep) : "v"(gsrc), "s"(lds_dst) : "memory"); }
__device__ __forceinline__ float max3f(float a, float b, float c) { float r; asm("v_max3_f32 %0, %1, %2, %3" : "=v"(r) : "v"(a), "v"(b), "v"(c)); return r; }
__device__ __forceinline__ float max2f(float a, float b) { float r; asm("v_max_f32_e32 %0, %1, %2" : "=v"(r) : "v"(a), "v"(b)); return r; }
__device__ __forceinline__ float fadd_s(float a, float b) { float r; asm("v_add_f32_e32 %0, %1, %2" : "=v"(r) : "v"(a), "v"(b)); return r; }
__device__ __forceinline__ float fsub_s(float a, float b) { float r; asm("v_sub_f32_e32 %0, %1, %2" : "=v"(r) : "v"(a), "v"(b)); return r; }
#define WAIT_BAR(N) asm volatile("s_waitcnt vmcnt(" #N ") lgkmcnt(0)\n\ts_barrier" ::: "memory")
typedef LAS const char* lds_cptr;
typedef short v4i16_t __attribute__((ext_vector_type(4)));
__device__ __forceinline__ void qkt(f32x16& p0, f32x16& p1, const char* Kslot, const bf16x8* qr, const f32x16& negm, int r32, int hi) {
    const char* kb = Kslot + hi * 1024 + r32 * 16;
#pragma unroll
    for (int d0 = 0; d0 < 4; ++d0) {
        const bf16x8 b0 = *reinterpret_cast<const bf16x8*>(kb + d0 * 2048);
        const bf16x8 b1 = *reinterpret_cast<const bf16x8*>(kb + d0 * 2048 + 512);
        if (d0 == 0) { p0 = __builtin_amdgcn_mfma_f32_32x32x16_bf16(b0, qr[0], negm, 0, 0, 0); p1 = __builtin_amdgcn_mfma_f32_32x32x16_bf16(b1, qr[0], negm, 0, 0, 0); }
        else { p0 = __builtin_amdgcn_mfma_f32_32x32x16_bf16(b0, qr[d0], p0, 0, 0, 0); p1 = __builtin_amdgcn_mfma_f32_32x32x16_bf16(b1, qr[d0], p1, 0, 0, 0); } }
}
__device__ __forceinline__ void kload8(bf16x8* kf, lds_cptr kp) {
    kf[0] = *(const LAS bf16x8*)(kp);        kf[1] = *(const LAS bf16x8*)(kp + 512);
    kf[2] = *(const LAS bf16x8*)(kp + 2048); kf[3] = *(const LAS bf16x8*)(kp + 2560);
    kf[4] = *(const LAS bf16x8*)(kp + 4096); kf[5] = *(const LAS bf16x8*)(kp + 4608);
    kf[6] = *(const LAS bf16x8*)(kp + 6144); kf[7] = *(const LAS bf16x8*)(kp + 6656);
}
__device__ __forceinline__ void kload2(bf16x8* kf, lds_cptr kp, int j) { kf[2 * j] = *(const LAS bf16x8*)(kp + j * 2048); kf[2 * j + 1] = *(const LAS bf16x8*)(kp + j * 2048 + 512); }
__device__ __forceinline__ s16x4 vtr(lds_cptr p) { return __builtin_bit_cast(s16x4, __builtin_amdgcn_ds_read_tr16_b64_v4i16((LAS v4i16_t*)p)); }
__device__ __forceinline__ float rowmax(const f32x16& p0, const f32x16& p1) {
    float a = max3f(p0[0], p0[1], p1[0]), b = max3f(p0[2], p0[3], p1[1]); a = max3f(a, p1[2], p1[3]);
#pragma unroll
    for (int r = 4; r < 16; r += 4) { a = max3f(a, p0[r], p0[r + 1]); b = max3f(b, p0[r + 2], p0[r + 3]); a = max3f(a, p1[r], p1[r + 1]); b = max3f(b, p1[r + 2], p1[r + 3]); }
    const float m = max2f(a, b);
    auto rr = __builtin_amdgcn_permlane32_swap(__float_as_uint(m), __float_as_uint(m), false, false);
    return max2f(__uint_as_float(rr[0]), __uint_as_float(rr[1]));
}
__device__ __forceinline__ void pv(f32x16* o, int vb, bf16x8 pa0, bf16x8 pa1, bf16x8 pa2, bf16x8 pa3) {
#pragma unroll
    for (int d0 = 0; d0 < 2; ++d0) { s16x4 lo[4], hi[4];
#pragma unroll
        for (int ks = 0; ks < 4; ++ks) {
            asm volatile("ds_read_b64_tr_b16 %0,%1 offset:%c2" : "=&v"(lo[ks]) : "v"(vb), "i"(d0 * 4096 + ks * 1024) : "memory");
            asm volatile("ds_read_b64_tr_b16 %0,%1 offset:%c2" : "=&v"(hi[ks]) : "v"(vb), "i"(d0 * 4096 + ks * 1024 + 512) : "memory"); }
        asm volatile("s_waitcnt lgkmcnt(0)" ::: "memory"); SBAR();
#define PK(k) (bf16x8){lo[k][0], lo[k][1], lo[k][2], lo[k][3], hi[k][0], hi[k][1], hi[k][2], hi[k][3]}
        o[d0] = __builtin_amdgcn_mfma_f32_32x32x16_bf16(pa0, PK(0), o[d0], 0, 0, 0);
        o[d0] = __builtin_amdgcn_mfma_f32_32x32x16_bf16(pa1, PK(1), o[d0], 0, 0, 0);
        o[d0] = __builtin_amdgcn_mfma_f32_32x32x16_bf16(pa2, PK(2), o[d0], 0, 0, 0);
        o[d0] = __builtin_amdgcn_mfma_f32_32x32x16_bf16(pa3, PK(3), o[d0], 0, 0, 0);
#undef PK
    }
}
__device__ __forceinline__ bf16x8 bias_frag(float b) {
    const unsigned u0 = cvtpk(b, 0.f) & 0xffffu; const float r1 = b - bf2f(u0);
    const unsigned u1 = cvtpk(r1, 0.f) & 0xffffu; const float r2 = r1 - bf2f(u1);
    const unsigned u2 = cvtpk(r2, 0.f) & 0xffffu;
    u32x4 w; w.x = u0 | (u1 << 16); w.y = u2 | 0x3F800000u; w.z = 0x3F803F80u; w.w = 0u; return __builtin_bit_cast(bf16x8, w);
}
__device__ __forceinline__ bf16x8 qext_frag(float nm, int hi) {
    const unsigned u0 = cvtpk(nm, 0.f) & 0xffffu; const float r1 = nm - bf2f(u0);
    const unsigned u1 = cvtpk(r1, 0.f) & 0xffffu; const float r2 = r1 - bf2f(u1);
    const unsigned u2 = cvtpk(r2, 0.f) & 0xffffu;
    u32x4 w; w.x = hi ? 0u : 0x3F803F80u; w.y = hi ? 0u : (0x3F80u | (u0 << 16)); w.z = hi ? 0u : (u1 | (u2 << 16)); w.w = 0u; return __builtin_bit_cast(bf16x8, w);
}

template <bool FOX, int THRL> __device__ __forceinline__ void attn_unit(long rowbase, int qcol, int vcol, int ocol, int OP, int qb, const bf16_t* Q, const bf16_t* __restrict__ K, const bf16_t* __restrict__ V, bf16_t* O,
                                                                         const float* __restrict__ bias, float bound2, char* shm) {
    int tid_ = threadIdx.x; asm volatile("" : "+v"(tid_));
    const int tid = tid_, lane = tid & 63, r32 = lane & 31, hi = lane >> 5; const int wid = __builtin_amdgcn_readfirstlane(tid >> 6);
    const int q0 = qb * QB;
    int NT = (q0 + QB) / KVBLK; int t0 = 0;
    if (FOX) {
        const float bq = bias[q0]; const int j = lane; float bj = 0.f; if (j < NT - 4) bj = bias[64 * j + 63];
        const unsigned long long bal = __ballot((j < NT - 4) && (bj < bq - bound2));
        t0 = __builtin_popcountll(bal) & ~1; t0 = __builtin_amdgcn_readfirstlane(t0);
        NT -= t0;
    }
    const bf16_t* Qw = Q + (rowbase + q0 + wid * QBLK) * DM + qcol;
    const bf16_t* Kh = K + (rowbase + (long)t0 * KVBLK) * DM + qcol; const bf16_t* Vh = V + (rowbase + (long)t0 * KVBLK) * DM + vcol;
    const int bofs = t0 * KVBLK + r32;
    const unsigned lds0 = (unsigned)(uintptr_t)shm;
    float* wsf = (float*)(shm + LDS_WS) + wid * 64;
    const bf16_t* ksrc = Kh + (long)lane * DM + wid * 8;
    const bf16_t* vsrc = Vh + (long)(16 * (wid & 3) + (lane >> 2)) * DM + (wid >> 2) * 32 + (lane & 3) * 8;
    const unsigned kdst = lds0 + LDS_K + wid * 1024, vdst = lds0 + LDS_V + wid * 1024;
#define DMA_K(t, slot) glds16(ksrc + (long)(t) * KVBLK * DM, (unsigned)__builtin_amdgcn_readfirstlane(kdst + (slot)))
#define DMA_V(t, slot) glds16(vsrc + (long)(t) * KVBLK * DM, (unsigned)__builtin_amdgcn_readfirstlane(vdst + (slot)))
    const int vb0 = (int)(lds0 + LDS_V) + ((lane >> 4) & 1) * 32 + (lane & 3) * 8 + (4 * hi + ((lane & 15) >> 2)) * 64;
    const char* Kbase = shm + LDS_K; bf16x8 kf[8];
    const lds_cptr shm3 = (lds_cptr)shm; const lds_cptr kp0 = shm3 + LDS_K + hi * 1024 + r32 * 16; const lds_cptr vp0 = shm3 + LDS_V + ((lane >> 4) & 1) * 32 + (lane & 3) * 8 + (4 * hi + ((lane & 15) >> 2)) * 64;
    DMA_K(0, 0); DMA_V(0, 0); DMA_K(1, SLOTB);
    bf16x8 qr[4];
#pragma unroll
    for (int d0 = 0; d0 < 4; ++d0) qr[d0] = *reinterpret_cast<const bf16x8*>(&Qw[(long)r32 * DM + d0 * 16 + hi * 8]);
    bf16x8 qone = qext_frag(0.f, hi);
    float cb0 = 0.f, cb1 = 0.f; if (FOX) { cb0 = bias[bofs]; cb1 = bias[bofs + 32]; }
    float mhat = 0.f, l_reg = 0.f; f32x16 o[2]; o[0] = f32x16{}; o[1] = f32x16{}; f32x16 negm = f32x16{}; if (!FOX) asm volatile("" : "+v"(negm));
    const int qrel = wid * QBLK + r32;
#define CMASK(P0, P1, t) do { int jb_ = (t) - (NT - 4); if (jb_ >= 0) { if (FOX) cmask(P0, P1, jb_, qrel, hi); else if (jb_ > (wid >> 1)) maskall(P0, P1); } } while (0)
    bool resc = false;
#define START(P0, P1) do { const float rm = rowmax(P0, P1); resc = false; \
    { const float dl = rm; mhat = fadd_s(mhat, dl); \
      _Pragma("unroll") for (int r = 0; r < 16; ++r) { P0[r] = fsub_s(P0[r], dl); P1[r] = fsub_s(P1[r], dl); } \
      if (FOX) { qone = qext_frag(-mhat, hi); } else { _Pragma("unroll") for (int r = 0; r < 16; ++r) negm[r] = -mhat; asm volatile("" : "+v"(negm)); } } \
    _Pragma("unroll") for (int r = 0; r < 16; ++r) P0[r] = __builtin_amdgcn_exp2f(P0[r]); } while (0)
#define RESC() do { if (resc) { asm volatile("s_waitcnt lgkmcnt(0)" ::: "memory"); \
      _Pragma("unroll") for (int d_ = 0; d_ < 2; ++d_) _Pragma("unroll") for (int r = 0; r < 16; ++r) o[d_][r] *= wsf[crow(r, hi)]; } } while (0)
    f32x16 pA0, pA1, pB0, pB1;
    int sl_prev = 0, sl_cur = 0, sl_next = SLOTB;
#define ROT() do { sl_prev = sl_cur; sl_cur = sl_next; sl_next = (sl_next == (NSLOT - 1) * SLOTB) ? 0 : sl_next + SLOTB; } while (0)
    DMA_K(2, 2 * SLOTB);
    WAIT_BAR(3);
    qkt(pA0, pA1, Kbase, qr, negm, r32, hi);
    if (FOX) { pA0 = __builtin_amdgcn_mfma_f32_32x32x16_bf16(bias_frag(cb0), qone, pA0, 0, 0, 0); pA1 = __builtin_amdgcn_mfma_f32_32x32x16_bf16(bias_frag(cb1), qone, pA1, 0, 0, 0);
               cb0 = bias[bofs + 64]; cb1 = bias[bofs + 96]; }
    asm volatile("s_nop 15\n\ts_nop 7" : "+v"(pA0), "+v"(pA1)); CMASK(pA0, pA1, 0);
    START(pA0, pA1);
    _Pragma("unroll") for (int r = 0; r < 16; ++r) pA1[r] = __builtin_amdgcn_exp2f(pA1[r]);
    WAIT_BAR(0);
    DMA_K(3, 0); DMA_V(1, SLOTB);
    ROT();
    kload8(kf, kp0 + sl_cur);
    WAIT_BAR(2);
    s16x4 vlo[8], vhi[8]; u32x4 pw0, pw1, pw2, pw3;
#define PKW(P, B) cvtpk(P[B], P[B + 1])
#define PAF(k) __builtin_bit_cast(bf16x8, pw##k)
#define VFR(i) (bf16x8){vlo[i][0], vlo[i][1], vlo[i][2], vlo[i][3], vhi[i][0], vhi[i][1], vhi[i][2], vhi[i][3]}
#define PIN(x) asm volatile("" : "+v"(x))
#define MX3(a, b, c) __builtin_fmaxf(__builtin_fmaxf((a), (b)), (c))
#define GAPA(MF, A0, A1, A2, A3, W0, W1, PW) do { MF; sacc += A0; sacc += A1; sacc += A2; sacc += A3; PIN(sacc); W0; W1; PIN(PW); SBAR(); } while (0)
#define EX(v) __builtin_amdgcn_exp2f(v)
#define GAPB(MF, X, B) do { MF; X[B] = EX(X[B]); X[B + 1] = EX(X[B + 1]); X[B + 2] = EX(X[B + 2]); X[B + 3] = EX(X[B + 3]); PIN(X); SBAR(); } while (0)
#define VRD(i) do { vlo[i] = vtr(vp_ + (((i) >> 2) * 4096 + ((i) & 3) * 1024)); vhi[i] = vtr(vp_ + (((i) >> 2) * 4096 + ((i) & 3) * 1024 + 512)); } while (0)
#define KRD(G, j) do { if (G) { kload2(kf, kp0 + sl_next, j); SBAR(); } } while (0)
#define STEP(C0, C1, P0, P1, t, GK, GV, GL) do { SBAR(); \
    const lds_cptr vp_ = vp0 + sl_prev; \
    VRD(0); SBAR(); float sacc = (P0[0] + P0[1]); \
    GAPA(C0 = __builtin_amdgcn_mfma_f32_32x32x16_bf16(kf[0], qr[0], negm, 0, 0, 0), P0[2], P0[3], P0[4], P0[5],     pw0[0] = PKW(P0, 0), pw0[1] = PKW(P0, 2), pw0); \
    VRD(4); SBAR(); GAPA(C1 = __builtin_amdgcn_mfma_f32_32x32x16_bf16(kf[1], qr[0], negm, 0, 0, 0), P0[6], P0[7], P0[8], P0[9],     pw0[2] = PKW(P0, 4), pw0[3] = PKW(P0, 6), pw0); \
    VRD(1); SBAR(); GAPA(C0 = __builtin_amdgcn_mfma_f32_32x32x16_bf16(kf[2], qr[1], C0, 0, 0, 0),   P0[10], P0[11], P0[12], P0[13], pw1[0] = PKW(P0, 8), pw1[1] = PKW(P0, 10), pw1); \
    VRD(5); SBAR(); GAPA(C1 = __builtin_amdgcn_mfma_f32_32x32x16_bf16(kf[3], qr[1], C1, 0, 0, 0),   P0[14], P0[15], P1[0], P1[1],   pw1[2] = PKW(P0, 12), pw1[3] = PKW(P0, 14), pw1); \
    VRD(2); SBAR(); GAPA(C0 = __builtin_amdgcn_mfma_f32_32x32x16_bf16(kf[4], qr[2], C0, 0, 0, 0),   P1[2], P1[3], P1[4], P1[5],     pw2[0] = PKW(P1, 0), pw2[1] = PKW(P1, 2), pw2); \
    VRD(6); SBAR(); GAPA(C1 = __builtin_amdgcn_mfma_f32_32x32x16_bf16(kf[5], qr[2], C1, 0, 0, 0),   P1[6], P1[7], P1[8], P1[9],     pw2[2] = PKW(P1, 4), pw2[3] = PKW(P1, 6), pw2); \
    VRD(3); SBAR(); GAPA(C0 = __builtin_amdgcn_mfma_f32_32x32x16_bf16(kf[6], qr[3], C0, 0, 0, 0),   P1[10], P1[11], P1[12], P1[13], pw3[0] = PKW(P1, 8), pw3[1] = PKW(P1, 10), pw3); \
    VRD(7); SBAR(); GAPA(C1 = __builtin_amdgcn_mfma_f32_32x32x16_bf16(kf[7], qr[3], C1, 0, 0, 0),   P1[14], P1[15], 0.f, 0.f,       pw3[2] = PKW(P1, 12), pw3[3] = PKW(P1, 14), pw3); \
    if (FOX) { const bf16x8 kb0_ = bias_frag(cb0), kb1_ = bias_frag(cb1); \
               C0 = __builtin_amdgcn_mfma_f32_32x32x16_bf16(kb0_, qone, C0, 0, 0, 0); C1 = __builtin_amdgcn_mfma_f32_32x32x16_bf16(kb1_, qone, C1, 0, 0, 0); \
               const int tn_ = ((t) + 1 < NT) ? (t) + 1 : (t); cb0 = bias[bofs + tn_ * 64]; cb1 = bias[bofs + tn_ * 64 + 32]; SBAR(); } \
    l_reg += sacc; \
    if (GK) { DMA_K((t) + 3, sl_cur); } if (GV) { DMA_V((t) + 1, sl_next); } \
    CMASK(C0, C1, t); \
    { float a = MX3(C0[0], C0[1], C1[0]), b = MX3(C0[2], C0[3], C1[1]); a = MX3(a, C1[2], C1[3]); \
      _Pragma("unroll") for (int r = 4; r < 16; r += 4) { a = MX3(a, C0[r], C0[r + 1]); b = MX3(b, C0[r + 2], C0[r + 3]); a = MX3(a, C1[r], C1[r + 1]); b = MX3(b, C1[r + 2], C1[r + 3]); } \
      float rm = __builtin_fmaxf(a, b); { auto rr = __builtin_amdgcn_permlane32_swap(__float_as_uint(rm), __float_as_uint(rm), false, false); rm = __builtin_fmaxf(__uint_as_float(rr[0]), __uint_as_float(rr[1])); } \
      resc = false; \
      if (__builtin_expect(__any(rm > (float)THRL), 0)) { const float dl = __builtin_fmaxf(rm, 0.f); mhat += dl; \
        _Pragma("unroll") for (int r = 0; r < 16; ++r) { C0[r] -= dl; C1[r] -= dl; } \
        if (FOX) { qone = qext_frag(-mhat, hi); } else { _Pragma("unroll") for (int r = 0; r < 16; ++r) negm[r] = -mhat; asm volatile("" : "+v"(negm)); } \
        const float f = __builtin_amdgcn_exp2f(-dl); l_reg *= f; if (hi == 0) wsf[r32] = f; resc = true; } } \
    SBAR(); \
    GAPB(o[0] = __builtin_amdgcn_mfma_f32_32x32x16_bf16(PAF(0), VFR(0), o[0], 0, 0, 0), C0, 0); \
    GAPB(o[1] = __builtin_amdgcn_mfma_f32_32x32x16_bf16(PAF(0), VFR(4), o[1], 0, 0, 0), C0, 4); \
    KRD(GL, 0); GAPB(o[0] = __builtin_amdgcn_mfma_f32_32x32x16_bf16(PAF(1), VFR(1), o[0], 0, 0, 0), C0, 8); \
    KRD(GL, 1); GAPB(o[1] = __builtin_amdgcn_mfma_f32_32x32x16_bf16(PAF(1), VFR(5), o[1], 0, 0, 0), C0, 12); \
    KRD(GL, 2); GAPB(o[0] = __builtin_amdgcn_mfma_f32_32x32x16_bf16(PAF(2), VFR(2), o[0], 0, 0, 0), C1, 0); \
    KRD(GL, 3); GAPB(o[1] = __builtin_amdgcn_mfma_f32_32x32x16_bf16(PAF(2), VFR(6), o[1], 0, 0, 0), C1, 4); \
    GAPB(o[0] = __builtin_amdgcn_mfma_f32_32x32x16_bf16(PAF(3), VFR(3), o[0], 0, 0, 0), C1, 8); \
    GAPB(o[1] = __builtin_amdgcn_mfma_f32_32x32x16_bf16(PAF(3), VFR(7), o[1], 0, 0, 0), C1, 12); \
    } while (0)
    int t = 1;
#undef CMASK
#define CMASK(P0, P1, t) do { } while (0)
    for (; t + 5 < NT; t += 2) {
        STEP(pB0, pB1, pA0, pA1, t, true, true, true);     WAIT_BAR(2); RESC(); ROT();
        STEP(pA0, pA1, pB0, pB1, t + 1, true, true, true); WAIT_BAR(2); RESC(); ROT();
    }
#undef CMASK
#define CMASK(P0, P1, t) do { int jb_ = (t) - (NT - 4); if (jb_ >= 0) { if (FOX) cmask(P0, P1, jb_, qrel, hi); else if (jb_ > (wid >> 1)) maskall(P0, P1); } } while (0)
#define ENDW(tt) do { if ((tt) + 3 < NT) { WAIT_BAR(2); } else if ((tt) + 2 < NT) { WAIT_BAR(1); } else { WAIT_BAR(0); } } while (0)
    for (; t + 1 < NT; t += 2) {
        STEP(pB0, pB1, pA0, pA1, t, (t + 3 < NT), (t + 1 < NT), (t + 1 < NT));         ENDW(t);     RESC(); ROT();
        STEP(pA0, pA1, pB0, pB1, t + 1, (t + 4 < NT), (t + 2 < NT), (t + 2 < NT));     ENDW(t + 1); RESC(); ROT();
    }
    STEP(pB0, pB1, pA0, pA1, NT - 1, false, false, false); RESC();
    { float sacc = pB0[0] + pB0[1]; _Pragma("unroll") for (int r = 2; r < 16; ++r) sacc += pB0[r]; _Pragma("unroll") for (int r = 0; r < 16; ++r) sacc += pB1[r]; l_reg += sacc;
      pw0 = (u32x4){PKW(pB0, 0), PKW(pB0, 2), PKW(pB0, 4), PKW(pB0, 6)}; pw1 = (u32x4){PKW(pB0, 8), PKW(pB0, 10), PKW(pB0, 12), PKW(pB0, 14)}; pw2 = (u32x4){PKW(pB1, 0), PKW(pB1, 2), PKW(pB1, 4), PKW(pB1, 6)}; pw3 = (u32x4){PKW(pB1, 8), PKW(pB1, 10), PKW(pB1, 12), PKW(pB1, 14)};
      SBAR(); pv(o, vb0 + sl_cur, PAF(0), PAF(1), PAF(2), PAF(3)); }
#undef PKW
#undef PAF
#undef VFR
#undef PIN
#undef MX3
#undef GAPA
#undef GAPB
#undef EX
#undef VRD
#undef KRD
#undef STEP
#undef ENDW
    { auto rr = __builtin_amdgcn_permlane32_swap(__float_as_uint(l_reg), __float_as_uint(l_reg), false, false); l_reg = __uint_as_float(rr[0]) + __uint_as_float(rr[1]); }
    if (hi == 0) wsf[32 + r32] = l_reg; asm volatile("s_waitcnt lgkmcnt(0)" ::: "memory");
    float rli[16];
#pragma unroll
    for (int r = 0; r < 16; ++r) rli[r] = __builtin_amdgcn_rcpf(wsf[32 + crow(r, hi)]);
    bf16_t* Ow = O + (rowbase + q0 + wid * QBLK) * OP + ocol;
    { bf16_t* stg = (bf16_t*)(shm + LDS_OST) + wid * 2048;
#pragma unroll
      for (int r = 0; r < 16; ++r) { const int orow = crow(r, hi);
#pragma unroll
        for (int d0 = 0; d0 < 2; ++d0) stg[orow * 64 + d0 * 32 + r32] = (bf16_t)f2bf(o[d0][r] * rli[r]); }
      asm volatile("s_waitcnt lgkmcnt(0)" ::: "memory");
#pragma unroll
      for (int i = 0; i < 4; ++i) { const int row = i * 8 + (lane >> 3), ch = lane & 7; const u32x4 v = *(const u32x4*)(stg + row * 64 + ch * 8); *(u32x4*)(Ow + (long)row * OP + ch * 8) = v; } }
    asm volatile("s_waitcnt lgkmcnt(0)\n\ts_barrier" ::: "memory");
#undef DMA_K
#undef DMA_V
#undef CMASK
#undef START
#undef RESC
#undef ROT
}
#undef SBAR
#undef WAIT_BAR
}

typedef GAS unsigned gu32;
#define XB_TMO      128
#define XB_XCNT(j)  (256  + 64 * (j))
#define XB_XSUB(j)  (1280 + 64 * (j))
#define XB_XGEN(j)  (2304 + 64 * (j))
#define XB_TOP      3328
#define XB_TOPGEN   3392
#define XCD_BAR_WORDS 3456
#define XB_SPIN_CAP (1u << 19)
__device__ __forceinline__ unsigned xb_ld(unsigned* p)              { return __hip_atomic_load(p, __ATOMIC_RELAXED, __HIP_MEMORY_SCOPE_AGENT); }
__device__ __forceinline__ unsigned xb_add(unsigned* p, unsigned v) { return __hip_atomic_fetch_add(p, v, __ATOMIC_RELAXED, __HIP_MEMORY_SCOPE_AGENT); }
__device__ __forceinline__ unsigned xb_xcc_id() { return (unsigned)__builtin_amdgcn_s_getreg((3 << 11) | 20) & 0xFu; }
#define XB_SPIN(cond, bar) do { unsigned _sp = 0; while (cond) { __builtin_amdgcn_s_sleep(1); \
    if ((++_sp & 255u) == 0u) { if (xb_ld(&(bar)[XB_TMO])) break; if (_sp > XB_SPIN_CAP) { atomicAdd(&(bar)[XB_TMO], 1u); break; } } } } while (0)
struct XcdBarrier { unsigned* bar; unsigned x; volatile LAS unsigned* st; };
__device__ __forceinline__ XcdBarrier xcd_barrier_post(unsigned* bar, volatile LAS unsigned* st) {
    XcdBarrier b; b.bar = bar; b.x = xb_xcc_id(); b.st = st;
    if (threadIdx.x == 0) (void)xb_add(&bar[XB_XCNT(b.x)], 1u);
    return b;
}
__device__ __forceinline__ void xcd_barrier_complete(unsigned* bar, unsigned x, unsigned& nloc, unsigned& nx) {
    const unsigned G = gridDim.x * gridDim.y * gridDim.z;
    unsigned sum, cnt, mine, sp = 0u;
    for (;;) {
        sum = 0u; cnt = 0u; mine = 0u;
#pragma unroll
        for (unsigned j = 0; j < 16; ++j) { const unsigned c = xb_ld(&bar[XB_XCNT(j)]); sum += c; cnt += (c > 0u) ? 1u : 0u; mine = (j == x) ? c : mine; }
        if (sum == G) break;
        __builtin_amdgcn_s_sleep(1);
        if ((++sp & 255u) == 0u) { if (xb_ld(&bar[XB_TMO])) break; if (sp > XB_SPIN_CAP) { atomicAdd(&bar[XB_TMO], 1u); break; } }
    }
    nloc = mine > 0u ? mine : 1u; nx = cnt > 0u ? cnt : 1u;
}
__device__ __forceinline__ void xcd_barrier(const XcdBarrier& b) {
    asm volatile("s_waitcnt vmcnt(0)" ::: "memory");
    __syncthreads();
    if (threadIdx.x == 0) {
        unsigned* bar = b.bar;
        __builtin_amdgcn_s_waitcnt(0);
        unsigned nloc = b.st[0], nx = b.st[1];
        if (nloc == 0u) { xcd_barrier_complete(bar, b.x, nloc, nx); b.st[0] = nloc; b.st[1] = nx; }
        const unsigned old = xb_add(&bar[XB_XSUB(b.x)], 1u);
        const unsigned gen = old / nloc;
        if (old + 1u == (gen + 1u) * nloc) {
            __builtin_amdgcn_fence(__ATOMIC_RELEASE, "agent");
            asm volatile("s_waitcnt vmcnt(0)" ::: "memory");
            const unsigned og = xb_add(&bar[XB_TOP], 1u);
            const unsigned tg = og / nx;
            if (og + 1u == (tg + 1u) * nx) xb_add(&bar[XB_TOPGEN], 1u);
            else XB_SPIN(xb_ld(&bar[XB_TOPGEN]) == tg, bar);
            __builtin_amdgcn_fence(__ATOMIC_ACQUIRE, "agent");
            xb_add(&bar[XB_XGEN(b.x)], 1u);
            asm volatile("s_waitcnt vmcnt(0)" ::: "memory");
        } else {
            XB_SPIN(xb_ld(&bar[XB_XGEN(b.x)]) == gen, bar);
            __builtin_amdgcn_fence(__ATOMIC_ACQUIRE, "agent");
            asm volatile("s_waitcnt vmcnt(0)" ::: "memory");
        }
    }
    __syncthreads();
}

struct Args {
    const float* in[28]; float* out; unsigned char* ws; int ph_lo, ph_hi, li, pad;
};
enum { I_X = 0, I_C, I_POS, I_WADA, I_BADA, I_GN1, I_WIN, I_BF, I_GQF, I_GKF, I_GQD, I_GKD, I_LQ1, I_LK1, I_LQ2, I_LK2, I_GSUB, I_WPF, I_WPD, I_WOUT, I_GN2, I_WRG, I_BRG, I_WRE, I_BRE, I_W1, I_W3, I_W2 };

__device__ __forceinline__ void transpose_item(const float* W, size_t ldw, int col0, int k0, bf16_t* WT, int drow, int Kd, LAS float* scr, int lane) {
#pragma unroll 8
    for (int i = 0; i < 32; ++i) { const int kk = 2 * i + (lane >> 5); scr[kk * 33 + (lane & 31)] = W[(size_t)(k0 + kk) * ldw + col0 + (lane & 31)]; }
    LDS_WAIT(); asm volatile("" ::: "memory");
    const int c = lane & 7;
#pragma unroll
    for (int j = 0; j < 4; ++j) { const int n = (lane >> 3) + 8 * j; const LAS float* s = scr + (8 * c) * 33 + n;
        u32x4 o; o.x = pk2(s[0 * 33], s[1 * 33]); o.y = pk2(s[2 * 33], s[3 * 33]); o.z = pk2(s[4 * 33], s[5 * 33]); o.w = pk2(s[6 * 33], s[7 * 33]);
        *(u32x4*)(WT + (size_t)(drow + n) * Kd + k0 + 8 * c) = o; }
    LDS_WAIT(); asm volatile("" ::: "memory");
}

__global__ void __launch_bounds__(NTHREADS, 2) fwd_kernel(Args args) {
    extern __shared__ __attribute__((aligned(16))) unsigned char lds_raw[];
    LAS unsigned char* lds = (LAS unsigned char*)lds_raw;
    volatile LAS unsigned* MISC = (volatile LAS unsigned*)(lds + MISC_OFF);
    const int tid = threadIdx.x, lane = tid & 63, wave = __builtin_amdgcn_readfirstlane(tid >> 6);
    const int G = gridDim.x; const int bx = blockIdx.x; const int vcu = (G % 8 == 0) ? (bx % 8) * (G / 8) + bx / 8 : bx;
    unsigned char* ws = args.ws;
    gu32* ctl = (gu32*)(ws + WS_CTL);
    const int gw = vcu * NWAVES + wave, NGW = G * NWAVES;

    for (int u = tid; u < (LDS_BYTES - LDSCTL_OFF) / 4; u += NTHREADS) ((LAS unsigned*)(lds + LDSCTL_OFF))[u] = 0u;
    __syncthreads();
    XcdBarrier bar; bar.bar = (unsigned*)(ctl + CW_BAR); bar.x = 0; bar.st = nullptr;
    const bool one_launch = (args.ph_hi - args.ph_lo) > 1;
    if (one_launch) bar = xcd_barrier_post((unsigned*)(ctl + CW_BAR), MISC + 8);
    const int lo = args.ph_lo, hi = args.ph_hi;
#ifdef ONLYP
#define IN(k) ((k) == ONLYP && lo <= (k) && (k) < hi)
#else
#define IN(k) (lo <= (k) && (k) < hi)
#endif
#define SEAM(k) do { if (IN(k) && IN((k) + 1)) xcd_barrier(bar); } while (0)

    float* mod = (float*)(ws + WS_MOD);
    float* logf = (float*)(ws + WS_LOGF);
    float* biasb = (float*)(ws + WS_BIAS);
    float* rope = (float*)(ws + WS_ROPE);
    bf16_t* Win_t = (bf16_t*)(ws + WS_WIN); bf16_t* Wpf_t = (bf16_t*)(ws + WS_WPF); bf16_t* Wpd_t = (bf16_t*)(ws + WS_WPD); bf16_t* Wout_t = (bf16_t*)(ws + WS_WOUT);
    bf16_t* W13_t = (bf16_t*)(ws + WS_W13); bf16_t* W2_t = (bf16_t*)(ws + WS_W2); bf16_t* Wr_t = (bf16_t*)(ws + WS_WR);
    bf16_t* H1 = (bf16_t*)(ws + WS_H1); bf16_t* OV = H1; bf16_t* H2 = H1;
    bf16_t* QF = (bf16_t*)(ws + WS_QF); bf16_t* KF = (bf16_t*)(ws + WS_KF); bf16_t* VF = (bf16_t*)(ws + WS_VF);
    bf16_t* QD = (bf16_t*)(ws + WS_QD); bf16_t* KD = (bf16_t*)(ws + WS_KD); bf16_t* VD = (bf16_t*)(ws + WS_VD);
    bf16_t* GT = (bf16_t*)(ws + WS_G); bf16_t* OD = (bf16_t*)(ws + WS_OD); bf16_t* MERGED = (bf16_t*)(ws + WS_MERGED);
    bf16_t* H2S = (bf16_t*)(ws + WS_H2S); bf16_t* YB = H2S; bf16_t* HH = (bf16_t*)(ws + WS_HH);
    float* LOGIT = (float*)(ws + WS_LOGIT);
    int* EID = (int*)(ws + WS_EID); int* RNK = (int*)(ws + WS_RNK); float* WGT = (float*)(ws + WS_WGT); int* POS = (int*)(ws + WS_POS);
    int* HIST = (int*)(ws + WS_HIST); int* MISCG = (int*)(ws + WS_MISC); float* gall = (float*)(ws + WS_GALL);
    const float* x = args.in[I_X];

    if (IN(0)) {
        if (vcu < 96) {
            LAS float* sl = (LAS float*)lds;
            LAS float* red = (LAS float*)(lds + 65536);
            const float* c = args.in[I_C];
            for (int i = tid; i < 16 * 1024; i += NTHREADS) { const int b = i >> 10, k = i & 1023; const float v = c[i]; sl[k * 16 + b] = v / (1.0f + __expf(-v)); }
            __syncthreads();
            const float* wa = args.in[I_WADA] + vcu * 64 + lane;
            float a[16];
#pragma unroll
            for (int b = 0; b < 16; ++b) a[b] = 0.f;
            for (int k = wave * 128; k < wave * 128 + 128; k += 4) {
                float w[4];
#pragma unroll
                for (int q = 0; q < 4; ++q) w[q] = wa[(size_t)(k + q) * 6144];
#pragma unroll
                for (int q = 0; q < 4; ++q) {
                    const LAS f32x4* sp = (const LAS f32x4*)(sl + (k + q) * 16);
#pragma unroll
                    for (int b4 = 0; b4 < 4; ++b4) { const f32x4 s = sp[b4]; a[4 * b4 + 0] += s[0] * w[q]; a[4 * b4 + 1] += s[1] * w[q]; a[4 * b4 + 2] += s[2] * w[q]; a[4 * b4 + 3] += s[3] * w[q]; }
                }
            }
#pragma unroll
            for (int b = 0; b < 16; ++b) red[(wave * 16 + b) * 64 + lane] = a[b];
            __syncthreads();
            for (int i = tid; i < 1024; i += NTHREADS) { const int b = i >> 6, cc = i & 63; float s = 0.f;
#pragma unroll
                for (int w = 0; w < 8; ++w) s += red[(w * 16 + b) * 64 + cc];
                mod[b * 6144 + vcu * 64 + cc] = s + args.in[I_BADA][vcu * 64 + cc]; }
            __syncthreads();
        }
        if (vcu == 100 && tid < 256) gall[tid] = args.in[I_GQF + (tid >> 6)][tid & 63];
        { const int* pos = (const int*)args.in[I_POS];
          for (int i = gw * 64 + lane; i < NTOK * 32; i += NGW * 64) { const int tk = i >> 5, fi = i & 31;
              const float invf = exp2f(-(float)fi * 0.41524101186092029f);
              const float ang = (float)pos[tk] * invf;
              const double rev = (double)ang * 0.15915494309189535; const float fr_ = (float)(rev - floor(rev));
              rope[(size_t)tk * 64 + fi] = __builtin_amdgcn_cosf(fr_); rope[(size_t)tk * 64 + 32 + fi] = __builtin_amdgcn_sinf(fr_); } }
        for (int i = gw * 64 + lane; i < 256 * 1024; i += NGW * 64) { const int r = i >> 10, k = i & 1023; float v = 0.f;
            if (r < 4) v = args.in[I_WRG][k * 4 + r]; else if (r < 36) v = args.in[I_WRE][k * 32 + (r - 4)];
            Wr_t[i] = (bf16_t)f2bf(v); }
        { LAS float* scr = (LAS float*)(lds + wave * 16384);
          constexpr int I_IN = 160 * 16, I_PF = 32 * 8, I_PD = 32 * 8, I_OUT = 32 * 16, I_13 = 32 * 2 * 16 * 16, I_2 = 32 * 32 * 8;
          constexpr int NITEMS = I_IN + I_PF + I_PD + I_OUT + I_13 + I_2;
          for (int it = gw; it < NITEMS; it += NGW) {
              int r = it;
              if (r < I_IN) { const int nb = r % 160, kb = r / 160; const int pn = nb >> 3, c0 = (nb & 7) * 32, bj = c0 >> 7, wc = (c0 & 127) >> 5; int col0;
                  if (pn >= 12) col0 = COL_GATE + (pn - 12) * 256 + c0;
                  else { const int sec = pn >> 1, pl = pn & 1; const int sb = sec == 0 ? COL_FQ : sec == 1 ? COL_FK : sec == 2 ? COL_FV : sec == 3 ? COL_DQ : sec == 4 ? COL_DK : COL_DV;
                      if (sec == 2 || sec == 5) col0 = sb + pl * 256 + c0; else col0 = sb + (4 * pl + wc) * 64 + 32 * bj; }
                  transpose_item(args.in[I_WIN], IN_COLS, col0, kb * 64, Win_t, nb * 32, 1024, scr, lane); continue; } r -= I_IN;
              if (r < I_PF) { const int nb = r % 32, kb = r / 32; transpose_item(args.in[I_WPF], 1024, nb * 32, kb * 64, Wpf_t, nb * 32, 512, scr, lane); continue; } r -= I_PF;
              if (r < I_PD) { const int nb = r % 32, kb = r / 32; transpose_item(args.in[I_WPD], 1024, nb * 32, kb * 64, Wpd_t, nb * 32, 512, scr, lane); continue; } r -= I_PD;
              if (r < I_OUT) { const int nb = r % 32, kb = r / 32; transpose_item(args.in[I_WOUT], 1024, nb * 32, kb * 64, Wout_t, nb * 32, 1024, scr, lane); continue; } r -= I_OUT;
              if (r < I_13) { const int nb = r % 16, kb = (r / 16) % 16, sr = (r / 256) % 2, e = r / 512; const int n0 = nb * 32, ct = n0 >> 7;
                  transpose_item(args.in[sr ? I_W3 : I_W1] + (size_t)e * 1024 * 512, 512, n0, kb * 64, W13_t, e * 1024 + ct * 256 + 128 * sr + (n0 - ct * 128), 1024, scr, lane); continue; } r -= I_13;
              { const int nb = r % 32, kb = (r / 32) % 8, e = r / 256;
                  transpose_item(args.in[I_W2] + (size_t)e * 512 * 1024, 1024, nb * 32, kb * 64, W2_t, e * 1024 + nb * 32, 512, scr, lane); }
          } }
    }
    SEAM(0);

    if (IN(1)) {
        LAS float* wff = (LAS float*)lds;
        for (int i = tid; i < 8 * 1024; i += NTHREADS) { const int k = i >> 3, q = i & 7; wff[q * 1024 + k] = args.in[I_WIN][(size_t)k * IN_COLS + COL_FF + q]; }
        __syncthreads();
        const int b = gw >> 7;
        const float* mb = mod + (size_t)b * 6144;
        f32x4 gm[4], sh[4];
#pragma unroll
        for (int j = 0; j < 4; ++j) { const int k = 256 * j + 4 * lane; const f32x4 g = *(const f32x4*)(args.in[I_GN1] + k), sc = *(const f32x4*)(mb + 1024 + k); sh[j] = *(const f32x4*)(mb + k); gm[j] = g * (1.0f + sc); }
        const float bfv = (lane < 8) ? args.in[I_BF][lane] : 0.f;
        for (int r = 0; r < 32; ++r) {
            const int row = gw * 32 + r;
            const f32x4* xr = (const f32x4*)(x + (size_t)row * 1024) + lane;
            f32x4 v[4]; float ss = 0.f;
#pragma unroll
            for (int j = 0; j < 4; ++j) { v[j] = xr[64 * j]; ss += (v[j][0] * v[j][0] + v[j][1] * v[j][1]) + (v[j][2] * v[j][2] + v[j][3] * v[j][3]); }
            const float rstd = 1.0f / sqrtf(wave_sum(ss) * (1.0f / 1024.0f) + EPS);
            unsigned long long* o8 = (unsigned long long*)(H1 + (size_t)row * 1024) + lane;
            float zf[8];
#pragma unroll
            for (int q = 0; q < 8; ++q) zf[q] = 0.f;
#pragma unroll
            for (int j = 0; j < 4; ++j) { v[j] = v[j] * rstd * gm[j] + sh[j];
                o8[64 * j] = (unsigned long long)cvtpk(v[j][0], v[j][1]) | ((unsigned long long)cvtpk(v[j][2], v[j][3]) << 32);
#pragma unroll
                for (int q = 0; q < 8; ++q) { const f32x4 w = *(const LAS f32x4*)(wff + q * 1024 + 256 * j + 4 * lane); zf[q] += (v[j][0] * w[0] + v[j][1] * w[1]) + (v[j][2] * w[2] + v[j][3] * w[3]); } }
            float mine = 0.f;
#pragma unroll
            for (int q = 0; q < 8; ++q) { const float s = wave_sum(zf[q]); if (lane == q) mine = s; }
            if (lane < 8) { const float z = mine + bfv; const float lf = fminf(z, 0.f) - log1pf(__expf(-fabsf(z)));
                logf[(size_t)(b * 8 + lane) * SEQ + (row & (SEQ - 1))] = lf; }
        }
    }
    SEAM(1);

    if (IN(2)) {
        if (vcu < 128 && wave == 0) {
            const float* lp = logf + (size_t)vcu * SEQ + 64 * lane; float v[64]; float run = 0.f;
#pragma unroll
            for (int i = 0; i < 16; ++i) { const f32x4 q = *(const f32x4*)(lp + 4 * i); v[4 * i] = q[0]; v[4 * i + 1] = q[1]; v[4 * i + 2] = q[2]; v[4 * i + 3] = q[3]; }
#pragma unroll
            for (int i = 0; i < 64; ++i) { run += v[i]; v[i] = run; }
            float incl = run;
#pragma unroll
            for (int o = 1; o < 64; o <<= 1) { const float t = __shfl_up(incl, o); if (lane >= o) incl += t; }
            const float excl = incl - run;
            float* bp = biasb + (size_t)vcu * SEQ + 64 * lane;
#pragma unroll
            for (int i = 0; i < 16; ++i) { f32x4 q; q[0] = -(excl + v[4 * i]) * LOG2E; q[1] = -(excl + v[4 * i + 1]) * LOG2E; q[2] = -(excl + v[4 * i + 2]) * LOG2E; q[3] = -(excl + v[4 * i + 3]) * LOG2E; *(f32x4*)(bp + 4 * i) = q; }
        }
        pg8::USched S{}; S.nM = NTOK / 256; S.nN = 20; S.G = G; S.c = bx; S.pair = 0; S.K = 1024; S.nseg = 1; S.A0 = (const char*)H1; S.A1 = S.A0; S.B0 = (const char*)Win_t; S.B1 = S.B0; S.segB = 0; S.tp = nullptr; S.rowst = nullptr;
        UEpi E{}; E.mode = 1; E.qkv6 = QF; E.gates = GT; E.gall = gall; E.rope = rope;
        pg8::gemm_phase<UEpi, pg8::USched>(lds, 1024, S, E);
    }
    SEAM(2);

    if (IN(3)) {
        float bound2;
        { const float gq = fabsf(args.in[I_GQF][lane]), gk = fabsf(args.in[I_GKF][lane]); const float smax = 8.0f * wave_max(gq) * wave_max(gk); bound2 = (2.0f * smax + 28.0f) * LOG2E; }
        const int grp = vcu >> 3, s8 = vcu & 7;
        for (int i = 0; i < 24; ++i) {
            const int stream = (i >> 1) * 32 + grp; const int qb = (i & 1) ? 15 - s8 : s8;
            if (G != 256) break;
#ifndef NO_FOX
            if (stream < 128) { const int b = stream >> 3, h = stream & 7;
                attn_body::attn_unit<true, 8>((long)b * SEQ, h * 64, h * 64, h * 64, 512, qb, QF, KF, VF, QF, biasb + (size_t)stream * SEQ, bound2, (char*)lds_raw);
            }
#endif
#ifndef NO_DIFF
            if (stream >= 128) { const int s2 = stream - 128; const int b = s2 >> 4, vh = s2 & 15; const int hd = vh >> 2, m = (vh >> 1) & 1, half = vh & 1;
                attn_body::attn_unit<false, 8>((long)b * SEQ, (hd * 2 + m) * 64, hd * 128 + half * 64, ((hd * 2 + m) * 2 + half) * 64, 1024, qb, QD, KD, VD, OV, biasb, 0.f, (char*)lds_raw);
            }
#endif
        }
    }
    SEAM(3);

    if (IN(4)) {
        float lam;
        { const float a = wave_sum(args.in[I_LQ1][lane] * args.in[I_LK1][lane]), c = wave_sum(args.in[I_LQ2][lane] * args.in[I_LK2][lane]); lam = __expf(a) - __expf(c) + LAM0; }
        const int hd = lane >> 4, d0 = (lane & 15) * 8;
        const f32x4 g0 = *(const f32x4*)(args.in[I_GSUB] + d0), g1 = *(const f32x4*)(args.in[I_GSUB] + d0 + 4);
        for (int row = gw; row < NTOK; row += NGW) {
            const bf16_t* op = OV + (size_t)row * 1024 + hd * 256 + d0;
            const u32x4 a = *(const u32x4*)op, c = *(const u32x4*)(op + 128);
            float d[8];
            d[0] = bf2f(a.x & 0xffffu) - lam * bf2f(c.x & 0xffffu); d[1] = bf2f(a.x >> 16) - lam * bf2f(c.x >> 16);
            d[2] = bf2f(a.y & 0xffffu) - lam * bf2f(c.y & 0xffffu); d[3] = bf2f(a.y >> 16) - lam * bf2f(c.y >> 16);
            d[4] = bf2f(a.z & 0xffffu) - lam * bf2f(c.z & 0xffffu); d[5] = bf2f(a.z >> 16) - lam * bf2f(c.z >> 16);
            d[6] = bf2f(a.w & 0xffffu) - lam * bf2f(c.w & 0xffffu); d[7] = bf2f(a.w >> 16) - lam * bf2f(c.w >> 16);
            float ss = 0.f;
#pragma unroll
            for (int e = 0; e < 8; ++e) ss += d[e] * d[e];
            ss += __shfl_xor(ss, 1); ss += __shfl_xor(ss, 2); ss += __shfl_xor(ss, 4); ss += __shfl_xor(ss, 8);
            const float rs = (1.0f - LAM0) / sqrtf(ss * (1.0f / 128.0f) + EPS);
            u32x4 w; w.x = cvtpk(d[0] * rs * g0[0], d[1] * rs * g0[1]); w.y = cvtpk(d[2] * rs * g0[2], d[3] * rs * g0[3]); w.z = cvtpk(d[4] * rs * g1[0], d[5] * rs * g1[1]); w.w = cvtpk(d[6] * rs * g1[2], d[7] * rs * g1[3]);
            *(u32x4*)(OD + (size_t)row * 512 + hd * 128 + d0) = w;
        }
    }
    SEAM(4);

    if (IN(5)) {
        pg8::USched S{}; S.nM = NTOK / 256; S.nN = 4; S.G = G; S.c = bx; S.pair = 1; S.K = 512; S.nseg = 1; S.A0 = (const char*)QF; S.A1 = (const char*)OD; S.B0 = (const char*)Wpf_t; S.B1 = (const char*)Wpd_t; S.segB = 0; S.tp = nullptr; S.rowst = nullptr;
        UEpi E{}; E.mode = 2; E.gates = GT; E.merged = MERGED;
        pg8::gemm_phase<UEpi, pg8::USched>(lds, 512, S, E);
    }
    SEAM(5);

    if (IN(6)) {
        pg8::USched S{}; S.nM = NTOK / 256; S.nN = 4; S.G = G; S.c = bx; S.pair = 0; S.K = 1024; S.nseg = 1; S.A0 = (const char*)MERGED; S.A1 = S.A0; S.B0 = (const char*)Wout_t; S.B1 = S.B0; S.segB = 0; S.tp = nullptr; S.rowst = nullptr;
        UEpi E{}; E.mode = 3; E.x = x; E.x1 = args.out; E.mod = mod;
        pg8::gemm_phase<UEpi, pg8::USched>(lds, 1024, S, E);
    }
    SEAM(6);

    if (IN(7)) {
        const int b = gw >> 7;
        const float* mb = mod + (size_t)b * 6144;
        f32x4 gm[4], sh[4];
#pragma unroll
        for (int j = 0; j < 4; ++j) { const int k = 256 * j + 4 * lane; const f32x4 g = *(const f32x4*)(args.in[I_GN2] + k), sc = *(const f32x4*)(mb + 4096 + k); sh[j] = *(const f32x4*)(mb + 3072 + k); gm[j] = g * (1.0f + sc); }
        for (int r = 0; r < 32; ++r) {
            const int row = gw * 32 + r;
            const f32x4* xr = (const f32x4*)(args.out + (size_t)row * 1024) + lane;
            f32x4 v[4]; float ss = 0.f;
#pragma unroll
            for (int j = 0; j < 4; ++j) { v[j] = xr[64 * j]; ss += (v[j][0] * v[j][0] + v[j][1] * v[j][1]) + (v[j][2] * v[j][2] + v[j][3] * v[j][3]); }
            const float rstd = 1.0f / sqrtf(wave_sum(ss) * (1.0f / 1024.0f) + EPS);
            unsigned long long* o8 = (unsigned long long*)(H2 + (size_t)row * 1024) + lane;
#pragma unroll
            for (int j = 0; j < 4; ++j) { v[j] = v[j] * rstd * gm[j] + sh[j];
                o8[64 * j] = (unsigned long long)cvtpk(v[j][0], v[j][1]) | ((unsigned long long)cvtpk(v[j][2], v[j][3]) << 32); }
        }
    }
    SEAM(7);

    if (IN(8)) {
        pg8::USched S{}; S.nM = NTOK / 256; S.nN = 1; S.G = G; S.c = bx; S.pair = 0; S.K = 1024; S.nseg = 1; S.A0 = (const char*)H2; S.A1 = S.A0; S.B0 = (const char*)Wr_t; S.B1 = S.B0; S.segB = 0; S.tp = nullptr; S.rowst = nullptr;
        UEpi E{}; E.mode = 4; E.logits = LOGIT;
        pg8::gemm_phase<UEpi, pg8::USched>(lds, 1024, S, E);
    }
    SEAM(8);

    if (IN(9)) {
        LAS unsigned* cnt = (LAS unsigned*)lds;
        if (tid < 32) cnt[tid] = 0u;
        __syncthreads();
        if (tid < 256) {
            const int tk = vcu * 256 + tid; const float* lp = LOGIT + (size_t)tk * 64;
            const f32x4 g = *(const f32x4*)lp;
            float gl[4]; gl[0] = g[0] + args.in[I_BRG][0]; gl[1] = g[1] + args.in[I_BRG][1]; gl[2] = g[2] + args.in[I_BRG][2]; gl[3] = g[3] + args.in[I_BRG][3];
            int gi = 0; float gmx = gl[0];
#pragma unroll
            for (int j = 1; j < 4; ++j) if (gl[j] > gmx) { gmx = gl[j]; gi = j; }
            float gs = 0.f;
#pragma unroll
            for (int j = 0; j < 4; ++j) gs += __expf(gl[j] - gmx);
            const float gwt = 1.0f / gs;
            const f32x4 e0 = *(const f32x4*)(lp + 4 + 8 * gi), e1 = *(const f32x4*)(lp + 8 + 8 * gi);
            const f32x4 b0 = *(const f32x4*)(args.in[I_BRE] + 8 * gi), b1 = *(const f32x4*)(args.in[I_BRE] + 8 * gi + 4);
            float el[8]; el[0] = e0[0] + b0[0]; el[1] = e0[1] + b0[1]; el[2] = e0[2] + b0[2]; el[3] = e0[3] + b0[3]; el[4] = e1[0] + b1[0]; el[5] = e1[1] + b1[1]; el[6] = e1[2] + b1[2]; el[7] = e1[3] + b1[3];
            int i1 = 0; float m1 = el[0];
#pragma unroll
            for (int j = 1; j < 8; ++j) if (el[j] > m1) { m1 = el[j]; i1 = j; }
            int i2 = -1; float m2 = -INFINITY;
#pragma unroll
            for (int j = 0; j < 8; ++j) if (j != i1 && el[j] > m2) { m2 = el[j]; i2 = j; }
            const float w1 = 1.0f / (1.0f + __expf(m2 - m1)); const float w2 = 1.0f - w1;
            const int ea = gi * 8 + i1, eb = gi * 8 + i2;
            const unsigned ra = atomicAdd((unsigned*)(lds_raw) + ea, 1u); const unsigned rb = atomicAdd((unsigned*)(lds_raw) + eb, 1u);
            EID[tk * 2] = ea; EID[tk * 2 + 1] = eb; RNK[tk * 2] = (int)ra; RNK[tk * 2 + 1] = (int)rb; WGT[tk * 2] = gwt * w1; WGT[tk * 2 + 1] = gwt * w2;
        }
        __syncthreads();
        if (tid < 32) HIST[vcu * 32 + tid] = (int)cnt[tid];
        __syncthreads();
    }
    SEAM(9);

    if (IN(10)) {
        LAS int* tb = (LAS int*)lds;
        if (tid < 32) { int base = 0, tot = 0; for (int b2 = 0; b2 < G; ++b2) { const int h = HIST[b2 * 32 + tid]; if (b2 < vcu) base += h; tot += h; } tb[tid] = base; tb[32 + tid] = tot; }
        __syncthreads();
        if (tid == 0) { int run = 0; for (int e = 0; e < 32; ++e) { tb[64 + e] = run; run += ((tb[32 + e] + 255) >> 8) << 8; } }
        __syncthreads();
        if (vcu == 0 && tid < 32) { MISCG[tid] = tb[32 + tid]; MISCG[32 + tid] = tb[64 + tid]; }
        { const int a = wave * 64 + lane; const int tk = vcu * 256 + (a >> 1), k = a & 1;
          const int e = EID[tk * 2 + k]; const int p = tb[64 + e] + tb[e] + RNK[tk * 2 + k];
          POS[tk * 2 + k] = p;
          for (int j = 0; j < 64; ++j) { const int pj = __shfl(p, j); const int tj = vcu * 256 + ((wave * 64 + j) >> 1);
              const u32x4* sp = (const u32x4*)(H2 + (size_t)tj * 1024) + lane; u32x4* dp = (u32x4*)(H2S + (size_t)pj * 1024) + lane;
              const u32x4 v0 = sp[0], v1 = sp[64]; dp[0] = v0; dp[64] = v1; } }
        __syncthreads();
    }
    SEAM(10);

    if (IN(11) || IN(12)) {
        LAS int* tp = (LAS int*)(lds + SCHED_OFF); LAS int* rowst = tp + 40;
        if (tid == 0) { int run = 0; for (int e = 0; e < 32; ++e) { tp[e] = run; run += (MISCG[e] + 255) >> 8; rowst[e] = MISCG[32 + e]; } tp[32] = run; }
        __syncthreads();
        const int ntile = tp[32];
        if (IN(11)) {
            pg8::USched S{}; S.nM = ntile; S.nN = 4; S.G = G; S.c = bx; S.pair = 0; S.K = 1024; S.nseg = 32; S.A0 = (const char*)H2S; S.A1 = S.A0; S.B0 = (const char*)W13_t; S.B1 = S.B0; S.segB = (size_t)1024 * 1024 * 2; S.tp = tp; S.rowst = rowst;
            UEpi E{}; E.mode = 5; E.hh = HH;
            pg8::gemm_phase<UEpi, pg8::USched>(lds, 1024, S, E);
        }
        SEAM(11);
        if (IN(12)) {
            pg8::USched S{}; S.nM = ntile; S.nN = 4; S.G = G; S.c = bx; S.pair = 0; S.K = 512; S.nseg = 32; S.A0 = (const char*)HH; S.A1 = S.A0; S.B0 = (const char*)W2_t; S.B1 = S.B0; S.segB = (size_t)1024 * 512 * 2; S.tp = tp; S.rowst = rowst;
            UEpi E{}; E.mode = 6; E.y = YB;
            pg8::gemm_phase<UEpi, pg8::USched>(lds, 512, S, E);
        }
    }
    SEAM(12);

    if (IN(13)) {
        for (int row = gw; row < NTOK; row += NGW) {
            const int b = row >> 12; const float* gt = mod + (size_t)b * 6144 + 5120;
            const int p0 = POS[row * 2], p1 = POS[row * 2 + 1]; const float w0 = WGT[row * 2], w1 = WGT[row * 2 + 1];
            float* orow = args.out + (size_t)row * 1024;
#pragma unroll
            for (int j = 0; j < 2; ++j) { const int k = 512 * j + 8 * lane;
                const u32x4 a = *(const u32x4*)(YB + (size_t)p0 * 1024 + k), c = *(const u32x4*)(YB + (size_t)p1 * 1024 + k);
                const f32x4 x0 = *(const f32x4*)(orow + k), x1v = *(const f32x4*)(orow + k + 4), g0 = *(const f32x4*)(gt + k), g1 = *(const f32x4*)(gt + k + 4);
                f32x4 y0, y1;
                y0[0] = w0 * bf2f(a.x & 0xffffu) + w1 * bf2f(c.x & 0xffffu); y0[1] = w0 * bf2f(a.x >> 16) + w1 * bf2f(c.x >> 16);
                y0[2] = w0 * bf2f(a.y & 0xffffu) + w1 * bf2f(c.y & 0xffffu); y0[3] = w0 * bf2f(a.y >> 16) + w1 * bf2f(c.y >> 16);
                y1[0] = w0 * bf2f(a.z & 0xffffu) + w1 * bf2f(c.z & 0xffffu); y1[1] = w0 * bf2f(a.z >> 16) + w1 * bf2f(c.z >> 16);
                y1[2] = w0 * bf2f(a.w & 0xffffu) + w1 * bf2f(c.w & 0xffffu); y1[3] = w0 * bf2f(a.w >> 16) + w1 * bf2f(c.w >> 16);
                *(f32x4*)(orow + k) = x0 + g0 * y0; *(f32x4*)(orow + k + 4) = x1v + g1 * y1; }
        }
    }
#undef IN
#undef SEAM
}

extern "C" void kernel_launch(void* const* d_in, const int* in_sizes, int n_in, void* d_out, int out_size, void* d_ws, size_t ws_size, hipStream_t stream) {
    static int grid = 0;
    if (grid == 0) {
        if (n_in != 28 || in_sizes[0] != NTOK * DMODEL || out_size != NTOK * DMODEL || ws_size < WS_END) { fprintf(stderr, "kernel_launch: unexpected shapes (n_in %d, in0 %d, out %d, ws %zu)\n", n_in, n_in > 0 ? in_sizes[0] : -1, out_size, ws_size); grid = -1; return; }
        int dev = 0, cus = 0, per_cu = 0;
        if (hipGetDevice(&dev) != hipSuccess || hipDeviceGetAttribute(&cus, hipDeviceAttributeMultiprocessorCount, dev) != hipSuccess) { grid = -1; return; }
        if (hipFuncSetAttribute((const void*)fwd_kernel, hipFuncAttributeMaxDynamicSharedMemorySize, LDS_BYTES) != hipSuccess) { fprintf(stderr, "kernel_launch: hipFuncSetAttribute failed\n"); grid = -1; return; }
        if (hipOccupancyMaxActiveBlocksPerMultiprocessor(&per_cu, (const void*)fwd_kernel, NTHREADS, LDS_BYTES) != hipSuccess || per_cu < 1) { fprintf(stderr, "kernel_launch: occupancy query says %d blocks per CU\n", per_cu); per_cu = 1; }
        (void)hipGetLastError();
        grid = cus * 1;
        if (grid != 256) fprintf(stderr, "kernel_launch: %d CUs; this kernel is laid out for 256\n", grid);
    }
    if (grid < 0) return;
    (void)hipMemsetAsync((char*)d_ws + WS_CTL, 0, CTL_ZERO_BYTES, stream);
    Args a{};
    for (int i = 0; i < 28; ++i) a.in[i] = (const float*)d_in[i];
    a.out = (float*)d_out; a.ws = (unsigned char*)d_ws;
    constexpr int NPH = 14;
    if (MK_N_LAUNCHES == 1) { a.ph_lo = 0; a.ph_hi = NPH; a.li = 0; hipLaunchKernelGGL(fwd_kernel, dim3(grid), dim3(NTHREADS), LDS_BYTES, stream, a); }
    else { for (int p = 0; p < NPH; ++p) { a.ph_lo = p; a.ph_hi = p + 1; a.li = p; hipLaunchKernelGGL(fwd_kernel, dim3(grid), dim3(NTHREADS), LDS_BYTES, stream, a); } }
}
```

```cpp
#include <hip/hip_runtime.h>
#include <cstdio>
#include <cstdint>
#include <cmath>

#ifndef MK_N_LAUNCHES
#define MK_N_LAUNCHES 1
#endif

#ifndef PROBE_REP
#define PROBE_REP 0
#endif
#define LAS __attribute__((address_space(3)))
#define GAS __attribute__((address_space(1)))
typedef unsigned short bf16_t;
typedef short bf16x8 __attribute__((ext_vector_type(8)));
typedef short s16x4 __attribute__((ext_vector_type(4)));
typedef float f32x4 __attribute__((ext_vector_type(4)));
typedef float f32x2 __attribute__((ext_vector_type(2)));
typedef float f32x16 __attribute__((ext_vector_type(16)));
typedef unsigned u32x4 __attribute__((ext_vector_type(4)));
typedef unsigned u32x2 __attribute__((ext_vector_type(2)));
typedef __bf16 bf16x2_t __attribute__((ext_vector_type(2)));

constexpr int NB = 16, SEQ = 4096, DMODEL = 1024, NTOK = NB * SEQ;
constexpr int IN_COLS = 5128, COL_FQ = 0, COL_FK = 512, COL_FV = 1024, COL_FF = 1536, COL_DQ = 1544, COL_DK = 2056, COL_DV = 2568, COL_GATE = 3080;
constexpr int NEXP = 32, DEXP = 512;
constexpr int NASSIGN = NTOK * 2;
constexpr int PADROWS = NASSIGN + NEXP * 256;
constexpr float EPS = 1e-6f;
constexpr float LOG2E = 1.4426950408889634f;
constexpr float C2 = 0.125f * LOG2E;
constexpr float LAM0 = 0.2f;

constexpr size_t MiB = 1u << 20;
constexpr size_t WS_CTL = 0, CTL_ZERO_BYTES = 1 * MiB;
constexpr size_t WS_MOD = 1 * MiB;
constexpr size_t WS_MISC = 1 * MiB + 512 * 1024;
constexpr size_t WS_GALL = 1 * MiB + 768 * 1024;
constexpr size_t WS_EID = 2 * MiB;
constexpr size_t WS_RNK = 2 * MiB + 512 * 1024;
constexpr size_t WS_WGT = 3 * MiB;
constexpr size_t WS_POS = 3 * MiB + 512 * 1024;
constexpr size_t WS_HIST = 4 * MiB;
constexpr size_t WS_ROWTOK = 4 * MiB + 256 * 1024;
constexpr size_t WS_LOGF = 5 * MiB;
constexpr size_t WS_BIAS = 7 * MiB;
constexpr size_t WS_WR = 10 * MiB;
constexpr size_t WS_LOGIT = 11 * MiB;
constexpr size_t WS_ROPE = 27 * MiB;
constexpr size_t WS_WIN = 43 * MiB;
constexpr size_t WS_WPF = 53 * MiB, WS_WPD = 54 * MiB, WS_WOUT = 55 * MiB;
constexpr size_t WS_W13 = 57 * MiB;
constexpr size_t WS_W2 = 121 * MiB;
constexpr size_t WS_H1 = 160 * MiB;
constexpr size_t WS_QF = 288 * MiB, WS_KF = 352 * MiB, WS_VF = 416 * MiB, WS_QD = 480 * MiB, WS_KD = 544 * MiB, WS_VD = 608 * MiB;
constexpr size_t WS_G = 672 * MiB;
constexpr size_t WS_OD = 928 * MiB;
constexpr size_t WS_MERGED = WS_KF;
constexpr size_t WS_H2S = WS_QD;
constexpr size_t WS_HH = 752 * MiB;
constexpr size_t WS_END = 1024 * MiB;
static_assert(WS_KF - WS_QF == 67108864 && WS_VD - WS_QF == 5 * 67108864, "six q/k/v buffers 64 MiB apart");
static_assert(WS_H2S + (size_t)PADROWS * 2048 <= WS_HH && WS_HH + (size_t)PADROWS * 1024 <= WS_OD, "ws map");

constexpr int CW_TMO = 0, CW_BAR = 4096;

constexpr int RING_BYTES = 131072, LDSCTL_OFF = RING_BYTES, MISC_OFF = LDSCTL_OFF + 320, SCHED_OFF = LDSCTL_OFF + 1024;
constexpr int LDS_BYTES = 147456;
constexpr int NWAVES = 8, NTHREADS = 512;

#define RLX_AGENT __ATOMIC_RELAXED, __HIP_MEMORY_SCOPE_AGENT
#define LDS_WAIT() asm volatile("s_waitcnt lgkmcnt(0)" ::: "memory")
#define VM_WAIT() asm volatile("s_waitcnt vmcnt(0)" ::: "memory")
__device__ __forceinline__ unsigned f2bf(float f) { unsigned u = __builtin_bit_cast(unsigned, f); return (u + 0x7fffu + ((u >> 16) & 1u)) >> 16; }
__device__ __forceinline__ unsigned pk2(float lo, float hi) { return f2bf(lo) | (f2bf(hi) << 16); }
__device__ __forceinline__ float bf2f(unsigned b) { return __builtin_bit_cast(float, b << 16); }
__device__ __forceinline__ unsigned cvtpk(float lo, float hi) { f32x2 v = {lo, hi}; bf16x2_t b = __builtin_convertvector(v, bf16x2_t); return __builtin_bit_cast(unsigned, b); }
__device__ __forceinline__ float wave_sum(float v) {
#pragma unroll
    for (int o = 1; o < 64; o <<= 1) v += __shfl_xor(v, o);
    return v;
}
__device__ __forceinline__ float wave_max(float v) {
#pragma unroll
    for (int o = 1; o < 64; o <<= 1) v = fmaxf(v, __shfl_xor(v, o));
    return v;
}
__device__ __forceinline__ float sigmoidf_(float x) { return __builtin_amdgcn_rcpf(1.0f + __builtin_amdgcn_exp2f(-LOG2E * x)); }

namespace pg8 {
constexpr int BM = 256, BK = 64, HALF = 128, HTB = HALF * BK * 2, STAGE_BYTES = 8 * HTB, NXCD = 8, WGM = 8;
__host__ __device__ __forceinline__ int lds_byte(int r, int c) { const int st = (r >> 4) * 2 + (c >> 5), rr = r & 15, cc = c & 31, ob = rr * 64 + cc * 2; return st * 1024 + (ob ^ (((ob >> 9) & 1) << 5)); }
__host__ __device__ __forceinline__ void stage_rc(int b, int& R, int& C) { const int st = b / 1024, sb = b % 1024, swz = sb ^ (((sb >> 9) & 1) << 5); R = (st >> 1) * 16 + swz / 64; C = (st & 1) * 32 + (swz % 64) / 2; }
__host__ __device__ __forceinline__ int perm32(int rho) { const int n = rho >> 4, i = rho & 15; return 8 * (i >> 2) + 4 * n + (i & 3); }

struct Unit { int row0, pn, seg, src; const char* A; const char* B; };

struct USched {
    int nM, nN, G, c, pair, K, nseg;
    const char *A0, *A1, *B0, *B1;
    size_t segB;
    const LAS int* tp;
    const LAS int* rowst;
    int direct;
    const LAS int* gidx;
    __device__ __forceinline__ bool next(int i, Unit& u) const {
        const int ii = pair ? (i >> 1) : i, src = pair ? (i & 1) : 0;
        int pm, pn;
        if (direct >= 0) { if (i > 0) return false; pm = direct; pn = 0; }
        else {
            const long L = (long)ii * G + c; const int nwg = nM * nN; if (L >= nwg) return false;
            int wgid = (int)L; { const int q = nwg / NXCD, r = nwg % NXCD, xcd = wgid % NXCD, off = wgid / NXCD; wgid = (xcd < r ? xcd * (q + 1) : r * (q + 1) + (xcd - r) * q) + off; }
            const int nig = WGM * nN, gid = wgid / nig, fm = gid * WGM, gsz = (nM - fm) < WGM ? (nM - fm) : WGM;
            pm = fm + ((wgid % nig) % gsz); pn = (wgid % nig) / gsz;
        }
        int s = 0, row0 = pm * BM;
        if (nseg > 1) { for (int j = 1; j < nseg; ++j) if (pm >= tp[j]) s = j; row0 = rowst[s] + (pm - tp[s]) * BM; }
        u.row0 = row0; u.pn = pn; u.seg = s; u.src = src;
        u.A = (src ? A1 : A0) + (gidx ? (size_t)0 : (size_t)row0 * K * 2);
        u.B = (src ? B1 : B0) + (size_t)s * segB + (size_t)pn * BM * K * 2;
        return true;
    }
    __device__ __forceinline__ unsigned a_off(int ui, int h, int R, int C) const {
        if (gidx) return (unsigned)(gidx[ui * BM + h * HALF + R] * K + C) * 2u;
        return (unsigned)((h * HALF + R) * K + C) * 2u;
    }
};

template <class Epi, class Sched>
__device__ __forceinline__ void gemm_phase(LAS unsigned char* lds, const int K, const Sched S, const Epi E) {
    int tid_ = threadIdx.x; asm volatile("" : "+v"(tid_));
    const int tid = tid_, wid = __builtin_amdgcn_readfirstlane(tid >> 6), lane = tid & 63, wr = wid >> 2, wc = wid & 3, fr = lane & 15, fq = lane >> 4;
    const int nt = K / BK;
    unsigned voffB[2]; int RA[2], CA[2];
#pragma unroll
    for (int i = 0; i < 2; ++i) { int R, C; stage_rc(tid * 16 + i * 8192, R, C); const int Rb = (R & ~31) + perm32(R & 31);
        RA[i] = R; CA[i] = C; voffB[i] = (unsigned)(Rb * K + C) * 2u; }
    unsigned vA[2][2], nvA[2][2];
#define PG8_FILL(v, ui_) do { _Pragma("unroll") for (int _h = 0; _h < 2; ++_h) _Pragma("unroll") for (int _i = 0; _i < 2; ++_i) v[_h][_i] = S.a_off(ui_, _h, RA[_i], CA[_i]); } while (0)
    const size_t kstep = (size_t)(BK * 2);
    const size_t hstep = (size_t)HALF * K * 2;
    const unsigned ldsw = (unsigned)wid * 1024u;
    const int aoff = lds_byte(wr * 64 + fr, fq * 8), boff = lds_byte(wc * 32 + fr, fq * 8);
#define PG8_SA(b, h) (((b) * 2 + (h)) * HTB)
#define PG8_SB(b, h) ((4 + (b) * 2 + (h)) * HTB)
#define PG8_STAGE(bufoff, gbase, voff) do { _Pragma("unroll") for (int _i = 0; _i < 2; ++_i) \
        __builtin_amdgcn_global_load_lds((const unsigned*)((const char*)(gbase) + (voff)[_i]), (LAS unsigned*)(lds + (bufoff) + ldsw + _i * 8192), 16, 0, 0); } while (0)
#define PG8_LDA(dst, b, h) do { _Pragma("unroll") for (int m = 0; m < 4; ++m) _Pragma("unroll") for (int k = 0; k < 2; ++k) dst[m][k] = *(const LAS bf16x8*)(lds + PG8_SA(b, h) + aoff + m * 2048 + k * 1024); } while (0)
#define PG8_LDB(dst, b, h) do { _Pragma("unroll") for (int n = 0; n < 2; ++n) _Pragma("unroll") for (int k = 0; k < 2; ++k) dst[n][k] = *(const LAS bf16x8*)(lds + PG8_SB(b, h) + boff + n * 2048 + k * 1024); } while (0)
#define PG8_MMA(ai, bj, At, Bt) do { __builtin_amdgcn_s_setprio(1); _Pragma("unroll") for (int m = 0; m < 4; ++m) _Pragma("unroll") for (int n = 0; n < 2; ++n) _Pragma("unroll") for (int k = 0; k < 2; ++k) \
        acc[ai][bj][m][n] = __builtin_amdgcn_mfma_f32_16x16x32_bf16(Bt[n][k], At[m][k], acc[ai][bj][m][n], 0, 0, 0); __builtin_amdgcn_s_setprio(0); } while (0)
#define PG8_WAIT_V(n) asm volatile("s_waitcnt vmcnt(" #n ")" ::: "memory")
#define PG8_WAIT_L(n) asm volatile("s_waitcnt lgkmcnt(" #n ")" ::: "memory")
#define PG8_BAR __builtin_amdgcn_s_barrier()
#define PG8_SCHED __builtin_amdgcn_sched_barrier(0)
    Unit cur, nxt; int ui = 0;
    if (!S.next(0, cur)) return;
    f32x4 acc[2][2][4][2];
#pragma unroll
    for (int a = 0; a < 2; ++a)
#pragma unroll
        for (int b = 0; b < 2; ++b)
#pragma unroll
            for (int m = 0; m < 4; ++m)
#pragma unroll
                for (int n = 0; n < 2; ++n) acc[a][b][m][n] = (f32x4){0.f, 0.f, 0.f, 0.f};
    bf16x8 At[4][2], B0[2][2], B1[2][2];
    const char* cA = cur.A; const char* cB = cur.B;
    PG8_FILL(vA, 0);
    PG8_STAGE(PG8_SB(0, 0), cB, voffB); PG8_STAGE(PG8_SB(0, 1), cB + hstep, voffB); PG8_STAGE(PG8_SA(0, 0), cA, vA[0]); PG8_STAGE(PG8_SA(0, 1), cA, vA[1]);
    if (wr == 1) PG8_BAR;
    PG8_WAIT_V(2); PG8_BAR;
    PG8_STAGE(PG8_SB(1, 0), cB + kstep, voffB); PG8_STAGE(PG8_SA(1, 0), cA + kstep, vA[0]); PG8_STAGE(PG8_SB(1, 1), cB + hstep + kstep, voffB);
    PG8_WAIT_V(6); PG8_BAR;
    for (;;) {
        const bool has_next = S.next(ui + 1, nxt);
        const char* nA = has_next ? nxt.A : cA; const char* nB = has_next ? nxt.B : cB;
        if (has_next) { PG8_FILL(nvA, ui + 1); } else { nvA[0][0] = vA[0][0]; nvA[0][1] = vA[0][1]; nvA[1][0] = vA[1][0]; nvA[1][1] = vA[1][1]; }
        for (int t = 0; t < nt; t += 2) {
            const bool last = (t == nt - 2);
            const char* a1 = cA + (size_t)(t + 1) * kstep;
            const char* a2 = last ? nA : cA + (size_t)(t + 2) * kstep; const char* b2 = last ? nB : cB + (size_t)(t + 2) * kstep;
            const char* a3 = a2 + kstep; const char* b3 = b2 + kstep;
            unsigned s0[2], s1[2]; s0[0] = last ? nvA[0][0] : vA[0][0]; s0[1] = last ? nvA[0][1] : vA[0][1]; s1[0] = last ? nvA[1][0] : vA[1][0]; s1[1] = last ? nvA[1][1] : vA[1][1];
            PG8_LDB(B0, 0, 0); PG8_LDB(B1, 0, 1); PG8_SCHED; PG8_LDA(At, 0, 0); PG8_STAGE(PG8_SA(1, 1), a1, vA[1]);
            PG8_WAIT_V(8); PG8_WAIT_L(0); PG8_BAR; PG8_MMA(0, 0, At, B0); PG8_MMA(0, 1, At, B1); PG8_BAR; PG8_SCHED;
            PG8_LDA(At, 0, 1); PG8_STAGE(PG8_SB(0, 0), b2, voffB); PG8_STAGE(PG8_SB(0, 1), b2 + hstep, voffB); PG8_STAGE(PG8_SA(0, 0), a2, s0);
            PG8_WAIT_V(8); PG8_WAIT_L(0); PG8_BAR; PG8_MMA(1, 0, At, B0); PG8_MMA(1, 1, At, B1); PG8_BAR; PG8_SCHED;
            PG8_LDB(B0, 1, 0); PG8_LDB(B1, 1, 1); PG8_SCHED; PG8_LDA(At, 1, 0); PG8_STAGE(PG8_SA(0, 1), a2, s1);
            PG8_WAIT_V(8); PG8_WAIT_L(0); PG8_BAR; PG8_MMA(0, 0, At, B0); PG8_MMA(0, 1, At, B1); PG8_BAR; PG8_SCHED;
            PG8_LDA(At, 1, 1); PG8_STAGE(PG8_SB(1, 0), b3, voffB); PG8_STAGE(PG8_SB(1, 1), b3 + hstep, voffB); PG8_STAGE(PG8_SA(1, 0), a3, s0);
            PG8_WAIT_V(8); PG8_WAIT_L(0); PG8_BAR; PG8_MMA(1, 0, At, B0); PG8_MMA(1, 1, At, B1); PG8_BAR; PG8_SCHED;
        }
        if (wr == 0) PG8_BAR;
        E(acc, cur, wr, wc, fr, fq);
        if (!has_next) break;
#pragma unroll
        for (int a = 0; a < 2; ++a)
#pragma unroll
            for (int b = 0; b < 2; ++b)
#pragma unroll
                for (int m = 0; m < 4; ++m)
#pragma unroll
                    for (int n = 0; n < 2; ++n) acc[a][b][m][n] = (f32x4){0.f, 0.f, 0.f, 0.f};
        cur = nxt; cA = nA; cB = nB; ++ui;
        vA[0][0] = nvA[0][0]; vA[0][1] = nvA[0][1]; vA[1][0] = nvA[1][0]; vA[1][1] = nvA[1][1];
        if (wr == 1) PG8_BAR;
    }
    PG8_WAIT_V(0);
    PG8_BAR;
#undef PG8_SA
#undef PG8_SB
#undef PG8_STAGE
#undef PG8_FILL
#undef PG8_LDA
#undef PG8_LDB
#undef PG8_MMA
#undef PG8_WAIT_V
#undef PG8_WAIT_L
#undef PG8_BAR
#undef PG8_SCHED
}
}

struct UEpi {
    int mode;
    bf16_t *qkv6, *gates; const float *gall, *rope;
    bf16_t* merged;
    const float* x; float* x1; const float* mod;
    float* logits;
    bf16_t* hh; bf16_t* y;
    __device__ __forceinline__ void operator()(const f32x4 (&acc)[2][2][4][2], const pg8::Unit& u, int wr, int wc, int fr, int fq) const {
        const int rbase = u.row0 + wr * 64 + fr;
        if (mode == 1) {
            const int pn = u.pn;
            if (pn >= 12 || pn == 4 || pn == 5 || pn == 10 || pn == 11) {
                const bool gate = pn >= 12;
                bf16_t* base; int ldc, colt;
                if (gate) { base = gates; ldc = 2048; colt = (pn - 12) * 256; }
                else { base = qkv6 + (size_t)(pn >> 1) * 33554432; ldc = 512; colt = (pn & 1) * 256; }
                const int col0 = colt + wc * 32 + 8 * fq;
#pragma unroll
                for (int ai = 0; ai < 2; ++ai)
#pragma unroll
                    for (int m = 0; m < 4; ++m) { bf16_t* rowp = base + (size_t)(rbase + ai * 128 + m * 16) * ldc + col0;
#pragma unroll
                        for (int bj = 0; bj < 2; ++bj) { f32x4 v0 = acc[ai][bj][m][0], v1 = acc[ai][bj][m][1];
                            if (gate) {
#pragma unroll
                                for (int e = 0; e < 4; ++e) { v0[e] = sigmoidf_(v0[e]); v1[e] = sigmoidf_(v1[e]); } }
                            u32x4 w; w.x = cvtpk(v0[0], v0[1]); w.y = cvtpk(v0[2], v0[3]); w.z = cvtpk(v1[0], v1[1]); w.w = cvtpk(v1[2], v1[3]);
                            *(u32x4*)(rowp + bj * 128) = w; } }
            } else {
                const int sec = pn >> 1;
                bf16_t* base = qkv6 + (size_t)sec * 33554432;
                const float* g = gall + (sec - (sec >= 3 ? 1 : 0)) * 64;
                const bool dorope = sec >= 3; const float sc = (sec == 0 || sec == 3) ? C2 : 1.0f;
                const int head = 4 * (pn & 1) + wc;
                f32x4 gv[2][2];
#pragma unroll
                for (int bj = 0; bj < 2; ++bj)
#pragma unroll
                    for (int n = 0; n < 2; ++n) { gv[bj][n] = *(const f32x4*)(g + 32 * bj + 8 * fq + 4 * n); gv[bj][n] = gv[bj][n] * sc; }
#pragma unroll
                for (int ai = 0; ai < 2; ++ai)
#pragma unroll
                    for (int m = 0; m < 4; ++m) {
                        const int row = rbase + ai * 128 + m * 16;
                        f32x4 v[2][2]; float ss = 0.f;
#pragma unroll
                        for (int bj = 0; bj < 2; ++bj)
#pragma unroll
                            for (int n = 0; n < 2; ++n) { v[bj][n] = acc[ai][bj][m][n]; const f32x4 q = v[bj][n] * v[bj][n]; ss += (q[0] + q[1]) + (q[2] + q[3]); }
                        ss += __shfl_xor(ss, 16); ss += __shfl_xor(ss, 32);
                        const float rstd = __builtin_amdgcn_rsqf(ss * (1.0f / 64.0f) + EPS);
#pragma unroll
                        for (int bj = 0; bj < 2; ++bj)
#pragma unroll
                            for (int n = 0; n < 2; ++n) v[bj][n] = v[bj][n] * rstd * gv[bj][n];
                        if (dorope) {
                            const float* rp = rope + (size_t)row * 64 + 8 * fq;
#pragma unroll
                            for (int n = 0; n < 2; ++n) { const f32x4 cs = *(const f32x4*)(rp + 4 * n), sn = *(const f32x4*)(rp + 32 + 4 * n);
                                const f32x4 x1 = v[0][n], x2 = v[1][n]; v[0][n] = x1 * cs - x2 * sn; v[1][n] = x2 * cs + x1 * sn; }
                        }
                        bf16_t* rowp = base + (size_t)row * 512 + head * 64 + 8 * fq;
#pragma unroll
                        for (int bj = 0; bj < 2; ++bj) { u32x4 w; w.x = cvtpk(v[bj][0][0], v[bj][0][1]); w.y = cvtpk(v[bj][0][2], v[bj][0][3]); w.z = cvtpk(v[bj][1][0], v[bj][1][1]); w.w = cvtpk(v[bj][1][2], v[bj][1][3]);
                            *(u32x4*)(rowp + bj * 32) = w; }
                    }
            }
        } else if (mode == 2) {
            const int col0 = u.pn * 256 + wc * 32 + 8 * fq; const int src = u.src;
#pragma unroll
            for (int ai = 0; ai < 2; ++ai)
#pragma unroll
                for (int m = 0; m < 4; ++m) { const size_t row = (size_t)(rbase + ai * 128 + m * 16);
#pragma unroll
                    for (int bj = 0; bj < 2; ++bj) { const int col = col0 + bj * 128;
                        const u32x4 gw = *(const u32x4*)(gates + row * 2048 + src * 1024 + col);
                        f32x4 v0 = acc[ai][bj][m][0], v1 = acc[ai][bj][m][1];
                        v0[0] *= bf2f(gw.x & 0xffffu); v0[1] *= bf2f(gw.x >> 16); v0[2] *= bf2f(gw.y & 0xffffu); v0[3] *= bf2f(gw.y >> 16);
                        v1[0] *= bf2f(gw.z & 0xffffu); v1[1] *= bf2f(gw.z >> 16); v1[2] *= bf2f(gw.w & 0xffffu); v1[3] *= bf2f(gw.w >> 16);
                        bf16_t* dp = merged + row * 1024 + col;
                        if (src) { const u32x4 t = *(const u32x4*)dp;
                            v0[0] += bf2f(t.x & 0xffffu); v0[1] += bf2f(t.x >> 16); v0[2] += bf2f(t.y & 0xffffu); v0[3] += bf2f(t.y >> 16);
                            v1[0] += bf2f(t.z & 0xffffu); v1[1] += bf2f(t.z >> 16); v1[2] += bf2f(t.w & 0xffffu); v1[3] += bf2f(t.w >> 16); }
                        u32x4 w; w.x = cvtpk(v0[0], v0[1]); w.y = cvtpk(v0[2], v0[3]); w.z = cvtpk(v1[0], v1[1]); w.w = cvtpk(v1[2], v1[3]);
                        *(u32x4*)dp = w; } }
        } else if (mode == 3) {
            const int col0 = u.pn * 256 + wc * 32 + 8 * fq; const int b = u.row0 >> 12;
            const float* gt = mod + (size_t)b * 6144 + 2048;
#pragma unroll
            for (int bj = 0; bj < 2; ++bj) { const int col = col0 + bj * 128; const f32x4 g0 = *(const f32x4*)(gt + col), g1 = *(const f32x4*)(gt + col + 4);
#pragma unroll
                for (int ai = 0; ai < 2; ++ai)
#pragma unroll
                    for (int m = 0; m < 4; ++m) { const size_t off = (size_t)(rbase + ai * 128 + m * 16) * 1024 + col;
                        const f32x4 x0 = *(const f32x4*)(x + off), xb = *(const f32x4*)(x + off + 4);
                        *(f32x4*)(x1 + off) = x0 + g0 * acc[ai][bj][m][0]; *(f32x4*)(x1 + off + 4) = xb + g1 * acc[ai][bj][m][1]; } }
        } else if (mode == 4) {
            if (wc < 2) { const int col = wc * 32 + 8 * fq;
#pragma unroll
                for (int ai = 0; ai < 2; ++ai)
#pragma unroll
                    for (int m = 0; m < 4; ++m) { float* dp = logits + (size_t)(rbase + ai * 128 + m * 16) * 64 + col;
                        *(f32x4*)dp = acc[ai][0][m][0]; *(f32x4*)(dp + 4) = acc[ai][0][m][1]; } }
        } else if (mode == 5) {
            const int col0 = u.pn * 128 + wc * 32 + 8 * fq;
#pragma unroll
            for (int ai = 0; ai < 2; ++ai)
#pragma unroll
                for (int m = 0; m < 4; ++m) { f32x4 h0, h1;
#pragma unroll
                    for (int e = 0; e < 4; ++e) { const float a0 = acc[ai][0][m][0][e], a1 = acc[ai][0][m][1][e];
                        h0[e] = a0 * sigmoidf_(a0) * acc[ai][1][m][0][e]; h1[e] = a1 * sigmoidf_(a1) * acc[ai][1][m][1][e]; }
                    u32x4 w; w.x = cvtpk(h0[0], h0[1]); w.y = cvtpk(h0[2], h0[3]); w.z = cvtpk(h1[0], h1[1]); w.w = cvtpk(h1[2], h1[3]);
                    *(u32x4*)(hh + (size_t)(rbase + ai * 128 + m * 16) * 512 + col0) = w; }
        } else {
            const int col0 = u.pn * 256 + wc * 32 + 8 * fq;
#pragma unroll
            for (int ai = 0; ai < 2; ++ai)
#pragma unroll
                for (int m = 0; m < 4; ++m) { bf16_t* rowp = y + (size_t)(rbase + ai * 128 + m * 16) * 1024 + col0;
#pragma unroll
                    for (int bj = 0; bj < 2; ++bj) { const f32x4 v0 = acc[ai][bj][m][0], v1 = acc[ai][bj][m][1];
                        u32x4 w; w.x = cvtpk(v0[0], v0[1]); w.y = cvtpk(v0[2], v0[3]); w.z = cvtpk(v1[0], v1[1]); w.w = cvtpk(v1[2], v1[3]);
                        *(u32x4*)(rowp + bj * 128) = w; } }
        }
    }
};

namespace attn_body {
constexpr int D = 64, DM = 512;
constexpr int NW = 8, QBLK = 32, QB = QBLK * NW, KVBLK = 64;
__device__ __forceinline__ int crow(int r, int hi) { return (r & 3) + 8 * (r >> 2) + 4 * hi; }
#define SBAR() __builtin_amdgcn_sched_barrier(0)
__device__ __forceinline__ void cmask(f32x16& p0, f32x16& p1, int jb, int qrel, int hi) {
    const float NEG = -INFINITY; int kb = 64 * jb + 4 * hi;
#pragma unroll
    for (int r = 0; r < 16; ++r) { int kv = kb + (r & 3) + 8 * (r >> 2); if (kv > qrel) p0[r] = NEG; if (kv + 32 > qrel) p1[r] = NEG; }
}
__device__ __forceinline__ void maskall(f32x16& p0, f32x16& p1) {
    const float NEG = -INFINITY;
#pragma unroll
    for (int r = 0; r < 16; ++r) { p0[r] = NEG; p1[r] = NEG; }
}
constexpr int NSLOT = 3, SLOTB = 8192;
constexpr int LDS_K = 0, LDS_V = NSLOT * SLOTB, LDS_WS = 2 * NSLOT * SLOTB, LDS_OST = LDS_WS + NW * 64 * 4, LDS_BYTES_A = LDS_OST + NW * 4096;
__device__ __forceinline__ void glds16(const void* gsrc, unsigned lds_dst) { unsigned keep;
    asm volatile("s_mov_b32 %0, m0\n\ts_mov_b32 m0, %2\n\ts_nop 0\n\tglobal_load_lds_dwordx4 %1, off\n\ts_mov_b32 m0, %0" : "=&s"(keep) : "v"(gsrc), "s"(lds_dst) : "memory"); }
__device__ __forceinline__ float max3f(float a, float b, float c) { float r; asm("v_max3_f32 %0, %1, %2, %3" : "=v"(r) : "v"(a), "v"(b), "v"(c)); return r; }
__device__ __forceinline__ float max2f(float a, float b) { float r; asm("v_max_f32_e32 %0, %1, %2" : "=v"(r) : "v"(a), "v"(b)); return r; }
__device__ __forceinline__ float fadd_s(float a, float b) { float r; asm("v_add_f32_e32 %0, %1, %2" : "=v"(r) : "v"(a), "v"(b)); return r; }
__device__ __forceinline__ float fsub_s(float a, float b) { float r; asm("v_sub_f32_e32 %0, %1, %2" : "=v"(r) : "v"(a), "v"(b)); return r; }
#define WAIT_BAR(N) asm volatile("s_waitcnt vmcnt(" #N ") lgkmcnt(0)\n\ts_barrier" ::: "memory")
typedef LAS const char* lds_cptr;
typedef short v4i16_t __attribute__((ext_vector_type(4)));
__device__ __forceinline__ void qkt(f32x16& p0, f32x16& p1, const char* Kslot, const bf16x8* qr, const f32x16& negm, int r32, int hi) {
    const char* kb = Kslot + hi * 1024 + r32 * 16;
#pragma unroll
    for (int d0 = 0; d0 < 4; ++d0) {
        const bf16x8 b0 = *reinterpret_cast<const bf16x8*>(kb + d0 * 2048);
        const bf16x8 b1 = *reinterpret_cast<const bf16x8*>(kb + d0 * 2048 + 512);
        if (d0 == 0) { p0 = __builtin_amdgcn_mfma_f32_32x32x16_bf16(b0, qr[0], negm, 0, 0, 0); p1 = __builtin_amdgcn_mfma_f32_32x32x16_bf16(b1, qr[0], negm, 0, 0, 0); }
        else { p0 = __builtin_amdgcn_mfma_f32_32x32x16_bf16(b0, qr[d0], p0, 0, 0, 0); p1 = __builtin_amdgcn_mfma_f32_32x32x16_bf16(b1, qr[d0], p1, 0, 0, 0); } }
}
__device__ __forceinline__ void kload8(bf16x8* kf, lds_cptr kp) {
    kf[0] = *(const LAS bf16x8*)(kp);        kf[1] = *(const LAS bf16x8*)(kp + 512);
    kf[2] = *(const LAS bf16x8*)(kp + 2048); kf[3] = *(const LAS bf16x8*)(kp + 2560);
    kf[4] = *(const LAS bf16x8*)(kp + 4096); kf[5] = *(const LAS bf16x8*)(kp + 4608);
    kf[6] = *(const LAS bf16x8*)(kp + 6144); kf[7] = *(const LAS bf16x8*)(kp + 6656);
}
__device__ __forceinline__ void kload2(bf16x8* kf, lds_cptr kp, int j) { kf[2 * j] = *(const LAS bf16x8*)(kp + j * 2048); kf[2 * j + 1] = *(const LAS bf16x8*)(kp + j * 2048 + 512); }
__device__ __forceinline__ s16x4 vtr(lds_cptr p) { return __builtin_bit_cast(s16x4, __builtin_amdgcn_ds_read_tr16_b64_v4i16((LAS v4i16_t*)p)); }
__device__ __forceinline__ float rowmax(const f32x16& p0, const f32x16& p1) {
    float a = max3f(p0[0], p0[1], p1[0]), b = max3f(p0[2], p0[3], p1[1]); a = max3f(a, p1[2], p1[3]);
#pragma unroll
    for (int r = 4; r < 16; r += 4) { a = max3f(a, p0[r], p0[r + 1]); b = max3f(b, p0[r + 2], p0[r + 3]); a = max3f(a, p1[r], p1[r + 1]); b = max3f(b, p1[r + 2], p1[r + 3]); }
    const float m = max2f(a, b);
    auto rr = __builtin_amdgcn_permlane32_swap(__float_as_uint(m), __float_as_uint(m), false, false);
    return max2f(__uint_as_float(rr[0]), __uint_as_float(rr[1]));
}
__device__ __forceinline__ void pv(f32x16* o, int vb, bf16x8 pa0, bf16x8 pa1, bf16x8 pa2, bf16x8 pa3) {
#pragma unroll
    for (int d0 = 0; d0 < 2; ++d0) { s16x4 lo[4], hi[4];
#pragma unroll
        for (int ks = 0; ks < 4; ++ks) {
            asm volatile("ds_read_b64_tr_b16 %0,%1 offset:%c2" : "=&v"(lo[ks]) : "v"(vb), "i"(d0 * 4096 + ks * 1024) : "memory");
            asm volatile("ds_read_b64_tr_b16 %0,%1 offset:%c2" : "=&v"(hi[ks]) : "v"(vb), "i"(d0 * 4096 + ks * 1024 + 512) : "memory"); }
        asm volatile("s_waitcnt lgkmcnt(0)" ::: "memory"); SBAR();
#define PK(k) (bf16x8){lo[k][0], lo[k][1], lo[k][2], lo[k][3], hi[k][0], hi[k][1], hi[k][2], hi[k][3]}
        o[d0] = __builtin_amdgcn_mfma_f32_32x32x16_bf16(pa0, PK(0), o[d0], 0, 0, 0);
        o[d0] = __builtin_amdgcn_mfma_f32_32x32x16_bf16(pa1, PK(1), o[d0], 0, 0, 0);
        o[d0] = __builtin_amdgcn_mfma_f32_32x32x16_bf16(pa2, PK(2), o[d0], 0, 0, 0);
        o[d0] = __builtin_amdgcn_mfma_f32_32x32x16_bf16(pa3, PK(3), o[d0], 0, 0, 0);
#undef PK
    }
}
__device__ __forceinline__ bf16x8 bias_frag(float b) {
    const unsigned u0 = cvtpk(b, 0.f) & 0xffffu; const float r1 = b - bf2f(u0);
    const unsigned u1 = cvtpk(r1, 0.f) & 0xffffu; const float r2 = r1 - bf2f(u1);
    const unsigned u2 = cvtpk(r2, 0.f) & 0xffffu;
    u32x4 w; w.x = u0 | (u1 << 16); w.y = u2 | 0x3F800000u; w.z = 0x3F803F80u; w.w = 0u; return __builtin_bit_cast(bf16x8, w);
}
__device__ __forceinline__ bf16x8 qext_frag(float nm, int hi) {
    const unsigned u0 = cvtpk(nm, 0.f) & 0xffffu; const float r1 = nm - bf2f(u0);
    const unsigned u1 = cvtpk(r1, 0.f) & 0xffffu; const float r2 = r1 - bf2f(u1);
    const unsigned u2 = cvtpk(r2, 0.f) & 0xffffu;
    u32x4 w; w.x = hi ? 0u : 0x3F803F80u; w.y = hi ? 0u : (0x3F80u | (u0 << 16)); w.z = hi ? 0u : (u1 | (u2 << 16)); w.w = 0u; return __builtin_bit_cast(bf16x8, w);
}

template <bool FOX, int THRL> __device__ __forceinline__ void attn_unit(long rowbase, int qcol, int vcol, int ocol, int OP, int qb, const bf16_t* Q, const bf16_t* __restrict__ K, const bf16_t* __restrict__ V, bf16_t* O,
                                                                         const float* __restrict__ bias, float bound2, char* shm) {
    int tid_ = threadIdx.x; asm volatile("" : "+v"(tid_));
    const int tid = tid_, lane = tid & 63, r32 = lane & 31, hi = lane >> 5; const int wid = __builtin_amdgcn_readfirstlane(tid >> 6);
    const int q0 = qb * QB;
    int NT = (q0 + QB) / KVBLK; int t0 = 0;
    if (FOX) {
        const float bq = bias[q0]; const int j = lane; float bj = 0.f; if (j < NT - 4) bj = bias[64 * j + 63];
        const unsigned long long bal = __ballot((j < NT - 4) && (bj < bq - bound2));
        t0 = __builtin_popcountll(bal) & ~1; t0 = __builtin_amdgcn_readfirstlane(t0);
        NT -= t0;
    }
    const bf16_t* Qw = Q + (rowbase + q0 + wid * QBLK) * DM + qcol;
    const bf16_t* Kh = K + (rowbase + (long)t0 * KVBLK) * DM + qcol; const bf16_t* Vh = V + (rowbase + (long)t0 * KVBLK) * DM + vcol;
    const int bofs = t0 * KVBLK + r32;
    const unsigned lds0 = (unsigned)(uintptr_t)shm;
    float* wsf = (float*)(shm + LDS_WS) + wid * 64;
    const bf16_t* ksrc = Kh + (long)lane * DM + wid * 8;
    const bf16_t* vsrc = Vh + (long)(16 * (wid & 3) + (lane >> 2)) * DM + (wid >> 2) * 32 + (lane & 3) * 8;
    const unsigned kdst = lds0 + LDS_K + wid * 1024, vdst = lds0 + LDS_V + wid * 1024;
#define DMA_K(t, slot) glds16(ksrc + (long)(t) * KVBLK * DM, (unsigned)__builtin_amdgcn_readfirstlane(kdst + (slot)))
#define DMA_V(t, slot) glds16(vsrc + (long)(t) * KVBLK * DM, (unsigned)__builtin_amdgcn_readfirstlane(vdst + (slot)))
    const int vb0 = (int)(lds0 + LDS_V) + ((lane >> 4) & 1) * 32 + (lane & 3) * 8 + (4 * hi + ((lane & 15) >> 2)) * 64;
    const char* Kbase = shm + LDS_K; bf16x8 kf[8];
    const lds_cptr shm3 = (lds_cptr)shm; const lds_cptr kp0 = shm3 + LDS_K + hi * 1024 + r32 * 16; const lds_cptr vp0 = shm3 + LDS_V + ((lane >> 4) & 1) * 32 + (lane & 3) * 8 + (4 * hi + ((lane & 15) >> 2)) * 64;
    DMA_K(0, 0); DMA_V(0, 0); DMA_K(1, SLOTB);
    bf16x8 qr[4];
#pragma unroll
    for (int d0 = 0; d0 < 4; ++d0) qr[d0] = *reinterpret_cast<const bf16x8*>(&Qw[(long)r32 * DM + d0 * 16 + hi * 8]);
    bf16x8 qone = qext_frag(0.f, hi);
    float cb0 = 0.f, cb1 = 0.f; if (FOX) { cb0 = bias[bofs]; cb1 = bias[bofs + 32]; }
    float mhat = 0.f, l_reg = 0.f; f32x16 o[2]; o[0] = f32x16{}; o[1] = f32x16{}; f32x16 negm = f32x16{}; if (!FOX) asm volatile("" : "+v"(negm));
    const int qrel = wid * QBLK + r32;
#define CMASK(P0, P1, t) do { int jb_ = (t) - (NT - 4); if (jb_ >= 0) { if (FOX) cmask(P0, P1, jb_, qrel, hi); else if (jb_ > (wid >> 1)) maskall(P0, P1); } } while (0)
    bool resc = false;
#define START(P0, P1) do { const float rm = rowmax(P0, P1); resc = false; \
    { const float dl = rm; mhat = fadd_s(mhat, dl); \
      _Pragma("unroll") for (int r = 0; r < 16; ++r) { P0[r] = fsub_s(P0[r], dl); P1[r] = fsub_s(P1[r], dl); } \
      if (FOX) { qone = qext_frag(-mhat, hi); } else { _Pragma("unroll") for (int r = 0; r < 16; ++r) negm[r] = -mhat; asm volatile("" : "+v"(negm)); } } \
    _Pragma("unroll") for (int r = 0; r < 16; ++r) P0[r] = __builtin_amdgcn_exp2f(P0[r]); } while (0)
#define RESC() do { if (resc) { asm volatile("s_waitcnt lgkmcnt(0)" ::: "memory"); \
      _Pragma("unroll") for (int d_ = 0; d_ < 2; ++d_) _Pragma("unroll") for (int r = 0; r < 16; ++r) o[d_][r] *= wsf[crow(r, hi)]; } } while (0)
    f32x16 pA0, pA1, pB0, pB1;
    int sl_prev = 0, sl_cur = 0, sl_next = SLOTB;
#define ROT() do { sl_prev = sl_cur; sl_cur = sl_next; sl_next = (sl_next == (NSLOT - 1) * SLOTB) ? 0 : sl_next + SLOTB; } while (0)
    DMA_K(2, 2 * SLOTB);
    WAIT_BAR(3);
    qkt(pA0, pA1, Kbase, qr, negm, r32, hi);
    if (FOX) { pA0 = __builtin_amdgcn_mfma_f32_32x32x16_bf16(bias_frag(cb0), qone, pA0, 0, 0, 0); pA1 = __builtin_amdgcn_mfma_f32_32x32x16_bf16(bias_frag(cb1), qone, pA1, 0, 0, 0);
               cb0 = bias[bofs + 64]; cb1 = bias[bofs + 96]; }
    asm volatile("s_nop 15\n\ts_nop 7" : "+v"(pA0), "+v"(pA1)); CMASK(pA0, pA1, 0);
    START(pA0, pA1);
    _Pragma("unroll") for (int r = 0; r < 16; ++r) pA1[r] = __builtin_amdgcn_exp2f(pA1[r]);
    WAIT_BAR(0);
    DMA_K(3, 0); DMA_V(1, SLOTB);
    ROT();
    kload8(kf, kp0 + sl_cur);
    WAIT_BAR(2);
    s16x4 vlo[8], vhi[8]; u32x4 pw0, pw1, pw2, pw3;
#define PKW(P, B) cvtpk(P[B], P[B + 1])
#define PAF(k) __builtin_bit_cast(bf16x8, pw##k)
#define VFR(i) (bf16x8){vlo[i][0], vlo[i][1], vlo[i][2], vlo[i][3], vhi[i][0], vhi[i][1], vhi[i][2], vhi[i][3]}
#define PIN(x) asm volatile("" : "+v"(x))
#define MX3(a, b, c) __builtin_fmaxf(__builtin_fmaxf((a), (b)), (c))
#define GAPA(MF, A0, A1, A2, A3, W0, W1, PW) do { MF; sacc += A0; sacc += A1; sacc += A2; sacc += A3; PIN(sacc); W0; W1; PIN(PW); SBAR(); } while (0)
#define EX(v) __builtin_amdgcn_exp2f(v)
#define GAPB(MF, X, B) do { MF; X[B] = EX(X[B]); X[B + 1] = EX(X[B + 1]); X[B + 2] = EX(X[B + 2]); X[B + 3] = EX(X[B + 3]); PIN(X); SBAR(); } while (0)
#define VRD(i) do { vlo[i] = vtr(vp_ + (((i) >> 2) * 4096 + ((i) & 3) * 1024)); vhi[i] = vtr(vp_ + (((i) >> 2) * 4096 + ((i) & 3) * 1024 + 512)); } while (0)
#define KRD(G, j) do { if (G) { kload2(kf, kp0 + sl_next, j); SBAR(); } } while (0)
#define STEP(C0, C1, P0, P1, t, GK, GV, GL) do { SBAR(); \
    const lds_cptr vp_ = vp0 + sl_prev; \
    VRD(0); SBAR(); float sacc = (P0[0] + P0[1]); \
    GAPA(C0 = __builtin_amdgcn_mfma_f32_32x32x16_bf16(kf[0], qr[0], negm, 0, 0, 0), P0[2], P0[3], P0[4], P0[5],     pw0[0] = PKW(P0, 0), pw0[1] = PKW(P0, 2), pw0); \
    VRD(4); SBAR(); GAPA(C1 = __builtin_amdgcn_mfma_f32_32x32x16_bf16(kf[1], qr[0], negm, 0, 0, 0), P0[6], P0[7], P0[8], P0[9],     pw0[2] = PKW(P0, 4), pw0[3] = PKW(P0, 6), pw0); \
    VRD(1); SBAR(); GAPA(C0 = __builtin_amdgcn_mfma_f32_32x32x16_bf16(kf[2], qr[1], C0, 0, 0, 0),   P0[10], P0[11], P0[12], P0[13], pw1[0] = PKW(P0, 8), pw1[1] = PKW(P0, 10), pw1); \
    VRD(5); SBAR(); GAPA(C1 = __builtin_amdgcn_mfma_f32_32x32x16_bf16(kf[3], qr[1], C1, 0, 0, 0),   P0[14], P0[15], P1[0], P1[1],   pw1[2] = PKW(P0, 12), pw1[3] = PKW(P0, 14), pw1); \
    VRD(2); SBAR(); GAPA(C0 = __builtin_amdgcn_mfma_f32_32x32x16_bf16(kf[4], qr[2], C0, 0, 0, 0),   P1[2], P1[3], P1[4], P1[5],     pw2[0] = PKW(P1, 0), pw2[1] = PKW(P1, 2), pw2); \
    VRD(6); SBAR(); GAPA(C1 = __builtin_amdgcn_mfma_f32_32x32x16_bf16(kf[5], qr[2], C1, 0, 0, 0),   P1[6], P1[7], P1[8], P1[9],     pw2[2] = PKW(P1, 4), pw2[3] = PKW(P1, 6), pw2); \
    VRD(3); SBAR(); GAPA(C0 = __builtin_amdgcn_mfma_f32_32x32x16_bf16(kf[6], qr[3], C0, 0, 0, 0),   P1[10], P1[11], P1[12], P1[13], pw3[0] = PKW(P1, 8), pw3[1] = PKW(P1, 10), pw3); \
    VRD(7); SBAR(); GAPA(C1 = __builtin_amdgcn_mfma_f32_32x32x16_bf16(kf[7], qr[3], C1, 0, 0, 0),   P1[14], P1[15], 0.f, 0.f,       pw3[2] = PKW(P1, 12), pw3[3] = PKW(P1, 14), pw3); \
    if (FOX) { const bf16x8 kb0_ = bias_frag(cb0), kb1_ = bias_frag(cb1); \
               C0 = __builtin_amdgcn_mfma_f32_32x32x16_bf16(kb0_, qone, C0, 0, 0, 0); C1 = __builtin_amdgcn_mfma_f32_32x32x16_bf16(kb1_, qone, C1, 0, 0, 0); \
               const int tn_ = ((t) + 1 < NT) ? (t) + 1 : (t); cb0 = bias[bofs + tn_ * 64]; cb1 = bias[bofs + tn_ * 64 + 32]; SBAR(); } \
    l_reg += sacc; \
    if (GK) { DMA_K((t) + 3, sl_cur); } if (GV) { DMA_V((t) + 1, sl_next); } \
    CMASK(C0, C1, t); \
    { float a = MX3(C0[0], C0[1], C1[0]), b = MX3(C0[2], C0[3], C1[1]); a = MX3(a, C1[2], C1[3]); \
      _Pragma("unroll") for (int r = 4; r < 16; r += 4) { a = MX3(a, C0[r], C0[r + 1]); b = MX3(b, C0[r + 2], C0[r + 3]); a = MX3(a, C1[r], C1[r + 1]); b = MX3(b, C1[r + 2], C1[r + 3]); } \
      float rm = __builtin_fmaxf(a, b); { auto rr = __builtin_amdgcn_permlane32_swap(__float_as_uint(rm), __float_as_uint(rm), false, false); rm = __builtin_fmaxf(__uint_as_float(rr[0]), __uint_as_float(rr[1])); } \
      resc = false; \
      if (__builtin_expect(__any(rm > (float)THRL), 0)) { const float dl = __builtin_fmaxf(rm, 0.f); mhat += dl; \
        _Pragma("unroll") for (int r = 0; r < 16; ++r) { C0[r] -= dl; C1[r] -= dl; } \
        if (FOX) { qone = qext_frag(-mhat, hi); } else { _Pragma("unroll") for (int r = 0; r < 16; ++r) negm[r] = -mhat; asm volatile("" : "+v"(negm)); } \
        const float f = __builtin_amdgcn_exp2f(-dl); l_reg *= f; if (hi == 0) wsf[r32] = f; resc = true; } } \
    SBAR(); \
    GAPB(o[0] = __builtin_amdgcn_mfma_f32_32x32x16_bf16(PAF(0), VFR(0), o[0], 0, 0, 0), C0, 0); \
    GAPB(o[1] = __builtin_amdgcn_mfma_f32_32x32x16_bf16(PAF(0), VFR(4), o[1], 0, 0, 0), C0, 4); \
    KRD(GL, 0); GAPB(o[0] = __builtin_amdgcn_mfma_f32_32x32x16_bf16(PAF(1), VFR(1), o[0], 0, 0, 0), C0, 8); \
    KRD(GL, 1); GAPB(o[1] = __builtin_amdgcn_mfma_f32_32x32x16_bf16(PAF(1), VFR(5), o[1], 0, 0, 0), C0, 12); \
    KRD(GL, 2); GAPB(o[0] = __builtin_amdgcn_mfma_f32_32x32x16_bf16(PAF(2), VFR(2), o[0], 0, 0, 0), C1, 0); \
    KRD(GL, 3); GAPB(o[1] = __builtin_amdgcn_mfma_f32_32x32x16_bf16(PAF(2), VFR(6), o[1], 0, 0, 0), C1, 4); \
    GAPB(o[0] = __builtin_amdgcn_mfma_f32_32x32x16_bf16(PAF(3), VFR(3), o[0], 0, 0, 0), C1, 8); \
    GAPB(o[1] = __builtin_amdgcn_mfma_f32_32x32x16_bf16(PAF(3), VFR(7), o[1], 0, 0, 0), C1, 12); \
    } while (0)
    int t = 1;
#undef CMASK
#define CMASK(P0, P1, t) do { } while (0)
    for (; t + 5 < NT; t += 2) {
        STEP(pB0, pB1, pA0, pA1, t, true, true, true);     WAIT_BAR(2); RESC(); ROT();
        STEP(pA0, pA1, pB0, pB1, t + 1, true, true, true); WAIT_BAR(2); RESC(); ROT();
    }
#undef CMASK
#define CMASK(P0, P1, t) do { int jb_ = (t) - (NT - 4); if (jb_ >= 0) { if (FOX) cmask(P0, P1, jb_, qrel, hi); else if (jb_ > (wid >> 1)) maskall(P0, P1); } } while (0)
#define ENDW(tt) do { if ((tt) + 3 < NT) { WAIT_BAR(2); } else if ((tt) + 2 < NT) { WAIT_BAR(1); } else { WAIT_BAR(0); } } while (0)
    for (; t + 1 < NT; t += 2) {
        STEP(pB0, pB1, pA0, pA1, t, (t + 3 < NT), (t + 1 < NT), (t + 1 < NT));         ENDW(t);     RESC(); ROT();
        STEP(pA0, pA1, pB0, pB1, t + 1, (t + 4 < NT), (t + 2 < NT), (t + 2 < NT));     ENDW(t + 1); RESC(); ROT();
    }
    STEP(pB0, pB1, pA0, pA1, NT - 1, false, false, false); RESC();
    { float sacc = pB0[0] + pB0[1]; _Pragma("unroll") for (int r = 2; r < 16; ++r) sacc += pB0[r]; _Pragma("unroll") for (int r = 0; r < 16; ++r) sacc += pB1[r]; l_reg += sacc;
      pw0 = (u32x4){PKW(pB0, 0), PKW(pB0, 2), PKW(pB0, 4), PKW(pB0, 6)}; pw1 = (u32x4){PKW(pB0, 8), PKW(pB0, 10), PKW(pB0, 12), PKW(pB0, 14)}; pw2 = (u32x4){PKW(pB1, 0), PKW(pB1, 2), PKW(pB1, 4), PKW(pB1, 6)}; pw3 = (u32x4){PKW(pB1, 8), PKW(pB1, 10), PKW(pB1, 12), PKW(pB1, 14)};
      SBAR(); pv(o, vb0 + sl_cur, PAF(0), PAF(1), PAF(2), PAF(3)); }
#undef PKW
#undef PAF
#undef VFR
#undef PIN
#undef MX3
#undef GAPA
#undef GAPB
#undef EX
#undef VRD
#undef KRD
#undef STEP
#undef ENDW
    { auto rr = __builtin_amdgcn_permlane32_swap(__float_as_uint(l_reg), __float_as_uint(l_reg), false, false); l_reg = __uint_as_float(rr[0]) + __uint_as_float(rr[1]); }
    if (hi == 0) wsf[32 + r32] = l_reg; asm volatile("s_waitcnt lgkmcnt(0)" ::: "memory");
    float rli[16];
#pragma unroll
    for (int r = 0; r < 16; ++r) rli[r] = __builtin_amdgcn_rcpf(wsf[32 + crow(r, hi)]);
    bf16_t* Ow = O + (rowbase + q0 + wid * QBLK) * OP + ocol;
    { bf16_t* stg = (bf16_t*)(shm + LDS_OST) + wid * 2048;
#pragma unroll
      for (int r = 0; r < 16; ++r) { const int orow = crow(r, hi);
#pragma unroll
        for (int d0 = 0; d0 < 2; ++d0) stg[orow * 64 + d0 * 32 + r32] = (bf16_t)f2bf(o[d0][r] * rli[r]); }
      asm volatile("s_waitcnt lgkmcnt(0)" ::: "memory");
#pragma unroll
      for (int i = 0; i < 4; ++i) { const int row = i * 8 + (lane >> 3), ch = lane & 7; const u32x4 v = *(const u32x4*)(stg + row * 64 + ch * 8); *(u32x4*)(Ow + (long)row * OP + ch * 8) = v; } }
    asm volatile("s_waitcnt lgkmcnt(0)\n\ts_barrier" ::: "memory");
#undef DMA_K
#undef DMA_V
#undef CMASK
#undef START
#undef RESC
#undef ROT
}
#undef SBAR
#undef WAIT_BAR
}

typedef GAS unsigned gu32;
#define XB_TMO      128
#define XB_XCNT(j)  (256  + 64 * (j))
#define XB_XSUB(j)  (1280 + 64 * (j))
#define XB_XGEN(j)  (2304 + 64 * (j))
#define XB_TOP      3328
#define XB_TOPGEN   3392
#define XCD_BAR_WORDS 3456
#define XB_SPIN_CAP (1u << 19)
__device__ __forceinline__ unsigned xb_ld(unsigned* p)              { return __hip_atomic_load(p, __ATOMIC_RELAXED, __HIP_MEMORY_SCOPE_AGENT); }
__device__ __forceinline__ unsigned xb_add(unsigned* p, unsigned v) { return __hip_atomic_fetch_add(p, v, __ATOMIC_RELAXED, __HIP_MEMORY_SCOPE_AGENT); }
__device__ __forceinline__ unsigned xb_xcc_id() { return (unsigned)__builtin_amdgcn_s_getreg((3 << 11) | 20) & 0xFu; }
#define XB_SPIN(cond, bar) do { unsigned _sp = 0; while (cond) { __builtin_amdgcn_s_sleep(1); \
    if ((++_sp & 255u) == 0u) { if (xb_ld(&(bar)[XB_TMO])) break; if (_sp > XB_SPIN_CAP) { atomicAdd(&(bar)[XB_TMO], 1u); break; } } } } while (0)
struct XcdBarrier { unsigned* bar; unsigned x; volatile LAS unsigned* st; };
__device__ __forceinline__ XcdBarrier xcd_barrier_post(unsigned* bar, volatile LAS unsigned* st) {
    XcdBarrier b; b.bar = bar; b.x = xb_xcc_id(); b.st = st;
    if (threadIdx.x == 0) (void)xb_add(&bar[XB_XCNT(b.x)], 1u);
    return b;
}
__device__ __forceinline__ void xcd_barrier_complete(unsigned* bar, unsigned x, unsigned& nloc, unsigned& nx) {
    const unsigned G = gridDim.x * gridDim.y * gridDim.z;
    unsigned sum, cnt, mine, sp = 0u;
    for (;;) {
        sum = 0u; cnt = 0u; mine = 0u;
#pragma unroll
        for (unsigned j = 0; j < 16; ++j) { const unsigned c = xb_ld(&bar[XB_XCNT(j)]); sum += c; cnt += (c > 0u) ? 1u : 0u; mine = (j == x) ? c : mine; }
        if (sum == G) break;
        __builtin_amdgcn_s_sleep(1);
        if ((++sp & 255u) == 0u) { if (xb_ld(&bar[XB_TMO])) break; if (sp > XB_SPIN_CAP) { atomicAdd(&bar[XB_TMO], 1u); break; } }
    }
    nloc = mine > 0u ? mine : 1u; nx = cnt > 0u ? cnt : 1u;
}
__device__ __forceinline__ void xcd_barrier(const XcdBarrier& b) {
    asm volatile("s_waitcnt vmcnt(0)" ::: "memory");
    __syncthreads();
    if (threadIdx.x == 0) {
        unsigned* bar = b.bar;
        __builtin_amdgcn_s_waitcnt(0);
        unsigned nloc = b.st[0], nx = b.st[1];
        if (nloc == 0u) { xcd_barrier_complete(bar, b.x, nloc, nx); b.st[0] = nloc; b.st[1] = nx; }
        const unsigned old = xb_add(&bar[XB_XSUB(b.x)], 1u);
        const unsigned gen = old / nloc;
        if (old + 1u == (gen + 1u) * nloc) {
            __builtin_amdgcn_fence(__ATOMIC_RELEASE, "agent");
            asm volatile("s_waitcnt vmcnt(0)" ::: "memory");
            const unsigned og = xb_add(&bar[XB_TOP], 1u);
            const unsigned tg = og / nx;
            if (og + 1u == (tg + 1u) * nx) xb_add(&bar[XB_TOPGEN], 1u);
            else XB_SPIN(xb_ld(&bar[XB_TOPGEN]) == tg, bar);
            __builtin_amdgcn_fence(__ATOMIC_ACQUIRE, "agent");
            xb_add(&bar[XB_XGEN(b.x)], 1u);
            asm volatile("s_waitcnt vmcnt(0)" ::: "memory");
        } else {
            XB_SPIN(xb_ld(&bar[XB_XGEN(b.x)]) == gen, bar);
            __builtin_amdgcn_fence(__ATOMIC_ACQUIRE, "agent");
            asm volatile("s_waitcnt vmcnt(0)" ::: "memory");
        }
    }
    __syncthreads();
}

struct Args {
    const float* in[28]; float* out; unsigned char* ws; int ph_lo, ph_hi, li, pad;
};
enum { I_X = 0, I_C, I_POS, I_WADA, I_BADA, I_GN1, I_WIN, I_BF, I_GQF, I_GKF, I_GQD, I_GKD, I_LQ1, I_LK1, I_LQ2, I_LK2, I_GSUB, I_WPF, I_WPD, I_WOUT, I_GN2, I_WRG, I_BRG, I_WRE, I_BRE, I_W1, I_W3, I_W2 };

__device__ __forceinline__ void transpose_item(const float* W, size_t ldw, int col0, int k0, bf16_t* WT, int drow, int Kd, LAS float* scr, int lane) {
#pragma unroll 8
    for (int i = 0; i < 32; ++i) { const int kk = 2 * i + (lane >> 5); scr[kk * 33 + (lane & 31)] = W[(size_t)(k0 + kk) * ldw + col0 + (lane & 31)]; }
    LDS_WAIT(); asm volatile("" ::: "memory");
    const int c = lane & 7;
#pragma unroll
    for (int j = 0; j < 4; ++j) { const int n = (lane >> 3) + 8 * j; const LAS float* s = scr + (8 * c) * 33 + n;
        u32x4 o; o.x = pk2(s[0 * 33], s[1 * 33]); o.y = pk2(s[2 * 33], s[3 * 33]); o.z = pk2(s[4 * 33], s[5 * 33]); o.w = pk2(s[6 * 33], s[7 * 33]);
        *(u32x4*)(WT + (size_t)(drow + n) * Kd + k0 + 8 * c) = o; }
    LDS_WAIT(); asm volatile("" ::: "memory");
}

__global__ void __launch_bounds__(NTHREADS, 2) fwd_kernel(Args args) {
    extern __shared__ __attribute__((aligned(16))) unsigned char lds_raw[];
    LAS unsigned char* lds = (LAS unsigned char*)lds_raw;
    volatile LAS unsigned* MISC = (volatile LAS unsigned*)(lds + MISC_OFF);
    const int tid = threadIdx.x, lane = tid & 63, wave = __builtin_amdgcn_readfirstlane(tid >> 6);
    const int G = gridDim.x; const int bx = blockIdx.x; const int vcu = (G % 8 == 0) ? (bx % 8) * (G / 8) + bx / 8 : bx;
    unsigned char* ws = args.ws;
    gu32* ctl = (gu32*)(ws + WS_CTL);
    const int gw = vcu * NWAVES + wave, NGW = G * NWAVES;

    for (int u = tid; u < (LDS_BYTES - LDSCTL_OFF) / 4; u += NTHREADS) ((LAS unsigned*)(lds + LDSCTL_OFF))[u] = 0u;
    __syncthreads();
    XcdBarrier bar; bar.bar = (unsigned*)(ctl + CW_BAR); bar.x = 0; bar.st = nullptr;
    const bool one_launch = (args.ph_hi - args.ph_lo) > 1;
    if (one_launch) bar = xcd_barrier_post((unsigned*)(ctl + CW_BAR), MISC + 8);
    const int lo = args.ph_lo, hi = args.ph_hi;
#ifdef ONLYP
#define IN(k) ((k) == ONLYP && lo <= (k) && (k) < hi)
#else
#define IN(k) (lo <= (k) && (k) < hi)
#endif
#define SEAM(k) do { if (IN(k) && IN((k) + 1)) xcd_barrier(bar); } while (0)

    float* mod = (float*)(ws + WS_MOD);
    float* logf = (float*)(ws + WS_LOGF);
    float* biasb = (float*)(ws + WS_BIAS);
    float* rope = (float*)(ws + WS_ROPE);
    bf16_t* Win_t = (bf16_t*)(ws + WS_WIN); bf16_t* Wpf_t = (bf16_t*)(ws + WS_WPF); bf16_t* Wpd_t = (bf16_t*)(ws + WS_WPD); bf16_t* Wout_t = (bf16_t*)(ws + WS_WOUT);
    bf16_t* W13_t = (bf16_t*)(ws + WS_W13); bf16_t* W2_t = (bf16_t*)(ws + WS_W2); bf16_t* Wr_t = (bf16_t*)(ws + WS_WR);
    bf16_t* H1 = (bf16_t*)(ws + WS_H1); bf16_t* OV = H1; bf16_t* H2 = H1;
    bf16_t* QF = (bf16_t*)(ws + WS_QF); bf16_t* KF = (bf16_t*)(ws + WS_KF); bf16_t* VF = (bf16_t*)(ws + WS_VF);
    bf16_t* QD = (bf16_t*)(ws + WS_QD); bf16_t* KD = (bf16_t*)(ws + WS_KD); bf16_t* VD = (bf16_t*)(ws + WS_VD);
    bf16_t* GT = (bf16_t*)(ws + WS_G); bf16_t* OD = (bf16_t*)(ws + WS_OD); bf16_t* MERGED = (bf16_t*)(ws + WS_MERGED);
    bf16_t* H2S = (bf16_t*)(ws + WS_H2S); bf16_t* YB = H2S; bf16_t* HH = (bf16_t*)(ws + WS_HH);
    float* LOGIT = (float*)(ws + WS_LOGIT);
    int* EID = (int*)(ws + WS_EID); int* RNK = (int*)(ws + WS_RNK); float* WGT = (float*)(ws + WS_WGT); int* POS = (int*)(ws + WS_POS);
    int* HIST = (int*)(ws + WS_HIST); int* MISCG = (int*)(ws + WS_MISC); int* ROWTOK = (int*)(ws + WS_ROWTOK); float* gall = (float*)(ws + WS_GALL);
    const float* x = args.in[I_X];

    for (int rep_ = 0; rep_ < 1 + ((PROBE_REP >> 0) & 1); ++rep_) if (IN(0)) {
        if (vcu < 96) {
            LAS float* sl = (LAS float*)lds;
            LAS float* red = (LAS float*)(lds + 65536);
            const float* c = args.in[I_C];
            for (int i = tid; i < 16 * 1024; i += NTHREADS) { const int b = i >> 10, k = i & 1023; const float v = c[i]; sl[k * 16 + b] = v / (1.0f + __expf(-v)); }
            __syncthreads();
            const float* wa = args.in[I_WADA] + vcu * 64 + lane;
            float a[16];
#pragma unroll
            for (int b = 0; b < 16; ++b) a[b] = 0.f;
            for (int k = wave * 128; k < wave * 128 + 128; k += 4) {
                float w[4];
#pragma unroll
                for (int q = 0; q < 4; ++q) w[q] = wa[(size_t)(k + q) * 6144];
#pragma unroll
                for (int q = 0; q < 4; ++q) {
                    const LAS f32x4* sp = (const LAS f32x4*)(sl + (k + q) * 16);
#pragma unroll
                    for (int b4 = 0; b4 < 4; ++b4) { const f32x4 s = sp[b4]; a[4 * b4 + 0] += s[0] * w[q]; a[4 * b4 + 1] += s[1] * w[q]; a[4 * b4 + 2] += s[2] * w[q]; a[4 * b4 + 3] += s[3] * w[q]; }
                }
            }
#pragma unroll
            for (int b = 0; b < 16; ++b) red[(wave * 16 + b) * 64 + lane] = a[b];
            __syncthreads();
            for (int i = tid; i < 1024; i += NTHREADS) { const int b = i >> 6, cc = i & 63; float s = 0.f;
#pragma unroll
                for (int w = 0; w < 8; ++w) s += red[(w * 16 + b) * 64 + cc];
                mod[b * 6144 + vcu * 64 + cc] = s + args.in[I_BADA][vcu * 64 + cc]; }
            __syncthreads();
        }
        if (vcu == 100 && tid < 256) gall[tid] = args.in[I_GQF + (tid >> 6)][tid & 63];
        { const int* pos = (const int*)args.in[I_POS];
          for (int i = gw * 64 + lane; i < NTOK * 32; i += NGW * 64) { const int tk = i >> 5, fi = i & 31;
              const float invf = exp2f(-(float)fi * 0.41524101186092029f);
              const float ang = (float)pos[tk] * invf;
              const double rev = (double)ang * 0.15915494309189535; const float fr_ = (float)(rev - floor(rev));
              rope[(size_t)tk * 64 + fi] = __builtin_amdgcn_cosf(fr_); rope[(size_t)tk * 64 + 32 + fi] = __builtin_amdgcn_sinf(fr_); } }
        for (int i = gw * 64 + lane; i < 256 * 1024; i += NGW * 64) { const int r = i >> 10, k = i & 1023; float v = 0.f;
            if (r < 4) v = args.in[I_WRG][k * 4 + r]; else if (r < 36) v = args.in[I_WRE][k * 32 + (r - 4)];
            Wr_t[i] = (bf16_t)f2bf(v); }
        { LAS float* scr = (LAS float*)(lds + wave * 16384);
          constexpr int I_IN = 160 * 16, I_PF = 32 * 8, I_PD = 32 * 8, I_OUT = 32 * 16, I_13 = 32 * 2 * 16 * 16, I_2 = 32 * 32 * 8;
          constexpr int NITEMS = I_IN + I_PF + I_PD + I_OUT + I_13 + I_2;
          for (int it = gw; it < NITEMS; it += NGW) {
              int r = it;
              if (r < I_IN) { const int nb = r % 160, kb = r / 160; const int pn = nb >> 3, c0 = (nb & 7) * 32, bj = c0 >> 7, wc = (c0 & 127) >> 5; int col0;
                  if (pn >= 12) col0 = COL_GATE + (pn - 12) * 256 + c0;
                  else { const int sec = pn >> 1, pl = pn & 1; const int sb = sec == 0 ? COL_FQ : sec == 1 ? COL_FK : sec == 2 ? COL_FV : sec == 3 ? COL_DQ : sec == 4 ? COL_DK : COL_DV;
                      if (sec == 2 || sec == 5) col0 = sb + pl * 256 + c0; else col0 = sb + (4 * pl + wc) * 64 + 32 * bj; }
                  transpose_item(args.in[I_WIN], IN_COLS, col0, kb * 64, Win_t, nb * 32, 1024, scr, lane); continue; } r -= I_IN;
              if (r < I_PF) { const int nb = r % 32, kb = r / 32; transpose_item(args.in[I_WPF], 1024, nb * 32, kb * 64, Wpf_t, nb * 32, 512, scr, lane); continue; } r -= I_PF;
              if (r < I_PD) { const int nb = r % 32, kb = r / 32; transpose_item(args.in[I_WPD], 1024, nb * 32, kb * 64, Wpd_t, nb * 32, 512, scr, lane); continue; } r -= I_PD;
              if (r < I_OUT) { const int nb = r % 32, kb = r / 32; transpose_item(args.in[I_WOUT], 1024, nb * 32, kb * 64, Wout_t, nb * 32, 1024, scr, lane); continue; } r -= I_OUT;
              if (r < I_13) { const int nb = r % 16, kb = (r / 16) % 16, sr = (r / 256) % 2, e = r / 512; const int n0 = nb * 32, ct = n0 >> 7;
                  transpose_item(args.in[sr ? I_W3 : I_W1] + (size_t)e * 1024 * 512, 512, n0, kb * 64, W13_t, e * 1024 + ct * 256 + 128 * sr + (n0 - ct * 128), 1024, scr, lane); continue; } r -= I_13;
              { const int nb = r % 32, kb = (r / 32) % 8, e = r / 256;
                  transpose_item(args.in[I_W2] + (size_t)e * 512 * 1024, 1024, nb * 32, kb * 64, W2_t, e * 1024 + nb * 32, 512, scr, lane); }
          } }
    }
    SEAM(0);

    for (int rep_ = 0; rep_ < 1 + ((PROBE_REP >> 1) & 1); ++rep_) if (IN(1)) {
        LAS float* wff = (LAS float*)lds;
        for (int i = tid; i < 8 * 1024; i += NTHREADS) { const int k = i >> 3, q = i & 7; wff[q * 1024 + k] = args.in[I_WIN][(size_t)k * IN_COLS + COL_FF + q]; }
        __syncthreads();
        const int b = gw >> 7;
        const float* mb = mod + (size_t)b * 6144;
        f32x4 gm[4], sh[4];
#pragma unroll
        for (int j = 0; j < 4; ++j) { const int k = 256 * j + 4 * lane; const f32x4 g = *(const f32x4*)(args.in[I_GN1] + k), sc = *(const f32x4*)(mb + 1024 + k); sh[j] = *(const f32x4*)(mb + k); gm[j] = g * (1.0f + sc); }
        const float bfv = (lane < 8) ? args.in[I_BF][lane] : 0.f;
        for (int r = 0; r < 32; ++r) {
            const int row = gw * 32 + r;
            const f32x4* xr = (const f32x4*)(x + (size_t)row * 1024) + lane;
            f32x4 v[4]; float ss = 0.f;
#pragma unroll
            for (int j = 0; j < 4; ++j) { v[j] = xr[64 * j]; ss += (v[j][0] * v[j][0] + v[j][1] * v[j][1]) + (v[j][2] * v[j][2] + v[j][3] * v[j][3]); }
            const float rstd = 1.0f / sqrtf(wave_sum(ss) * (1.0f / 1024.0f) + EPS);
            unsigned long long* o8 = (unsigned long long*)(H1 + (size_t)row * 1024) + lane;
            float zf[8];
#pragma unroll
            for (int q = 0; q < 8; ++q) zf[q] = 0.f;
#pragma unroll
            for (int j = 0; j < 4; ++j) { v[j] = v[j] * rstd * gm[j] + sh[j];
                o8[64 * j] = (unsigned long long)cvtpk(v[j][0], v[j][1]) | ((unsigned long long)cvtpk(v[j][2], v[j][3]) << 32);
#pragma unroll
                for (int q = 0; q < 8; ++q) { const f32x4 w = *(const LAS f32x4*)(wff + q * 1024 + 256 * j + 4 * lane); zf[q] += (v[j][0] * w[0] + v[j][1] * w[1]) + (v[j][2] * w[2] + v[j][3] * w[3]); } }
            float mine = 0.f;
#pragma unroll
            for (int q = 0; q < 8; ++q) { const float s = wave_sum(zf[q]); if (lane == q) mine = s; }
            if (lane < 8) { const float z = mine + bfv; const float lf = fminf(z, 0.f) - log1pf(__expf(-fabsf(z)));
                logf[(size_t)(b * 8 + lane) * SEQ + (row & (SEQ - 1))] = lf; }
        }
    }
    SEAM(1);

    for (int rep_ = 0; rep_ < 1 + ((PROBE_REP >> 2) & 1); ++rep_) if (IN(2)) {
        if (vcu < 128 && wave == 0) {
            const float* lp = logf + (size_t)vcu * SEQ + 64 * lane; float v[64]; float run = 0.f;
#pragma unroll
            for (int i = 0; i < 16; ++i) { const f32x4 q = *(const f32x4*)(lp + 4 * i); v[4 * i] = q[0]; v[4 * i + 1] = q[1]; v[4 * i + 2] = q[2]; v[4 * i + 3] = q[3]; }
#pragma unroll
            for (int i = 0; i < 64; ++i) { run += v[i]; v[i] = run; }
            float incl = run;
#pragma unroll
            for (int o = 1; o < 64; o <<= 1) { const float t = __shfl_up(incl, o); if (lane >= o) incl += t; }
            const float excl = incl - run;
            float* bp = biasb + (size_t)vcu * SEQ + 64 * lane;
#pragma unroll
            for (int i = 0; i < 16; ++i) { f32x4 q; q[0] = -(excl + v[4 * i]) * LOG2E; q[1] = -(excl + v[4 * i + 1]) * LOG2E; q[2] = -(excl + v[4 * i + 2]) * LOG2E; q[3] = -(excl + v[4 * i + 3]) * LOG2E; *(f32x4*)(bp + 4 * i) = q; }
        }
        pg8::USched S{}; S.nM = NTOK / 256; S.nN = 20; S.G = G; S.c = bx; S.pair = 0; S.K = 1024; S.nseg = 1; S.A0 = (const char*)H1; S.A1 = S.A0; S.B0 = (const char*)Win_t; S.B1 = S.B0; S.segB = 0; S.tp = nullptr; S.rowst = nullptr; S.direct = -1; S.gidx = nullptr;
        UEpi E{}; E.mode = 1; E.qkv6 = QF; E.gates = GT; E.gall = gall; E.rope = rope;
        pg8::gemm_phase<UEpi, pg8::USched>(lds, 1024, S, E);
    }
    SEAM(2);

    if (IN(3)) {
        float bound2;
        { const float gq = fabsf(args.in[I_GQF][lane]), gk = fabsf(args.in[I_GKF][lane]); const float smax = 8.0f * wave_max(gq) * wave_max(gk); bound2 = (2.0f * smax + 28.0f) * LOG2E; }
        const int grp = vcu >> 3, s8 = vcu & 7;
        for (int rep_ = 0; rep_ < 1 + ((PROBE_REP >> 20) & 1); ++rep_)
        for (int i = rep_ ? 8 : 0; i < 24; ++i) {
            const int stream = (i >> 1) * 32 + grp; const int qb = (i & 1) ? 15 - s8 : s8;
            if (G != 256) break;
#ifndef NO_FOX
            if (stream < 128) { const int b = stream >> 3, h = stream & 7;
                attn_body::attn_unit<true, 8>((long)b * SEQ, h * 64, h * 64, h * 64, 512, qb, QF, KF, VF, QF, biasb + (size_t)stream * SEQ, bound2, (char*)lds_raw);
            }
#endif
#ifndef NO_DIFF
            if (stream >= 128) { const int s2 = stream - 128; const int b = s2 >> 4, vh = s2 & 15; const int hd = vh >> 2, m = (vh >> 1) & 1, half = vh & 1;
                attn_body::attn_unit<false, 8>((long)b * SEQ, (hd * 2 + m) * 64, hd * 128 + half * 64, ((hd * 2 + m) * 2 + half) * 64, 1024, qb, QD, KD, VD, OV, biasb, 0.f, (char*)lds_raw);
            }
#endif
        }
    }
    SEAM(3);

    for (int rep_ = 0; rep_ < 1 + ((PROBE_REP >> 4) & 1); ++rep_) if (IN(4)) {
        float lam;
        { const float a = wave_sum(args.in[I_LQ1][lane] * args.in[I_LK1][lane]), c = wave_sum(args.in[I_LQ2][lane] * args.in[I_LK2][lane]); lam = __expf(a) - __expf(c) + LAM0; }
        const int hd = lane >> 4, d0 = (lane & 15) * 8;
        const f32x4 g0 = *(const f32x4*)(args.in[I_GSUB] + d0), g1 = *(const f32x4*)(args.in[I_GSUB] + d0 + 4);
        for (int row = gw; row < NTOK; row += NGW) {
            const bf16_t* op = OV + (size_t)row * 1024 + hd * 256 + d0;
            const u32x4 a = *(const u32x4*)op, c = *(const u32x4*)(op + 128);
            float d[8];
            d[0] = bf2f(a.x & 0xffffu) - lam * bf2f(c.x & 0xffffu); d[1] = bf2f(a.x >> 16) - lam * bf2f(c.x >> 16);
            d[2] = bf2f(a.y & 0xffffu) - lam * bf2f(c.y & 0xffffu); d[3] = bf2f(a.y >> 16) - lam * bf2f(c.y >> 16);
            d[4] = bf2f(a.z & 0xffffu) - lam * bf2f(c.z & 0xffffu); d[5] = bf2f(a.z >> 16) - lam * bf2f(c.z >> 16);
            d[6] = bf2f(a.w & 0xffffu) - lam * bf2f(c.w & 0xffffu); d[7] = bf2f(a.w >> 16) - lam * bf2f(c.w >> 16);
            float ss = 0.f;
#pragma unroll
            for (int e = 0; e < 8; ++e) ss += d[e] * d[e];
            ss += __shfl_xor(ss, 1); ss += __shfl_xor(ss, 2); ss += __shfl_xor(ss, 4); ss += __shfl_xor(ss, 8);
            const float rs = (1.0f - LAM0) / sqrtf(ss * (1.0f / 128.0f) + EPS);
            u32x4 w; w.x = cvtpk(d[0] * rs * g0[0], d[1] * rs * g0[1]); w.y = cvtpk(d[2] * rs * g0[2], d[3] * rs * g0[3]); w.z = cvtpk(d[4] * rs * g1[0], d[5] * rs * g1[1]); w.w = cvtpk(d[6] * rs * g1[2], d[7] * rs * g1[3]);
            *(u32x4*)(OD + (size_t)row * 512 + hd * 128 + d0) = w;
        }
    }
    SEAM(4);

    for (int rep_ = 0; rep_ < 1 + ((PROBE_REP >> 5) & 1); ++rep_) if (IN(5)) {
        pg8::USched S{}; S.nM = NTOK / 256; S.nN = 4; S.G = G; S.c = bx; S.pair = 1; S.K = 512; S.nseg = 1; S.A0 = (const char*)QF; S.A1 = (const char*)OD; S.B0 = (const char*)Wpf_t; S.B1 = (const char*)Wpd_t; S.segB = 0; S.tp = nullptr; S.rowst = nullptr; S.direct = -1; S.gidx = nullptr;
        UEpi E{}; E.mode = 2; E.gates = GT; E.merged = MERGED;
        pg8::gemm_phase<UEpi, pg8::USched>(lds, 512, S, E);
    }
    SEAM(5);

    for (int rep_ = 0; rep_ < 1 + ((PROBE_REP >> 6) & 1); ++rep_) if (IN(6)) {
        pg8::USched S{}; S.nM = NTOK / 256; S.nN = 4; S.G = G; S.c = bx; S.pair = 0; S.K = 1024; S.nseg = 1; S.A0 = (const char*)MERGED; S.A1 = S.A0; S.B0 = (const char*)Wout_t; S.B1 = S.B0; S.segB = 0; S.tp = nullptr; S.rowst = nullptr; S.direct = -1; S.gidx = nullptr;
        UEpi E{}; E.mode = 3; E.x = x; E.x1 = args.out; E.mod = mod;
        pg8::gemm_phase<UEpi, pg8::USched>(lds, 1024, S, E);
    }
    SEAM(6);

    for (int rep_ = 0; rep_ < 1 + ((PROBE_REP >> 7) & 1); ++rep_) if (IN(7)) {
        const int b = gw >> 7;
        const float* mb = mod + (size_t)b * 6144;
        f32x4 gm[4], sh[4];
#pragma unroll
        for (int j = 0; j < 4; ++j) { const int k = 256 * j + 4 * lane; const f32x4 g = *(const f32x4*)(args.in[I_GN2] + k), sc = *(const f32x4*)(mb + 4096 + k); sh[j] = *(const f32x4*)(mb + 3072 + k); gm[j] = g * (1.0f + sc); }
        for (int r = 0; r < 32; ++r) {
            const int row = gw * 32 + r;
            const f32x4* xr = (const f32x4*)(args.out + (size_t)row * 1024) + lane;
            f32x4 v[4]; float ss = 0.f;
#pragma unroll
            for (int j = 0; j < 4; ++j) { v[j] = xr[64 * j]; ss += (v[j][0] * v[j][0] + v[j][1] * v[j][1]) + (v[j][2] * v[j][2] + v[j][3] * v[j][3]); }
            const float rstd = 1.0f / sqrtf(wave_sum(ss) * (1.0f / 1024.0f) + EPS);
            unsigned long long* o8 = (unsigned long long*)(H2 + (size_t)row * 1024) + lane;
#pragma unroll
            for (int j = 0; j < 4; ++j) { v[j] = v[j] * rstd * gm[j] + sh[j];
                o8[64 * j] = (unsigned long long)cvtpk(v[j][0], v[j][1]) | ((unsigned long long)cvtpk(v[j][2], v[j][3]) << 32); }
        }
    }
    if (IN(7) && IN(8)) { VM_WAIT(); __syncthreads(); }

    for (int rep_ = 0; rep_ < 1 + ((PROBE_REP >> 8) & 1); ++rep_) if (IN(8)) {
        pg8::USched S{}; S.nM = NTOK / 256; S.nN = 1; S.G = G; S.c = bx; S.pair = 0; S.K = 1024; S.nseg = 1; S.A0 = (const char*)H2; S.A1 = S.A0; S.B0 = (const char*)Wr_t; S.B1 = S.B0; S.segB = 0; S.tp = nullptr; S.rowst = nullptr; S.direct = vcu; S.gidx = nullptr;
        UEpi E{}; E.mode = 4; E.logits = LOGIT;
        pg8::gemm_phase<UEpi, pg8::USched>(lds, 1024, S, E);
    }
    if (IN(8) && IN(9)) { VM_WAIT(); __syncthreads(); }

    for (int rep_ = 0; rep_ < 1 + ((PROBE_REP >> 9) & 1); ++rep_) if (IN(9)) {
        LAS unsigned* cnt = (LAS unsigned*)lds;
        if (tid < 32) cnt[tid] = 0u;
        __syncthreads();
        if (tid < 256) {
            const int tk = vcu * 256 + tid; const float* lp = LOGIT + (size_t)tk * 64;
            const f32x4 g = *(const f32x4*)lp;
            float gl[4]; gl[0] = g[0] + args.in[I_BRG][0]; gl[1] = g[1] + args.in[I_BRG][1]; gl[2] = g[2] + args.in[I_BRG][2]; gl[3] = g[3] + args.in[I_BRG][3];
            int gi = 0; float gmx = gl[0];
#pragma unroll
            for (int j = 1; j < 4; ++j) if (gl[j] > gmx) { gmx = gl[j]; gi = j; }
            float gs = 0.f;
#pragma unroll
            for (int j = 0; j < 4; ++j) gs += __expf(gl[j] - gmx);
            const float gwt = 1.0f / gs;
            const f32x4 e0 = *(const f32x4*)(lp + 4 + 8 * gi), e1 = *(const f32x4*)(lp + 8 + 8 * gi);
            const f32x4 b0 = *(const f32x4*)(args.in[I_BRE] + 8 * gi), b1 = *(const f32x4*)(args.in[I_BRE] + 8 * gi + 4);
            float el[8]; el[0] = e0[0] + b0[0]; el[1] = e0[1] + b0[1]; el[2] = e0[2] + b0[2]; el[3] = e0[3] + b0[3]; el[4] = e1[0] + b1[0]; el[5] = e1[1] + b1[1]; el[6] = e1[2] + b1[2]; el[7] = e1[3] + b1[3];
            int i1 = 0; float m1 = el[0];
#pragma unroll
            for (int j = 1; j < 8; ++j) if (el[j] > m1) { m1 = el[j]; i1 = j; }
            int i2 = -1; float m2 = -INFINITY;
#pragma unroll
            for (int j = 0; j < 8; ++j) if (j != i1 && el[j] > m2) { m2 = el[j]; i2 = j; }
            const float w1 = 1.0f / (1.0f + __expf(m2 - m1)); const float w2 = 1.0f - w1;
            const int ea = gi * 8 + i1, eb = gi * 8 + i2;
            const unsigned ra = atomicAdd((unsigned*)(lds_raw) + ea, 1u); const unsigned rb = atomicAdd((unsigned*)(lds_raw) + eb, 1u);
            EID[tk * 2] = ea; EID[tk * 2 + 1] = eb; RNK[tk * 2] = (int)ra; RNK[tk * 2 + 1] = (int)rb; WGT[tk * 2] = gwt * w1; WGT[tk * 2 + 1] = gwt * w2;
        }
        __syncthreads();
        if (tid < 32) HIST[vcu * 32 + tid] = (int)cnt[tid];
        __syncthreads();
    }
    SEAM(9);

    for (int rep_ = 0; rep_ < 1 + ((PROBE_REP >> 10) & 1); ++rep_) if (IN(10)) {
        LAS int* tb = (LAS int*)lds;
        if (tid < 32) { int base = 0, tot = 0; for (int b2 = 0; b2 < G; ++b2) { const int h = HIST[b2 * 32 + tid]; if (b2 < vcu) base += h; tot += h; } tb[tid] = base; tb[32 + tid] = tot; }
        __syncthreads();
        if (tid == 0) { int run = 0; for (int e = 0; e < 32; ++e) { tb[64 + e] = run; run += ((tb[32 + e] + 255) >> 8) << 8; } }
        __syncthreads();
        if (vcu == 0 && tid < 32) { MISCG[tid] = tb[32 + tid]; MISCG[32 + tid] = tb[64 + tid]; }
        { const int a = wave * 64 + lane; const int tk = vcu * 256 + (a >> 1), k = a & 1;
          const int e = EID[tk * 2 + k]; const int p = tb[64 + e] + tb[e] + RNK[tk * 2 + k];
          POS[tk * 2 + k] = p; ROWTOK[p] = tk; }
        if (vcu < 32) { const int e = vcu; const int beg = tb[64 + e] + tb[32 + e], end = tb[64 + e] + (((tb[32 + e] + 255) >> 8) << 8);
            for (int p = beg + tid; p < end; p += NTHREADS) ROWTOK[p] = 0; }
        __syncthreads();
    }
    SEAM(10);

    if (IN(11) || IN(12)) {
        LAS int* tp = (LAS int*)(lds + SCHED_OFF); LAS int* rowst = tp + 40;
        if (tid == 0) { int run = 0; for (int e = 0; e < 32; ++e) { tp[e] = run; run += (MISCG[e] + 255) >> 8; rowst[e] = MISCG[32 + e]; } tp[32] = run; }
        __syncthreads();
        const int ntile = tp[32];
        for (int rep_ = 0; rep_ < 1 + ((PROBE_REP >> 11) & 1); ++rep_) if (IN(11)) {
            pg8::USched S{}; S.nM = ntile; S.nN = 4; S.G = G; S.c = bx; S.pair = 0; S.K = 1024; S.nseg = 32; S.A0 = (const char*)H2; S.A1 = S.A0; S.B0 = (const char*)W13_t; S.B1 = S.B0; S.segB = (size_t)1024 * 1024 * 2; S.tp = tp; S.rowst = rowst; S.direct = -1;
            LAS int* gidx = (LAS int*)(lds + LDSCTL_OFF + 2048);
            S.gidx = gidx;
            { pg8::Unit u; for (int i = 0; i < 12 && S.next(i, u); ++i) if (tid < 256) gidx[i * 256 + tid] = ROWTOK[u.row0 + tid]; }
            __syncthreads();
            UEpi E{}; E.mode = 5; E.hh = HH;
            pg8::gemm_phase<UEpi, pg8::USched>(lds, 1024, S, E);
        }
        SEAM(11);
        for (int rep_ = 0; rep_ < 1 + ((PROBE_REP >> 12) & 1); ++rep_) if (IN(12)) {
            pg8::USched S{}; S.nM = ntile; S.nN = 4; S.G = G; S.c = bx; S.pair = 0; S.K = 512; S.nseg = 32; S.A0 = (const char*)HH; S.A1 = S.A0; S.B0 = (const char*)W2_t; S.B1 = S.B0; S.segB = (size_t)1024 * 512 * 2; S.tp = tp; S.rowst = rowst; S.direct = -1; S.gidx = nullptr;
            UEpi E{}; E.mode = 6; E.y = YB;
            pg8::gemm_phase<UEpi, pg8::USched>(lds, 512, S, E);
        }
    }
    SEAM(12);

    if (IN(13)) {
        for (int row = gw; row < NTOK; row += NGW) {
            const int b = row >> 12; const float* gt = mod + (size_t)b * 6144 + 5120;
            const int p0 = POS[row * 2], p1 = POS[row * 2 + 1]; const float w0 = WGT[row * 2], w1 = WGT[row * 2 + 1];
            float* orow = args.out + (size_t)row * 1024;
#pragma unroll
            for (int j = 0; j < 2; ++j) { const int k = 512 * j + 8 * lane;
                const u32x4 a = *(const u32x4*)(YB + (size_t)p0 * 1024 + k), c = *(const u32x4*)(YB + (size_t)p1 * 1024 + k);
                const f32x4 x0 = *(const f32x4*)(orow + k), x1v = *(const f32x4*)(orow + k + 4), g0 = *(const f32x4*)(gt + k), g1 = *(const f32x4*)(gt + k + 4);
                f32x4 y0, y1;
                y0[0] = w0 * bf2f(a.x & 0xffffu) + w1 * bf2f(c.x & 0xffffu); y0[1] = w0 * bf2f(a.x >> 16) + w1 * bf2f(c.x >> 16);
                y0[2] = w0 * bf2f(a.y & 0xffffu) + w1 * bf2f(c.y & 0xffffu); y0[3] = w0 * bf2f(a.y >> 16) + w1 * bf2f(c.y >> 16);
                y1[0] = w0 * bf2f(a.z & 0xffffu) + w1 * bf2f(c.z & 0xffffu); y1[1] = w0 * bf2f(a.z >> 16) + w1 * bf2f(c.z >> 16);
                y1[2] = w0 * bf2f(a.w & 0xffffu) + w1 * bf2f(c.w & 0xffffu); y1[3] = w0 * bf2f(a.w >> 16) + w1 * bf2f(c.w >> 16);
                *(f32x4*)(orow + k) = x0 + g0 * y0; *(f32x4*)(orow + k + 4) = x1v + g1 * y1; }
        }
    }
#undef IN
#undef SEAM
}

extern "C" void kernel_launch(void* const* d_in, const int* in_sizes, int n_in, void* d_out, int out_size, void* d_ws, size_t ws_size, hipStream_t stream) {
    static int grid = 0;
    if (grid == 0) {
        if (n_in != 28 || in_sizes[0] != NTOK * DMODEL || out_size != NTOK * DMODEL || ws_size < WS_END) { fprintf(stderr, "kernel_launch: unexpected shapes (n_in %d, in0 %d, out %d, ws %zu)\n", n_in, n_in > 0 ? in_sizes[0] : -1, out_size, ws_size); grid = -1; return; }
        int dev = 0, cus = 0, per_cu = 0;
        if (hipGetDevice(&dev) != hipSuccess || hipDeviceGetAttribute(&cus, hipDeviceAttributeMultiprocessorCount, dev) != hipSuccess) { grid = -1; return; }
        if (hipFuncSetAttribute((const void*)fwd_kernel, hipFuncAttributeMaxDynamicSharedMemorySize, LDS_BYTES) != hipSuccess) { fprintf(stderr, "kernel_launch: hipFuncSetAttribute failed\n"); grid = -1; return; }
        if (hipOccupancyMaxActiveBlocksPerMultiprocessor(&per_cu, (const void*)fwd_kernel, NTHREADS, LDS_BYTES) != hipSuccess || per_cu < 1) { fprintf(stderr, "kernel_launch: occupancy query says %d blocks per CU\n", per_cu); per_cu = 1; }
        (void)hipGetLastError();
        grid = cus * 1;
        if (grid != 256) fprintf(stderr, "kernel_launch: %d CUs; this kernel is laid out for 256\n", grid);
    }
    if (grid < 0) return;
    (void)hipMemsetAsync((char*)d_ws + WS_CTL, 0, CTL_ZERO_BYTES, stream);
    Args a{};
    for (int i = 0; i < 28; ++i) a.in[i] = (const float*)d_in[i];
    a.out = (float*)d_out; a.ws = (unsigned char*)d_ws;
    constexpr int NPH = 14;
    if (MK_N_LAUNCHES == 1) { a.ph_lo = 0; a.ph_hi = NPH; a.li = 0; hipLaunchKernelGGL(fwd_kernel, dim3(grid), dim3(NTHREADS), LDS_BYTES, stream, a); }
    else { for (int p = 0; p < NPH; ++p) { a.ph_lo = p; a.ph_hi = p + 1; a.li = p; hipLaunchKernelGGL(fwd_kernel, dim3(grid), dim3(NTHREADS), LDS_BYTES, stream, a); } }
}
```

```cpp
#include <hip/hip_runtime.h>
#include <cstdio>
#include <cstdint>
#include <cmath>

#ifndef MK_N_LAUNCHES
#define MK_N_LAUNCHES 1
#endif

#ifndef PROBE_REP
#define PROBE_REP 0
#endif
#define LAS __attribute__((address_space(3)))
#define GAS __attribute__((address_space(1)))
typedef unsigned short bf16_t;
typedef short bf16x8 __attribute__((ext_vector_type(8)));
typedef short s16x4 __attribute__((ext_vector_type(4)));
typedef float f32x4 __attribute__((ext_vector_type(4)));
typedef float f32x2 __attribute__((ext_vector_type(2)));
typedef float f32x16 __attribute__((ext_vector_type(16)));
typedef unsigned u32x4 __attribute__((ext_vector_type(4)));
typedef unsigned u32x2 __attribute__((ext_vector_type(2)));
typedef __bf16 bf16x2_t __attribute__((ext_vector_type(2)));

constexpr int NB = 16, SEQ = 4096, DMODEL = 1024, NTOK = NB * SEQ;
constexpr int IN_COLS = 5128, COL_FQ = 0, COL_FK = 512, COL_FV = 1024, COL_FF = 1536, COL_DQ = 1544, COL_DK = 2056, COL_DV = 2568, COL_GATE = 3080;
constexpr int NEXP = 32, DEXP = 512;
constexpr int NASSIGN = NTOK * 2;
constexpr int PADROWS = NASSIGN + NEXP * 256;
constexpr float EPS = 1e-6f;
constexpr float LOG2E = 1.4426950408889634f;
constexpr float C2 = 0.125f * LOG2E;
constexpr float LAM0 = 0.2f;

constexpr size_t MiB = 1u << 20;
constexpr size_t WS_CTL = 0, CTL_ZERO_BYTES = 1 * MiB;
constexpr size_t WS_MOD = 1 * MiB;
constexpr size_t WS_MISC = 1 * MiB + 512 * 1024;
constexpr size_t WS_GALL = 1 * MiB + 768 * 1024;
constexpr size_t WS_EID = 2 * MiB;
constexpr size_t WS_RNK = 2 * MiB + 512 * 1024;
constexpr size_t WS_WGT = 3 * MiB;
constexpr size_t WS_POS = 3 * MiB + 512 * 1024;
constexpr size_t WS_HIST = 4 * MiB;
constexpr size_t WS_ROWTOK = 4 * MiB + 256 * 1024;
constexpr size_t WS_LOGF = 5 * MiB;
constexpr size_t WS_BIAS = 7 * MiB;
constexpr size_t WS_WR = 10 * MiB;
constexpr size_t WS_LOGIT = 11 * MiB;
constexpr size_t WS_ROPE = 27 * MiB;
constexpr size_t WS_WIN = 43 * MiB;
constexpr size_t WS_WPF = 53 * MiB, WS_WPD = 54 * MiB, WS_WOUT = 55 * MiB;
constexpr size_t WS_W13 = 57 * MiB;
constexpr size_t WS_W2 = 121 * MiB;
constexpr size_t WS_H1 = 160 * MiB;
constexpr size_t WS_QF = 288 * MiB, WS_KF = 352 * MiB, WS_VF = 416 * MiB, WS_QD = 480 * MiB, WS_KD = 544 * MiB, WS_VD = 608 * MiB;
constexpr size_t WS_G = 672 * MiB;
constexpr size_t WS_OD = 928 * MiB;
constexpr size_t WS_MERGED = WS_KF;
constexpr size_t WS_H2S = WS_QD;
constexpr size_t WS_HH = 752 * MiB;
constexpr size_t WS_END = 1024 * MiB;
static_assert(WS_KF - WS_QF == 67108864 && WS_VD - WS_QF == 5 * 67108864, "six q/k/v buffers 64 MiB apart");
static_assert(WS_H2S + (size_t)PADROWS * 2048 <= WS_HH && WS_HH + (size_t)PADROWS * 1024 <= WS_OD, "ws map");

constexpr int CW_TMO = 0, CW_BAR = 4096;

constexpr int RING_BYTES = 131072, LDSCTL_OFF = RING_BYTES, MISC_OFF = LDSCTL_OFF + 320, SCHED_OFF = LDSCTL_OFF + 1024;
constexpr int LDS_BYTES = 147456;
constexpr int NWAVES = 8, NTHREADS = 512;

#define RLX_AGENT __ATOMIC_RELAXED, __HIP_MEMORY_SCOPE_AGENT
#define LDS_WAIT() asm volatile("s_waitcnt lgkmcnt(0)" ::: "memory")
#define VM_WAIT() asm volatile("s_waitcnt vmcnt(0)" ::: "memory")
__device__ __forceinline__ unsigned f2bf(float f) { unsigned u = __builtin_bit_cast(unsigned, f); return (u + 0x7fffu + ((u >> 16) & 1u)) >> 16; }
__device__ __forceinline__ unsigned pk2(float lo, float hi) { return f2bf(lo) | (f2bf(hi) << 16); }
__device__ __forceinline__ float bf2f(unsigned b) { return __builtin_bit_cast(float, b << 16); }
__device__ __forceinline__ unsigned cvtpk(float lo, float hi) { f32x2 v = {lo, hi}; bf16x2_t b = __builtin_convertvector(v, bf16x2_t); return __builtin_bit_cast(unsigned, b); }
__device__ __forceinline__ float wave_sum(float v) {
#pragma unroll
    for (int o = 1; o < 64; o <<= 1) v += __shfl_xor(v, o);
    return v;
}
__device__ __forceinline__ float wave_max(float v) {
#pragma unroll
    for (int o = 1; o < 64; o <<= 1) v = fmaxf(v, __shfl_xor(v, o));
    return v;
}
__device__ __forceinline__ float sigmoidf_(float x) { return __builtin_amdgcn_rcpf(1.0f + __builtin_amdgcn_exp2f(-LOG2E * x)); }

namespace pg8 {
constexpr int BM = 256, BK = 64, HALF = 128, HTB = HALF * BK * 2, STAGE_BYTES = 8 * HTB, NXCD = 8, WGM = 8;
__host__ __device__ __forceinline__ int lds_byte(int r, int c) { const int st = (r >> 4) * 2 + (c >> 5), rr = r & 15, cc = c & 31, ob = rr * 64 + cc * 2; return st * 1024 + (ob ^ (((ob >> 9) & 1) << 5)); }
__host__ __device__ __forceinline__ void stage_rc(int b, int& R, int& C) { const int st = b / 1024, sb = b % 1024, swz = sb ^ (((sb >> 9) & 1) << 5); R = (st >> 1) * 16 + swz / 64; C = (st & 1) * 32 + (swz % 64) / 2; }
__host__ __device__ __forceinline__ int perm32(int rho) { const int n = rho >> 4, i = rho & 15; return 8 * (i >> 2) + 4 * n + (i & 3); }

struct Unit { int row0, pn, seg, src; const char* A; const char* B; };

struct USched {
    int nM, nN, G, c, pair, K, nseg;
    const char *A0, *A1, *B0, *B1;
    size_t segB;
    const LAS int* tp;
    const LAS int* rowst;
    int direct;
    const LAS int* gidx;
    __device__ __forceinline__ bool next(int i, Unit& u) const {
        const int ii = pair ? (i >> 1) : i, src = pair ? (i & 1) : 0;
        int pm, pn;
        if (direct >= 0) { if (i > 0) return false; pm = direct; pn = 0; }
        else {
            const long L = (long)ii * G + c; const int nwg = nM * nN; if (L >= nwg) return false;
            int wgid = (int)L; { const int q = nwg / NXCD, r = nwg % NXCD, xcd = wgid % NXCD, off = wgid / NXCD; wgid = (xcd < r ? xcd * (q + 1) : r * (q + 1) + (xcd - r) * q) + off; }
            const int nig = WGM * nN, gid = wgid / nig, fm = gid * WGM, gsz = (nM - fm) < WGM ? (nM - fm) : WGM;
            pm = fm + ((wgid % nig) % gsz); pn = (wgid % nig) / gsz;
        }
        int s = 0, row0 = pm * BM;
        if (nseg > 1) { for (int j = 1; j < nseg; ++j) if (pm >= tp[j]) s = j; row0 = rowst[s] + (pm - tp[s]) * BM; }
        u.row0 = row0; u.pn = pn; u.seg = s; u.src = src;
        u.A = (src ? A1 : A0) + (gidx ? (size_t)0 : (size_t)row0 * K * 2);
        u.B = (src ? B1 : B0) + (size_t)s * segB + (size_t)pn * BM * K * 2;
        return true;
    }
    __device__ __forceinline__ unsigned a_off(int ui, int h, int R, int C) const {
        if (gidx) return (unsigned)(gidx[ui * BM + h * HALF + R] * K + C) * 2u;
        return (unsigned)((h * HALF + R) * K + C) * 2u;
    }
};

template <class Epi, class Sched>
__device__ __forceinline__ void gemm_phase(LAS unsigned char* lds, const int K, const Sched S, const Epi E) {
    int tid_ = threadIdx.x; asm volatile("" : "+v"(tid_));
    const int tid = tid_, wid = __builtin_amdgcn_readfirstlane(tid >> 6), lane = tid & 63, wr = wid >> 2, wc = wid & 3, fr = lane & 15, fq = lane >> 4;
    const int nt = K / BK;
    unsigned voffB[2]; int RA[2], CA[2];
#pragma unroll
    for (int i = 0; i < 2; ++i) { int R, C; stage_rc(tid * 16 + i * 8192, R, C); const int Rb = (R & ~31) + perm32(R & 31);
        RA[i] = R; CA[i] = C; voffB[i] = (unsigned)(Rb * K + C) * 2u; }
    unsigned vA[2][2], nvA[2][2];
#define PG8_FILL(v, ui_) do { _Pragma("unroll") for (int _h = 0; _h < 2; ++_h) _Pragma("unroll") for (int _i = 0; _i < 2; ++_i) v[_h][_i] = S.a_off(ui_, _h, RA[_i], CA[_i]); } while (0)
    const size_t kstep = (size_t)(BK * 2);
    const size_t hstep = (size_t)HALF * K * 2;
    const unsigned ldsw = (unsigned)wid * 1024u;
    const int aoff = lds_byte(wr * 64 + fr, fq * 8), boff = lds_byte(wc * 32 + fr, fq * 8);
#define PG8_SA(b, h) (((b) * 2 + (h)) * HTB)
#define PG8_SB(b, h) ((4 + (b) * 2 + (h)) * HTB)
#define PG8_STAGE(bufoff, gbase, voff) do { _Pragma("unroll") for (int _i = 0; _i < 2; ++_i) \
        __builtin_amdgcn_global_load_lds((const unsigned*)((const char*)(gbase) + (voff)[_i]), (LAS unsigned*)(lds + (bufoff) + ldsw + _i * 8192), 16, 0, 0); } while (0)
#define PG8_LDA(dst, b, h) do { _Pragma("unroll") for (int m = 0; m < 4; ++m) _Pragma("unroll") for (int k = 0; k < 2; ++k) dst[m][k] = *(const LAS bf16x8*)(lds + PG8_SA(b, h) + aoff + m * 2048 + k * 1024); } while (0)
#define PG8_LDB(dst, b, h) do { _Pragma("unroll") for (int n = 0; n < 2; ++n) _Pragma("unroll") for (int k = 0; k < 2; ++k) dst[n][k] = *(const LAS bf16x8*)(lds + PG8_SB(b, h) + boff + n * 2048 + k * 1024); } while (0)
#define PG8_MMA(ai, bj, At, Bt) do { __builtin_amdgcn_s_setprio(1); _Pragma("unroll") for (int m = 0; m < 4; ++m) _Pragma("unroll") for (int n = 0; n < 2; ++n) _Pragma("unroll") for (int k = 0; k < 2; ++k) \
        acc[ai][bj][m][n] = __builtin_amdgcn_mfma_f32_16x16x32_bf16(Bt[n][k], At[m][k], acc[ai][bj][m][n], 0, 0, 0); __builtin_amdgcn_s_setprio(0); } while (0)
#define PG8_WAIT_V(n) asm volatile("s_waitcnt vmcnt(" #n ")" ::: "memory")
#define PG8_WAIT_L(n) asm volatile("s_waitcnt lgkmcnt(" #n ")" ::: "memory")
#define PG8_BAR __builtin_amdgcn_s_barrier()
#define PG8_SCHED __builtin_amdgcn_sched_barrier(0)
    Unit cur, nxt; int ui = 0;
    if (!S.next(0, cur)) return;
    f32x4 acc[2][2][4][2];
#pragma unroll
    for (int a = 0; a < 2; ++a)
#pragma unroll
        for (int b = 0; b < 2; ++b)
#pragma unroll
            for (int m = 0; m < 4; ++m)
#pragma unroll
                for (int n = 0; n < 2; ++n) acc[a][b][m][n] = (f32x4){0.f, 0.f, 0.f, 0.f};
    bf16x8 At[4][2], B0[2][2], B1[2][2];
    const char* cA = cur.A; const char* cB = cur.B;
    PG8_FILL(vA, 0);
    PG8_STAGE(PG8_SB(0, 0), cB, voffB); PG8_STAGE(PG8_SB(0, 1), cB + hstep, voffB); PG8_STAGE(PG8_SA(0, 0), cA, vA[0]); PG8_STAGE(PG8_SA(0, 1), cA, vA[1]);
    if (wr == 1) PG8_BAR;
    PG8_WAIT_V(2); PG8_BAR;
    PG8_STAGE(PG8_SB(1, 0), cB + kstep, voffB); PG8_STAGE(PG8_SA(1, 0), cA + kstep, vA[0]); PG8_STAGE(PG8_SB(1, 1), cB + hstep + kstep, voffB);
    PG8_WAIT_V(6); PG8_BAR;
    for (;;) {
        const bool has_next = S.next(ui + 1, nxt);
        const char* nA = has_next ? nxt.A : cA; const char* nB = has_next ? nxt.B : cB;
        if (has_next) { PG8_FILL(nvA, ui + 1); } else { nvA[0][0] = vA[0][0]; nvA[0][1] = vA[0][1]; nvA[1][0] = vA[1][0]; nvA[1][1] = vA[1][1]; }
        for (int t = 0; t < nt; t += 2) {
            const bool last = (t == nt - 2);
            const char* a1 = cA + (size_t)(t + 1) * kstep;
            const char* a2 = last ? nA : cA + (size_t)(t + 2) * kstep; const char* b2 = last ? nB : cB + (size_t)(t + 2) * kstep;
            const char* a3 = a2 + kstep; const char* b3 = b2 + kstep;
            unsigned s0[2], s1[2]; s0[0] = last ? nvA[0][0] : vA[0][0]; s0[1] = last ? nvA[0][1] : vA[0][1]; s1[0] = last ? nvA[1][0] : vA[1][0]; s1[1] = last ? nvA[1][1] : vA[1][1];
            PG8_LDB(B0, 0, 0); PG8_LDB(B1, 0, 1); PG8_SCHED; PG8_LDA(At, 0, 0); PG8_STAGE(PG8_SA(1, 1), a1, vA[1]);
            PG8_WAIT_V(8); PG8_WAIT_L(0); PG8_BAR; PG8_MMA(0, 0, At, B0); PG8_MMA(0, 1, At, B1); PG8_BAR; PG8_SCHED;
            PG8_LDA(At, 0, 1); PG8_STAGE(PG8_SB(0, 0), b2, voffB); PG8_STAGE(PG8_SB(0, 1), b2 + hstep, voffB); PG8_STAGE(PG8_SA(0, 0), a2, s0);
            PG8_WAIT_V(8); PG8_WAIT_L(0); PG8_BAR; PG8_MMA(1, 0, At, B0); PG8_MMA(1, 1, At, B1); PG8_BAR; PG8_SCHED;
            PG8_LDB(B0, 1, 0); PG8_LDB(B1, 1, 1); PG8_SCHED; PG8_LDA(At, 1, 0); PG8_STAGE(PG8_SA(0, 1), a2, s1);
            PG8_WAIT_V(8); PG8_WAIT_L(0); PG8_BAR; PG8_MMA(0, 0, At, B0); PG8_MMA(0, 1, At, B1); PG8_BAR; PG8_SCHED;
            PG8_LDA(At, 1, 1); PG8_STAGE(PG8_SB(1, 0), b3, voffB); PG8_STAGE(PG8_SB(1, 1), b3 + hstep, voffB); PG8_STAGE(PG8_SA(1, 0), a3, s0);
            PG8_WAIT_V(8); PG8_WAIT_L(0); PG8_BAR; PG8_MMA(1, 0, At, B0); PG8_MMA(1, 1, At, B1); PG8_BAR; PG8_SCHED;
        }
        if (wr == 0) PG8_BAR;
        E(acc, cur, wr, wc, fr, fq);
        if (!has_next) break;
#pragma unroll
        for (int a = 0; a < 2; ++a)
#pragma unroll
            for (int b = 0; b < 2; ++b)
#pragma unroll
                for (int m = 0; m < 4; ++m)
#pragma unroll
                    for (int n = 0; n < 2; ++n) acc[a][b][m][n] = (f32x4){0.f, 0.f, 0.f, 0.f};
        cur = nxt; cA = nA; cB = nB; ++ui;
        vA[0][0] = nvA[0][0]; vA[0][1] = nvA[0][1]; vA[1][0] = nvA[1][0]; vA[1][1] = nvA[1][1];
        if (wr == 1) PG8_BAR;
    }
    PG8_WAIT_V(0);
    PG8_BAR;
#undef PG8_SA
#undef PG8_SB
#undef PG8_STAGE
#undef PG8_FILL
#undef PG8_LDA
#undef PG8_LDB
#undef PG8_MMA
#undef PG8_WAIT_V
#undef PG8_WAIT_L
#undef PG8_BAR
#undef PG8_SCHED
}
}

struct UEpi {
    int mode;
    bf16_t *qkv6, *gates; const float *gall, *rope;
    bf16_t* merged;
    const float* x; float* x1; const float* mod;
    float* logits;
    bf16_t* hh; bf16_t* y;
    __device__ __forceinline__ void operator()(const f32x4 (&acc)[2][2][4][2], const pg8::Unit& u, int wr, int wc, int fr, int fq) const {
        const int rbase = u.row0 + wr * 64 + fr;
        if (mode == 1) {
            const int pn = u.pn;
            if (pn >= 12 || pn == 4 || pn == 5 || pn == 10 || pn == 11) {
                const bool gate = pn >= 12;
                bf16_t* base; int ldc, colt;
                if (gate) { base = gates; ldc = 2048; colt = (pn - 12) * 256; }
                else { base = qkv6 + (size_t)(pn >> 1) * 33554432; ldc = 512; colt = (pn & 1) * 256; }
                const int col0 = colt + wc * 32 + 8 * fq;
#pragma unroll
                for (int ai = 0; ai < 2; ++ai)
#pragma unroll
                    for (int m = 0; m < 4; ++m) { bf16_t* rowp = base + (size_t)(rbase + ai * 128 + m * 16) * ldc + col0;
#pragma unroll
                        for (int bj = 0; bj < 2; ++bj) { f32x4 v0 = acc[ai][bj][m][0], v1 = acc[ai][bj][m][1];
                            if (gate) {
#pragma unroll
                                for (int e = 0; e < 4; ++e) { v0[e] = sigmoidf_(v0[e]); v1[e] = sigmoidf_(v1[e]); } }
                            u32x4 w; w.x = cvtpk(v0[0], v0[1]); w.y = cvtpk(v0[2], v0[3]); w.z = cvtpk(v1[0], v1[1]); w.w = cvtpk(v1[2], v1[3]);
                            *(u32x4*)(rowp + bj * 128) = w; } }
            } else {
                const int sec = pn >> 1;
                bf16_t* base = qkv6 + (size_t)sec * 33554432;
                const float* g = gall + (sec - (sec >= 3 ? 1 : 0)) * 64;
                const bool dorope = sec >= 3; const float sc = (sec == 0 || sec == 3) ? C2 : 1.0f;
                const int head = 4 * (pn & 1) + wc;
                f32x4 gv[2][2];
#pragma unroll
                for (int bj = 0; bj < 2; ++bj)
#pragma unroll
                    for (int n = 0; n < 2; ++n) { gv[bj][n] = *(const f32x4*)(g + 32 * bj + 8 * fq + 4 * n); gv[bj][n] = gv[bj][n] * sc; }
#pragma unroll
                for (int ai = 0; ai < 2; ++ai)
#pragma unroll
                    for (int m = 0; m < 4; ++m) {
                        const int row = rbase + ai * 128 + m * 16;
                        f32x4 v[2][2]; float ss = 0.f;
#pragma unroll
                        for (int bj = 0; bj < 2; ++bj)
#pragma unroll
                            for (int n = 0; n < 2; ++n) { v[bj][n] = acc[ai][bj][m][n]; const f32x4 q = v[bj][n] * v[bj][n]; ss += (q[0] + q[1]) + (q[2] + q[3]); }
                        ss += __shfl_xor(ss, 16); ss += __shfl_xor(ss, 32);
                        const float rstd = __builtin_amdgcn_rsqf(ss * (1.0f / 64.0f) + EPS);
#pragma unroll
                        for (int bj = 0; bj < 2; ++bj)
#pragma unroll
                            for (int n = 0; n < 2; ++n) v[bj][n] = v[bj][n] * rstd * gv[bj][n];
                        if (dorope) {
                            const float* rp = rope + (size_t)row * 64 + 8 * fq;
#pragma unroll
                            for (int n = 0; n < 2; ++n) { const f32x4 cs = *(const f32x4*)(rp + 4 * n), sn = *(const f32x4*)(rp + 32 + 4 * n);
                                const f32x4 x1 = v[0][n], x2 = v[1][n]; v[0][n] = x1 * cs - x2 * sn; v[1][n] = x2 * cs + x1 * sn; }
                        }
                        bf16_t* rowp = base + (size_t)row * 512 + head * 64 + 8 * fq;
#pragma unroll
                        for (int bj = 0; bj < 2; ++bj) { u32x4 w; w.x = cvtpk(v[bj][0][0], v[bj][0][1]); w.y = cvtpk(v[bj][0][2], v[bj][0][3]); w.z = cvtpk(v[bj][1][0], v[bj][1][1]); w.w = cvtpk(v[bj][1][2], v[bj][1][3]);
                            *(u32x4*)(rowp + bj * 32) = w; }
                    }
            }
        } else if (mode == 2) {
            const int col0 = u.pn * 256 + wc * 32 + 8 * fq; const int src = u.src;
#pragma unroll
            for (int ai = 0; ai < 2; ++ai)
#pragma unroll
                for (int m = 0; m < 4; ++m) { const size_t row = (size_t)(rbase + ai * 128 + m * 16);
#pragma unroll
                    for (int bj = 0; bj < 2; ++bj) { const int col = col0 + bj * 128;
                        const u32x4 gw = *(const u32x4*)(gates + row * 2048 + src * 1024 + col);
                        f32x4 v0 = acc[ai][bj][m][0], v1 = acc[ai][bj][m][1];
                        v0[0] *= bf2f(gw.x & 0xffffu); v0[1] *= bf2f(gw.x >> 16); v0[2] *= bf2f(gw.y & 0xffffu); v0[3] *= bf2f(gw.y >> 16);
                        v1[0] *= bf2f(gw.z & 0xffffu); v1[1] *= bf2f(gw.z >> 16); v1[2] *= bf2f(gw.w & 0xffffu); v1[3] *= bf2f(gw.w >> 16);
                        bf16_t* dp = merged + row * 1024 + col;
                        if (src) { const u32x4 t = *(const u32x4*)dp;
                            v0[0] += bf2f(t.x & 0xffffu); v0[1] += bf2f(t.x >> 16); v0[2] += bf2f(t.y & 0xffffu); v0[3] += bf2f(t.y >> 16);
                            v1[0] += bf2f(t.z & 0xffffu); v1[1] += bf2f(t.z >> 16); v1[2] += bf2f(t.w & 0xffffu); v1[3] += bf2f(t.w >> 16); }
                        u32x4 w; w.x = cvtpk(v0[0], v0[1]); w.y = cvtpk(v0[2], v0[3]); w.z = cvtpk(v1[0], v1[1]); w.w = cvtpk(v1[2], v1[3]);
                        *(u32x4*)dp = w; } }
        } else if (mode == 3) {
            const int col0 = u.pn * 256 + wc * 32 + 8 * fq; const int b = u.row0 >> 12;
            const float* gt = mod + (size_t)b * 6144 + 2048;
#pragma unroll
            for (int bj = 0; bj < 2; ++bj) { const int col = col0 + bj * 128; const f32x4 g0 = *(const f32x4*)(gt + col), g1 = *(const f32x4*)(gt + col + 4);
#pragma unroll
                for (int ai = 0; ai < 2; ++ai)
#pragma unroll
                    for (int m = 0; m < 4; ++m) { const size_t off = (size_t)(rbase + ai * 128 + m * 16) * 1024 + col;
                        const f32x4 x0 = *(const f32x4*)(x + off), xb = *(const f32x4*)(x + off + 4);
                        *(f32x4*)(x1 + off) = x0 + g0 * acc[ai][bj][m][0]; *(f32x4*)(x1 + off + 4) = xb + g1 * acc[ai][bj][m][1]; } }
        } else if (mode == 4) {
            if (wc < 2) { const int col = wc * 32 + 8 * fq;
#pragma unroll
                for (int ai = 0; ai < 2; ++ai)
#pragma unroll
                    for (int m = 0; m < 4; ++m) { float* dp = logits + (size_t)(rbase + ai * 128 + m * 16) * 64 + col;
                        *(f32x4*)dp = acc[ai][0][m][0]; *(f32x4*)(dp + 4) = acc[ai][0][m][1]; } }
        } else if (mode == 5) {
            const int col0 = u.pn * 128 + wc * 32 + 8 * fq;
#pragma unroll
            for (int ai = 0; ai < 2; ++ai)
#pragma unroll
                for (int m = 0; m < 4; ++m) { f32x4 h0, h1;
#pragma unroll
                    for (int e = 0; e < 4; ++e) { const float a0 = acc[ai][0][m][0][e], a1 = acc[ai][0][m][1][e];
                        h0[e] = a0 * sigmoidf_(a0) * acc[ai][1][m][0][e]; h1[e] = a1 * sigmoidf_(a1) * acc[ai][1][m][1][e]; }
                    u32x4 w; w.x = cvtpk(h0[0], h0[1]); w.y = cvtpk(h0[2], h0[3]); w.z = cvtpk(h1[0], h1[1]); w.w = cvtpk(h1[2], h1[3]);
                    *(u32x4*)(hh + (size_t)(rbase + ai * 128 + m * 16) * 512 + col0) = w; }
        } else {
            const int col0 = u.pn * 256 + wc * 32 + 8 * fq;
#pragma unroll
            for (int ai = 0; ai < 2; ++ai)
#pragma unroll
                for (int m = 0; m < 4; ++m) { bf16_t* rowp = y + (size_t)(rbase + ai * 128 + m * 16) * 1024 + col0;
#pragma unroll
                    for (int bj = 0; bj < 2; ++bj) { const f32x4 v0 = acc[ai][bj][m][0], v1 = acc[ai][bj][m][1];
                        u32x4 w; w.x = cvtpk(v0[0], v0[1]); w.y = cvtpk(v0[2], v0[3]); w.z = cvtpk(v1[0], v1[1]); w.w = cvtpk(v1[2], v1[3]);
                        *(u32x4*)(rowp + bj * 128) = w; } }
        }
    }
};

namespace attn_body {
constexpr int D = 64, DM = 512;
constexpr int NW = 8, QBLK = 32, QB = QBLK * NW, KVBLK = 64;
__device__ __forceinline__ int crow(int r, int hi) { return (r & 3) + 8 * (r >> 2) + 4 * hi; }
#define SBAR() __builtin_amdgcn_sched_barrier(0)
__device__ __forceinline__ void cmask(f32x16& p0, f32x16& p1, int jb, int qrel, int hi) {
    const float NEG = -INFINITY; int kb = 64 * jb + 4 * hi;
#pragma unroll
    for (int r = 0; r < 16; ++r) { int kv = kb + (r & 3) + 8 * (r >> 2); if (kv > qrel) p0[r] = NEG; if (kv + 32 > qrel) p1[r] = NEG; }
}
__device__ __forceinline__ void maskall(f32x16& p0, f32x16& p1) {
    const float NEG = -INFINITY;
#pragma unroll
    for (int r = 0; r < 16; ++r) { p0[r] = NEG; p1[r] = NEG; }
}
constexpr int NSLOT = 3, SLOTB = 8192;
constexpr int LDS_K = 0, LDS_V = NSLOT * SLOTB, LDS_WS = 2 * NSLOT * SLOTB, LDS_OST = LDS_WS + NW * 64 * 4, LDS_BYTES_A = LDS_OST + NW * 4096;
__device__ __forceinline__ void glds16(const void* gsrc, unsigned lds_dst) { unsigned keep;
    asm volatile("s_mov_b32 %0, m0\n\ts_mov_b32 m0, %2\n\ts_nop 0\n\tglobal_load_lds_dwordx4 %1, off\n\ts_mov_b32 m0, %0" : "=&s"(keep) : "v"(gsrc), "s"(lds_dst) : "memory"); }
__device__ __forceinline__ float max3f(float a, float b, float c) { float r; asm("v_max3_f32 %0, %1, %2, %3" : "=v"(r) : "v"(a), "v"(b), "v"(c)); return r; }
__device__ __forceinline__ float max2f(float a, float b) { float r; asm("v_max_f32_e32 %0, %1, %2" : "=v"(r) : "v"(a), "v"(b)); return r; }
__device__ __forceinline__ float fadd_s(float a, float b) { float r; asm("v_add_f32_e32 %0, %1, %2" : "=v"(r) : "v"(a), "v"(b)); return r; }
__device__ __forceinline__ float fsub_s(float a, float b) { float r; asm("v_sub_f32_e32 %0, %1, %2" : "=v"(r) : "v"(a), "v"(b)); return r; }
#define WAIT_BAR(N) asm volatile("s_waitcnt vmcnt(" #N ") lgkmcnt(0)\n\ts_barrier" ::: "memory")
typedef LAS const char* lds_cptr;
typedef short v4i16_t __attribute__((ext_vector_type(4)));
__device__ __forceinline__ void qkt(f32x16& p0, f32x16& p1, const char* Kslot, const bf16x8* qr, const f32x16& negm, int r32, int hi) {
    const char* kb = Kslot + hi * 1024 + r32 * 16;
#pragma unroll
    for (int d0 = 0; d0 < 4; ++d0) {
        const bf16x8 b0 = *reinterpret_cast<const bf16x8*>(kb + d0 * 2048);
        const bf16x8 b1 = *reinterpret_cast<const bf16x8*>(kb + d0 * 2048 + 512);
        if (d0 == 0) { p0 = __builtin_amdgcn_mfma_f32_32x32x16_bf16(b0, qr[0], negm, 0, 0, 0); p1 = __builtin_amdgcn_mfma_f32_32x32x16_bf16(b1, qr[0], negm, 0, 0, 0); }
        else { p0 = __builtin_amdgcn_mfma_f32_32x32x16_bf16(b0, qr[d0], p0, 0, 0, 0); p1 = __builtin_amdgcn_mfma_f32_32x32x16_bf16(b1, qr[d0], p1, 0, 0, 0); } }
}
__device__ __forceinline__ void kload8(bf16x8* kf, lds_cptr kp) {
    kf[0] = *(const LAS bf16x8*)(kp);        kf[1] = *(const LAS bf16x8*)(kp + 512);
    kf[2] = *(const LAS bf16x8*)(kp + 2048); kf[3] = *(const LAS bf16x8*)(kp + 2560);
    kf[4] = *(const LAS bf16x8*)(kp + 4096); kf[5] = *(const LAS bf16x8*)(kp + 4608);
    kf[6] = *(const LAS bf16x8*)(kp + 6144); kf[7] = *(const LAS bf16x8*)(kp + 6656);
}
__device__ __forceinline__ void kload2(bf16x8* kf, lds_cptr kp, int j) { kf[2 * j] = *(const LAS bf16x8*)(kp + j * 2048); kf[2 * j + 1] = *(const LAS bf16x8*)(kp + j * 2048 + 512); }
__device__ __forceinline__ s16x4 vtr(lds_cptr p) { return __builtin_bit_cast(s16x4, __builtin_amdgcn_ds_read_tr16_b64_v4i16((LAS v4i16_t*)p)); }
__device__ __forceinline__ float rowmax(const f32x16& p0, const f32x16& p1) {
    float a = max3f(p0[0], p0[1], p1[0]), b = max3f(p0[2], p0[3], p1[1]); a = max3f(a, p1[2], p1[3]);
#pragma unroll
    for (int r = 4; r < 16; r += 4) { a = max3f(a, p0[r], p0[r + 1]); b = max3f(b, p0[r + 2], p0[r + 3]); a = max3f(a, p1[r], p1[r + 1]); b = max3f(b, p1[r + 2], p1[r + 3]); }
    const float m = max2f(a, b);
    auto rr = __builtin_amdgcn_permlane32_swap(__float_as_uint(m), __float_as_uint(m), false, false);
    return max2f(__uint_as_float(rr[0]), __uint_as_float(rr[1]));
}
__device__ __forceinline__ void pv(f32x16* o, int vb, bf16x8 pa0, bf16x8 pa1, bf16x8 pa2, bf16x8 pa3) {
#pragma unroll
    for (int d0 = 0; d0 < 2; ++d0) { s16x4 lo[4], hi[4];
#pragma unroll
        for (int ks = 0; ks < 4; ++ks) {
            asm volatile("ds_read_b64_tr_b16 %0,%1 offset:%c2" : "=&v"(lo[ks]) : "v"(vb), "i"(d0 * 4096 + ks * 1024) : "memory");
            asm volatile("ds_read_b64_tr_b16 %0,%1 offset:%c2" : "=&v"(hi[ks]) : "v"(vb), "i"(d0 * 4096 + ks * 1024 + 512) : "memory"); }
        asm volatile("s_waitcnt lgkmcnt(0)" ::: "memory"); SBAR();
#define PK(k) (bf16x8){lo[k][0], lo[k][1], lo[k][2], lo[k][3], hi[k][0], hi[k][1], hi[k][2], hi[k][3]}
        o[d0] = __builtin_amdgcn_mfma_f32_32x32x16_bf16(pa0, PK(0), o[d0], 0, 0, 0);
        o[d0] = __builtin_amdgcn_mfma_f32_32x32x16_bf16(pa1, PK(1), o[d0], 0, 0, 0);
        o[d0] = __builtin_amdgcn_mfma_f32_32x32x16_bf16(pa2, PK(2), o[d0], 0, 0, 0);
        o[d0] = __builtin_amdgcn_mfma_f32_32x32x16_bf16(pa3, PK(3), o[d0], 0, 0, 0);
#undef PK
    }
}
__device__ __forceinline__ bf16x8 bias_frag(float b) {
    const unsigned u0 = cvtpk(b, 0.f) & 0xffffu; const float r1 = b - bf2f(u0);
    const unsigned u1 = cvtpk(r1, 0.f) & 0xffffu; const float r2 = r1 - bf2f(u1);
    const unsigned u2 = cvtpk(r2, 0.f) & 0xffffu;
    u32x4 w; w.x = u0 | (u1 << 16); w.y = u2 | 0x3F800000u; w.z = 0x3F803F80u; w.w = 0u; return __builtin_bit_cast(bf16x8, w);
}
__device__ __forceinline__ bf16x8 qext_frag(float nm, int hi) {
    const unsigned u0 = cvtpk(nm, 0.f) & 0xffffu; const float r1 = nm - bf2f(u0);
    const unsigned u1 = cvtpk(r1, 0.f) & 0xffffu; const float r2 = r1 - bf2f(u1);
    const unsigned u2 = cvtpk(r2, 0.f) & 0xffffu;
    u32x4 w; w.x = hi ? 0u : 0x3F803F80u; w.y = hi ? 0u : (0x3F80u | (u0 << 16)); w.z = hi ? 0u : (u1 | (u2 << 16)); w.w = 0u; return __builtin_bit_cast(bf16x8, w);
}

template <bool FOX, int THRL> __device__ __forceinline__ void attn_unit(long rowbase, int qcol, int vcol, int ocol, int OP, int qb, const bf16_t* Q, const bf16_t* __restrict__ K, const bf16_t* __restrict__ V, bf16_t* O,
                                                                         const float* __restrict__ bias, float bound2, char* shm) {
    int tid_ = threadIdx.x; asm volatile("" : "+v"(tid_));
    const int tid = tid_, lane = tid & 63, r32 = lane & 31, hi = lane >> 5; const int wid = __builtin_amdgcn_readfirstlane(tid >> 6);
    const int q0 = qb * QB;
    int NT = (q0 + QB) / KVBLK; int t0 = 0;
    if (FOX) {
        const float bq = bias[q0]; const int j = lane; float bj = 0.f; if (j < NT - 4) bj = bias[64 * j + 63];
        const unsigned long long bal = __ballot((j < NT - 4) && (bj < bq - bound2));
        t0 = __builtin_popcountll(bal) & ~1; t0 = __builtin_amdgcn_readfirstlane(t0);
        NT -= t0;
    }
    const bf16_t* Qw = Q + (rowbase + q0 + wid * QBLK) * DM + qcol;
    const bf16_t* Kh = K + (rowbase + (long)t0 * KVBLK) * DM + qcol; const bf16_t* Vh = V + (rowbase + (long)t0 * KVBLK) * DM + vcol;
    const int bofs = t0 * KVBLK + r32;
    const unsigned lds0 = (unsigned)(uintptr_t)shm;
    float* wsf = (float*)(shm + LDS_WS) + wid * 64;
    const bf16_t* ksrc = Kh + (long)lane * DM + wid * 8;
    const bf16_t* vsrc = Vh + (long)(16 * (wid & 3) + (lane >> 2)) * DM + (wid >> 2) * 32 + (lane & 3) * 8;
    const unsigned kdst = lds0 + LDS_K + wid * 1024, vdst = lds0 + LDS_V + wid * 1024;
#define DMA_K(t, slot) glds16(ksrc + (long)(t) * KVBLK * DM, (unsigned)__builtin_amdgcn_readfirstlane(kdst + (slot)))
#define DMA_V(t, slot) glds16(vsrc + (long)(t) * KVBLK * DM, (unsigned)__builtin_amdgcn_readfirstlane(vdst + (slot)))
    const int vb0 = (int)(lds0 + LDS_V) + ((lane >> 4) & 1) * 32 + (lane & 3) * 8 + (4 * hi + ((lane & 15) >> 2)) * 64;
    const char* Kbase = shm + LDS_K; bf16x8 kf[8];
    const lds_cptr shm3 = (lds_cptr)shm; const lds_cptr kp0 = shm3 + LDS_K + hi * 1024 + r32 * 16; const lds_cptr vp0 = shm3 + LDS_V + ((lane >> 4) & 1) * 32 + (lane & 3) * 8 + (4 * hi + ((lane & 15) >> 2)) * 64;
    DMA_K(0, 0); DMA_V(0, 0); DMA_K(1, SLOTB);
    bf16x8 qr[4];
#pragma unroll
    for (int d0 = 0; d0 < 4; ++d0) qr[d0] = *reinterpret_cast<const bf16x8*>(&Qw[(long)r32 * DM + d0 * 16 + hi * 8]);
    bf16x8 qone = qext_frag(0.f, hi);
    float cb0 = 0.f, cb1 = 0.f; if (FOX) { cb0 = bias[bofs]; cb1 = bias[bofs + 32]; }
    float mhat = 0.f, l_reg = 0.f; f32x16 o[2]; o[0] = f32x16{}; o[1] = f32x16{}; f32x16 negm = f32x16{}; if (!FOX) asm volatile("" : "+v"(negm));
    const int qrel = wid * QBLK + r32;
#define CMASK(P0, P1, t) do { int jb_ = (t) - (NT - 4); if (jb_ >= 0) { if (FOX) cmask(P0, P1, jb_, qrel, hi); else if (jb_ > (wid >> 1)) maskall(P0, P1); } } while (0)
    bool resc = false;
#define START(P0, P1) do { const float rm = rowmax(P0, P1); resc = false; \
    { const float dl = rm; mhat = fadd_s(mhat, dl); \
      _Pragma("unroll") for (int r = 0; r < 16; ++r) { P0[r] = fsub_s(P0[r], dl); P1[r] = fsub_s(P1[r], dl); } \
      if (FOX) { qone = qext_frag(-mhat, hi); } else { _Pragma("unroll") for (int r = 0; r < 16; ++r) negm[r] = -mhat; asm volatile("" : "+v"(negm)); } } \
    _Pragma("unroll") for (int r = 0; r < 16; ++r) P0[r] = __builtin_amdgcn_exp2f(P0[r]); } while (0)
#define RESC() do { if (resc) { asm volatile("s_waitcnt lgkmcnt(0)" ::: "memory"); \
      _Pragma("unroll") for (int d_ = 0; d_ < 2; ++d_) _Pragma("unroll") for (int r = 0; r < 16; ++r) o[d_][r] *= wsf[crow(r, hi)]; } } while (0)
    f32x16 pA0, pA1, pB0, pB1;
    int sl_prev = 0, sl_cur = 0, sl_next = SLOTB;
#define ROT() do { sl_prev = sl_cur; sl_cur = sl_next; sl_next = (sl_next == (NSLOT - 1) * SLOTB) ? 0 : sl_next + SLOTB; } while (0)
    DMA_K(2, 2 * SLOTB);
    WAIT_BAR(3);
    qkt(pA0, pA1, Kbase, qr, negm, r32, hi);
    if (FOX) { pA0 = __builtin_amdgcn_mfma_f32_32x32x16_bf16(bias_frag(cb0), qone, pA0, 0, 0, 0); pA1 = __builtin_amdgcn_mfma_f32_32x32x16_bf16(bias_frag(cb1), qone, pA1, 0, 0, 0);
               cb0 = bias[bofs + 64]; cb1 = bias[bofs + 96]; }
    asm volatile("s_nop 15\n\ts_nop 7" : "+v"(pA0), "+v"(pA1)); CMASK(pA0, pA1, 0);
    START(pA0, pA1);
    _Pragma("unroll") for (int r = 0; r < 16; ++r) pA1[r] = __builtin_amdgcn_exp2f(pA1[r]);
    WAIT_BAR(0);
    DMA_K(3, 0); DMA_V(1, SLOTB);
    ROT();
    kload8(kf, kp0 + sl_cur);
    WAIT_BAR(2);
    s16x4 vlo[8], vhi[8]; u32x4 pw0, pw1, pw2, pw3;
#define PKW(P, B) cvtpk(P[B], P[B + 1])
#define PAF(k) __builtin_bit_cast(bf16x8, pw##k)
#define VFR(i) (bf16x8){vlo[i][0], vlo[i][1], vlo[i][2], vlo[i][3], vhi[i][0], vhi[i][1], vhi[i][2], vhi[i][3]}
#define PIN(x) asm volatile("" : "+v"(x))
#define MX3(a, b, c) __builtin_fmaxf(__builtin_fmaxf((a), (b)), (c))
#define GAPA(MF, A0, A1, A2, A3, W0, W1, PW) do { MF; sacc += A0; sacc += A1; sacc += A2; sacc += A3; PIN(sacc); W0; W1; PIN(PW); SBAR(); } while (0)
#define EX(v) __builtin_amdgcn_exp2f(v)
#define GAPB(MF, X, B) do { MF; X[B] = EX(X[B]); X[B + 1] = EX(X[B + 1]); X[B + 2] = EX(X[B + 2]); X[B + 3] = EX(X[B + 3]); PIN(X); SBAR(); } while (0)
#define VRD(i) do { vlo[i] = vtr(vp_ + (((i) >> 2) * 4096 + ((i) & 3) * 1024)); vhi[i] = vtr(vp_ + (((i) >> 2) * 4096 + ((i) & 3) * 1024 + 512)); } while (0)
#define KRD(G, j) do { if (G) { kload2(kf, kp0 + sl_next, j); SBAR(); } } while (0)
#define STEP(C0, C1, P0, P1, t, GK, GV, GL) do { SBAR(); \
    const lds_cptr vp_ = vp0 + sl_prev; \
    VRD(0); SBAR(); float sacc = (P0[0] + P0[1]); \
    GAPA(C0 = __builtin_amdgcn_mfma_f32_32x32x16_bf16(kf[0], qr[0], negm, 0, 0, 0), P0[2], P0[3], P0[4], P0[5],     pw0[0] = PKW(P0, 0), pw0[1] = PKW(P0, 2), pw0); \
    VRD(4); SBAR(); GAPA(C1 = __builtin_amdgcn_mfma_f32_32x32x16_bf16(kf[1], qr[0], negm, 0, 0, 0), P0[6], P0[7], P0[8], P0[9],     pw0[2] = PKW(P0, 4), pw0[3] = PKW(P0, 6), pw0); \
    VRD(1); SBAR(); GAPA(C0 = __builtin_amdgcn_mfma_f32_32x32x16_bf16(kf[2], qr[1], C0, 0, 0, 0),   P0[10], P0[11], P0[12], P0[13], pw1[0] = PKW(P0, 8), pw1[1] = PKW(P0, 10), pw1); \
    VRD(5); SBAR(); GAPA(C1 = __builtin_amdgcn_mfma_f32_32x32x16_bf16(kf[3], qr[1], C1, 0, 0, 0),   P0[14], P0[15], P1[0], P1[1],   pw1[2] = PKW(P0, 12), pw1[3] = PKW(P0, 14), pw1); \
    VRD(2); SBAR(); GAPA(C0 = __builtin_amdgcn_mfma_f32_32x32x16_bf16(kf[4], qr[2], C0, 0, 0, 0),   P1[2], P1[3], P1[4], P1[5],     pw2[0] = PKW(P1, 0), pw2[1] = PKW(P1, 2), pw2); \
    VRD(6); SBAR(); GAPA(C1 = __builtin_amdgcn_mfma_f32_32x32x16_bf16(kf[5], qr[2], C1, 0, 0, 0),   P1[6], P1[7], P1[8], P1[9],     pw2[2] = PKW(P1, 4), pw2[3] = PKW(P1, 6), pw2); \
    VRD(3); SBAR(); GAPA(C0 = __builtin_amdgcn_mfma_f32_32x32x16_bf16(kf[6], qr[3], C0, 0, 0, 0),   P1[10], P1[11], P1[12], P1[13], pw3[0] = PKW(P1, 8), pw3[1] = PKW(P1, 10), pw3); \
    VRD(7); SBAR(); GAPA(C1 = __builtin_amdgcn_mfma_f32_32x32x16_bf16(kf[7], qr[3], C1, 0, 0, 0),   P1[14], P1[15], 0.f, 0.f,       pw3[2] = PKW(P1, 12), pw3[3] = PKW(P1, 14), pw3); \
    if (FOX) { const bf16x8 kb0_ = bias_frag(cb0), kb1_ = bias_frag(cb1); \
               C0 = __builtin_amdgcn_mfma_f32_32x32x16_bf16(kb0_, qone, C0, 0, 0, 0); C1 = __builtin_amdgcn_mfma_f32_32x32x16_bf16(kb1_, qone, C1, 0, 0, 0); \
               const int tn_ = ((t) + 1 < NT) ? (t) + 1 : (t); cb0 = bias[bofs + tn_ * 64]; cb1 = bias[bofs + tn_ * 64 + 32]; SBAR(); } \
    l_reg += sacc; \
    if (GK) { DMA_K((t) + 3, sl_cur); } if (GV) { DMA_V((t) + 1, sl_next); } \
    CMASK(C0, C1, t); \
    { float a = MX3(C0[0], C0[1], C1[0]), b = MX3(C0[2], C0[3], C1[1]); a = MX3(a, C1[2], C1[3]); \
      _Pragma("unroll") for (int r = 4; r < 16; r += 4) { a = MX3(a, C0[r], C0[r + 1]); b = MX3(b, C0[r + 2], C0[r + 3]); a = MX3(a, C1[r], C1[r + 1]); b = MX3(b, C1[r + 2], C1[r + 3]); } \
      float rm = __builtin_fmaxf(a, b); { auto rr = __builtin_amdgcn_permlane32_swap(__float_as_uint(rm), __float_as_uint(rm), false, false); rm = __builtin_fmaxf(__uint_as_float(rr[0]), __uint_as_float(rr[1])); } \
      resc = false; \
      if (__builtin_expect(__any(rm > (float)THRL), 0)) { const float dl = __builtin_fmaxf(rm, 0.f); mhat += dl; \
        _Pragma("unroll") for (int r = 0; r < 16; ++r) { C0[r] -= dl; C1[r] -= dl; } \
        if (FOX) { qone = qext_frag(-mhat, hi); } else { _Pragma("unroll") for (int r = 0; r < 16; ++r) negm[r] = -mhat; asm volatile("" : "+v"(negm)); } \
        const float f = __builtin_amdgcn_exp2f(-dl); l_reg *= f; if (hi == 0) wsf[r32] = f; resc = true; } } \
    SBAR(); \
    GAPB(o[0] = __builtin_amdgcn_mfma_f32_32x32x16_bf16(PAF(0), VFR(0), o[0], 0, 0, 0), C0, 0); \
    GAPB(o[1] = __builtin_amdgcn_mfma_f32_32x32x16_bf16(PAF(0), VFR(4), o[1], 0, 0, 0), C0, 4); \
    KRD(GL, 0); GAPB(o[0] = __builtin_amdgcn_mfma_f32_32x32x16_bf16(PAF(1), VFR(1), o[0], 0, 0, 0), C0, 8); \
    KRD(GL, 1); GAPB(o[1] = __builtin_amdgcn_mfma_f32_32x32x16_bf16(PAF(1), VFR(5), o[1], 0, 0, 0), C0, 12); \
    KRD(GL, 2); GAPB(o[0] = __builtin_amdgcn_mfma_f32_32x32x16_bf16(PAF(2), VFR(2), o[0], 0, 0, 0), C1, 0); \
    KRD(GL, 3); GAPB(o[1] = __builtin_amdgcn_mfma_f32_32x32x16_bf16(PAF(2), VFR(6), o[1], 0, 0, 0), C1, 4); \
    GAPB(o[0] = __builtin_amdgcn_mfma_f32_32x32x16_bf16(PAF(3), VFR(3), o[0], 0, 0, 0), C1, 8); \
    GAPB(o[1] = __builtin_amdgcn_mfma_f32_32x32x16_bf16(PAF(3), VFR(7), o[1], 0, 0, 0), C1, 12); \
    } while (0)
    int t = 1;
#undef CMASK
#define CMASK(P0, P1, t) do { } while (0)
    for (; t + 5 < NT; t += 2) {
        STEP(pB0, pB1, pA0, pA1, t, true, true, true);     WAIT_BAR(2); RESC(); ROT();
        STEP(pA0, pA1, pB0, pB1, t + 1, true, true, true); WAIT_BAR(2); RESC(); ROT();
    }
#undef CMASK
#define CMASK(P0, P1, t) do { int jb_ = (t) - (NT - 4); if (jb_ >= 0) { if (FOX) cmask(P0, P1, jb_, qrel, hi); else if (jb_ > (wid >> 1)) maskall(P0, P1); } } while (0)
#define ENDW(tt) do { if ((tt) + 3 < NT) { WAIT_BAR(2); } else if ((tt) + 2 < NT) { WAIT_BAR(1); } else { WAIT_BAR(0); } } while (0)
    for (; t + 1 < NT; t += 2) {
        STEP(pB0, pB1, pA0, pA1, t, (t + 3 < NT), (t + 1 < NT), (t + 1 < NT));         ENDW(t);     RESC(); ROT();
        STEP(pA0, pA1, pB0, pB1, t + 1, (t + 4 < NT), (t + 2 < NT), (t + 2 < NT));     ENDW(t + 1); RESC(); ROT();
    }
    STEP(pB0, pB1, pA0, pA1, NT - 1, false, false, false); RESC();
    { float sacc = pB0[0] + pB0[1]; _Pragma("unroll") for (int r = 2; r < 16; ++r) sacc += pB0[r]; _Pragma("unroll") for (int r = 0; r < 16; ++r) sacc += pB1[r]; l_reg += sacc;
      pw0 = (u32x4){PKW(pB0, 0), PKW(pB0, 2), PKW(pB0, 4), PKW(pB0, 6)}; pw1 = (u32x4){PKW(pB0, 8), PKW(pB0, 10), PKW(pB0, 12), PKW(pB0, 14)}; pw2 = (u32x4){PKW(pB1, 0), PKW(pB1, 2), PKW(pB1, 4), PKW(pB1, 6)}; pw3 = (u32x4){PKW(pB1, 8), PKW(pB1, 10), PKW(pB1, 12), PKW(pB1, 14)};
      SBAR(); pv(o, vb0 + sl_cur, PAF(0), PAF(1), PAF(2), PAF(3)); }
#undef PKW
#undef PAF
#undef VFR
#undef PIN
#undef MX3
#undef GAPA
#undef GAPB
#undef EX
#undef VRD
#undef KRD
#undef STEP
#undef ENDW
    { auto rr = __builtin_amdgcn_permlane32_swap(__float_as_uint(l_reg), __float_as_uint(l_reg), false, false); l_reg = __uint_as_float(rr[0]) + __uint_as_float(rr[1]); }
    if (hi == 0) wsf[32 + r32] = l_reg; asm volatile("s_waitcnt lgkmcnt(0)" ::: "memory");
    float rli[16];
#pragma unroll
    for (int r = 0; r < 16; ++r) rli[r] = __builtin_amdgcn_rcpf(wsf[32 + crow(r, hi)]);
    bf16_t* Ow = O + (rowbase + q0 + wid * QBLK) * OP + ocol;
    { bf16_t* stg = (bf16_t*)(shm + LDS_OST) + wid * 2048;
#pragma unroll
      for (int r = 0; r < 16; ++r) { const int orow = crow(r, hi);
#pragma unroll
        for (int d0 = 0; d0 < 2; ++d0) stg[orow * 64 + d0 * 32 + r32] = (bf16_t)f2bf(o[d0][r] * rli[r]); }
      asm volatile("s_waitcnt lgkmcnt(0)" ::: "memory");
#pragma unroll
      for (int i = 0; i < 4; ++i) { const int row = i * 8 + (lane >> 3), ch = lane & 7; const u32x4 v = *(const u32x4*)(stg + row * 64 + ch * 8); *(u32x4*)(Ow + (long)row * OP + ch * 8) = v; } }
    asm volatile("s_waitcnt lgkmcnt(0)\n\ts_barrier" ::: "memory");
#undef DMA_K
#undef DMA_V
#undef CMASK
#undef START
#undef RESC
#undef ROT
}

constexpr int L2_K = 0, L2_V = 3 * 8192, L2_WS = L2_V + 3 * 16384, L2_OST = L2_WS + NW * 64 * 4, LDS_BYTES_D128 = L2_OST + NW * 4096;
template <int THRL> __device__ __forceinline__ void attn_unit_d128(long rowbase, int qcol, int vcol, int ocol, int OP, int qb, const bf16_t* Q, const bf16_t* __restrict__ K, const bf16_t* __restrict__ V, bf16_t* O, char* shm) {
    int tid_ = threadIdx.x; asm volatile("" : "+v"(tid_));
    const int tid = tid_, lane = tid & 63, r32 = lane & 31, hi = lane >> 5; const int wid = __builtin_amdgcn_readfirstlane(tid >> 6);
    const int q0 = qb * QB; const int NT = (q0 + QB) / KVBLK;
    const bf16_t* Qw = Q + (rowbase + q0 + wid * QBLK) * DM + qcol;
    const bf16_t* Kh = K + rowbase * DM + qcol; const bf16_t* Vh = V + rowbase * DM + vcol;
    const unsigned lds0 = (unsigned)(uintptr_t)shm;
    float* wsf = (float*)(shm + L2_WS) + wid * 64;
    const bf16_t* ksrc = Kh + (long)lane * DM + wid * 8;
    const bf16_t* vsrc = Vh + (long)(16 * (wid & 3) + (lane >> 2)) * DM + (wid >> 2) * 32 + (lane & 3) * 8;
    const unsigned kdst = lds0 + L2_K + wid * 1024, vdst = lds0 + L2_V + wid * 1024;
#define DMA_K(t, slot) glds16(ksrc + (long)(t) * KVBLK * DM, (unsigned)__builtin_amdgcn_readfirstlane(kdst + (slot)))
#define DMA_V(t, slot) do { glds16(vsrc + (long)(t) * KVBLK * DM, (unsigned)__builtin_amdgcn_readfirstlane(vdst + 2 * (slot))); glds16(vsrc + (long)(t) * KVBLK * DM + 64, (unsigned)__builtin_amdgcn_readfirstlane(vdst + 2 * (slot) + 8192)); } while (0)
    const char* Kbase = shm + L2_K; bf16x8 kf[8];
    const lds_cptr shm3 = (lds_cptr)shm; const lds_cptr kp0 = shm3 + L2_K + hi * 1024 + r32 * 16; const lds_cptr vp0 = shm3 + L2_V + ((lane >> 4) & 1) * 32 + (lane & 3) * 8 + (4 * hi + ((lane & 15) >> 2)) * 64;
    DMA_K(0, 0); DMA_V(0, 0); DMA_K(1, SLOTB);
    bf16x8 qr[4];
#pragma unroll
    for (int d0 = 0; d0 < 4; ++d0) qr[d0] = *reinterpret_cast<const bf16x8*>(&Qw[(long)r32 * DM + d0 * 16 + hi * 8]);
    float mhat = 0.f, l_reg = 0.f; f32x16 o[4]; o[0] = f32x16{}; o[1] = f32x16{}; o[2] = f32x16{}; o[3] = f32x16{}; f32x16 negm = f32x16{}; asm volatile("" : "+v"(negm));
#define CMASK(P0, P1, t) do { int jb_ = (t) - (NT - 4); if (jb_ > (wid >> 1)) maskall(P0, P1); } while (0)
    bool resc = false;
#define RESC() do { if (resc) { asm volatile("s_waitcnt lgkmcnt(0)" ::: "memory"); \
      _Pragma("unroll") for (int d_ = 0; d_ < 4; ++d_) _Pragma("unroll") for (int r = 0; r < 16; ++r) o[d_][r] *= wsf[crow(r, hi)]; } } while (0)
    f32x16 C0, C1; u32x4 pwa0, pwa1, pwa2, pwa3, pwb0, pwb1, pwb2, pwb3;
    int sl_prev = 0, sl_cur = 0, sl_next = SLOTB;
#define ROT() do { sl_prev = sl_cur; sl_cur = sl_next; sl_next = (sl_next == (NSLOT - 1) * SLOTB) ? 0 : sl_next + SLOTB; } while (0)
    DMA_K(2, 2 * SLOTB);
    WAIT_BAR(3);
    qkt(C0, C1, Kbase, qr, negm, r32, hi);
    asm volatile("s_nop 15\n\ts_nop 7" : "+v"(C0), "+v"(C1)); CMASK(C0, C1, 0);
    { const float rm = rowmax(C0, C1); mhat = rm;
#pragma unroll
      for (int r = 0; r < 16; ++r) { C0[r] = __builtin_amdgcn_exp2f(C0[r] - rm); C1[r] = __builtin_amdgcn_exp2f(C1[r] - rm); }
#pragma unroll
      for (int r = 0; r < 16; ++r) negm[r] = -mhat;
      asm volatile("" : "+v"(negm));
      float sacc = 0.f;
#pragma unroll
      for (int r = 0; r < 16; ++r) sacc += C0[r] + C1[r];
      l_reg = sacc;
      pwa0 = (u32x4){cvtpk(C0[0], C0[1]), cvtpk(C0[2], C0[3]), cvtpk(C0[4], C0[5]), cvtpk(C0[6], C0[7])}; pwa1 = (u32x4){cvtpk(C0[8], C0[9]), cvtpk(C0[10], C0[11]), cvtpk(C0[12], C0[13]), cvtpk(C0[14], C0[15])};
      pwa2 = (u32x4){cvtpk(C1[0], C1[1]), cvtpk(C1[2], C1[3]), cvtpk(C1[4], C1[5]), cvtpk(C1[6], C1[7])}; pwa3 = (u32x4){cvtpk(C1[8], C1[9]), cvtpk(C1[10], C1[11]), cvtpk(C1[12], C1[13]), cvtpk(C1[14], C1[15])}; }
    WAIT_BAR(0);
    DMA_K(3, 0); DMA_V(1, SLOTB);
    ROT();
    kload8(kf, kp0 + sl_cur);
    WAIT_BAR(3);
    s16x4 vlo[4], vhi[4];
#define PAFX(w) __builtin_bit_cast(bf16x8, w)
#define VFR(i) (bf16x8){vlo[i][0], vlo[i][1], vlo[i][2], vlo[i][3], vhi[i][0], vhi[i][1], vhi[i][2], vhi[i][3]}
#define PIN(x) asm volatile("" : "+v"(x))
#define MX3(a, b, c) __builtin_fmaxf(__builtin_fmaxf((a), (b)), (c))
#define VRDN(i, ks, dq) do { vlo[i] = vtr(vp_ + ((dq) * 4096 + (ks) * 1024)); vhi[i] = vtr(vp_ + ((dq) * 4096 + (ks) * 1024 + 512)); } while (0)
#define KRD(G, j) do { if (G) { kload2(kf, kp0 + sl_next, j); } } while (0)
#define EXP2(X, B, W) do { X[B] = __builtin_amdgcn_exp2f(X[B]); X[B + 1] = __builtin_amdgcn_exp2f(X[B + 1]); sacc += X[B]; sacc += X[B + 1]; W = cvtpk(X[B], X[B + 1]); PIN(sacc); PIN(W); } while (0)
#define MF(a, b, c) __builtin_amdgcn_mfma_f32_32x32x16_bf16(a, b, c, 0, 0, 0)
#define STEPD(CU0, CU1, CU2, CU3, NX0, NX1, NX2, NX3, t, GK, GV, GL) do { SBAR(); \
    const lds_cptr vp_ = vp0 + 2 * sl_prev; \
    C0 = MF(kf[0], qr[0], negm); SBAR(); \
    C1 = MF(kf[1], qr[0], negm); SBAR(); \
    C0 = MF(kf[2], qr[1], C0); SBAR(); \
    C1 = MF(kf[3], qr[1], C1); SBAR(); \
    VRDN(0, 0, 0); SBAR(); C0 = MF(kf[4], qr[2], C0); SBAR(); \
    VRDN(1, 0, 1); SBAR(); C1 = MF(kf[5], qr[2], C1); SBAR(); \
    VRDN(2, 0, 2); SBAR(); C0 = MF(kf[6], qr[3], C0); SBAR(); \
    VRDN(3, 0, 3); SBAR(); C1 = MF(kf[7], qr[3], C1); SBAR(); \
    if (GK) { DMA_K((t) + 3, sl_cur); } if (GV) { DMA_V((t) + 1, sl_next); } \
    CMASK(C0, C1, t); \
    { float a = MX3(C0[0], C0[1], C1[0]), b = MX3(C0[2], C0[3], C1[1]); a = MX3(a, C1[2], C1[3]); \
      _Pragma("unroll") for (int r = 4; r < 16; r += 4) { a = MX3(a, C0[r], C0[r + 1]); b = MX3(b, C0[r + 2], C0[r + 3]); a = MX3(a, C1[r], C1[r + 1]); b = MX3(b, C1[r + 2], C1[r + 3]); } \
      float rm = __builtin_fmaxf(a, b); { auto rr = __builtin_amdgcn_permlane32_swap(__float_as_uint(rm), __float_as_uint(rm), false, false); rm = __builtin_fmaxf(__uint_as_float(rr[0]), __uint_as_float(rr[1])); } \
      resc = false; \
      if (__builtin_expect(__any(rm > (float)THRL), 0)) { const float dl = __builtin_fmaxf(rm, 0.f); mhat += dl; \
        _Pragma("unroll") for (int r = 0; r < 16; ++r) { C0[r] -= dl; C1[r] -= dl; } \
        _Pragma("unroll") for (int r = 0; r < 16; ++r) negm[r] = -mhat; asm volatile("" : "+v"(negm)); \
        const float f = __builtin_amdgcn_exp2f(-dl); l_reg *= f; if (hi == 0) wsf[r32] = f; resc = true; } } \
    float sacc = 0.f; \
    SBAR(); \
    o[0] = MF(PAFX(CU0), VFR(0), o[0]); VRDN(0, 1, 0); EXP2(C0, 0, NX0[0]); SBAR(); \
    o[1] = MF(PAFX(CU0), VFR(1), o[1]); VRDN(1, 1, 1); EXP2(C0, 2, NX0[1]); SBAR(); \
    o[2] = MF(PAFX(CU0), VFR(2), o[2]); VRDN(2, 1, 2); EXP2(C0, 4, NX0[2]); SBAR(); \
    o[3] = MF(PAFX(CU0), VFR(3), o[3]); VRDN(3, 1, 3); EXP2(C0, 6, NX0[3]); SBAR(); \
    o[0] = MF(PAFX(CU1), VFR(0), o[0]); VRDN(0, 2, 0); EXP2(C0, 8, NX1[0]); SBAR(); \
    o[1] = MF(PAFX(CU1), VFR(1), o[1]); VRDN(1, 2, 1); EXP2(C0, 10, NX1[1]); SBAR(); \
    o[2] = MF(PAFX(CU1), VFR(2), o[2]); VRDN(2, 2, 2); EXP2(C0, 12, NX1[2]); SBAR(); \
    o[3] = MF(PAFX(CU1), VFR(3), o[3]); VRDN(3, 2, 3); EXP2(C0, 14, NX1[3]); SBAR(); \
    o[0] = MF(PAFX(CU2), VFR(0), o[0]); VRDN(0, 3, 0); EXP2(C1, 0, NX2[0]); SBAR(); \
    o[1] = MF(PAFX(CU2), VFR(1), o[1]); VRDN(1, 3, 1); EXP2(C1, 2, NX2[1]); SBAR(); \
    o[2] = MF(PAFX(CU2), VFR(2), o[2]); VRDN(2, 3, 2); EXP2(C1, 4, NX2[2]); SBAR(); \
    o[3] = MF(PAFX(CU2), VFR(3), o[3]); VRDN(3, 3, 3); EXP2(C1, 6, NX2[3]); SBAR(); \
    KRD(GL, 0); o[0] = MF(PAFX(CU3), VFR(0), o[0]); EXP2(C1, 8, NX3[0]); SBAR(); \
    KRD(GL, 1); o[1] = MF(PAFX(CU3), VFR(1), o[1]); EXP2(C1, 10, NX3[1]); SBAR(); \
    KRD(GL, 2); o[2] = MF(PAFX(CU3), VFR(2), o[2]); EXP2(C1, 12, NX3[2]); SBAR(); \
    KRD(GL, 3); o[3] = MF(PAFX(CU3), VFR(3), o[3]); EXP2(C1, 14, NX3[3]); SBAR(); \
    l_reg += sacc; \
    } while (0)
#define STEP_AB(t, GK, GV, GL) STEPD(pwa0, pwa1, pwa2, pwa3, pwb0, pwb1, pwb2, pwb3, t, GK, GV, GL)
#define STEP_BA(t, GK, GV, GL) STEPD(pwb0, pwb1, pwb2, pwb3, pwa0, pwa1, pwa2, pwa3, t, GK, GV, GL)
    int t = 1;
#undef CMASK
#define CMASK(P0, P1, t) do { } while (0)
    for (; t + 5 < NT; t += 2) {
        STEP_AB(t, true, true, true);     WAIT_BAR(3); RESC(); ROT();
        STEP_BA(t + 1, true, true, true); WAIT_BAR(3); RESC(); ROT();
    }
#undef CMASK
#define CMASK(P0, P1, t) do { int jb_ = (t) - (NT - 4); if (jb_ > (wid >> 1)) maskall(P0, P1); } while (0)
#define ENDW(tt) do { if ((tt) + 3 < NT) { WAIT_BAR(3); } else if ((tt) + 2 < NT) { WAIT_BAR(2); } else { WAIT_BAR(0); } } while (0)
    for (; t + 1 < NT; t += 2) {
        STEP_AB(t, (t + 3 < NT), (t + 1 < NT), (t + 1 < NT));         ENDW(t);     RESC(); ROT();
        STEP_BA(t + 1, (t + 4 < NT), (t + 2 < NT), (t + 2 < NT));     ENDW(t + 1); RESC(); ROT();
    }
    STEP_AB(NT - 1, false, false, false); RESC();
    { const lds_cptr vp_ = vp0 + 2 * sl_cur; SBAR();
#pragma unroll
      for (int ks = 0; ks < 4; ++ks) {
          const bf16x8 pa = ks == 0 ? PAFX(pwb0) : ks == 1 ? PAFX(pwb1) : ks == 2 ? PAFX(pwb2) : PAFX(pwb3);
#pragma unroll
          for (int dq = 0; dq < 4; ++dq) { const s16x4 lo = vtr(vp_ + (dq * 4096 + ks * 1024)), hh = vtr(vp_ + (dq * 4096 + ks * 1024 + 512));
              const bf16x8 vf = (bf16x8){lo[0], lo[1], lo[2], lo[3], hh[0], hh[1], hh[2], hh[3]}; o[dq] = MF(pa, vf, o[dq]); } } }
#undef PAFX
#undef VFR
#undef PIN
#undef MX3
#undef VRDN
#undef KRD
#undef EXP2
#undef MF
#undef STEPD
#undef STEP_AB
#undef STEP_BA
#undef ENDW
    { auto rr = __builtin_amdgcn_permlane32_swap(__float_as_uint(l_reg), __float_as_uint(l_reg), false, false); l_reg = __uint_as_float(rr[0]) + __uint_as_float(rr[1]); }
    if (hi == 0) wsf[32 + r32] = l_reg; asm volatile("s_waitcnt lgkmcnt(0)" ::: "memory");
    float rli[16];
#pragma unroll
    for (int r = 0; r < 16; ++r) rli[r] = __builtin_amdgcn_rcpf(wsf[32 + crow(r, hi)]);
    bf16_t* Ow = O + (rowbase + q0 + wid * QBLK) * OP + ocol;
    bf16_t* stg = (bf16_t*)(shm + L2_OST) + wid * 2048;
#pragma unroll
    for (int p = 0; p < 2; ++p) {
#pragma unroll
        for (int r = 0; r < 16; ++r) { const int orow = crow(r, hi);
#pragma unroll
            for (int dd = 0; dd < 2; ++dd) stg[orow * 64 + dd * 32 + r32] = (bf16_t)f2bf(o[2 * p + dd][r] * rli[r]); }
        asm volatile("s_waitcnt lgkmcnt(0)" ::: "memory");
#pragma unroll
        for (int i = 0; i < 4; ++i) { const int row = i * 8 + (lane >> 3), ch = lane & 7; const u32x4 v = *(const u32x4*)(stg + row * 64 + ch * 8); *(u32x4*)(Ow + (long)row * OP + p * 64 + ch * 8) = v; }
        asm volatile("s_waitcnt lgkmcnt(0)" ::: "memory");
    }
    asm volatile("s_waitcnt lgkmcnt(0)\n\ts_barrier" ::: "memory");
#undef DMA_K
#undef DMA_V
#undef CMASK
#undef RESC
#undef ROT
}
#undef SBAR
#undef WAIT_BAR
}

typedef GAS unsigned gu32;
#define XB_TMO      128
#define XB_XCNT(j)  (256  + 64 * (j))
#define XB_XSUB(j)  (1280 + 64 * (j))
#define XB_XGEN(j)  (2304 + 64 * (j))
#define XB_TOP      3328
#define XB_TOPGEN   3392
#define XCD_BAR_WORDS 3456
#define XB_SPIN_CAP (1u << 19)
__device__ __forceinline__ unsigned xb_ld(unsigned* p)              { return __hip_atomic_load(p, __ATOMIC_RELAXED, __HIP_MEMORY_SCOPE_AGENT); }
__device__ __forceinline__ unsigned xb_add(unsigned* p, unsigned v) { return __hip_atomic_fetch_add(p, v, __ATOMIC_RELAXED, __HIP_MEMORY_SCOPE_AGENT); }
__device__ __forceinline__ unsigned xb_xcc_id() { return (unsigned)__builtin_amdgcn_s_getreg((3 << 11) | 20) & 0xFu; }
#define XB_SPIN(cond, bar) do { unsigned _sp = 0; while (cond) { __builtin_amdgcn_s_sleep(1); \
    if ((++_sp & 255u) == 0u) { if (xb_ld(&(bar)[XB_TMO])) break; if (_sp > XB_SPIN_CAP) { atomicAdd(&(bar)[XB_TMO], 1u); break; } } } } while (0)
struct XcdBarrier { unsigned* bar; unsigned x; volatile LAS unsigned* st; };
__device__ __forceinline__ XcdBarrier xcd_barrier_post(unsigned* bar, volatile LAS unsigned* st) {
    XcdBarrier b; b.bar = bar; b.x = xb_xcc_id(); b.st = st;
    if (threadIdx.x == 0) (void)xb_add(&bar[XB_XCNT(b.x)], 1u);
    return b;
}
__device__ __forceinline__ void xcd_barrier_complete(unsigned* bar, unsigned x, unsigned& nloc, unsigned& nx) {
    const unsigned G = gridDim.x * gridDim.y * gridDim.z;
    unsigned sum, cnt, mine, sp = 0u;
    for (;;) {
        sum = 0u; cnt = 0u; mine = 0u;
#pragma unroll
        for (unsigned j = 0; j < 16; ++j) { const unsigned c = xb_ld(&bar[XB_XCNT(j)]); sum += c; cnt += (c > 0u) ? 1u : 0u; mine = (j == x) ? c : mine; }
        if (sum == G) break;
        __builtin_amdgcn_s_sleep(1);
        if ((++sp & 255u) == 0u) { if (xb_ld(&bar[XB_TMO])) break; if (sp > XB_SPIN_CAP) { atomicAdd(&bar[XB_TMO], 1u); break; } }
    }
    nloc = mine > 0u ? mine : 1u; nx = cnt > 0u ? cnt : 1u;
}
__device__ __forceinline__ void xcd_barrier(const XcdBarrier& b) {
    asm volatile("s_waitcnt vmcnt(0)" ::: "memory");
    __syncthreads();
    if (threadIdx.x == 0) {
        unsigned* bar = b.bar;
        __builtin_amdgcn_s_waitcnt(0);
        unsigned nloc = b.st[0], nx = b.st[1];
        if (nloc == 0u) { xcd_barrier_complete(bar, b.x, nloc, nx); b.st[0] = nloc; b.st[1] = nx; }
        const unsigned old = xb_add(&bar[XB_XSUB(b.x)], 1u);
        const unsigned gen = old / nloc;
        if (old + 1u == (gen + 1u) * nloc) {
            __builtin_amdgcn_fence(__ATOMIC_RELEASE, "agent");
            asm volatile("s_waitcnt vmcnt(0)" ::: "memory");
            const unsigned og = xb_add(&bar[XB_TOP], 1u);
            const unsigned tg = og / nx;
            if (og + 1u == (tg + 1u) * nx) xb_add(&bar[XB_TOPGEN], 1u);
            else XB_SPIN(xb_ld(&bar[XB_TOPGEN]) == tg, bar);
            __builtin_amdgcn_fence(__ATOMIC_ACQUIRE, "agent");
            xb_add(&bar[XB_XGEN(b.x)], 1u);
            asm volatile("s_waitcnt vmcnt(0)" ::: "memory");
        } else {
            XB_SPIN(xb_ld(&bar[XB_XGEN(b.x)]) == gen, bar);
            __builtin_amdgcn_fence(__ATOMIC_ACQUIRE, "agent");
            asm volatile("s_waitcnt vmcnt(0)" ::: "memory");
        }
    }
    __syncthreads();
}

struct Args {
    const float* in[28]; float* out; unsigned char* ws; int ph_lo, ph_hi, li, pad;
};
enum { I_X = 0, I_C, I_POS, I_WADA, I_BADA, I_GN1, I_WIN, I_BF, I_GQF, I_GKF, I_GQD, I_GKD, I_LQ1, I_LK1, I_LQ2, I_LK2, I_GSUB, I_WPF, I_WPD, I_WOUT, I_GN2, I_WRG, I_BRG, I_WRE, I_BRE, I_W1, I_W3, I_W2 };

__device__ __forceinline__ void transpose_item(const float* W, size_t ldw, int col0, int k0, bf16_t* WT, int drow, int Kd, LAS float* scr, int lane) {
#pragma unroll 8
    for (int i = 0; i < 32; ++i) { const int kk = 2 * i + (lane >> 5); scr[kk * 33 + (lane & 31)] = W[(size_t)(k0 + kk) * ldw + col0 + (lane & 31)]; }
    LDS_WAIT(); asm volatile("" ::: "memory");
    const int c = lane & 7;
#pragma unroll
    for (int j = 0; j < 4; ++j) { const int n = (lane >> 3) + 8 * j; const LAS float* s = scr + (8 * c) * 33 + n;
        u32x4 o; o.x = pk2(s[0 * 33], s[1 * 33]); o.y = pk2(s[2 * 33], s[3 * 33]); o.z = pk2(s[4 * 33], s[5 * 33]); o.w = pk2(s[6 * 33], s[7 * 33]);
        *(u32x4*)(WT + (size_t)(drow + n) * Kd + k0 + 8 * c) = o; }
    LDS_WAIT(); asm volatile("" ::: "memory");
}

__global__ void __launch_bounds__(NTHREADS, 2) fwd_kernel(Args args) {
    extern __shared__ __attribute__((aligned(16))) unsigned char lds_raw[];
    LAS unsigned char* lds = (LAS unsigned char*)lds_raw;
    volatile LAS unsigned* MISC = (volatile LAS unsigned*)(lds + MISC_OFF);
    const int tid = threadIdx.x, lane = tid & 63, wave = __builtin_amdgcn_readfirstlane(tid >> 6);
    const int G = gridDim.x; const int bx = blockIdx.x; const int vcu = (G % 8 == 0) ? (bx % 8) * (G / 8) + bx / 8 : bx;
    unsigned char* ws = args.ws;
    gu32* ctl = (gu32*)(ws + WS_CTL);
    const int gw = vcu * NWAVES + wave, NGW = G * NWAVES;

    for (int u = tid; u < (LDS_BYTES - LDSCTL_OFF) / 4; u += NTHREADS) ((LAS unsigned*)(lds + LDSCTL_OFF))[u] = 0u;
    __syncthreads();
    XcdBarrier bar; bar.bar = (unsigned*)(ctl + CW_BAR); bar.x = 0; bar.st = nullptr;
    const bool one_launch = (args.ph_hi - args.ph_lo) > 1;
    if (one_launch) bar = xcd_barrier_post((unsigned*)(ctl + CW_BAR), MISC + 8);
    const int lo = args.ph_lo, hi = args.ph_hi;
#ifdef ONLYP
#define IN(k) ((k) == ONLYP && lo <= (k) && (k) < hi)
#else
#define IN(k) (lo <= (k) && (k) < hi)
#endif
#define SEAM(k) do { if (IN(k) && IN((k) + 1)) xcd_barrier(bar); } while (0)

    float* mod = (float*)(ws + WS_MOD);
    float* logf = (float*)(ws + WS_LOGF);
    float* biasb = (float*)(ws + WS_BIAS);
    float* rope = (float*)(ws + WS_ROPE);
    bf16_t* Win_t = (bf16_t*)(ws + WS_WIN); bf16_t* Wpf_t = (bf16_t*)(ws + WS_WPF); bf16_t* Wpd_t = (bf16_t*)(ws + WS_WPD); bf16_t* Wout_t = (bf16_t*)(ws + WS_WOUT);
    bf16_t* W13_t = (bf16_t*)(ws + WS_W13); bf16_t* W2_t = (bf16_t*)(ws + WS_W2); bf16_t* Wr_t = (bf16_t*)(ws + WS_WR);
    bf16_t* H1 = (bf16_t*)(ws + WS_H1); bf16_t* OV = H1; bf16_t* H2 = H1;
    bf16_t* QF = (bf16_t*)(ws + WS_QF); bf16_t* KF = (bf16_t*)(ws + WS_KF); bf16_t* VF = (bf16_t*)(ws + WS_VF);
    bf16_t* QD = (bf16_t*)(ws + WS_QD); bf16_t* KD = (bf16_t*)(ws + WS_KD); bf16_t* VD = (bf16_t*)(ws + WS_VD);
    bf16_t* GT = (bf16_t*)(ws + WS_G); bf16_t* OD = (bf16_t*)(ws + WS_OD); bf16_t* MERGED = (bf16_t*)(ws + WS_MERGED);
    bf16_t* H2S = (bf16_t*)(ws + WS_H2S); bf16_t* YB = H2S; bf16_t* HH = (bf16_t*)(ws + WS_HH);
    float* LOGIT = (float*)(ws + WS_LOGIT);
    int* EID = (int*)(ws + WS_EID); int* RNK = (int*)(ws + WS_RNK); float* WGT = (float*)(ws + WS_WGT); int* POS = (int*)(ws + WS_POS);
    int* HIST = (int*)(ws + WS_HIST); int* MISCG = (int*)(ws + WS_MISC); int* ROWTOK = (int*)(ws + WS_ROWTOK); float* gall = (float*)(ws + WS_GALL);
    const float* x = args.in[I_X];

    for (int rep_ = 0; rep_ < 1 + ((PROBE_REP >> 0) & 1); ++rep_) if (IN(0)) {
        if (vcu < 96) {
            LAS float* sl = (LAS float*)lds;
            LAS float* red = (LAS float*)(lds + 65536);
            const float* c = args.in[I_C];
            for (int i = tid; i < 16 * 1024; i += NTHREADS) { const int b = i >> 10, k = i & 1023; const float v = c[i]; sl[k * 16 + b] = v / (1.0f + __expf(-v)); }
            __syncthreads();
            const float* wa = args.in[I_WADA] + vcu * 64 + lane;
            float a[16];
#pragma unroll
            for (int b = 0; b < 16; ++b) a[b] = 0.f;
            for (int k = wave * 128; k < wave * 128 + 128; k += 4) {
                float w[4];
#pragma unroll
                for (int q = 0; q < 4; ++q) w[q] = wa[(size_t)(k + q) * 6144];
#pragma unroll
                for (int q = 0; q < 4; ++q) {
                    const LAS f32x4* sp = (const LAS f32x4*)(sl + (k + q) * 16);
#pragma unroll
                    for (int b4 = 0; b4 < 4; ++b4) { const f32x4 s = sp[b4]; a[4 * b4 + 0] += s[0] * w[q]; a[4 * b4 + 1] += s[1] * w[q]; a[4 * b4 + 2] += s[2] * w[q]; a[4 * b4 + 3] += s[3] * w[q]; }
                }
            }
#pragma unroll
            for (int b = 0; b < 16; ++b) red[(wave * 16 + b) * 64 + lane] = a[b];
            __syncthreads();
            for (int i = tid; i < 1024; i += NTHREADS) { const int b = i >> 6, cc = i & 63; float s = 0.f;
#pragma unroll
                for (int w = 0; w < 8; ++w) s += red[(w * 16 + b) * 64 + cc];
                mod[b * 6144 + vcu * 64 + cc] = s + args.in[I_BADA][vcu * 64 + cc]; }
            __syncthreads();
        }
        if (vcu == 100 && tid < 256) gall[tid] = args.in[I_GQF + (tid >> 6)][tid & 63];
        { const int* pos = (const int*)args.in[I_POS];
          for (int i = gw * 64 + lane; i < NTOK * 32; i += NGW * 64) { const int tk = i >> 5, fi = i & 31;
              const float invf = exp2f(-(float)fi * 0.41524101186092029f);
              const float ang = (float)pos[tk] * invf;
              const double rev = (double)ang * 0.15915494309189535; const float fr_ = (float)(rev - floor(rev));
              rope[(size_t)tk * 64 + fi] = __builtin_amdgcn_cosf(fr_); rope[(size_t)tk * 64 + 32 + fi] = __builtin_amdgcn_sinf(fr_); } }
        for (int i = gw * 64 + lane; i < 256 * 1024; i += NGW * 64) { const int r = i >> 10, k = i & 1023; float v = 0.f;
            if (r < 4) v = args.in[I_WRG][k * 4 + r]; else if (r < 36) v = args.in[I_WRE][k * 32 + (r - 4)];
            Wr_t[i] = (bf16_t)f2bf(v); }
        { LAS float* scr = (LAS float*)(lds + wave * 16384);
          constexpr int I_IN = 160 * 16, I_PF = 32 * 8, I_PD = 32 * 8, I_OUT = 32 * 16, I_13 = 32 * 2 * 16 * 16, I_2 = 32 * 32 * 8;
          constexpr int NITEMS = I_IN + I_PF + I_PD + I_OUT + I_13 + I_2;
          for (int it = gw; it < NITEMS; it += NGW) {
              int r = it;
              if (r < I_IN) { const int nb = r % 160, kb = r / 160; const int pn = nb >> 3, c0 = (nb & 7) * 32, bj = c0 >> 7, wc = (c0 & 127) >> 5; int col0;
                  if (pn >= 12) col0 = COL_GATE + (pn - 12) * 256 + c0;
                  else { const int sec = pn >> 1, pl = pn & 1; const int sb = sec == 0 ? COL_FQ : sec == 1 ? COL_FK : sec == 2 ? COL_FV : sec == 3 ? COL_DQ : sec == 4 ? COL_DK : COL_DV;
                      if (sec == 2 || sec == 5) col0 = sb + pl * 256 + c0; else col0 = sb + (4 * pl + wc) * 64 + 32 * bj; }
                  transpose_item(args.in[I_WIN], IN_COLS, col0, kb * 64, Win_t, nb * 32, 1024, scr, lane); continue; } r -= I_IN;
              if (r < I_PF) { const int nb = r % 32, kb = r / 32; transpose_item(args.in[I_WPF], 1024, nb * 32, kb * 64, Wpf_t, nb * 32, 512, scr, lane); continue; } r -= I_PF;
              if (r < I_PD) { const int nb = r % 32, kb = r / 32; transpose_item(args.in[I_WPD], 1024, nb * 32, kb * 64, Wpd_t, nb * 32, 512, scr, lane); continue; } r -= I_PD;
              if (r < I_OUT) { const int nb = r % 32, kb = r / 32; transpose_item(args.in[I_WOUT], 1024, nb * 32, kb * 64, Wout_t, nb * 32, 1024, scr, lane); continue; } r -= I_OUT;
              if (r < I_13) { const int nb = r % 16, kb = (r / 16) % 16, sr = (r / 256) % 2, e = r / 512; const int n0 = nb * 32, ct = n0 >> 7;
                  transpose_item(args.in[sr ? I_W3 : I_W1] + (size_t)e * 1024 * 512, 512, n0, kb * 64, W13_t, e * 1024 + ct * 256 + 128 * sr + (n0 - ct * 128), 1024, scr, lane); continue; } r -= I_13;
              { const int nb = r % 32, kb = (r / 32) % 8, e = r / 256;
                  transpose_item(args.in[I_W2] + (size_t)e * 512 * 1024, 1024, nb * 32, kb * 64, W2_t, e * 1024 + nb * 32, 512, scr, lane); }
          } }
    }
    SEAM(0);

    for (int rep_ = 0; rep_ < 1 + ((PROBE_REP >> 1) & 1); ++rep_) if (IN(1)) {
        LAS float* wff = (LAS float*)lds;
        for (int i = tid; i < 8 * 1024; i += NTHREADS) { const int k = i >> 3, q = i & 7; wff[q * 1024 + k] = args.in[I_WIN][(size_t)k * IN_COLS + COL_FF + q]; }
        __syncthreads();
        const int b = gw >> 7;
        const float* mb = mod + (size_t)b * 6144;
        f32x4 gm[4], sh[4];
#pragma unroll
        for (int j = 0; j < 4; ++j) { const int k = 256 * j + 4 * lane; const f32x4 g = *(const f32x4*)(args.in[I_GN1] + k), sc = *(const f32x4*)(mb + 1024 + k); sh[j] = *(const f32x4*)(mb + k); gm[j] = g * (1.0f + sc); }
        const float bfv = (lane < 8) ? args.in[I_BF][lane] : 0.f;
        for (int r = 0; r < 32; ++r) {
            const int row = gw * 32 + r;
            const f32x4* xr = (const f32x4*)(x + (size_t)row * 1024) + lane;
            f32x4 v[4]; float ss = 0.f;
#pragma unroll
            for (int j = 0; j < 4; ++j) { v[j] = xr[64 * j]; ss += (v[j][0] * v[j][0] + v[j][1] * v[j][1]) + (v[j][2] * v[j][2] + v[j][3] * v[j][3]); }
            const float rstd = 1.0f / sqrtf(wave_sum(ss) * (1.0f / 1024.0f) + EPS);
            unsigned long long* o8 = (unsigned long long*)(H1 + (size_t)row * 1024) + lane;
            float zf[8];
#pragma unroll
            for (int q = 0; q < 8; ++q) zf[q] = 0.f;
#pragma unroll
            for (int j = 0; j < 4; ++j) { v[j] = v[j] * rstd * gm[j] + sh[j];
                o8[64 * j] = (unsigned long long)cvtpk(v[j][0], v[j][1]) | ((unsigned long long)cvtpk(v[j][2], v[j][3]) << 32);
#pragma unroll
                for (int q = 0; q < 8; ++q) { const f32x4 w = *(const LAS f32x4*)(wff + q * 1024 + 256 * j + 4 * lane); zf[q] += (v[j][0] * w[0] + v[j][1] * w[1]) + (v[j][2] * w[2] + v[j][3] * w[3]); } }
            float mine = 0.f;
#pragma unroll
            for (int q = 0; q < 8; ++q) { const float s = wave_sum(zf[q]); if (lane == q) mine = s; }
            if (lane < 8) { const float z = mine + bfv; const float lf = fminf(z, 0.f) - log1pf(__expf(-fabsf(z)));
                logf[(size_t)(b * 8 + lane) * SEQ + (row & (SEQ - 1))] = lf; }
        }
    }
    SEAM(1);

    for (int rep_ = 0; rep_ < 1 + ((PROBE_REP >> 2) & 1); ++rep_) if (IN(2)) {
        if (vcu < 128 && wave == 0) {
            const float* lp = logf + (size_t)vcu * SEQ + 64 * lane; float v[64]; float run = 0.f;
#pragma unroll
            for (int i = 0; i < 16; ++i) { const f32x4 q = *(const f32x4*)(lp + 4 * i); v[4 * i] = q[0]; v[4 * i + 1] = q[1]; v[4 * i + 2] = q[2]; v[4 * i + 3] = q[3]; }
#pragma unroll
            for (int i = 0; i < 64; ++i) { run += v[i]; v[i] = run; }
            float incl = run;
#pragma unroll
            for (int o = 1; o < 64; o <<= 1) { const float t = __shfl_up(incl, o); if (lane >= o) incl += t; }
            const float excl = incl - run;
            float* bp = biasb + (size_t)vcu * SEQ + 64 * lane;
#pragma unroll
            for (int i = 0; i < 16; ++i) { f32x4 q; q[0] = -(excl + v[4 * i]) * LOG2E; q[1] = -(excl + v[4 * i + 1]) * LOG2E; q[2] = -(excl + v[4 * i + 2]) * LOG2E; q[3] = -(excl + v[4 * i + 3]) * LOG2E; *(f32x4*)(bp + 4 * i) = q; }
        }
        pg8::USched S{}; S.nM = NTOK / 256; S.nN = 20; S.G = G; S.c = bx; S.pair = 0; S.K = 1024; S.nseg = 1; S.A0 = (const char*)H1; S.A1 = S.A0; S.B0 = (const char*)Win_t; S.B1 = S.B0; S.segB = 0; S.tp = nullptr; S.rowst = nullptr; S.direct = -1; S.gidx = nullptr;
        UEpi E{}; E.mode = 1; E.qkv6 = QF; E.gates = GT; E.gall = gall; E.rope = rope;
        pg8::gemm_phase<UEpi, pg8::USched>(lds, 1024, S, E);
    }
    SEAM(2);

    if (IN(3)) {
        float bound2;
        { const float gq = fabsf(args.in[I_GQF][lane]), gk = fabsf(args.in[I_GKF][lane]); const float smax = 8.0f * wave_max(gq) * wave_max(gk); bound2 = (2.0f * smax + 28.0f) * LOG2E; }
        const int grp = vcu >> 3, s8 = vcu & 7;
        for (int rep_ = 0; rep_ < 1 + ((PROBE_REP >> 20) & 1); ++rep_)
        for (int i = rep_ ? 8 : 0; i < 16; ++i) {
            const int stream = (i >> 1) * 32 + grp; const int qb = (i & 1) ? 15 - s8 : s8;
            if (G != 256) break;
#ifndef NO_FOX
            if (stream < 128) { const int b = stream >> 3, h = stream & 7;
                attn_body::attn_unit<true, 8>((long)b * SEQ, h * 64, h * 64, h * 64, 512, qb, QF, KF, VF, QF, biasb + (size_t)stream * SEQ, bound2, (char*)lds_raw);
            }
#endif
#ifndef NO_DIFF
            if (stream >= 128) { const int s2 = stream - 128; const int b = s2 >> 3, hm = s2 & 7; const int hd = hm >> 1;
                attn_body::attn_unit_d128<8>((long)b * SEQ, hm * 64, hd * 128, hm * 128, 1024, qb, QD, KD, VD, OV, (char*)lds_raw);
            }
#endif
        }
    }
    SEAM(3);

    for (int rep_ = 0; rep_ < 1 + ((PROBE_REP >> 4) & 1); ++rep_) if (IN(4)) {
        float lam;
        { const float a = wave_sum(args.in[I_LQ1][lane] * args.in[I_LK1][lane]), c = wave_sum(args.in[I_LQ2][lane] * args.in[I_LK2][lane]); lam = __expf(a) - __expf(c) + LAM0; }
        const int hd = lane >> 4, d0 = (lane & 15) * 8;
        const f32x4 g0 = *(const f32x4*)(args.in[I_GSUB] + d0), g1 = *(const f32x4*)(args.in[I_GSUB] + d0 + 4);
        for (int row = gw; row < NTOK; row += NGW) {
            const bf16_t* op = OV + (size_t)row * 1024 + hd * 256 + d0;
            const u32x4 a = *(const u32x4*)op, c = *(const u32x4*)(op + 128);
            float d[8];
            d[0] = bf2f(a.x & 0xffffu) - lam * bf2f(c.x & 0xffffu); d[1] = bf2f(a.x >> 16) - lam * bf2f(c.x >> 16);
            d[2] = bf2f(a.y & 0xffffu) - lam * bf2f(c.y & 0xffffu); d[3] = bf2f(a.y >> 16) - lam * bf2f(c.y >> 16);
            d[4] = bf2f(a.z & 0xffffu) - lam * bf2f(c.z & 0xffffu); d[5] = bf2f(a.z >> 16) - lam * bf2f(c.z >> 16);
            d[6] = bf2f(a.w & 0xffffu) - lam * bf2f(c.w & 0xffffu); d[7] = bf2f(a.w >> 16) - lam * bf2f(c.w >> 16);
            float ss = 0.f;
#pragma unroll
            for (int e = 0; e < 8; ++e) ss += d[e] * d[e];
            ss += __shfl_xor(ss, 1); ss += __shfl_xor(ss, 2); ss += __shfl_xor(ss, 4); ss += __shfl_xor(ss, 8);
            const float rs = (1.0f - LAM0) / sqrtf(ss * (1.0f / 128.0f) + EPS);
            u32x4 w; w.x = cvtpk(d[0] * rs * g0[0], d[1] * rs * g0[1]); w.y = cvtpk(d[2] * rs * g0[2], d[3] * rs * g0[3]); w.z = cvtpk(d[4] * rs * g1[0], d[5] * rs * g1[1]); w.w = cvtpk(d[6] * rs * g1[2], d[7] * rs * g1[3]);
            *(u32x4*)(OD + (size_t)row * 512 + hd * 128 + d0) = w;
        }
    }
    SEAM(4);

    for (int rep_ = 0; rep_ < 1 + ((PROBE_REP >> 5) & 1); ++rep_) if (IN(5)) {
        pg8::USched S{}; S.nM = NTOK / 256; S.nN = 4; S.G = G; S.c = bx; S.pair = 1; S.K = 512; S.nseg = 1; S.A0 = (const char*)QF; S.A1 = (const char*)OD; S.B0 = (const char*)Wpf_t; S.B1 = (const char*)Wpd_t; S.segB = 0; S.tp = nullptr; S.rowst = nullptr; S.direct = -1; S.gidx = nullptr;
        UEpi E{}; E.mode = 2; E.gates = GT; E.merged = MERGED;
        pg8::gemm_phase<UEpi, pg8::USched>(lds, 512, S, E);
    }
    SEAM(5);

    for (int rep_ = 0; rep_ < 1 + ((PROBE_REP >> 6) & 1); ++rep_) if (IN(6)) {
        pg8::USched S{}; S.nM = NTOK / 256; S.nN = 4; S.G = G; S.c = bx; S.pair = 0; S.K = 1024; S.nseg = 1; S.A0 = (const char*)MERGED; S.A1 = S.A0; S.B0 = (const char*)Wout_t; S.B1 = S.B0; S.segB = 0; S.tp = nullptr; S.rowst = nullptr; S.direct = -1; S.gidx = nullptr;
        UEpi E{}; E.mode = 3; E.x = x; E.x1 = args.out; E.mod = mod;
        pg8::gemm_phase<UEpi, pg8::USched>(lds, 1024, S, E);
    }
    SEAM(6);

    for (int rep_ = 0; rep_ < 1 + ((PROBE_REP >> 7) & 1); ++rep_) if (IN(7)) {
        const int b = gw >> 7;
        const float* mb = mod + (size_t)b * 6144;
        f32x4 gm[4], sh[4];
#pragma unroll
        for (int j = 0; j < 4; ++j) { const int k = 256 * j + 4 * lane; const f32x4 g = *(const f32x4*)(args.in[I_GN2] + k), sc = *(const f32x4*)(mb + 4096 + k); sh[j] = *(const f32x4*)(mb + 3072 + k); gm[j] = g * (1.0f + sc); }
        for (int r = 0; r < 32; ++r) {
            const int row = gw * 32 + r;
            const f32x4* xr = (const f32x4*)(args.out + (size_t)row * 1024) + lane;
            f32x4 v[4]; float ss = 0.f;
#pragma unroll
            for (int j = 0; j < 4; ++j) { v[j] = xr[64 * j]; ss += (v[j][0] * v[j][0] + v[j][1] * v[j][1]) + (v[j][2] * v[j][2] + v[j][3] * v[j][3]); }
            const float rstd = 1.0f / sqrtf(wave_sum(ss) * (1.0f / 1024.0f) + EPS);
            unsigned long long* o8 = (unsigned long long*)(H2 + (size_t)row * 1024) + lane;
#pragma unroll
            for (int j = 0; j < 4; ++j) { v[j] = v[j] * rstd * gm[j] + sh[j];
                o8[64 * j] = (unsigned long long)cvtpk(v[j][0], v[j][1]) | ((unsigned long long)cvtpk(v[j][2], v[j][3]) << 32); }
        }
    }
    if (IN(7) && IN(8)) { VM_WAIT(); __syncthreads(); }

    for (int rep_ = 0; rep_ < 1 + ((PROBE_REP >> 8) & 1); ++rep_) if (IN(8)) {
        pg8::USched S{}; S.nM = NTOK / 256; S.nN = 1; S.G = G; S.c = bx; S.pair = 0; S.K = 1024; S.nseg = 1; S.A0 = (const char*)H2; S.A1 = S.A0; S.B0 = (const char*)Wr_t; S.B1 = S.B0; S.segB = 0; S.tp = nullptr; S.rowst = nullptr; S.direct = vcu; S.gidx = nullptr;
        UEpi E{}; E.mode = 4; E.logits = LOGIT;
        pg8::gemm_phase<UEpi, pg8::USched>(lds, 1024, S, E);
    }
    if (IN(8) && IN(9)) { VM_WAIT(); __syncthreads(); }

    for (int rep_ = 0; rep_ < 1 + ((PROBE_REP >> 9) & 1); ++rep_) if (IN(9)) {
        LAS unsigned* cnt = (LAS unsigned*)lds;
        if (tid < 32) cnt[tid] = 0u;
        __syncthreads();
        if (tid < 256) {
            const int tk = vcu * 256 + tid; const float* lp = LOGIT + (size_t)tk * 64;
            const f32x4 g = *(const f32x4*)lp;
            float gl[4]; gl[0] = g[0] + args.in[I_BRG][0]; gl[1] = g[1] + args.in[I_BRG][1]; gl[2] = g[2] + args.in[I_BRG][2]; gl[3] = g[3] + args.in[I_BRG][3];
            int gi = 0; float gmx = gl[0];
#pragma unroll
            for (int j = 1; j < 4; ++j) if (gl[j] > gmx) { gmx = gl[j]; gi = j; }
            float gs = 0.f;
#pragma unroll
            for (int j = 0; j < 4; ++j) gs += __expf(gl[j] - gmx);
            const float gwt = 1.0f / gs;
            const f32x4 e0 = *(const f32x4*)(lp + 4 + 8 * gi), e1 = *(const f32x4*)(lp + 8 + 8 * gi);
            const f32x4 b0 = *(const f32x4*)(args.in[I_BRE] + 8 * gi), b1 = *(const f32x4*)(args.in[I_BRE] + 8 * gi + 4);
            float el[8]; el[0] = e0[0] + b0[0]; el[1] = e0[1] + b0[1]; el[2] = e0[2] + b0[2]; el[3] = e0[3] + b0[3]; el[4] = e1[0] + b1[0]; el[5] = e1[1] + b1[1]; el[6] = e1[2] + b1[2]; el[7] = e1[3] + b1[3];
            int i1 = 0; float m1 = el[0];
#pragma unroll
            for (int j = 1; j < 8; ++j) if (el[j] > m1) { m1 = el[j]; i1 = j; }
            int i2 = -1; float m2 = -INFINITY;
#pragma unroll
            for (int j = 0; j < 8; ++j) if (j != i1 && el[j] > m2) { m2 = el[j]; i2 = j; }
            const float w1 = 1.0f / (1.0f + __expf(m2 - m1)); const float w2 = 1.0f - w1;
            const int ea = gi * 8 + i1, eb = gi * 8 + i2;
            const unsigned ra = atomicAdd((unsigned*)(lds_raw) + ea, 1u); const unsigned rb = atomicAdd((unsigned*)(lds_raw) + eb, 1u);
            EID[tk * 2] = ea; EID[tk * 2 + 1] = eb; RNK[tk * 2] = (int)ra; RNK[tk * 2 + 1] = (int)rb; WGT[tk * 2] = gwt * w1; WGT[tk * 2 + 1] = gwt * w2;
        }
        __syncthreads();
        if (tid < 32) HIST[vcu * 32 + tid] = (int)cnt[tid];
        __syncthreads();
    }
    SEAM(9);

    for (int rep_ = 0; rep_ < 1 + ((PROBE_REP >> 10) & 1); ++rep_) if (IN(10)) {
        LAS int* tb = (LAS int*)lds;
        if (tid < 32) { int base = 0, tot = 0; for (int b2 = 0; b2 < G; ++b2) { const int h = HIST[b2 * 32 + tid]; if (b2 < vcu) base += h; tot += h; } tb[tid] = base; tb[32 + tid] = tot; }
        __syncthreads();
        if (tid == 0) { int run = 0; for (int e = 0; e < 32; ++e) { tb[64 + e] = run; run += ((tb[32 + e] + 255) >> 8) << 8; } }
        __syncthreads();
        if (vcu == 0 && tid < 32) { MISCG[tid] = tb[32 + tid]; MISCG[32 + tid] = tb[64 + tid]; }
        { const int a = wave * 64 + lane; const int tk = vcu * 256 + (a >> 1), k = a & 1;
          const int e = EID[tk * 2 + k]; const int p = tb[64 + e] + tb[e] + RNK[tk * 2 + k];
          POS[tk * 2 + k] = p; ROWTOK[p] = tk; }
        if (vcu < 32) { const int e = vcu; const int beg = tb[64 + e] + tb[32 + e], end = tb[64 + e] + (((tb[32 + e] + 255) >> 8) << 8);
            for (int p = beg + tid; p < end; p += NTHREADS) ROWTOK[p] = 0; }
        __syncthreads();
    }
    SEAM(10);

    if (IN(11) || IN(12)) {
        LAS int* tp = (LAS int*)(lds + SCHED_OFF); LAS int* rowst = tp + 40;
        if (tid == 0) { int run = 0; for (int e = 0; e < 32; ++e) { tp[e] = run; run += (MISCG[e] + 255) >> 8; rowst[e] = MISCG[32 + e]; } tp[32] = run; }
        __syncthreads();
        const int ntile = tp[32];
        for (int rep_ = 0; rep_ < 1 + ((PROBE_REP >> 11) & 1); ++rep_) if (IN(11)) {
            pg8::USched S{}; S.nM = ntile; S.nN = 4; S.G = G; S.c = bx; S.pair = 0; S.K = 1024; S.nseg = 32; S.A0 = (const char*)H2; S.A1 = S.A0; S.B0 = (const char*)W13_t; S.B1 = S.B0; S.segB = (size_t)1024 * 1024 * 2; S.tp = tp; S.rowst = rowst; S.direct = -1;
            LAS int* gidx = (LAS int*)(lds + LDSCTL_OFF + 2048);
            S.gidx = gidx;
            { pg8::Unit u; for (int i = 0; i < 12 && S.next(i, u); ++i) if (tid < 256) gidx[i * 256 + tid] = ROWTOK[u.row0 + tid]; }
            __syncthreads();
            UEpi E{}; E.mode = 5; E.hh = HH;
            pg8::gemm_phase<UEpi, pg8::USched>(lds, 1024, S, E);
        }
        SEAM(11);
        for (int rep_ = 0; rep_ < 1 + ((PROBE_REP >> 12) & 1); ++rep_) if (IN(12)) {
            pg8::USched S{}; S.nM = ntile; S.nN = 4; S.G = G; S.c = bx; S.pair = 0; S.K = 512; S.nseg = 32; S.A0 = (const char*)HH; S.A1 = S.A0; S.B0 = (const char*)W2_t; S.B1 = S.B0; S.segB = (size_t)1024 * 512 * 2; S.tp = tp; S.rowst = rowst; S.direct = -1; S.gidx = nullptr;
            UEpi E{}; E.mode = 6; E.y = YB;
            pg8::gemm_phase<UEpi, pg8::USched>(lds, 512, S, E);
        }
    }
    SEAM(12);

    if (IN(13)) {
        for (int row = gw; row < NTOK; row += NGW) {
            const int b = row >> 12; const float* gt = mod + (size_t)b * 6144 + 5120;
            const int p0 = POS[row * 2], p1 = POS[row * 2 + 1]; const float w0 = WGT[row * 2], w1 = WGT[row * 2 + 1];
            float* orow = args.out + (size_t)row * 1024;
#pragma unroll
            for (int j = 0; j < 2; ++j) { const int k = 512 * j + 8 * lane;
                const u32x4 a = *(const u32x4*)(YB + (size_t)p0 * 1024 + k), c = *(const u32x4*)(YB + (size_t)p1 * 1024 + k);
                const f32x4 x0 = *(const f32x4*)(orow + k), x1v = *(const f32x4*)(orow + k + 4), g0 = *(const f32x4*)(gt + k), g1 = *(const f32x4*)(gt + k + 4);
                f32x4 y0, y1;
                y0[0] = w0 * bf2f(a.x & 0xffffu) + w1 * bf2f(c.x & 0xffffu); y0[1] = w0 * bf2f(a.x >> 16) + w1 * bf2f(c.x >> 16);
                y0[2] = w0 * bf2f(a.y & 0xffffu) + w1 * bf2f(c.y & 0xffffu); y0[3] = w0 * bf2f(a.y >> 16) + w1 * bf2f(c.y >> 16);
                y1[0] = w0 * bf2f(a.z & 0xffffu) + w1 * bf2f(c.z & 0xffffu); y1[1] = w0 * bf2f(a.z >> 16) + w1 * bf2f(c.z >> 16);
                y1[2] = w0 * bf2f(a.w & 0xffffu) + w1 * bf2f(c.w & 0xffffu); y1[3] = w0 * bf2f(a.w >> 16) + w1 * bf2f(c.w >> 16);
                *(f32x4*)(orow + k) = x0 + g0 * y0; *(f32x4*)(orow + k + 4) = x1v + g1 * y1; }
        }
    }
#undef IN
#undef SEAM
}

extern "C" void kernel_launch(void* const* d_in, const int* in_sizes, int n_in, void* d_out, int out_size, void* d_ws, size_t ws_size, hipStream_t stream) {
    static int grid = 0;
    if (grid == 0) {
        if (n_in != 28 || in_sizes[0] != NTOK * DMODEL || out_size != NTOK * DMODEL || ws_size < WS_END) { fprintf(stderr, "kernel_launch: unexpected shapes (n_in %d, in0 %d, out %d, ws %zu)\n", n_in, n_in > 0 ? in_sizes[0] : -1, out_size, ws_size); grid = -1; return; }
        int dev = 0, cus = 0, per_cu = 0;
        if (hipGetDevice(&dev) != hipSuccess || hipDeviceGetAttribute(&cus, hipDeviceAttributeMultiprocessorCount, dev) != hipSuccess) { grid = -1; return; }
        if (hipFuncSetAttribute((const void*)fwd_kernel, hipFuncAttributeMaxDynamicSharedMemorySize, LDS_BYTES) != hipSuccess) { fprintf(stderr, "kernel_launch: hipFuncSetAttribute failed\n"); grid = -1; return; }
        if (hipOccupancyMaxActiveBlocksPerMultiprocessor(&per_cu, (const void*)fwd_kernel, NTHREADS, LDS_BYTES) != hipSuccess || per_cu < 1) { fprintf(stderr, "kernel_launch: occupancy query says %d blocks per CU\n", per_cu); per_cu = 1; }
        (void)hipGetLastError();
        grid = cus * 1;
        if (grid != 256) fprintf(stderr, "kernel_launch: %d CUs; this kernel is laid out for 256\n", grid);
    }
    if (grid < 0) return;
    (void)hipMemsetAsync((char*)d_ws + WS_CTL, 0, CTL_ZERO_BYTES, stream);
    Args a{};
    for (int i = 0; i < 28; ++i) a.in[i] = (const float*)d_in[i];
    a.out = (float*)d_out; a.ws = (unsigned char*)d_ws;
    constexpr int NPH = 14;
    if (MK_N_LAUNCHES == 1) { a.ph_lo = 0; a.ph_hi = NPH; a.li = 0; hipLaunchKernelGGL(fwd_kernel, dim3(grid), dim3(NTHREADS), LDS_BYTES, stream, a); }
    else { for (int p = 0; p < NPH; ++p) { a.ph_lo = p; a.ph_hi = p + 1; a.li = p; hipLaunchKernelGGL(fwd_kernel, dim3(grid), dim3(NTHREADS), LDS_BYTES, stream, a); } }
}
```

```cpp
#include <hip/hip_runtime.h>
#include <cstdio>
#include <cstdint>
#include <cmath>

#ifndef MK_N_LAUNCHES
#define MK_N_LAUNCHES 1
#endif

#ifndef STAG1
#define STAG1 0
#endif
#ifndef PROBE_REP
#define PROBE_REP 0
#endif
#define LAS __attribute__((address_space(3)))
#define GAS __attribute__((address_space(1)))
typedef unsigned short bf16_t;
typedef short bf16x8 __attribute__((ext_vector_type(8)));
typedef short s16x4 __attribute__((ext_vector_type(4)));
typedef float f32x4 __attribute__((ext_vector_type(4)));
typedef float f32x2 __attribute__((ext_vector_type(2)));
typedef float f32x16 __attribute__((ext_vector_type(16)));
typedef unsigned u32x4 __attribute__((ext_vector_type(4)));
typedef unsigned u32x2 __attribute__((ext_vector_type(2)));
typedef __bf16 bf16x2_t __attribute__((ext_vector_type(2)));

constexpr int NB = 16, SEQ = 4096, DMODEL = 1024, NTOK = NB * SEQ;
constexpr int IN_COLS = 5128, COL_FQ = 0, COL_FK = 512, COL_FV = 1024, COL_FF = 1536, COL_DQ = 1544, COL_DK = 2056, COL_DV = 2568, COL_GATE = 3080;
constexpr int NEXP = 32, DEXP = 512;
constexpr int NASSIGN = NTOK * 2;
constexpr int PADROWS = NASSIGN + NEXP * 256;
constexpr float EPS = 1e-6f;
constexpr float LOG2E = 1.4426950408889634f;
constexpr float C2 = 0.125f * LOG2E;
constexpr float LAM0 = 0.2f;

constexpr size_t MiB = 1u << 20;
constexpr size_t WS_CTL = 0, CTL_ZERO_BYTES = 128 * 1024;
constexpr size_t WS_MOD = 1 * MiB;
constexpr size_t WS_MISC = 1 * MiB + 512 * 1024;
constexpr size_t WS_GALL = 1 * MiB + 768 * 1024;
constexpr size_t WS_EID = 2 * MiB;
constexpr size_t WS_RNK = 2 * MiB + 512 * 1024;
constexpr size_t WS_WGT = 3 * MiB;
constexpr size_t WS_POS = 3 * MiB + 512 * 1024;
constexpr size_t WS_HIST = 4 * MiB;
constexpr size_t WS_ROWTOK = 4 * MiB + 256 * 1024;
constexpr size_t WS_LOGF = 5 * MiB;
constexpr size_t WS_BIAS = 7 * MiB;
constexpr size_t WS_WR = 10 * MiB;
constexpr size_t WS_LOGIT = 11 * MiB;
constexpr size_t WS_ROPE = 27 * MiB;
constexpr size_t WS_WIN = 43 * MiB;
constexpr size_t WS_WPF = 53 * MiB, WS_WPD = 54 * MiB, WS_WOUT = 55 * MiB;
constexpr size_t WS_W13 = 57 * MiB;
constexpr size_t WS_W2 = 121 * MiB;
constexpr size_t WS_H1 = 160 * MiB;
constexpr size_t WS_QF = 288 * MiB, WS_KF = 352 * MiB, WS_VF = 416 * MiB, WS_QD = 480 * MiB, WS_KD = 544 * MiB, WS_VD = 608 * MiB;
constexpr size_t WS_G = 672 * MiB;
constexpr size_t WS_OD = 928 * MiB;
constexpr size_t WS_MERGED = WS_KF;
constexpr size_t WS_H2S = WS_QD;
constexpr size_t WS_HH = 800 * MiB;
constexpr size_t WS_H2 = WS_G;
constexpr size_t WS_END = 1024 * MiB;
static_assert(WS_KF - WS_QF == 67108864 && WS_VD - WS_QF == 5 * 67108864, "six q/k/v buffers 64 MiB apart");
static_assert(WS_H2S + (size_t)PADROWS * 2048 <= WS_HH && WS_HH + (size_t)PADROWS * 1024 <= WS_END && WS_H2 + (size_t)NTOK * 2048 <= WS_HH, "ws map");

constexpr int CW_TMO = 0, CW_BAR = 4096, CW_GCNT = 16384;

constexpr int RING_BYTES = 131072, LDSCTL_OFF = RING_BYTES, MISC_OFF = LDSCTL_OFF + 320, SCHED_OFF = LDSCTL_OFF + 1024;
constexpr int LDS_BYTES = 147456;
constexpr int NWAVES = 8, NTHREADS = 512;

#define RLX_AGENT __ATOMIC_RELAXED, __HIP_MEMORY_SCOPE_AGENT
#define LDS_WAIT() asm volatile("s_waitcnt lgkmcnt(0)" ::: "memory")
#define VM_WAIT() asm volatile("s_waitcnt vmcnt(0)" ::: "memory")
__device__ __forceinline__ unsigned f2bf(float f) { unsigned u = __builtin_bit_cast(unsigned, f); return (u + 0x7fffu + ((u >> 16) & 1u)) >> 16; }
__device__ __forceinline__ unsigned pk2(float lo, float hi) { return f2bf(lo) | (f2bf(hi) << 16); }
__device__ __forceinline__ float bf2f(unsigned b) { return __builtin_bit_cast(float, b << 16); }
__device__ __forceinline__ unsigned cvtpk(float lo, float hi) { f32x2 v = {lo, hi}; bf16x2_t b = __builtin_convertvector(v, bf16x2_t); return __builtin_bit_cast(unsigned, b); }
__device__ __forceinline__ float wave_sum(float v) {
#pragma unroll
    for (int o = 1; o < 64; o <<= 1) v += __shfl_xor(v, o);
    return v;
}
__device__ __forceinline__ float wave_max(float v) {
#pragma unroll
    for (int o = 1; o < 64; o <<= 1) v = fmaxf(v, __shfl_xor(v, o));
    return v;
}
__device__ __forceinline__ unsigned pk4_fp8(float a, float b, float c, float d) {
    a = fminf(fmaxf(a, -448.f), 448.f); b = fminf(fmaxf(b, -448.f), 448.f); c = fminf(fmaxf(c, -448.f), 448.f); d = fminf(fmaxf(d, -448.f), 448.f);
    int p = __builtin_amdgcn_cvt_pk_fp8_f32(a, b, __float_as_int(a), false); p = __builtin_amdgcn_cvt_pk_fp8_f32(c, d, p, true); return (unsigned)p; }
__device__ __forceinline__ unsigned pk4_fp8_nc(float a, float b, float c, float d) { int p = __builtin_amdgcn_cvt_pk_fp8_f32(a, b, __float_as_int(a), false); p = __builtin_amdgcn_cvt_pk_fp8_f32(c, d, p, true); return (unsigned)p; }
constexpr float QS8 = 2.0f, KS8 = 0.5f;
constexpr float W8S = 64.0f, H8S = 4.0f, Y8S = 8.0f, M8S = 16.0f;
__device__ __forceinline__ float sigmoidf_(float x) { return __builtin_amdgcn_rcpf(1.0f + __builtin_amdgcn_exp2f(-LOG2E * x)); }

namespace pg8 {
constexpr int BM = 256, BK = 64, HALF = 128, HTB = HALF * BK * 2, STAGE_BYTES = 8 * HTB, NXCD = 8, WGM = 8;
__host__ __device__ __forceinline__ int lds_byte(int r, int c) { const int st = (r >> 4) * 2 + (c >> 5), rr = r & 15, cc = c & 31, ob = rr * 64 + cc * 2; return st * 1024 + (ob ^ (((ob >> 9) & 1) << 5)); }
__host__ __device__ __forceinline__ void stage_rc(int b, int& R, int& C) { const int st = b / 1024, sb = b % 1024, swz = sb ^ (((sb >> 9) & 1) << 5); R = (st >> 1) * 16 + swz / 64; C = (st & 1) * 32 + (swz % 64) / 2; }
__host__ __device__ __forceinline__ int perm32(int rho) { const int n = rho >> 4, i = rho & 15; return 8 * (i >> 2) + 4 * n + (i & 3); }

struct Unit { int row0, pn, seg, src; const char* A; const char* B; };

struct USched {
    int nM, nN, G, c, pair, K, nseg;
    const char *A0, *A1, *B0, *B1;
    size_t segB;
    const LAS int* tp;
    const LAS int* rowst;
    int direct;
    const LAS int* gidx;
    __device__ __forceinline__ bool next(int i, Unit& u) const {
        const int ii = pair ? (i >> 1) : i, src = pair ? (i & 1) : 0;
        int pm, pn;
        if (direct >= 0) { if (i > 0) return false; pm = direct; pn = 0; }
        else {
            const long L = (long)ii * G + c; const int nwg = nM * nN; if (L >= nwg) return false;
            int wgid = (int)L; { const int q = nwg / NXCD, r = nwg % NXCD, xcd = wgid % NXCD, off = wgid / NXCD; wgid = (xcd < r ? xcd * (q + 1) : r * (q + 1) + (xcd - r) * q) + off; }
            const int nig = WGM * nN, gid = wgid / nig, fm = gid * WGM, gsz = (nM - fm) < WGM ? (nM - fm) : WGM;
            pm = fm + ((wgid % nig) % gsz); pn = (wgid % nig) / gsz;
        }
        int s = 0, row0 = pm * BM;
        if (nseg > 1) { for (int j = 1; j < nseg; ++j) if (pm >= tp[j]) s = j; row0 = rowst[s] + (pm - tp[s]) * BM; }
        u.row0 = row0; u.pn = pn; u.seg = s; u.src = src;
        u.A = (src ? A1 : A0) + (gidx ? (size_t)0 : (size_t)row0 * K * 2);
        u.B = (src ? B1 : B0) + (size_t)s * segB + (size_t)pn * BM * K * 2;
        return true;
    }
    __device__ __forceinline__ unsigned a_off(int ui, int h, int R, int C) const {
        if (gidx) return (unsigned)(gidx[ui * BM + h * HALF + R] * K + C) * 2u;
        return (unsigned)((h * HALF + R) * K + C) * 2u;
    }
};

typedef int i32x8 __attribute__((ext_vector_type(8)));
typedef int i32x8a __attribute__((ext_vector_type(8), aligned(16)));
__device__ __forceinline__ i32x8 pg8_cat8(const u32x4 a, const u32x4 b) { return (i32x8){(int)a.x, (int)a.y, (int)a.z, (int)a.w, (int)b.x, (int)b.y, (int)b.z, (int)b.w}; }
template <class Epi, class Sched, bool FP8 = false>
__device__ __forceinline__ void gemm_phase(LAS unsigned char* lds, const int K, const Sched S, const Epi E, const unsigned delay_ticks = 0) {
    if (delay_ticks) { const unsigned long long t0_ = __builtin_amdgcn_s_memrealtime(); while (__builtin_amdgcn_s_memrealtime() - t0_ < delay_ticks) __builtin_amdgcn_s_sleep(16); }
    int tid_ = threadIdx.x; asm volatile("" : "+v"(tid_));
    const int tid = tid_, wid = __builtin_amdgcn_readfirstlane(tid >> 6), lane = tid & 63, wr = wid >> 2, wc = wid & 3, fr = lane & 15, fq = lane >> 4;
    const int nt = K / BK;
    unsigned voffB[2]; int RA[2], CA[2];
#pragma unroll
    for (int i = 0; i < 2; ++i) { int R, C; stage_rc(tid * 16 + i * 8192, R, C); const int Rb = (R & ~31) + perm32(R & 31);
        RA[i] = R; CA[i] = C; voffB[i] = (unsigned)(Rb * K + C) * 2u; }
    unsigned vA[2][2], nvA[2][2];
#define PG8_FILL(v, ui_) do { _Pragma("unroll") for (int _h = 0; _h < 2; ++_h) _Pragma("unroll") for (int _i = 0; _i < 2; ++_i) v[_h][_i] = S.a_off(ui_, _h, RA[_i], CA[_i]); } while (0)
    const size_t kstep = (size_t)(BK * 2);
    const size_t hstep = (size_t)HALF * K * 2;
    const unsigned ldsw = (unsigned)wid * 1024u;
    const int aoff = lds_byte(wr * 64 + fr, fq * 8);
    const int boff = lds_byte(wc * 32 + fr, fq * 8);
#define PG8_SA(b, h) (((b) * 2 + (h)) * HTB)
#define PG8_SB(b, h) ((4 + (b) * 2 + (h)) * HTB)
#define PG8_STAGE(bufoff, gbase, voff) do { _Pragma("unroll") for (int _i = 0; _i < 2; ++_i) \
        __builtin_amdgcn_global_load_lds((const unsigned*)((const char*)(gbase) + (voff)[_i]), (LAS unsigned*)(lds + (bufoff) + ldsw + _i * 8192), 16, 0, 0); } while (0)
#define PG8_RD8(p_) pg8_cat8(*(const LAS u32x4*)(p_), *(const LAS u32x4*)((p_) + 1024))
#define PG8_LDA(b, h) do { if constexpr (FP8) { _Pragma("unroll") for (int m = 0; m < 4; ++m) A8[m] = PG8_RD8(lds + PG8_SA(b, h) + aoff + m * 2048); } \
        else { _Pragma("unroll") for (int m = 0; m < 4; ++m) _Pragma("unroll") for (int k = 0; k < 2; ++k) At[m][k] = *(const LAS bf16x8*)(lds + PG8_SA(b, h) + aoff + m * 2048 + k * 1024); } } while (0)
#define PG8_LDB(dst, dst8, b, h) do { if constexpr (FP8) { _Pragma("unroll") for (int n = 0; n < 2; ++n) dst8[n] = PG8_RD8(lds + PG8_SB(b, h) + boff + n * 2048); } \
        else { _Pragma("unroll") for (int n = 0; n < 2; ++n) _Pragma("unroll") for (int k = 0; k < 2; ++k) dst[n][k] = *(const LAS bf16x8*)(lds + PG8_SB(b, h) + boff + n * 2048 + k * 1024); } } while (0)
#define PG8_MMA(ai, bj, Bt, Bt8) do { __builtin_amdgcn_s_setprio(1); \
        if constexpr (FP8) { _Pragma("unroll") for (int m = 0; m < 4; ++m) _Pragma("unroll") for (int n = 0; n < 2; ++n) \
            asm volatile("v_mfma_f32_16x16x128_f8f6f4 %0, %1, %2, %0" : "+v"(acc[ai][bj][m][n]) : "v"(Bt8[n]), "v"(A8[m])); }   \
        else { _Pragma("unroll") for (int m = 0; m < 4; ++m) _Pragma("unroll") for (int n = 0; n < 2; ++n) _Pragma("unroll") for (int k = 0; k < 2; ++k) \
            acc[ai][bj][m][n] = __builtin_amdgcn_mfma_f32_16x16x32_bf16(Bt[n][k], At[m][k], acc[ai][bj][m][n], 0, 0, 0); } \
        __builtin_amdgcn_s_setprio(0); } while (0)
#define PG8_WAIT_V(n) asm volatile("s_waitcnt vmcnt(" #n ")" ::: "memory")
#define PG8_WAIT_L(n) asm volatile("s_waitcnt lgkmcnt(" #n ")" ::: "memory")
#define PG8_BAR __builtin_amdgcn_s_barrier()
#define PG8_SCHED __builtin_amdgcn_sched_barrier(0)
    Unit cur, nxt; int ui = 0;
    if (!S.next(0, cur)) return;
    f32x4 acc[2][2][4][2];
#pragma unroll
    for (int a = 0; a < 2; ++a)
#pragma unroll
        for (int b = 0; b < 2; ++b)
#pragma unroll
            for (int m = 0; m < 4; ++m)
#pragma unroll
                for (int n = 0; n < 2; ++n) acc[a][b][m][n] = (f32x4){0.f, 0.f, 0.f, 0.f};
    bf16x8 At[4][2], B0[2][2], B1[2][2]; i32x8 A8[4], B08[2], B18[2];
    const char* cA = cur.A; const char* cB = cur.B;
    PG8_FILL(vA, 0);
    PG8_STAGE(PG8_SB(0, 0), cB, voffB); PG8_STAGE(PG8_SB(0, 1), cB + hstep, voffB); PG8_STAGE(PG8_SA(0, 0), cA, vA[0]); PG8_STAGE(PG8_SA(0, 1), cA, vA[1]);
    if (wr == 1) PG8_BAR;
    PG8_WAIT_V(2); PG8_BAR;
    PG8_STAGE(PG8_SB(1, 0), cB + kstep, voffB); PG8_STAGE(PG8_SA(1, 0), cA + kstep, vA[0]); PG8_STAGE(PG8_SB(1, 1), cB + hstep + kstep, voffB);
    PG8_WAIT_V(6); PG8_BAR;
    for (;;) {
        const bool has_next = S.next(ui + 1, nxt);
        const char* nA = has_next ? nxt.A : cA; const char* nB = has_next ? nxt.B : cB;
        if (has_next) { PG8_FILL(nvA, ui + 1); } else { nvA[0][0] = vA[0][0]; nvA[0][1] = vA[0][1]; nvA[1][0] = vA[1][0]; nvA[1][1] = vA[1][1]; }
        for (int t = 0; t < nt; t += 2) {
            const bool last = (t == nt - 2);
            const char* a1 = cA + (size_t)(t + 1) * kstep;
            const char* a2 = last ? nA : cA + (size_t)(t + 2) * kstep; const char* b2 = last ? nB : cB + (size_t)(t + 2) * kstep;
            const char* a3 = a2 + kstep; const char* b3 = b2 + kstep;
            if (E.mode == 2 && t == (nt >> 1)) E.mid(acc, cur, wr, wc, fr, fq);
            unsigned s0[2], s1[2]; s0[0] = last ? nvA[0][0] : vA[0][0]; s0[1] = last ? nvA[0][1] : vA[0][1]; s1[0] = last ? nvA[1][0] : vA[1][0]; s1[1] = last ? nvA[1][1] : vA[1][1];
            PG8_LDB(B0, B08, 0, 0); PG8_LDB(B1, B18, 0, 1); PG8_SCHED; PG8_LDA(0, 0); PG8_STAGE(PG8_SA(1, 1), a1, vA[1]);
            PG8_WAIT_V(8); PG8_WAIT_L(0); PG8_BAR; PG8_MMA(0, 0, B0, B08); PG8_MMA(0, 1, B1, B18); PG8_BAR; PG8_SCHED;
            PG8_LDA(0, 1); PG8_STAGE(PG8_SB(0, 0), b2, voffB); PG8_STAGE(PG8_SB(0, 1), b2 + hstep, voffB); PG8_STAGE(PG8_SA(0, 0), a2, s0);
            PG8_WAIT_V(8); PG8_WAIT_L(0); PG8_BAR; PG8_MMA(1, 0, B0, B08); PG8_MMA(1, 1, B1, B18); PG8_BAR; PG8_SCHED;
            PG8_LDB(B0, B08, 1, 0); PG8_LDB(B1, B18, 1, 1); PG8_SCHED; PG8_LDA(1, 0); PG8_STAGE(PG8_SA(0, 1), a2, s1);
            PG8_WAIT_V(8); PG8_WAIT_L(0); PG8_BAR; PG8_MMA(0, 0, B0, B08); PG8_MMA(0, 1, B1, B18); PG8_BAR; PG8_SCHED;
            PG8_LDA(1, 1); PG8_STAGE(PG8_SB(1, 0), b3, voffB); PG8_STAGE(PG8_SB(1, 1), b3 + hstep, voffB); PG8_STAGE(PG8_SA(1, 0), a3, s0);
            PG8_WAIT_V(8); PG8_WAIT_L(0); PG8_BAR; PG8_MMA(1, 0, B0, B08); PG8_MMA(1, 1, B1, B18); PG8_BAR; PG8_SCHED;
        }
        if (wr == 0) PG8_BAR;
        if constexpr (FP8) asm volatile("s_nop 15\n\ts_nop 7" ::: "memory");
        E(acc, cur, wr, wc, fr, fq);
        if (!has_next) break;
#pragma unroll
        for (int a = 0; a < 2; ++a)
#pragma unroll
            for (int b = 0; b < 2; ++b)
#pragma unroll
                for (int m = 0; m < 4; ++m)
#pragma unroll
                    for (int n = 0; n < 2; ++n) acc[a][b][m][n] = (f32x4){0.f, 0.f, 0.f, 0.f};
        cur = nxt; cA = nA; cB = nB; ++ui;
        vA[0][0] = nvA[0][0]; vA[0][1] = nvA[0][1]; vA[1][0] = nvA[1][0]; vA[1][1] = nvA[1][1];
        if (wr == 1) PG8_BAR;
    }
    PG8_WAIT_V(0);
    PG8_BAR;
#undef PG8_SA
#undef PG8_SB
#undef PG8_STAGE
#undef PG8_FILL
#undef PG8_RD8
#undef PG8_LDA
#undef PG8_LDB
#undef PG8_MMA
#undef PG8_WAIT_V
#undef PG8_WAIT_L
#undef PG8_BAR
#undef PG8_SCHED
}
}

struct UEpi {
    int pnoff; float ascale;
    int mode;
    bf16_t *qkv6, *gates; const float *gall; const int* pos;
    bf16_t* merged;
    const float* x; bf16_t* x1; const float* mod;
    float* logits;
    unsigned char* hh; unsigned char* y;
    __device__ __forceinline__ void mid(f32x4 (&acc)[2][2][4][2], const pg8::Unit& u, int wr, int wc, int fr, int fq) const {
        int rbase = u.row0 + wr * 64 + fr; asm volatile("" : "+v"(rbase));
        const int col0 = u.pn * 256 + wc * 32 + 8 * fq;
#define RAT_(a, b) ((float)(a) * __builtin_amdgcn_rcpf(fmaxf((float)(b), 1.0f)))
#pragma unroll
        for (int ai = 0; ai < 2; ++ai) {
            u32x2 ga[4][2], gb[4][2];
#pragma unroll
            for (int m = 0; m < 4; ++m) { const unsigned char* rp = (const unsigned char*)gates + (size_t)(rbase + ai * 128 + m * 16) * 2048 + col0;
#pragma unroll
                for (int bj = 0; bj < 2; ++bj) { ga[m][bj] = *(const u32x2*)(rp + bj * 128); gb[m][bj] = *(const u32x2*)(rp + 1024 + bj * 128); } }
#pragma unroll
            for (int m = 0; m < 4; ++m)
#pragma unroll
                for (int bj = 0; bj < 2; ++bj) { const u32x2 a = ga[m][bj], b = gb[m][bj];
                    acc[ai][bj][m][0][0] *= RAT_(a.x & 0xffu, b.x & 0xffu); acc[ai][bj][m][0][1] *= RAT_((a.x >> 8) & 0xffu, (b.x >> 8) & 0xffu);
                    acc[ai][bj][m][0][2] *= RAT_((a.x >> 16) & 0xffu, (b.x >> 16) & 0xffu); acc[ai][bj][m][0][3] *= RAT_(a.x >> 24, b.x >> 24);
                    acc[ai][bj][m][1][0] *= RAT_(a.y & 0xffu, b.y & 0xffu); acc[ai][bj][m][1][1] *= RAT_((a.y >> 8) & 0xffu, (b.y >> 8) & 0xffu);
                    acc[ai][bj][m][1][2] *= RAT_((a.y >> 16) & 0xffu, (b.y >> 16) & 0xffu); acc[ai][bj][m][1][3] *= RAT_(a.y >> 24, b.y >> 24); }
            asm volatile("" ::: "memory");
        }
#undef RAT_
    }
    __device__ __forceinline__ void operator()(const f32x4 (&acc)[2][2][4][2], const pg8::Unit& u, int wr, int wc, int fr, int fq) const {
        const int rbase = u.row0 + wr * 64 + fr;
        if (mode == 1) {
            const int pn = u.pn;
            if (pn >= 12 || pn == 4 || pn == 5 || pn == 10 || pn == 11) {
                const bool gate = pn >= 12;
                if (gate) {
                    unsigned char* gb = (unsigned char*)gates; const int col0 = (pn - 12) * 256 + wc * 32 + 8 * fq;
                    const float kexp = -LOG2E * ascale, c255 = 1.0f / 255.0f;
#pragma unroll
                    for (int ai = 0; ai < 2; ++ai)
#pragma unroll
                        for (int m = 0; m < 4; ++m) { unsigned char* rowp = gb + (size_t)(rbase + ai * 128 + m * 16) * 2048 + col0;
#pragma unroll
                            for (int bj = 0; bj < 2; ++bj) { const f32x4 v0 = acc[ai][bj][m][0], v1 = acc[ai][bj][m][1]; u32x2 w; unsigned p = 0u, q = 0u;
#define G255_(x_) __builtin_amdgcn_rcpf(__builtin_fmaf(__builtin_amdgcn_exp2f((x_) * kexp), c255, c255))
                                p = __builtin_amdgcn_cvt_pk_u8_f32(G255_(v0[0]), 0, p); p = __builtin_amdgcn_cvt_pk_u8_f32(G255_(v0[1]), 1, p);
                                p = __builtin_amdgcn_cvt_pk_u8_f32(G255_(v0[2]), 2, p); p = __builtin_amdgcn_cvt_pk_u8_f32(G255_(v0[3]), 3, p);
                                q = __builtin_amdgcn_cvt_pk_u8_f32(G255_(v1[0]), 0, q); q = __builtin_amdgcn_cvt_pk_u8_f32(G255_(v1[1]), 1, q);
                                q = __builtin_amdgcn_cvt_pk_u8_f32(G255_(v1[2]), 2, q); q = __builtin_amdgcn_cvt_pk_u8_f32(G255_(v1[3]), 3, q);
#undef G255_
                                w.x = p; w.y = q; *(u32x2*)(rowp + bj * 128) = w; } }
                } else if (pn >= 10) {
                    unsigned char* vb = (unsigned char*)(qkv6 + (size_t)5 * 33554432); const int col0 = (pn & 1) * 256 + wc * 32 + 8 * fq;
#pragma unroll
                    for (int ai = 0; ai < 2; ++ai)
#pragma unroll
                        for (int m = 0; m < 4; ++m) { unsigned char* rowp = vb + (size_t)(rbase + ai * 128 + m * 16) * 512 + col0;
#pragma unroll
                            for (int bj = 0; bj < 2; ++bj) { const f32x4 v0 = acc[ai][bj][m][0], v1 = acc[ai][bj][m][1];
                                u32x2 w; w.x = pk4_fp8(v0[0] * ascale, v0[1] * ascale, v0[2] * ascale, v0[3] * ascale); w.y = pk4_fp8(v1[0] * ascale, v1[1] * ascale, v1[2] * ascale, v1[3] * ascale);
                                *(u32x2*)(rowp + bj * 128) = w; } }
                } else {
                    bf16_t* base = qkv6 + (size_t)(pn >> 1) * 33554432; const int ldc = 512, colt = (pn & 1) * 256;
                    const int col0 = colt + wc * 32 + 8 * fq;
#pragma unroll
                    for (int ai = 0; ai < 2; ++ai)
#pragma unroll
                        for (int m = 0; m < 4; ++m) { bf16_t* rowp = base + (size_t)(rbase + ai * 128 + m * 16) * ldc + col0;
#pragma unroll
                            for (int bj = 0; bj < 2; ++bj) { const f32x4 v0 = acc[ai][bj][m][0], v1 = acc[ai][bj][m][1];
                                u32x4 w; w.x = cvtpk(v0[0] * ascale, v0[1] * ascale); w.y = cvtpk(v0[2] * ascale, v0[3] * ascale); w.z = cvtpk(v1[0] * ascale, v1[1] * ascale); w.w = cvtpk(v1[2] * ascale, v1[3] * ascale);
                                *(u32x4*)(rowp + bj * 128) = w; } }
                }
            } else {
                const int sec = pn >> 1;
                bf16_t* base = qkv6 + (size_t)sec * 33554432;
                const float* g = gall + (sec - (sec >= 3 ? 1 : 0)) * 64;
                const bool dorope = sec >= 3; const float sc = (sec == 0 || sec == 3) ? C2 * QS8 : KS8;
                const int head = 4 * (pn & 1) + wc;
                f32x4 gv[2][2];
#pragma unroll
                for (int bj = 0; bj < 2; ++bj)
#pragma unroll
                    for (int n = 0; n < 2; ++n) { gv[bj][n] = *(const f32x4*)(g + 32 * bj + 8 * fq + 4 * n); gv[bj][n] = gv[bj][n] * sc; }
                f32x4 ivf[2];
#pragma unroll
                for (int n = 0; n < 2; ++n)
#pragma unroll
                    for (int e = 0; e < 4; ++e) ivf[n][e] = __builtin_amdgcn_exp2f(-(float)(8 * fq + 4 * n + e) * 0.41524101186092029f);
                const float asc2 = ascale * ascale * (1.0f / 64.0f);
#pragma unroll
                for (int ai = 0; ai < 2; ++ai)
#pragma unroll
                    for (int m = 0; m < 4; ++m) {
                        const int row = rbase + ai * 128 + m * 16;
                        f32x4 v[2][2]; float ss = 0.f;
#pragma unroll
                        for (int bj = 0; bj < 2; ++bj)
#pragma unroll
                            for (int n = 0; n < 2; ++n) { v[bj][n] = acc[ai][bj][m][n]; const f32x4 q = v[bj][n] * v[bj][n]; ss += (q[0] + q[1]) + (q[2] + q[3]); }
                        ss += __shfl_xor(ss, 16); ss += __shfl_xor(ss, 32);
                        const float rstd = __builtin_amdgcn_rsqf(ss * asc2 + EPS) * ascale;
#pragma unroll
                        for (int bj = 0; bj < 2; ++bj)
#pragma unroll
                            for (int n = 0; n < 2; ++n) v[bj][n] = v[bj][n] * rstd * gv[bj][n];
                        if (dorope) {
                            const float pr = (float)pos[row];
#pragma unroll
                            for (int n = 0; n < 2; ++n) { f32x4 cs, sn;
#pragma unroll
                                for (int e = 0; e < 4; ++e) { const float ang = pr * ivf[n][e]; const float fr_ = __builtin_amdgcn_fractf(ang * 0.15915494309189535f);
                                    cs[e] = __builtin_amdgcn_cosf(fr_); sn[e] = __builtin_amdgcn_sinf(fr_); }
                                const f32x4 x1 = v[0][n], x2 = v[1][n]; v[0][n] = x1 * cs - x2 * sn; v[1][n] = x2 * cs + x1 * sn; }
                        }
                        unsigned char* rowp = (unsigned char*)base + (size_t)row * 512 + head * 64 + 8 * fq;
#pragma unroll
                        for (int bj = 0; bj < 2; ++bj) { u32x2 w; w.x = pk4_fp8(v[bj][0][0], v[bj][0][1], v[bj][0][2], v[bj][0][3]); w.y = pk4_fp8(v[bj][1][0], v[bj][1][1], v[bj][1][2], v[bj][1][3]);
                            *(u32x2*)(rowp + bj * 32) = w; }
                    }
            }
        } else if (mode == 2) {
            const int col0 = u.pn * 256 + wc * 32 + 8 * fq;
#pragma unroll
            for (int ai = 0; ai < 2; ++ai)
#pragma unroll
                for (int m = 0; m < 4; ++m) { const size_t row = (size_t)(rbase + ai * 128 + m * 16);
#pragma unroll
                    for (int bj = 0; bj < 2; ++bj) { const int col = col0 + bj * 128;
                        const u32x2 gw = *(const u32x2*)((const unsigned char*)gates + row * 2048 + 1024 + col);
                        f32x4 v0 = acc[ai][bj][m][0], v1 = acc[ai][bj][m][1];
#define G1_(b) (fmaxf((float)(b), 1.0f) * (1.0f / 255.0f))
                        v0[0] *= G1_(gw.x & 0xffu); v0[1] *= G1_((gw.x >> 8) & 0xffu); v0[2] *= G1_((gw.x >> 16) & 0xffu); v0[3] *= G1_(gw.x >> 24);
                        v1[0] *= G1_(gw.y & 0xffu); v1[1] *= G1_((gw.y >> 8) & 0xffu); v1[2] *= G1_((gw.y >> 16) & 0xffu); v1[3] *= G1_(gw.y >> 24);
#undef G1_
                        u32x2 w; w.x = pk4_fp8(M8S * v0[0], M8S * v0[1], M8S * v0[2], M8S * v0[3]); w.y = pk4_fp8(M8S * v1[0], M8S * v1[1], M8S * v1[2], M8S * v1[3]);
                        *(u32x2*)((unsigned char*)merged + row * 1024 + col) = w; } }
        } else if (mode == 3) {
            const int col0 = u.pn * 256 + wc * 32 + 8 * fq; const int b = u.row0 >> 12;
            const float* gt = mod + (size_t)b * 6144 + 2048;
#pragma unroll
            for (int bj = 0; bj < 2; ++bj) { const int col = col0 + bj * 128; const f32x4 g0 = *(const f32x4*)(gt + col) * ascale, g1 = *(const f32x4*)(gt + col + 4) * ascale;
#pragma unroll
                for (int ai = 0; ai < 2; ++ai)
#pragma unroll
                    for (int m = 0; m < 4; ++m) { const size_t off = (size_t)(rbase + ai * 128 + m * 16) * 1024 + col;
                        const f32x4 x0 = *(const f32x4*)(x + off), xb = *(const f32x4*)(x + off + 4);
                        const f32x4 v0 = x0 + g0 * acc[ai][bj][m][0], v1 = xb + g1 * acc[ai][bj][m][1];
                        u32x4 w; w.x = cvtpk(v0[0], v0[1]); w.y = cvtpk(v0[2], v0[3]); w.z = cvtpk(v1[0], v1[1]); w.w = cvtpk(v1[2], v1[3]);
                        *(u32x4*)(x1 + off) = w; } }
        } else if (mode == 4) {
            if (wc < 2) { const int col = wc * 32 + 8 * fq;
#pragma unroll
                for (int ai = 0; ai < 2; ++ai)
#pragma unroll
                    for (int m = 0; m < 4; ++m) { float* dp = logits + (size_t)(rbase + ai * 128 + m * 16) * 64 + col;
                        *(f32x4*)dp = acc[ai][0][m][0]; *(f32x4*)(dp + 4) = acc[ai][0][m][1]; } }
        } else if (mode == 5) {
            const int col0 = u.pn * 128 + wc * 32 + 8 * fq;
#pragma unroll
            for (int ai = 0; ai < 2; ++ai)
#pragma unroll
                for (int m = 0; m < 4; ++m) { f32x4 h0, h1;
#pragma unroll
                    for (int e = 0; e < 4; ++e) {
                        const float A0 = acc[ai][0][m][0][e], A1 = acc[ai][0][m][1][e];
                        const float d0 = __builtin_amdgcn_rcpf(__builtin_fmaf(__builtin_amdgcn_exp2f(A0 * (-LOG2E / W8S)), W8S * W8S / H8S, W8S * W8S / H8S));
                        const float d1 = __builtin_amdgcn_rcpf(__builtin_fmaf(__builtin_amdgcn_exp2f(A1 * (-LOG2E / W8S)), W8S * W8S / H8S, W8S * W8S / H8S));
                        h0[e] = A0 * acc[ai][1][m][0][e] * d0; h1[e] = A1 * acc[ai][1][m][1][e] * d1; }
                    u32x2 w; w.x = pk4_fp8(h0[0], h0[1], h0[2], h0[3]); w.y = pk4_fp8(h1[0], h1[1], h1[2], h1[3]);
                    *(u32x2*)(hh + (size_t)(rbase + ai * 128 + m * 16) * 512 + col0) = w; }
        } else if (mode == 6) {
            const int col0 = u.pn * 256 + wc * 32 + 8 * fq;
#pragma unroll
            for (int ai = 0; ai < 2; ++ai)
#pragma unroll
                for (int m = 0; m < 4; ++m) { unsigned char* rowp = y + (size_t)(rbase + ai * 128 + m * 16) * 1024 + col0;
#pragma unroll
                    for (int bj = 0; bj < 2; ++bj) { const f32x4 v0 = acc[ai][bj][m][0] * (Y8S / (W8S * H8S)), v1 = acc[ai][bj][m][1] * (Y8S / (W8S * H8S));
                        u32x2 w; w.x = pk4_fp8(v0[0], v0[1], v0[2], v0[3]); w.y = pk4_fp8(v1[0], v1[1], v1[2], v1[3]);
                        *(u32x2*)(rowp + bj * 128) = w; } }
        }
    }
};

namespace attn_body {
constexpr int D = 64, DM = 512;
constexpr int NW = 8, QBLK = 32, QB = QBLK * NW, KVBLK = 64;
__device__ __forceinline__ int crow(int r, int hi) { return (r & 3) + 8 * (r >> 2) + 4 * hi; }
#define SBAR() __builtin_amdgcn_sched_barrier(0)
__device__ __forceinline__ void cmask(f32x16& p0, f32x16& p1, int jb, int qrel, int hi) {
    const float NEG = -INFINITY; int kb = 64 * jb + 4 * hi;
#pragma unroll
    for (int r = 0; r < 16; ++r) { int kv = kb + (r & 3) + 8 * (r >> 2); if (kv > qrel) p0[r] = NEG; if (kv + 32 > qrel) p1[r] = NEG; }
}
__device__ __forceinline__ void maskall(f32x16& p0, f32x16& p1) {
    const float NEG = -INFINITY;
#pragma unroll
    for (int r = 0; r < 16; ++r) { p0[r] = NEG; p1[r] = NEG; }
}
constexpr int NSLOT = 3, SLOTB = 8192;
constexpr int LDS_K = 0, LDS_V = NSLOT * SLOTB, LDS_WS = 2 * NSLOT * SLOTB, LDS_OST = LDS_WS + NW * 64 * 4, LDS_BIAS = LDS_OST + NW * 4096, LDS_BYTES_A = LDS_BIAS + NSLOT * 256;
__device__ __forceinline__ void glds16(const void* gsrc, unsigned lds_dst) { unsigned keep;
    asm volatile("s_mov_b32 %0, m0\n\ts_mov_b32 m0, %2\n\ts_nop 0\n\tglobal_load_lds_dwordx4 %1, off\n\ts_mov_b32 m0, %0" : "=&s"(keep) : "v"(gsrc), "s"(lds_dst) : "memory"); }
__device__ __forceinline__ void glds4(const void* gsrc, unsigned lds_dst) { unsigned keep;
    asm volatile("s_mov_b32 %0, m0\n\ts_mov_b32 m0, %2\n\ts_nop 0\n\tglobal_load_lds_dword %1, off\n\ts_mov_b32 m0, %0" : "=&s"(keep) : "v"(gsrc), "s"(lds_dst) : "memory"); }
__device__ __forceinline__ float max3f(float a, float b, float c) { float r; asm("v_max3_f32 %0, %1, %2, %3" : "=v"(r) : "v"(a), "v"(b), "v"(c)); return r; }
__device__ __forceinline__ float max2f(float a, float b) { float r; asm("v_max_f32_e32 %0, %1, %2" : "=v"(r) : "v"(a), "v"(b)); return r; }
__device__ __forceinline__ float fadd_s(float a, float b) { float r; asm("v_add_f32_e32 %0, %1, %2" : "=v"(r) : "v"(a), "v"(b)); return r; }
__device__ __forceinline__ float fsub_s(float a, float b) { float r; asm("v_sub_f32_e32 %0, %1, %2" : "=v"(r) : "v"(a), "v"(b)); return r; }
#define WAIT_BAR(N) asm volatile("s_waitcnt vmcnt(" #N ") lgkmcnt(0)\n\ts_barrier" ::: "memory")
typedef LAS const char* lds_cptr;
typedef short v4i16_t __attribute__((ext_vector_type(4)));
typedef int i32x8 __attribute__((ext_vector_type(8)));
typedef int i32x8a __attribute__((ext_vector_type(8), aligned(16)));
#define MF8(a, b, c) __builtin_amdgcn_mfma_scale_f32_32x32x64_f8f6f4(a, b, c, 0, 0, 0, 0, 0, 0)
__device__ __forceinline__ void kload8(i32x8* kf, lds_cptr kp) { kf[0] = *(const LAS i32x8a*)(kp); kf[1] = *(const LAS i32x8a*)(kp + 1024); }
__device__ __forceinline__ void kload2(i32x8* kf, lds_cptr kp, int j) { if (j < 2) kf[j] = *(const LAS i32x8a*)(kp + j * 1024); }
__device__ __forceinline__ void qkt(f32x16& p0, f32x16& p1, lds_cptr kp, const i32x8& qr, const f32x16& negm) {
    const i32x8 k0 = *(const LAS i32x8a*)(kp), k1 = *(const LAS i32x8a*)(kp + 1024);
    p0 = MF8(k0, qr, negm); p1 = MF8(k1, qr, negm);
}
__device__ __forceinline__ void qkt(f32x16& p0, f32x16& p1, lds_cptr kp, const i32x8& qr, const f32x16& c0, const f32x16& c1) {
    const i32x8 k0 = *(const LAS i32x8a*)(kp), k1 = *(const LAS i32x8a*)(kp + 1024);
    p0 = MF8(k0, qr, c0); p1 = MF8(k1, qr, c1);
}
__device__ __forceinline__ s16x4 vtr(lds_cptr p) { return __builtin_bit_cast(s16x4, __builtin_amdgcn_ds_read_tr16_b64_v4i16((LAS v4i16_t*)p)); }
__device__ __forceinline__ float rowmax(const f32x16& p0, const f32x16& p1) {
    float a = max3f(p0[0], p0[1], p1[0]), b = max3f(p0[2], p0[3], p1[1]); a = max3f(a, p1[2], p1[3]);
#pragma unroll
    for (int r = 4; r < 16; r += 4) { a = max3f(a, p0[r], p0[r + 1]); b = max3f(b, p0[r + 2], p0[r + 3]); a = max3f(a, p1[r], p1[r + 1]); b = max3f(b, p1[r + 2], p1[r + 3]); }
    const float m = max2f(a, b);
    auto rr = __builtin_amdgcn_permlane32_swap(__float_as_uint(m), __float_as_uint(m), false, false);
    return max2f(__uint_as_float(rr[0]), __uint_as_float(rr[1]));
}
__device__ __forceinline__ void pv(f32x16* o, int vb, bf16x8 pa0, bf16x8 pa1, bf16x8 pa2, bf16x8 pa3) {
#pragma unroll
    for (int d0 = 0; d0 < 2; ++d0) { s16x4 lo[4], hi[4];
#pragma unroll
        for (int ks = 0; ks < 4; ++ks) {
            asm volatile("ds_read_b64_tr_b16 %0,%1 offset:%c2" : "=&v"(lo[ks]) : "v"(vb), "i"(d0 * 4096 + ks * 1024) : "memory");
            asm volatile("ds_read_b64_tr_b16 %0,%1 offset:%c2" : "=&v"(hi[ks]) : "v"(vb), "i"(d0 * 4096 + ks * 1024 + 512) : "memory"); }
        asm volatile("s_waitcnt lgkmcnt(0)" ::: "memory"); SBAR();
#define PK(k) (bf16x8){lo[k][0], lo[k][1], lo[k][2], lo[k][3], hi[k][0], hi[k][1], hi[k][2], hi[k][3]}
        o[d0] = __builtin_amdgcn_mfma_f32_32x32x16_bf16(pa0, PK(0), o[d0], 0, 0, 0);
        o[d0] = __builtin_amdgcn_mfma_f32_32x32x16_bf16(pa1, PK(1), o[d0], 0, 0, 0);
        o[d0] = __builtin_amdgcn_mfma_f32_32x32x16_bf16(pa2, PK(2), o[d0], 0, 0, 0);
        o[d0] = __builtin_amdgcn_mfma_f32_32x32x16_bf16(pa3, PK(3), o[d0], 0, 0, 0);
#undef PK
    }
}
__device__ __forceinline__ bf16x8 bias_frag(float b) {
    const unsigned u0 = cvtpk(b, 0.f) & 0xffffu; const float r1 = b - bf2f(u0);
    const unsigned u1 = cvtpk(r1, 0.f) & 0xffffu; const float r2 = r1 - bf2f(u1);
    const unsigned u2 = cvtpk(r2, 0.f) & 0xffffu;
    u32x4 w; w.x = u0 | (u1 << 16); w.y = u2 | 0x3F800000u; w.z = 0x3F803F80u; w.w = 0u; return __builtin_bit_cast(bf16x8, w);
}
__device__ __forceinline__ bf16x8 qext_frag(float nm, int hi) {
    const unsigned u0 = cvtpk(nm, 0.f) & 0xffffu; const float r1 = nm - bf2f(u0);
    const unsigned u1 = cvtpk(r1, 0.f) & 0xffffu; const float r2 = r1 - bf2f(u1);
    const unsigned u2 = cvtpk(r2, 0.f) & 0xffffu;
    u32x4 w; w.x = hi ? 0u : 0x3F803F80u; w.y = hi ? 0u : (0x3F80u | (u0 << 16)); w.z = hi ? 0u : (u1 | (u2 << 16)); w.w = 0u; return __builtin_bit_cast(bf16x8, w);
}

template <bool FOX, int THRL> __device__ __forceinline__ void attn_unit(long rowbase, int qcol, int vcol, int ocol, int OP, int qb, const unsigned char* Q, const unsigned char* __restrict__ K, const bf16_t* __restrict__ V, bf16_t* O,
                                                                         const float* __restrict__ bias, int t0in, float smax2, char* shm) {
    int tid_ = threadIdx.x; asm volatile("" : "+v"(tid_));
    const int tid = tid_, lane = tid & 63, r32 = lane & 31, hi = lane >> 5; const int wid = __builtin_amdgcn_readfirstlane(tid >> 6);
    const int q0 = qb * QB;
    int NT = (q0 + QB) / KVBLK; int t0 = 0;
    if (FOX) { t0 = t0in; NT -= t0; }
    const bool wlo = wid < 5;
    const unsigned char* Qw = Q + (rowbase + q0 + wid * QBLK) * 512 + qcol;
    const unsigned char* Kh = K + (rowbase + (long)t0 * KVBLK) * 512 + qcol; const bf16_t* Vh = V + (rowbase + (long)t0 * KVBLK) * DM + vcol;
    const int bofs0 = t0 * KVBLK;
    const unsigned lds0 = (unsigned)(uintptr_t)shm;
    float* wsf = (float*)(shm + LDS_WS) + wid * 64;
    const unsigned char* ksrc = Kh + (long)(32 * (wid & 1) + (lane >> 1)) * 512 + ((wid >> 1) & 1) * 32 + (lane & 1) * 16;
    const bf16_t* vsrc = Vh + (long)(16 * (wid & 3) + (lane >> 2)) * DM + (wid >> 2) * 32 + (lane & 3) * 8;
    const unsigned kdst = lds0 + LDS_K + wid * 1024, vdst = lds0 + LDS_V + wid * 1024;
    const float* bsrc = bias + bofs0 + lane;
#define DMA_K(t, slot) do { if (wid < 4) glds16(ksrc + (long)(t) * KVBLK * 512, (unsigned)__builtin_amdgcn_readfirstlane(kdst + ((slot) >> 1))); \
        else if (FOX && wid == 4) glds4(bsrc + (t) * KVBLK, (unsigned)__builtin_amdgcn_readfirstlane(lds0 + LDS_BIAS + ((slot) >> 5))); } while (0)
#define DMA_V(t, slot) glds16(vsrc + (long)(t) * KVBLK * DM, (unsigned)__builtin_amdgcn_readfirstlane(vdst + (slot)))
    const int vb0 = (int)(lds0 + LDS_V) + ((lane >> 4) & 1) * 32 + (lane & 3) * 8 + (4 * hi + ((lane & 15) >> 2)) * 64;
    i32x8 kf[2];
    const lds_cptr shm3 = (lds_cptr)shm; const lds_cptr shm3b = shm3; const lds_cptr kp0 = shm3 + LDS_K + hi * 2048 + r32 * 32; const lds_cptr vp0 = shm3 + LDS_V + ((lane >> 4) & 1) * 32 + (lane & 3) * 8 + (4 * hi + ((lane & 15) >> 2)) * 64;
    DMA_K(0, 0); DMA_V(0, 0); DMA_K(1, SLOTB);
    const i32x8 qr = *reinterpret_cast<const i32x8a*>(Qw + (long)r32 * 512 + hi * 32);
    float mhat = 0.f; if (FOX) mhat = bias[q0 + wid * QBLK + r32] + smax2;
    bf16x8 qone = qext_frag(-mhat, hi);
    f32x16 CB0 = f32x16{}, CB1 = f32x16{};
    bf16x8 kones; { u32x4 w_; w_.x = 0u; w_.y = 0x3F800000u; w_.z = 0x3F803F80u; w_.w = 0u; kones = __builtin_bit_cast(bf16x8, w_); }
    const lds_cptr bp0 = shm3b + LDS_BIAS + 16 * hi;
#define BRD4(CB, base, g) do { const f32x4 q_ = *(const LAS f32x4*)((base) + 32 * (g)); CB[4 * (g)] = q_[0]; CB[4 * (g) + 1] = q_[1]; CB[4 * (g) + 2] = q_[2]; CB[4 * (g) + 3] = q_[3]; } while (0)
    float l_reg = 0.f; f32x16 o[2]; o[0] = f32x16{}; o[1] = f32x16{}; f32x16 negm = f32x16{}; if (!FOX) asm volatile("" : "+v"(negm));
    const int qrel = wid * QBLK + r32;
#define CMASK(P0, P1, t) do { int jb_ = (t) - (NT - 4); if (jb_ >= 0) { if (FOX) cmask(P0, P1, jb_, qrel, hi); else if (jb_ > (wid >> 1)) maskall(P0, P1); } } while (0)
    bool resc = false;
#define START(P0, P1) do { resc = false; \
    if (!FOX) { const float rm = rowmax(P0, P1); const float dl = rm; mhat = fadd_s(mhat, dl); \
      _Pragma("unroll") for (int r = 0; r < 16; ++r) { P0[r] = fsub_s(P0[r], dl); P1[r] = fsub_s(P1[r], dl); } \
      if (FOX) { qone = qext_frag(-mhat, hi); } else { _Pragma("unroll") for (int r = 0; r < 16; ++r) negm[r] = -mhat; asm volatile("" : "+v"(negm)); } } \
    _Pragma("unroll") for (int r = 0; r < 16; ++r) P0[r] = __builtin_amdgcn_exp2f(P0[r]); } while (0)
#define RESC() do { if (resc) { asm volatile("s_waitcnt lgkmcnt(0)" ::: "memory"); \
      _Pragma("unroll") for (int d_ = 0; d_ < 2; ++d_) _Pragma("unroll") for (int r = 0; r < 16; ++r) o[d_][r] *= wsf[crow(r, hi)]; } } while (0)
    f32x16 pA0, pA1, pB0, pB1;
    int sl_prev = 0, sl_cur = 0, sl_next = SLOTB;
#define ROT() do { sl_prev = sl_cur; sl_cur = sl_next; sl_next = (sl_next == (NSLOT - 1) * SLOTB) ? 0 : sl_next + SLOTB; } while (0)
#define WB(NLO, NHI) do { if (wlo) { WAIT_BAR(NLO); } else { WAIT_BAR(NHI); } } while (0)
    DMA_K(2, 2 * SLOTB);
    WB(3, 1);
    if (FOX) { _Pragma("unroll") for (int g_ = 0; g_ < 4; ++g_) { BRD4(CB0, bp0, g_); BRD4(CB1, bp0 + 128, g_); }
               asm volatile("s_waitcnt lgkmcnt(0)" ::: "memory");
               qkt(pA0, pA1, kp0, qr, CB0, CB1);
               pA0 = __builtin_amdgcn_mfma_f32_32x32x16_bf16(kones, qone, pA0, 0, 0, 0); pA1 = __builtin_amdgcn_mfma_f32_32x32x16_bf16(kones, qone, pA1, 0, 0, 0); }
    else qkt(pA0, pA1, kp0, qr, negm);
    asm volatile("s_nop 15\n\ts_nop 7" : "+v"(pA0), "+v"(pA1)); CMASK(pA0, pA1, 0);
    START(pA0, pA1);
    _Pragma("unroll") for (int r = 0; r < 16; ++r) pA1[r] = __builtin_amdgcn_exp2f(pA1[r]);
    WAIT_BAR(0);
    DMA_K(3, 0); DMA_V(1, SLOTB);
    ROT();
    kload8(kf, kp0 + (sl_cur >> 1));
    if (FOX) { _Pragma("unroll") for (int g_ = 0; g_ < 4; ++g_) { BRD4(CB0, bp0 + (sl_cur >> 5), g_); BRD4(CB1, bp0 + (sl_cur >> 5) + 128, g_); } }
    WB(2, 1);
    s16x4 vlo[8], vhi[8]; u32x4 pw0, pw1, pw2, pw3;
#define PKW(P, B) cvtpk(P[B], P[B + 1])
#define PAF(k) __builtin_bit_cast(bf16x8, pw##k)
#define VFR(i) (bf16x8){vlo[i][0], vlo[i][1], vlo[i][2], vlo[i][3], vhi[i][0], vhi[i][1], vhi[i][2], vhi[i][3]}
#define PIN(x) asm volatile("" : "+v"(x))
#define MX3(a, b, c) __builtin_fmaxf(__builtin_fmaxf((a), (b)), (c))
#define GAPA(MF, A0, A1, A2, A3, W0, W1, PW) do { MF; sacc += A0; sacc += A1; sacc += A2; sacc += A3; PIN(sacc); W0; W1; PIN(PW); SBAR(); } while (0)
#define EX(v) __builtin_amdgcn_exp2f(v)
#define GAPB(MF, X, B) do { MF; X[B] = EX(X[B]); X[B + 1] = EX(X[B + 1]); X[B + 2] = EX(X[B + 2]); X[B + 3] = EX(X[B + 3]); PIN(X); SBAR(); } while (0)
#define VRD(i) do { vlo[i] = vtr(vp_ + (((i) >> 2) * 4096 + ((i) & 3) * 1024)); vhi[i] = vtr(vp_ + (((i) >> 2) * 4096 + ((i) & 3) * 1024 + 512)); } while (0)
#define KRD(G, j) do { if (G) { kload2(kf, kp0 + (sl_next >> 1), j); if (FOX) { BRD4(CB0, bp0 + (sl_next >> 5), j); BRD4(CB1, bp0 + (sl_next >> 5) + 128, j); } SBAR(); } } while (0)
#define STEP(C0, C1, P0, P1, t, GK, GV, GL) do { SBAR(); \
    const lds_cptr vp_ = vp0 + sl_prev; \
    VRD(0); SBAR(); float sacc = (P0[0] + P0[1]); \
    GAPA(C0 = MF8(kf[0], qr, (FOX ? CB0 : negm)), P0[2], P0[3], P0[4], P0[5],     pw0[0] = PKW(P0, 0), pw0[1] = PKW(P0, 2), pw0); \
    VRD(4); SBAR(); GAPA(C1 = MF8(kf[1], qr, (FOX ? CB1 : negm)), P0[6], P0[7], P0[8], P0[9],     pw0[2] = PKW(P0, 4), pw0[3] = PKW(P0, 6), pw0); \
    VRD(1); SBAR(); GAPA((void)0,   P0[10], P0[11], P0[12], P0[13], pw1[0] = PKW(P0, 8), pw1[1] = PKW(P0, 10), pw1); \
    VRD(5); SBAR(); GAPA((void)0,   P0[14], P0[15], P1[0], P1[1],   pw1[2] = PKW(P0, 12), pw1[3] = PKW(P0, 14), pw1); \
    VRD(2); SBAR(); GAPA((void)0,   P1[2], P1[3], P1[4], P1[5],     pw2[0] = PKW(P1, 0), pw2[1] = PKW(P1, 2), pw2); \
    VRD(6); SBAR(); GAPA((void)0,   P1[6], P1[7], P1[8], P1[9],     pw2[2] = PKW(P1, 4), pw2[3] = PKW(P1, 6), pw2); \
    VRD(3); SBAR(); GAPA((void)0,   P1[10], P1[11], P1[12], P1[13], pw3[0] = PKW(P1, 8), pw3[1] = PKW(P1, 10), pw3); \
    VRD(7); SBAR(); GAPA((void)0,   P1[14], P1[15], 0.f, 0.f,       pw3[2] = PKW(P1, 12), pw3[3] = PKW(P1, 14), pw3); \
    if (FOX) { C0 = __builtin_amdgcn_mfma_f32_32x32x16_bf16(kones, qone, C0, 0, 0, 0); C1 = __builtin_amdgcn_mfma_f32_32x32x16_bf16(kones, qone, C1, 0, 0, 0); SBAR(); } \
    l_reg += sacc; \
    if (GK) { DMA_K((t) + 3, sl_cur); } if (GV) { DMA_V((t) + 1, sl_next); } \
    CMASK(C0, C1, t); \
    if (!FOX) { float a = MX3(C0[0], C0[1], C1[0]), b = MX3(C0[2], C0[3], C1[1]); a = MX3(a, C1[2], C1[3]); \
      _Pragma("unroll") for (int r = 4; r < 16; r += 4) { a = MX3(a, C0[r], C0[r + 1]); b = MX3(b, C0[r + 2], C0[r + 3]); a = MX3(a, C1[r], C1[r + 1]); b = MX3(b, C1[r + 2], C1[r + 3]); } \
      float rm = __builtin_fmaxf(a, b); { auto rr = __builtin_amdgcn_permlane32_swap(__float_as_uint(rm), __float_as_uint(rm), false, false); rm = __builtin_fmaxf(__uint_as_float(rr[0]), __uint_as_float(rr[1])); } \
      resc = false; \
      if (__builtin_expect(__any(rm > (float)THRL), 0)) { const float dl = __builtin_fmaxf(rm, 0.f); mhat += dl; \
        _Pragma("unroll") for (int r = 0; r < 16; ++r) { C0[r] -= dl; C1[r] -= dl; } \
        if (FOX) { qone = qext_frag(-mhat, hi); } else { _Pragma("unroll") for (int r = 0; r < 16; ++r) negm[r] = -mhat; asm volatile("" : "+v"(negm)); } \
        const float f = __builtin_amdgcn_exp2f(-dl); l_reg *= f; if (hi == 0) wsf[r32] = f; resc = true; } } \
    SBAR(); \
    GAPB(o[0] = __builtin_amdgcn_mfma_f32_32x32x16_bf16(PAF(0), VFR(0), o[0], 0, 0, 0), C0, 0); \
    GAPB(o[1] = __builtin_amdgcn_mfma_f32_32x32x16_bf16(PAF(0), VFR(4), o[1], 0, 0, 0), C0, 4); \
    KRD(GL, 0); GAPB(o[0] = __builtin_amdgcn_mfma_f32_32x32x16_bf16(PAF(1), VFR(1), o[0], 0, 0, 0), C0, 8); \
    KRD(GL, 1); GAPB(o[1] = __builtin_amdgcn_mfma_f32_32x32x16_bf16(PAF(1), VFR(5), o[1], 0, 0, 0), C0, 12); \
    KRD(GL, 2); GAPB(o[0] = __builtin_amdgcn_mfma_f32_32x32x16_bf16(PAF(2), VFR(2), o[0], 0, 0, 0), C1, 0); \
    KRD(GL, 3); GAPB(o[1] = __builtin_amdgcn_mfma_f32_32x32x16_bf16(PAF(2), VFR(6), o[1], 0, 0, 0), C1, 4); \
    GAPB(o[0] = __builtin_amdgcn_mfma_f32_32x32x16_bf16(PAF(3), VFR(3), o[0], 0, 0, 0), C1, 8); \
    GAPB(o[1] = __builtin_amdgcn_mfma_f32_32x32x16_bf16(PAF(3), VFR(7), o[1], 0, 0, 0), C1, 12); \
    } while (0)
    int t = 1;
#undef CMASK
#define CMASK(P0, P1, t) do { } while (0)
    for (; t + 5 < NT; t += 2) {
        STEP(pB0, pB1, pA0, pA1, t, true, true, true);     WB(2, 1); RESC(); ROT();
        STEP(pA0, pA1, pB0, pB1, t + 1, true, true, true); WB(2, 1); RESC(); ROT();
    }
#undef CMASK
#define CMASK(P0, P1, t) do { int jb_ = (t) - (NT - 4); if (jb_ >= 0) { if (FOX) cmask(P0, P1, jb_, qrel, hi); else if (jb_ > (wid >> 1)) maskall(P0, P1); } } while (0)
#define ENDW(tt) do { if ((tt) + 3 < NT) { WB(2, 1); } else if ((tt) + 2 < NT) { WAIT_BAR(1); } else { WAIT_BAR(0); } } while (0)
    for (; t + 1 < NT; t += 2) {
        STEP(pB0, pB1, pA0, pA1, t, (t + 3 < NT), (t + 1 < NT), (t + 1 < NT));         ENDW(t);     RESC(); ROT();
        STEP(pA0, pA1, pB0, pB1, t + 1, (t + 4 < NT), (t + 2 < NT), (t + 2 < NT));     ENDW(t + 1); RESC(); ROT();
    }
    STEP(pB0, pB1, pA0, pA1, NT - 1, false, false, false); RESC();
    { float sacc = pB0[0] + pB0[1]; _Pragma("unroll") for (int r = 2; r < 16; ++r) sacc += pB0[r]; _Pragma("unroll") for (int r = 0; r < 16; ++r) sacc += pB1[r]; l_reg += sacc;
      pw0 = (u32x4){PKW(pB0, 0), PKW(pB0, 2), PKW(pB0, 4), PKW(pB0, 6)}; pw1 = (u32x4){PKW(pB0, 8), PKW(pB0, 10), PKW(pB0, 12), PKW(pB0, 14)}; pw2 = (u32x4){PKW(pB1, 0), PKW(pB1, 2), PKW(pB1, 4), PKW(pB1, 6)}; pw3 = (u32x4){PKW(pB1, 8), PKW(pB1, 10), PKW(pB1, 12), PKW(pB1, 14)};
      SBAR(); pv(o, vb0 + sl_cur, PAF(0), PAF(1), PAF(2), PAF(3)); }
#undef PKW
#undef PAF
#undef VFR
#undef PIN
#undef MX3
#undef GAPA
#undef GAPB
#undef EX
#undef VRD
#undef KRD
#undef BRD4
#undef STEP
#undef ENDW
#undef WB
    { auto rr = __builtin_amdgcn_permlane32_swap(__float_as_uint(l_reg), __float_as_uint(l_reg), false, false); l_reg = __uint_as_float(rr[0]) + __uint_as_float(rr[1]); }
    if (hi == 0) wsf[32 + r32] = l_reg; asm volatile("s_waitcnt lgkmcnt(0)" ::: "memory");
    float rli[16];
#pragma unroll
    for (int r = 0; r < 16; ++r) rli[r] = __builtin_amdgcn_rcpf(wsf[32 + crow(r, hi)]);
    bf16_t* Ow = O + (rowbase + q0 + wid * QBLK) * OP + ocol;
    { bf16_t* stg = (bf16_t*)(shm + LDS_OST) + wid * 2048;
#pragma unroll
      for (int r = 0; r < 16; ++r) { const int orow = crow(r, hi);
#pragma unroll
        for (int d0 = 0; d0 < 2; ++d0) stg[orow * 64 + d0 * 32 + r32] = (bf16_t)f2bf(o[d0][r] * rli[r]); }
      asm volatile("s_waitcnt lgkmcnt(0)" ::: "memory");
#pragma unroll
      for (int i = 0; i < 4; ++i) { const int row = i * 8 + (lane >> 3), ch = lane & 7; const u32x4 v = *(const u32x4*)(stg + row * 64 + ch * 8); *(u32x4*)(Ow + (long)row * OP + ch * 8) = v; } }
    asm volatile("s_waitcnt lgkmcnt(0)\n\ts_barrier" ::: "memory");
#undef DMA_K
#undef DMA_V
#undef CMASK
#undef START
#undef RESC
#undef ROT
}

constexpr int L2_K = 0, L2_V = 3 * 8192, L2_WS = L2_V + 3 * 16384, L2_OST = L2_WS + NW * 64 * 4, LDS_BYTES_D128 = L2_OST + NW * 4096;
template <int THRL, bool COMBINE> __device__ __forceinline__ void attn_unit_d128(long rowbase, int qcol, int vcol, int ocol, int OP, int qb, const unsigned char* Q, const unsigned char* __restrict__ K, const unsigned char* __restrict__ V, bf16_t* O,
                                                                                const bf16_t* O1, int o1col, float lam, const float* __restrict__ gsub, char* shm) {
    int tid_ = threadIdx.x; asm volatile("" : "+v"(tid_));
    const int tid = tid_, lane = tid & 63, r32 = lane & 31, hi = lane >> 5; const int wid = __builtin_amdgcn_readfirstlane(tid >> 6);
    const int q0 = qb * QB; const int NT = (q0 + QB) / KVBLK;
    const bool wlo = wid < 4;
    const unsigned char* Qw = Q + (rowbase + q0 + wid * QBLK) * 512 + qcol;
    const unsigned char* Kh = K + rowbase * 512 + qcol; const unsigned char* Vh = V + rowbase * 512 + vcol;
    const unsigned lds0 = (unsigned)(uintptr_t)shm;
    float* wsf = (float*)(shm + L2_WS) + wid * 64;
    const unsigned char* ksrc = Kh + (long)(32 * (wid & 1) + (lane >> 1)) * 512 + ((wid >> 1) & 1) * 32 + (lane & 1) * 16;
    const int vj_ = lane >> 1, vg_ = wid & 1; const int vkey_ = (vj_ < 16) ? crow(vj_, vg_) : 32 + crow(vj_ - 16, vg_);
    const unsigned char* vsrc = Vh + (long)vkey_ * 512 + (wid >> 1) * 32 + (lane & 1) * 16;
    const unsigned kdst = lds0 + L2_K + wid * 1024, vdst = lds0 + L2_V + wid * 1024;
#define DMA_K(t, slot) do { if (wlo) glds16(ksrc + (long)(t) * KVBLK * 512, (unsigned)__builtin_amdgcn_readfirstlane(kdst + ((slot) >> 1))); } while (0)
#define DMA_V(t, slot) glds16(vsrc + (long)(t) * KVBLK * 512, (unsigned)__builtin_amdgcn_readfirstlane(vdst + (slot)))
    i32x8 kf[2];
    const lds_cptr shm3 = (lds_cptr)shm; const lds_cptr kp0 = shm3 + L2_K + hi * 2048 + r32 * 32; const lds_cptr vp0 = shm3 + L2_V + (32 * hi + ((lane & 15) >> 1)) * 32 + ((lane >> 4) & 1) * 16 + (lane & 1) * 8;
    DMA_K(0, 0); DMA_V(0, 0); DMA_K(1, SLOTB);
    const i32x8 qr = *reinterpret_cast<const i32x8a*>(Qw + (long)r32 * 512 + hi * 32);
    float mhat = 0.f, l_reg = 0.f; f32x16 o[4]; o[0] = f32x16{}; o[1] = f32x16{}; o[2] = f32x16{}; o[3] = f32x16{}; f32x16 ol = f32x16{};
    constexpr int L2_ONES = LDS_BYTES_D128;
    if (tid == 0) { u32x4 o4_; o4_.x = o4_.y = o4_.z = o4_.w = 0x38383838u; *(u32x4*)(shm + L2_ONES) = o4_; *(u32x4*)(shm + L2_ONES + 16) = o4_; }
    i32x8 vone;
    f32x16 negm = f32x16{}; asm volatile("" : "+v"(negm));
#define CMASK(P0, P1, t) do { int jb_ = (t) - (NT - 4); if (jb_ > (wid >> 1)) maskall(P0, P1); } while (0)
    bool resc = false;
#define RESC() do { if (resc) { asm volatile("s_waitcnt lgkmcnt(0)" ::: "memory"); \
      _Pragma("unroll") for (int d_ = 0; d_ < 4; ++d_) _Pragma("unroll") for (int r = 0; r < 16; ++r) o[d_][r] *= wsf[crow(r, hi)]; \
      _Pragma("unroll") for (int r = 0; r < 16; ++r) ol[r] *= wsf[crow(r, hi)]; } } while (0)
    f32x16 C0, C1; i32x8 pwa, pwb;
    int sl_prev = 0, sl_cur = 0, sl_next = SLOTB;
#define ROT() do { sl_prev = sl_cur; sl_cur = sl_next; sl_next = (sl_next == (NSLOT - 1) * SLOTB) ? 0 : sl_next + SLOTB; } while (0)
#define WB(NLO, NHI) do { if (wlo) { WAIT_BAR(NLO); } else { WAIT_BAR(NHI); } } while (0)
    DMA_K(2, 2 * SLOTB);
    WB(3, 1);
    qkt(C0, C1, kp0, qr, negm);
    asm volatile("s_nop 15\n\ts_nop 7" : "+v"(C0), "+v"(C1)); CMASK(C0, C1, 0);
    { const float rm = rowmax(C0, C1) - 6.0f; mhat = rm;
#pragma unroll
      for (int r = 0; r < 16; ++r) { C0[r] = __builtin_amdgcn_exp2f(C0[r] - rm); C1[r] = __builtin_amdgcn_exp2f(C1[r] - rm); }
#pragma unroll
      for (int r = 0; r < 16; ++r) negm[r] = -mhat;
      asm volatile("" : "+v"(negm));
#pragma unroll
      for (int w = 0; w < 4; ++w) { pwa[w] = (int)pk4_fp8_nc(C0[4 * w], C0[4 * w + 1], C0[4 * w + 2], C0[4 * w + 3]); pwa[4 + w] = (int)pk4_fp8_nc(C1[4 * w], C1[4 * w + 1], C1[4 * w + 2], C1[4 * w + 3]); } }
    WAIT_BAR(0);
    DMA_K(3, 0); DMA_V(1, SLOTB);
    ROT();
    kload8(kf, kp0 + (sl_cur >> 1));
    WB(2, 1);
    typedef int v2i_t __attribute__((ext_vector_type(2)));
    i32x8 vf[4];
#define PIN(x) asm volatile("" : "+v"(x))
#define MX3(a, b, c) __builtin_fmaxf(__builtin_fmaxf((a), (b)), (c))
#define VTR8(p_) __builtin_amdgcn_ds_read_tr8_b64_v2i32((LAS v2i_t*)(p_))
#define VRDN(dq) do { const v2i_t a_ = VTR8(vp_ + (dq) * 2048), b_ = VTR8(vp_ + (dq) * 2048 + 256), c_ = VTR8(vp_ + (dq) * 2048 + 512), d_ = VTR8(vp_ + (dq) * 2048 + 768); \
        vf[dq] = (i32x8){a_.x, a_.y, b_.x, b_.y, c_.x, c_.y, d_.x, d_.y}; } while (0)
#define KRD(G, j) do { if (G) { kload2(kf, kp0 + (sl_next >> 1), j); } } while (0)
#define EXP4(X, B, W) do { X[B] = __builtin_amdgcn_exp2f(X[B]); X[B + 1] = __builtin_amdgcn_exp2f(X[B + 1]); X[B + 2] = __builtin_amdgcn_exp2f(X[B + 2]); X[B + 3] = __builtin_amdgcn_exp2f(X[B + 3]); \
        W = (int)pk4_fp8_nc(X[B], X[B + 1], X[B + 2], X[B + 3]); PIN(W); } while (0)
#define STEPD(CU, NX, t, GK, GV, GL) do { SBAR(); \
    const lds_cptr vp_ = vp0 + sl_prev; \
    C0 = MF8(kf[0], qr, negm); SBAR(); \
    VRDN(0); VRDN(1); SBAR(); \
    C1 = MF8(kf[1], qr, negm); SBAR(); \
    VRDN(2); VRDN(3); vone = *(const LAS i32x8a*)(shm3 + L2_ONES); SBAR(); \
    if (GK) { DMA_K((t) + 3, sl_cur); } if (GV) { DMA_V((t) + 1, sl_next); } \
    CMASK(C0, C1, t); \
    { float a = MX3(C0[0], C0[1], C1[0]), b = MX3(C0[2], C0[3], C1[1]); a = MX3(a, C1[2], C1[3]); \
      _Pragma("unroll") for (int r = 4; r < 16; r += 4) { a = MX3(a, C0[r], C0[r + 1]); b = MX3(b, C0[r + 2], C0[r + 3]); a = MX3(a, C1[r], C1[r + 1]); b = MX3(b, C1[r + 2], C1[r + 3]); } \
      float rm = __builtin_fmaxf(a, b); { auto rr = __builtin_amdgcn_permlane32_swap(__float_as_uint(rm), __float_as_uint(rm), false, false); rm = __builtin_fmaxf(__uint_as_float(rr[0]), __uint_as_float(rr[1])); } \
      resc = false; \
      if (__builtin_expect(__any(rm > (float)THRL), 0)) { const float dl = __builtin_fmaxf(rm - 6.0f, 0.f); mhat += dl; \
        _Pragma("unroll") for (int r = 0; r < 16; ++r) { C0[r] -= dl; C1[r] -= dl; } \
        _Pragma("unroll") for (int r = 0; r < 16; ++r) negm[r] = -mhat; asm volatile("" : "+v"(negm)); \
        const float f = __builtin_amdgcn_exp2f(-dl); if (hi == 0) wsf[r32] = f; resc = true; } } \
    SBAR(); \
    ol = MF8(CU, vone, ol); SBAR(); \
    o[0] = MF8(CU, vf[0], o[0]); EXP4(C0, 0, NX[0]); EXP4(C0, 4, NX[1]); SBAR(); \
    o[1] = MF8(CU, vf[1], o[1]); EXP4(C0, 8, NX[2]); EXP4(C0, 12, NX[3]); SBAR(); \
    KRD(GL, 0); o[2] = MF8(CU, vf[2], o[2]); EXP4(C1, 0, NX[4]); EXP4(C1, 4, NX[5]); SBAR(); \
    KRD(GL, 1); o[3] = MF8(CU, vf[3], o[3]); EXP4(C1, 8, NX[6]); EXP4(C1, 12, NX[7]); SBAR(); \
    } while (0)
#define STEP_AB(t, GK, GV, GL) STEPD(pwa, pwb, t, GK, GV, GL)
#define STEP_BA(t, GK, GV, GL) STEPD(pwb, pwa, t, GK, GV, GL)
    int t = 1;
#undef CMASK
#define CMASK(P0, P1, t) do { } while (0)
    for (; t + 5 < NT; t += 2) {
        STEP_AB(t, true, true, true);     WB(2, 1); RESC(); ROT();
        STEP_BA(t + 1, true, true, true); WB(2, 1); RESC(); ROT();
    }
#undef CMASK
#define CMASK(P0, P1, t) do { int jb_ = (t) - (NT - 4); if (jb_ > (wid >> 1)) maskall(P0, P1); } while (0)
#define ENDW(tt) do { if ((tt) + 3 < NT) { WB(2, 1); } else if ((tt) + 2 < NT) { WAIT_BAR(1); } else { WAIT_BAR(0); } } while (0)
    for (; t + 1 < NT; t += 2) {
        STEP_AB(t, (t + 3 < NT), (t + 1 < NT), (t + 1 < NT));         ENDW(t);     RESC(); ROT();
        STEP_BA(t + 1, (t + 4 < NT), (t + 2 < NT), (t + 2 < NT));     ENDW(t + 1); RESC(); ROT();
    }
    STEP_AB(NT - 1, false, false, false); RESC();
    { const lds_cptr vp_ = vp0 + sl_cur; SBAR(); VRDN(0); VRDN(1); VRDN(2); VRDN(3); vone = *(const LAS i32x8a*)(shm3 + L2_ONES);
      ol = MF8(pwb, vone, ol); o[0] = MF8(pwb, vf[0], o[0]); o[1] = MF8(pwb, vf[1], o[1]); o[2] = MF8(pwb, vf[2], o[2]); o[3] = MF8(pwb, vf[3], o[3]); }
#undef PIN
#undef MX3
#undef VTR8
#undef VRDN
#undef KRD
#undef EXP4
#undef STEPD
#undef STEP_AB
#undef STEP_BA
#undef ENDW
#undef WB
    float rli[16];
#pragma unroll
    for (int r = 0; r < 16; ++r) rli[r] = __builtin_amdgcn_rcpf(ol[r]);
    bf16_t* Ow = O + (rowbase + q0 + wid * QBLK) * OP + ocol;
    if (!COMBINE) {
        bf16_t* stg = (bf16_t*)(shm + L2_OST) + wid * 2048;
#pragma unroll
        for (int p = 0; p < 2; ++p) {
#pragma unroll
            for (int r = 0; r < 16; ++r) { const int orow = crow(r, hi);
#pragma unroll
                for (int dd = 0; dd < 2; ++dd) stg[orow * 64 + dd * 32 + r32] = (bf16_t)f2bf(o[2 * p + dd][r] * rli[r]); }
            asm volatile("s_waitcnt lgkmcnt(0)" ::: "memory");
#pragma unroll
            for (int i = 0; i < 4; ++i) { const int row = i * 8 + (lane >> 3), ch = lane & 7; const u32x4 v = *(const u32x4*)(stg + row * 64 + ch * 8); *(u32x4*)(Ow + (long)row * OP + p * 64 + ch * 8) = v; }
            asm volatile("s_waitcnt lgkmcnt(0)" ::: "memory");
        }
    } else {
        asm volatile("s_waitcnt lgkmcnt(0)\n\ts_barrier" ::: "memory");
        constexpr int SROW = 136;
        bf16_t* stg = (bf16_t*)shm + wid * (32 * SROW);
#pragma unroll
        for (int r = 0; r < 16; ++r) { const int orow = crow(r, hi);
#pragma unroll
            for (int dq = 0; dq < 4; ++dq) stg[orow * SROW + dq * 32 + r32] = (bf16_t)f2bf(o[dq][r] * rli[r]); }
        asm volatile("s_waitcnt vmcnt(0) lgkmcnt(0)" ::: "memory");
        const int row = lane >> 1, hf = lane & 1;
        const bf16_t* o1p = O1 + (rowbase + q0 + wid * QBLK + row) * 512 + o1col + hf * 64;
        const bf16_t* o2p = stg + row * SROW + hf * 64;
        float d[64]; float ss = 0.f;
#pragma unroll
        for (int i = 0; i < 8; ++i) { const u32x4 a = *(const u32x4*)(o1p + 8 * i), c = *(const u32x4*)(o2p + 8 * i);
            d[8 * i + 0] = bf2f(a.x & 0xffffu) - lam * bf2f(c.x & 0xffffu); d[8 * i + 1] = bf2f(a.x >> 16) - lam * bf2f(c.x >> 16);
            d[8 * i + 2] = bf2f(a.y & 0xffffu) - lam * bf2f(c.y & 0xffffu); d[8 * i + 3] = bf2f(a.y >> 16) - lam * bf2f(c.y >> 16);
            d[8 * i + 4] = bf2f(a.z & 0xffffu) - lam * bf2f(c.z & 0xffffu); d[8 * i + 5] = bf2f(a.z >> 16) - lam * bf2f(c.z >> 16);
            d[8 * i + 6] = bf2f(a.w & 0xffffu) - lam * bf2f(c.w & 0xffffu); d[8 * i + 7] = bf2f(a.w >> 16) - lam * bf2f(c.w >> 16);
#pragma unroll
            for (int e = 0; e < 8; ++e) ss += d[8 * i + e] * d[8 * i + e]; }
        ss += __shfl_xor(ss, 1);
        const float rs = (1.0f - LAM0) * __builtin_amdgcn_rsqf(ss * (1.0f / 128.0f) + EPS);
        bf16_t* op = Ow + (long)row * OP + hf * 64;
#pragma unroll
        for (int i = 0; i < 8; ++i) { const f32x4 g0 = *(const f32x4*)(gsub + hf * 64 + 8 * i), g1 = *(const f32x4*)(gsub + hf * 64 + 8 * i + 4);
            u32x4 w; w.x = cvtpk(d[8 * i] * rs * g0[0], d[8 * i + 1] * rs * g0[1]); w.y = cvtpk(d[8 * i + 2] * rs * g0[2], d[8 * i + 3] * rs * g0[3]);
            w.z = cvtpk(d[8 * i + 4] * rs * g1[0], d[8 * i + 5] * rs * g1[1]); w.w = cvtpk(d[8 * i + 6] * rs * g1[2], d[8 * i + 7] * rs * g1[3]);
            *(u32x4*)(op + 8 * i) = w; }
    }
    asm volatile("s_waitcnt lgkmcnt(0)\n\ts_barrier" ::: "memory");
#undef DMA_K
#undef DMA_V
#undef CMASK
#undef RESC
#undef ROT
}
#undef SBAR
#undef WAIT_BAR
}

typedef GAS unsigned gu32;
#define XB_TMO      128
#define XB_XCNT(j)  (256  + 64 * (j))
#define XB_XSUB(j)  (1280 + 64 * (j))
#define XB_XGEN(j)  (2304 + 64 * (j))
#define XB_TOP      3328
#define XB_TOPGEN   3392
#define XCD_BAR_WORDS 3456
#define XB_SPIN_CAP (1u << 19)
__device__ __forceinline__ unsigned xb_ld(unsigned* p)              { return __hip_atomic_load(p, __ATOMIC_RELAXED, __HIP_MEMORY_SCOPE_AGENT); }
__device__ __forceinline__ unsigned xb_add(unsigned* p, unsigned v) { return __hip_atomic_fetch_add(p, v, __ATOMIC_RELAXED, __HIP_MEMORY_SCOPE_AGENT); }
__device__ __forceinline__ unsigned xb_xcc_id() { return (unsigned)__builtin_amdgcn_s_getreg((3 << 11) | 20) & 0xFu; }
#define XB_SPIN(cond, bar) do { unsigned _sp = 0; while (cond) { __builtin_amdgcn_s_sleep(1); \
    if ((++_sp & 255u) == 0u) { if (xb_ld(&(bar)[XB_TMO])) break; if (_sp > XB_SPIN_CAP) { atomicAdd(&(bar)[XB_TMO], 1u); break; } } } } while (0)
struct XcdBarrier { unsigned* bar; unsigned x; volatile LAS unsigned* st; };
__device__ __forceinline__ XcdBarrier xcd_barrier_post(unsigned* bar, volatile LAS unsigned* st) {
    XcdBarrier b; b.bar = bar; b.x = xb_xcc_id(); b.st = st;
    if (threadIdx.x == 0) (void)xb_add(&bar[XB_XCNT(b.x)], 1u);
    return b;
}
__device__ __forceinline__ void xcd_barrier_complete(unsigned* bar, unsigned x, unsigned& nloc, unsigned& nx) {
    const unsigned G = gridDim.x * gridDim.y * gridDim.z;
    unsigned sum, cnt, mine, sp = 0u;
    for (;;) {
        sum = 0u; cnt = 0u; mine = 0u;
#pragma unroll
        for (unsigned j = 0; j < 16; ++j) { const unsigned c = xb_ld(&bar[XB_XCNT(j)]); sum += c; cnt += (c > 0u) ? 1u : 0u; mine = (j == x) ? c : mine; }
        if (sum == G) break;
        __builtin_amdgcn_s_sleep(1);
        if ((++sp & 255u) == 0u) { if (xb_ld(&bar[XB_TMO])) break; if (sp > XB_SPIN_CAP) { atomicAdd(&bar[XB_TMO], 1u); break; } }
    }
    nloc = mine > 0u ? mine : 1u; nx = cnt > 0u ? cnt : 1u;
}
__device__ __forceinline__ void xcd_barrier(const XcdBarrier& b) {
    asm volatile("s_waitcnt vmcnt(0)" ::: "memory");
    __syncthreads();
    if (threadIdx.x == 0) {
        unsigned* bar = b.bar;
        __builtin_amdgcn_s_waitcnt(0);
        unsigned nloc = b.st[0], nx = b.st[1];
        if (nloc == 0u) { xcd_barrier_complete(bar, b.x, nloc, nx); b.st[0] = nloc; b.st[1] = nx; }
        const unsigned old = xb_add(&bar[XB_XSUB(b.x)], 1u);
        const unsigned gen = old / nloc;
        if (old + 1u == (gen + 1u) * nloc) {
            __builtin_amdgcn_fence(__ATOMIC_RELEASE, "agent");
            asm volatile("s_waitcnt vmcnt(0)" ::: "memory");
            const unsigned og = xb_add(&bar[XB_TOP], 1u);
            const unsigned tg = og / nx;
            if (og + 1u == (tg + 1u) * nx) xb_add(&bar[XB_TOPGEN], 1u);
            else XB_SPIN(xb_ld(&bar[XB_TOPGEN]) == tg, bar);
            xb_add(&bar[XB_XGEN(b.x)], 1u);
            __builtin_amdgcn_fence(__ATOMIC_ACQUIRE, "agent");
            asm volatile("s_waitcnt vmcnt(0)" ::: "memory");
        } else {
            XB_SPIN(xb_ld(&bar[XB_XGEN(b.x)]) == gen, bar);
            __builtin_amdgcn_fence(__ATOMIC_ACQUIRE, "agent");
            asm volatile("s_waitcnt vmcnt(0)" ::: "memory");
        }
    }
    __syncthreads();
}

struct Args {
    const float* in[28]; float* out; unsigned char* ws; int ph_lo, ph_hi, li, pad;
};
enum { I_X = 0, I_C, I_POS, I_WADA, I_BADA, I_GN1, I_WIN, I_BF, I_GQF, I_GKF, I_GQD, I_GKD, I_LQ1, I_LK1, I_LQ2, I_LK2, I_GSUB, I_WPF, I_WPD, I_WOUT, I_GN2, I_WRG, I_BRG, I_WRE, I_BRE, I_W1, I_W3, I_W2 };

template <bool F8 = false> __device__ __forceinline__ void transpose_item(const float* W, size_t ldw, int col0, int k0, bf16_t* WT, int drow, int Kd, LAS float* scr, int lane, int kd0 = 0) {
    float v[32];
    const float* wp = W + (size_t)(k0 + (lane >> 5)) * ldw + col0 + (lane & 31);
#pragma unroll
    for (int i = 0; i < 32; ++i) v[i] = wp[(size_t)(2 * i) * ldw];
#pragma unroll
    for (int i = 0; i < 32; ++i) scr[(2 * i + (lane >> 5)) * 33 + (lane & 31)] = v[i];
    LDS_WAIT(); asm volatile("" ::: "memory");
    const int c = lane & 7;
#pragma unroll
    for (int j = 0; j < 4; ++j) { const int n = (lane >> 3) + 8 * j; const LAS float* s = scr + (8 * c) * 33 + n;
        u32x4 o; o.x = pk2(s[0 * 33], s[1 * 33]); o.y = pk2(s[2 * 33], s[3 * 33]); o.z = pk2(s[4 * 33], s[5 * 33]); o.w = pk2(s[6 * 33], s[7 * 33]);
        if (F8) { u32x2 o8; o8.x = pk4_fp8(W8S * s[0 * 33], W8S * s[1 * 33], W8S * s[2 * 33], W8S * s[3 * 33]); o8.y = pk4_fp8(W8S * s[4 * 33], W8S * s[5 * 33], W8S * s[6 * 33], W8S * s[7 * 33]);
                  *(u32x2*)((unsigned char*)WT + (size_t)(drow + n) * Kd + kd0 + k0 + 8 * c) = o8; }
        else *(u32x4*)(WT + (size_t)(drow + n) * Kd + kd0 + k0 + 8 * c) = o; }
    LDS_WAIT(); asm volatile("" ::: "memory");
}

__global__ void __launch_bounds__(NTHREADS, 2) fwd_kernel(Args args) {
    extern __shared__ __attribute__((aligned(16))) unsigned char lds_raw[];
    LAS unsigned char* lds = (LAS unsigned char*)lds_raw;
    volatile LAS unsigned* MISC = (volatile LAS unsigned*)(lds + MISC_OFF);
    const int tid = threadIdx.x, lane = tid & 63, wave = __builtin_amdgcn_readfirstlane(tid >> 6);
    const int G = gridDim.x; const int bx = blockIdx.x; const int vcu = (G % 8 == 0) ? (bx % 8) * (G / 8) + bx / 8 : bx;
    unsigned char* ws = args.ws;
    gu32* ctl = (gu32*)(ws + WS_CTL);
    const int gw = vcu * NWAVES + wave, NGW = G * NWAVES;

    for (int u = tid; u < (LDS_BYTES - LDSCTL_OFF) / 4; u += NTHREADS) ((LAS unsigned*)(lds + LDSCTL_OFF))[u] = 0u;
    __syncthreads();
    XcdBarrier bar; bar.bar = (unsigned*)(ctl + CW_BAR); bar.x = 0; bar.st = nullptr;
    const bool one_launch = (args.ph_hi - args.ph_lo) > 1;
    if (one_launch) bar = xcd_barrier_post((unsigned*)(ctl + CW_BAR), MISC + 8);
    const int lo = args.ph_lo, hi = args.ph_hi;
#ifdef ONLYP
#define IN(k) ((k) == ONLYP && lo <= (k) && (k) < hi)
#else
#define IN(k) (lo <= (k) && (k) < hi)
#endif
#define SEAM(k) do { if (IN(k) && IN((k) + 1)) xcd_barrier(bar); } while (0)

    float* mod = (float*)(ws + WS_MOD);
    float* logf = (float*)(ws + WS_LOGF);
    float* biasb = (float*)(ws + WS_BIAS);
    bf16_t* Win_t = (bf16_t*)(ws + WS_WIN); bf16_t* Wpf_t = (bf16_t*)(ws + WS_WPF); bf16_t* Wpd_t = (bf16_t*)(ws + WS_WPD); bf16_t* Wout_t = (bf16_t*)(ws + WS_WOUT);
    bf16_t* W13_t = (bf16_t*)(ws + WS_W13); bf16_t* W2_t = (bf16_t*)(ws + WS_W2); bf16_t* Wr_t = (bf16_t*)(ws + WS_WR);
    bf16_t* H1 = (bf16_t*)(ws + WS_H1); bf16_t* OCAT = H1;     bf16_t* X1B = H1; bf16_t* H2 = (bf16_t*)(ws + WS_H2);
    bf16_t* QF = (bf16_t*)(ws + WS_QF); bf16_t* KF = (bf16_t*)(ws + WS_KF); bf16_t* VF = (bf16_t*)(ws + WS_VF);
    bf16_t* QD = (bf16_t*)(ws + WS_QD); bf16_t* KD = (bf16_t*)(ws + WS_KD); bf16_t* VD = (bf16_t*)(ws + WS_VD);
    bf16_t* GT = (bf16_t*)(ws + WS_G); bf16_t* O1T = (bf16_t*)(ws + WS_OD);     bf16_t* MERGED = (bf16_t*)(ws + WS_MERGED);
    bf16_t* H2S = (bf16_t*)(ws + WS_H2S); bf16_t* YB = H2S; unsigned char* HH8 = (unsigned char*)(ws + WS_HH);
    unsigned char* H1F8 = (unsigned char*)(ws + WS_OD);
    unsigned char* WG8 = (unsigned char*)(ws + WS_W13 + 32 * MiB);
    unsigned char* H2F8 = (unsigned char*)(ws + WS_QF);
    float* LOGIT = (float*)(ws + WS_LOGIT);
    int* EID = (int*)(ws + WS_EID); int* RNK = (int*)(ws + WS_RNK); float* WGT = (float*)(ws + WS_WGT); int* POS = (int*)(ws + WS_POS);
    int* HIST = (int*)(ws + WS_HIST); int* ELIST = (int*)(ws + WS_ROPE);
    unsigned* GCNT = (unsigned*)(ctl + CW_GCNT); float* gall = (float*)(ws + WS_GALL);
    const float* x = args.in[I_X];

    for (int rep_ = 0; rep_ < 1 + ((PROBE_REP >> 0) & 1); ++rep_) if (IN(0)) {
        if (vcu < 96) {
            LAS float* sl = (LAS float*)lds;
            LAS float* red = (LAS float*)(lds + 65536);
            const float* c = args.in[I_C];
            for (int i = tid; i < 16 * 1024; i += NTHREADS) { const int b = i >> 10, k = i & 1023; const float v = c[i]; sl[k * 16 + b] = v / (1.0f + __expf(-v)); }
            __syncthreads();
            const float* wa = args.in[I_WADA] + vcu * 64 + lane;
            float a[16];
#pragma unroll
            for (int b = 0; b < 16; ++b) a[b] = 0.f;
            for (int k = wave * 128; k < wave * 128 + 128; k += 16) {
                float w[16];
#pragma unroll
                for (int q = 0; q < 16; ++q) w[q] = wa[(size_t)(k + q) * 6144];
#pragma unroll
                for (int q = 0; q < 16; ++q) {
                    const LAS f32x4* sp = (const LAS f32x4*)(sl + (k + q) * 16);
#pragma unroll
                    for (int b4 = 0; b4 < 4; ++b4) { const f32x4 s = sp[b4]; a[4 * b4 + 0] += s[0] * w[q]; a[4 * b4 + 1] += s[1] * w[q]; a[4 * b4 + 2] += s[2] * w[q]; a[4 * b4 + 3] += s[3] * w[q]; }
                    __builtin_amdgcn_sched_barrier(0);
                }
            }
#pragma unroll
            for (int b = 0; b < 16; ++b) red[(wave * 16 + b) * 64 + lane] = a[b];
            __syncthreads();
            for (int i = tid; i < 1024; i += NTHREADS) { const int b = i >> 6, cc = i & 63; float s = 0.f;
#pragma unroll
                for (int w = 0; w < 8; ++w) s += red[(w * 16 + b) * 64 + cc];
                mod[b * 6144 + vcu * 64 + cc] = s + args.in[I_BADA][vcu * 64 + cc]; }
            __syncthreads();
        }
        if (vcu == 100 && tid < 256) gall[tid] = args.in[I_GQF + (tid >> 6)][tid & 63];
        for (int i = gw * 64 + lane; i < 256 * 1024; i += NGW * 64) { const int r = i >> 10, k = i & 1023; float v = 0.f;
            if (r < 4) v = args.in[I_WRG][k * 4 + r]; else if (r < 36) v = args.in[I_WRE][k * 32 + (r - 4)];
            Wr_t[i] = (bf16_t)f2bf(v); }
        { LAS float* scr = (LAS float*)(lds + wave * 16384);
          constexpr int I_IN = 160 * 16, I_PF = 32 * 8, I_PD = 32 * 8, I_OUT = 32 * 16, I_13 = 32 * 2 * 16 * 16, I_2 = 32 * 32 * 8;
          constexpr int NITEMS = I_IN + I_PF + I_PD + I_OUT + I_13 + I_2;
          constexpr int NADA = 96 * NWAVES, ITA = 11 * NADA;
          const bool ada_ = (G == 256) && (vcu < 96);
          const int it0 = (G != 256) ? gw : (ada_ ? vcu * NWAVES + wave : ITA + (vcu - 96) * NWAVES + wave), it1 = (G != 256) ? NITEMS : (ada_ ? ITA : NITEMS), its = (G != 256) ? NGW : (ada_ ? NADA : NGW - NADA);
          for (int it = it0; it < it1; it += its) {
              int r = it;
              if (r < I_IN) { const int nb = r % 160, kb = r / 160; const int pn = nb >> 3, c0 = (nb & 7) * 32, bj = c0 >> 7, wc = (c0 & 127) >> 5; int col0;
                  if (pn >= 12) col0 = COL_GATE + (pn - 12) * 256 + c0;
                  else { const int sec = pn >> 1, pl = pn & 1; const int sb = sec == 0 ? COL_FQ : sec == 1 ? COL_FK : sec == 2 ? COL_FV : sec == 3 ? COL_DQ : sec == 4 ? COL_DK : COL_DV;
                      if (sec == 2 || sec == 5) col0 = sb + pl * 256 + c0; else col0 = sb + (4 * pl + wc) * 64 + 32 * bj; }
                  transpose_item<true>(args.in[I_WIN], IN_COLS, col0, kb * 64, (bf16_t*)WG8, nb * 32, 1024, scr, lane);
                  continue; } r -= I_IN;
              if (r < I_PF) { const int nb = r % 32, kb = r / 32; transpose_item(args.in[I_WPF], 1024, nb * 32, kb * 64, Wpf_t, nb * 32, 1024, scr, lane, 0); continue; } r -= I_PF;
              if (r < I_PD) { const int nb = r % 32, kb = r / 32; transpose_item(args.in[I_WPD], 1024, nb * 32, kb * 64, Wpf_t, nb * 32, 1024, scr, lane, 512); continue; } r -= I_PD;
              if (r < I_OUT) { const int nb = r % 32, kb = r / 32; transpose_item<true>(args.in[I_WOUT], 1024, nb * 32, kb * 64, Wout_t, nb * 32, 1024, scr, lane); continue; }     r -= I_OUT;
              if (r < I_13) { const int nb = r % 16, kb = (r / 16) % 16, sr = (r / 256) % 2, e = r / 512; const int n0 = nb * 32, ct = n0 >> 7;
                  transpose_item<true>(args.in[sr ? I_W3 : I_W1] + (size_t)e * 1024 * 512, 512, n0, kb * 64, W13_t, e * 1024 + ct * 256 + 128 * sr + (n0 - ct * 128), 1024, scr, lane); continue; } r -= I_13;
              { const int nb = r % 32, kb = (r / 32) % 8, e = r / 256;
                  transpose_item<true>(args.in[I_W2] + (size_t)e * 512 * 1024, 1024, nb * 32, kb * 64, W2_t, e * 1024 + nb * 32, 512, scr, lane); }
          } }
    }
    SEAM(0);

    for (int rep_ = 0; rep_ < 1 + ((PROBE_REP >> 1) & 1); ++rep_) if (IN(1)) {
        LAS float* wff = (LAS float*)lds;
        for (int i = tid; i < 8 * 1024; i += NTHREADS) { const int k = i >> 3, q = i & 7; wff[q * 1024 + k] = args.in[I_WIN][(size_t)k * IN_COLS + COL_FF + q]; }
        __syncthreads();
        const int b = gw >> 7;
        const float* mb = mod + (size_t)b * 6144;
        f32x4 gm[4], sh[4];
#pragma unroll
        for (int j = 0; j < 4; ++j) { const int k = 256 * j + 4 * lane; const f32x4 g = *(const f32x4*)(args.in[I_GN1] + k), sc = *(const f32x4*)(mb + 1024 + k); sh[j] = *(const f32x4*)(mb + k); gm[j] = g * (1.0f + sc); }
        const float bfv = (lane < 8) ? args.in[I_BF][lane] : 0.f;
        for (int r = 0; r < 32; ++r) {
            const int row = gw * 32 + r;
            const f32x4* xr = (const f32x4*)(x + (size_t)row * 1024) + lane;
            f32x4 v[4]; float ss = 0.f;
#pragma unroll
            for (int j = 0; j < 4; ++j) { v[j] = xr[64 * j]; ss += (v[j][0] * v[j][0] + v[j][1] * v[j][1]) + (v[j][2] * v[j][2] + v[j][3] * v[j][3]); }
            const float rstd = 1.0f / sqrtf(wave_sum(ss) * (1.0f / 1024.0f) + EPS);
            unsigned long long* o8 = (unsigned long long*)(H1 + (size_t)row * 1024) + lane;
            float zf[8];
#pragma unroll
            for (int q = 0; q < 8; ++q) zf[q] = 0.f;
#pragma unroll
            for (int j = 0; j < 4; ++j) { v[j] = v[j] * rstd * gm[j] + sh[j];
                *((unsigned*)(H1F8 + (size_t)row * 1024 + 256 * j) + lane) = pk4_fp8(v[j][0], v[j][1], v[j][2], v[j][3]);
#pragma unroll
                for (int q = 0; q < 8; ++q) { const f32x4 w = *(const LAS f32x4*)(wff + q * 1024 + 256 * j + 4 * lane); zf[q] += (v[j][0] * w[0] + v[j][1] * w[1]) + (v[j][2] * w[2] + v[j][3] * w[3]); } }
            float mine = 0.f;
#pragma unroll
            for (int q = 0; q < 8; ++q) { const float s = wave_sum(zf[q]); if (lane == q) mine = s; }
            if (lane < 8) { const float z = mine + bfv; const float lf = fminf(z, 0.f) - log1pf(__expf(-fabsf(z)));
                logf[(size_t)(b * 8 + lane) * SEQ + (row & (SEQ - 1))] = lf; }
        }
    }
    SEAM(1);

    for (int rep_ = 0; rep_ < 1 + ((PROBE_REP >> 2) & 1); ++rep_) if (IN(2)) {
        if (vcu < 128 && wave == 0) {
            const float* lp = logf + (size_t)vcu * SEQ + 64 * lane; float v[64]; float run = 0.f;
#pragma unroll
            for (int i = 0; i < 16; ++i) { const f32x4 q = *(const f32x4*)(lp + 4 * i); v[4 * i] = q[0]; v[4 * i + 1] = q[1]; v[4 * i + 2] = q[2]; v[4 * i + 3] = q[3]; }
#pragma unroll
            for (int i = 0; i < 64; ++i) { run += v[i]; v[i] = run; }
            float incl = run;
#pragma unroll
            for (int o = 1; o < 64; o <<= 1) { const float t = __shfl_up(incl, o); if (lane >= o) incl += t; }
            const float excl = incl - run;
            float* bp = biasb + (size_t)vcu * SEQ + 64 * lane;
#pragma unroll
            for (int i = 0; i < 16; ++i) { f32x4 q; q[0] = -(excl + v[4 * i]) * LOG2E; q[1] = -(excl + v[4 * i + 1]) * LOG2E; q[2] = -(excl + v[4 * i + 2]) * LOG2E; q[3] = -(excl + v[4 * i + 3]) * LOG2E; *(f32x4*)(bp + 4 * i) = q; }
        }
        { pg8::USched S{}; S.nM = NTOK / 256; S.nN = 20; S.G = G; S.c = bx; S.pair = 0; S.K = 512  ; S.nseg = 1; S.A0 = (const char*)H1F8; S.A1 = S.A0; S.B0 = (const char*)WG8; S.B1 = S.B0; S.segB = 0; S.tp = nullptr; S.rowst = nullptr; S.direct = -1; S.gidx = nullptr;
          UEpi E{}; E.mode = (((PROBE_REP >> 21) & 1) && rep_) ? 99 : 1; E.pnoff = 12; E.ascale = 1.0f / W8S; E.qkv6 = QF; E.gates = GT; E.gall = gall; E.pos = (const int*)args.in[I_POS];
          pg8::gemm_phase<UEpi, pg8::USched, true>(lds, 512, S, E); }
    }
    SEAM(2);

    if (IN(3)) {
        float bound2;
        float smax2;
        { const float gq = fabsf(args.in[I_GQF][lane]), gk = fabsf(args.in[I_GKF][lane]); const float smax = 8.0f * wave_max(gq) * wave_max(gk); bound2 = (2.0f * smax + 19.5f) * LOG2E; smax2 = smax * LOG2E * 1.02f + 0.5f; }
        const int grp = vcu >> 3, s8 = vcu & 7;
        float lam;
        { const float a = wave_sum(args.in[I_LQ1][lane] * args.in[I_LK1][lane]), c = wave_sum(args.in[I_LQ2][lane] * args.in[I_LK2][lane]); lam = __expf(a) - __expf(c) + LAM0; }
        LAS int* t0tab = (LAS int*)(lds + LDSCTL_OFF + 768);
        { const int i = wave; const int stream = (i >> 1) * 32 + grp; const int sr = (s8 + 2 * (i >> 1)) & 7; const int qb = (i & 1) ? 15 - sr : sr;
          const int b = stream >> 3, h = ((stream & 7) + (b & 3) + 2 * (i >> 1)) & 7;
          const float* bias = biasb + (size_t)(b * 8 + h) * SEQ; const int q0 = qb * 256, NT0 = (q0 + 256) / 64;
          const float bq = bias[q0]; const int j = lane; float bj = 0.f; if (j < NT0 - 4) bj = bias[64 * j + 63];
          const unsigned long long bal = __ballot((j < NT0 - 4) && (bj < bq - bound2));
          const int t0 = __builtin_popcountll(bal) & ~1; if (lane == 0) t0tab[i] = t0; }
        __syncthreads();
        for (int rep_ = 0; rep_ < 1 + (((PROBE_REP >> 20) | (PROBE_REP >> 22)) & 1); ++rep_)
        for (int i = (rep_ && ((PROBE_REP >> 20) & 1)) ? 8 : 0; i < ((rep_ && ((PROBE_REP >> 22) & 1)) ? 8 : 16); ++i) {
            if (i >= 8) {
                if (G != 256) break;
                const int u4 = (i - 8) & 3, ps = ((i - 8) >> 2) * 32 + grp; const int b = ps >> 2, hd = ps & 3, m = u4 & 1, qb2 = (u4 >> 1) ? 15 - s8 : s8; const int hm = hd * 2 + m;
                if (m == 0) attn_body::attn_unit_d128<8, false>((long)b * SEQ, hm * 64, hd * 128, hd * 128, 512, qb2, (const unsigned char*)QD, (const unsigned char*)KD, (const unsigned char*)VD, O1T, nullptr, 0, 0.f, nullptr, (char*)lds_raw);
                else        attn_body::attn_unit_d128<8, true>((long)b * SEQ, hm * 64, hd * 128, 512 + hd * 128, 1024, qb2, (const unsigned char*)QD, (const unsigned char*)KD, (const unsigned char*)VD, OCAT, O1T, hd * 128, lam, args.in[I_GSUB], (char*)lds_raw);
                continue;
            }
            const int stream = (i >> 1) * 32 + grp; const int sr = (s8 + 2 * (i >> 1)) & 7; const int qb = (i & 1) ? 15 - sr : sr;
            if (G != 256) break;
#ifndef NO_FOX
            if (stream < 128) { const int b = stream >> 3, h = ((stream & 7) + (b & 3) + 2 * (i >> 1)) & 7;
                attn_body::attn_unit<true, 8>((long)b * SEQ, h * 64, h * 64, h * 64, 1024, qb, (const unsigned char*)QF, (const unsigned char*)KF, VF, OCAT, biasb + (size_t)(b * 8 + h) * SEQ, __builtin_amdgcn_readfirstlane(t0tab[i]), smax2, (char*)lds_raw);
            }
#endif
#ifndef NO_DIFF
            if (stream >= 128) {   }
#endif
        }
    }
    SEAM(3);


    for (int rep_ = 0; rep_ < 1 + ((PROBE_REP >> 5) & 1); ++rep_) if (IN(5)) {
        pg8::USched S{}; S.nM = NTOK / 256; S.nN = 4; S.G = G; S.c = bx; S.pair = 0; S.K = 1024; S.nseg = 1; S.A0 = (const char*)OCAT; S.A1 = S.A0; S.B0 = (const char*)Wpf_t; S.B1 = S.B0; S.segB = 0; S.tp = nullptr; S.rowst = nullptr; S.direct = -1; S.gidx = nullptr;
        UEpi E{}; E.mode = 2; E.gates = GT; E.merged = MERGED;
        pg8::gemm_phase<UEpi, pg8::USched>(lds, 1024, S, E);
    }
    SEAM(5);

    for (int rep_ = 0; rep_ < 1 + ((PROBE_REP >> 6) & 1); ++rep_) if (IN(6)) {
        pg8::USched S{}; S.nM = NTOK / 256; S.nN = 4; S.G = G; S.c = bx; S.pair = 0; S.K = 512  ; S.nseg = 1; S.A0 = (const char*)MERGED; S.A1 = S.A0; S.B0 = (const char*)Wout_t; S.B1 = S.B0; S.segB = 0; S.tp = nullptr; S.rowst = nullptr; S.direct = -1; S.gidx = nullptr;
        UEpi E{}; E.mode = 3; E.x = x; E.x1 = X1B; E.mod = mod; E.ascale = 1.0f / (W8S * M8S);
        pg8::gemm_phase<UEpi, pg8::USched, true>(lds, 512, S, E);
    }
    SEAM(6);

    for (int rep_ = 0; rep_ < 1 + ((PROBE_REP >> 7) & 1); ++rep_) if (IN(7)) {
        int t7 = threadIdx.x; asm volatile("" : "+v"(t7));
        const int l7 = t7 & 63, r7 = l7 & 15, kg = l7 >> 4;
        constexpr int WRP = 2064;
        LAS unsigned char* wr48 = lds; LAS float* gmt = (LAS float*)(lds + 48 * WRP); LAS float* sht = gmt + 1024;
        for (int i = t7; i < 48 * 128; i += NTHREADS) { const int n = i >> 7, c = i & 127; *(LAS u32x4*)(wr48 + n * WRP + c * 16) = *(const u32x4*)((const char*)Wr_t + (size_t)n * 2048 + c * 16); }
        { const int b = vcu >> 4; const float* mb = mod + (size_t)b * 6144;
          for (int k = t7; k < 1024; k += NTHREADS) { gmt[k] = args.in[I_GN2][k] * (1.0f + mb[4096 + k]); sht[k] = mb[3072 + k]; } }
        __syncthreads();
        for (int g = 0; g < 2; ++g) {
            const int row0 = gw * 32 + g * 16;
            const u32x4* xp = (const u32x4*)(X1B + (size_t)(row0 + r7) * 1024 + 8 * kg);
            float ss = 0.f;
#pragma unroll
            for (int q_ = 0; q_ < 2; ++q_) { u32x4 t_[16];
#pragma unroll
                for (int j_ = 0; j_ < 16; ++j_) t_[j_] = xp[4 * (16 * q_ + j_)];
#pragma unroll
                for (int j_ = 0; j_ < 16; ++j_) { const u32x4 w = t_[j_];
                    const float a0 = bf2f(w.x & 0xffffu), a1 = bf2f(w.x >> 16), a2 = bf2f(w.y & 0xffffu), a3 = bf2f(w.y >> 16), a4 = bf2f(w.z & 0xffffu), a5 = bf2f(w.z >> 16), a6 = bf2f(w.w & 0xffffu), a7 = bf2f(w.w >> 16);
                    ss += ((a0 * a0 + a1 * a1) + (a2 * a2 + a3 * a3)) + ((a4 * a4 + a5 * a5) + (a6 * a6 + a7 * a7)); }
                __builtin_amdgcn_sched_barrier(0); }
            ss += __shfl_xor(ss, 16); ss += __shfl_xor(ss, 32);
            const float rstd = 1.0f / sqrtf(ss * (1.0f / 1024.0f) + EPS);
            u32x4 win[16];
#pragma unroll
            for (int j_ = 0; j_ < 16; ++j_) win[j_] = xp[4 * j_];
            f32x4 lacc[3]; lacc[0] = (f32x4){0.f, 0.f, 0.f, 0.f}; lacc[1] = lacc[0]; lacc[2] = lacc[0];
            unsigned char* h8 = H2F8 + (size_t)(row0 + r7) * 1024 + 8 * kg;
#pragma unroll
            for (int s_ = 0; s_ < 32; ++s_) { const u32x4 w = win[s_ & 15]; if (s_ + 16 < 32) win[s_ & 15] = xp[4 * (s_ + 16)]; const int k0 = 32 * s_ + 8 * kg;
                const f32x4 g0 = *(const LAS f32x4*)(gmt + k0), g1 = *(const LAS f32x4*)(gmt + k0 + 4), s0 = *(const LAS f32x4*)(sht + k0), s1 = *(const LAS f32x4*)(sht + k0 + 4);
                f32x4 h0, h1;
                h0[0] = bf2f(w.x & 0xffffu) * rstd * g0[0] + s0[0]; h0[1] = bf2f(w.x >> 16) * rstd * g0[1] + s0[1]; h0[2] = bf2f(w.y & 0xffffu) * rstd * g0[2] + s0[2]; h0[3] = bf2f(w.y >> 16) * rstd * g0[3] + s0[3];
                h1[0] = bf2f(w.z & 0xffffu) * rstd * g1[0] + s1[0]; h1[1] = bf2f(w.z >> 16) * rstd * g1[1] + s1[1]; h1[2] = bf2f(w.w & 0xffffu) * rstd * g1[2] + s1[2]; h1[3] = bf2f(w.w >> 16) * rstd * g1[3] + s1[3];
                u32x2 w8; w8.x = pk4_fp8(h0[0], h0[1], h0[2], h0[3]); w8.y = pk4_fp8(h1[0], h1[1], h1[2], h1[3]);
                *(u32x2*)(h8 + 32 * s_) = w8;
                u32x4 aw; aw.x = cvtpk(h0[0], h0[1]); aw.y = cvtpk(h0[2], h0[3]); aw.z = cvtpk(h1[0], h1[1]); aw.w = cvtpk(h1[2], h1[3]);
                const bf16x8 af = __builtin_bit_cast(bf16x8, aw);
#pragma unroll
                for (int blk = 0; blk < 3; ++blk) { const bf16x8 bfr = *(const LAS bf16x8*)(wr48 + (blk * 16 + r7) * WRP + k0 * 2);
                    lacc[blk] = __builtin_amdgcn_mfma_f32_16x16x32_bf16(af, bfr, lacc[blk], 0, 0, 0); }
                __builtin_amdgcn_sched_barrier(0); }
#pragma unroll
            for (int blk = 0; blk < 3; ++blk)
#pragma unroll
                for (int i = 0; i < 4; ++i) LOGIT[(size_t)(row0 + 4 * kg + i) * 64 + blk * 16 + r7] = lacc[blk][i];
        }
    }
    if (IN(7) && IN(9)) { VM_WAIT(); __syncthreads(); }

    for (int rep_ = 0; rep_ < 1 + ((PROBE_REP >> 9) & 1); ++rep_) if (IN(9)) {
        LAS unsigned* cnt = (LAS unsigned*)lds;
        int t9 = threadIdx.x; asm volatile("" : "+v"(t9));
        if (tid < 32) cnt[t9] = 0u;
        __syncthreads();
        unsigned ra = 0, rb = 0; int eA = 0, eB = 0, tkk = 0;
        if (tid < 256) {
            const int tk = vcu * 256 + tid; const float* lp = LOGIT + (size_t)tk * 64;
            const f32x4 g = *(const f32x4*)lp;
            float gl[4]; gl[0] = g[0] + args.in[I_BRG][0]; gl[1] = g[1] + args.in[I_BRG][1]; gl[2] = g[2] + args.in[I_BRG][2]; gl[3] = g[3] + args.in[I_BRG][3];
            int gi = 0; float gmx = gl[0];
#pragma unroll
            for (int j = 1; j < 4; ++j) if (gl[j] > gmx) { gmx = gl[j]; gi = j; }
            float gs = 0.f;
#pragma unroll
            for (int j = 0; j < 4; ++j) gs += __expf(gl[j] - gmx);
            const float gwt = 1.0f / gs;
            const f32x4 e0 = *(const f32x4*)(lp + 4 + 8 * gi), e1 = *(const f32x4*)(lp + 8 + 8 * gi);
            const f32x4 b0 = *(const f32x4*)(args.in[I_BRE] + 8 * gi), b1 = *(const f32x4*)(args.in[I_BRE] + 8 * gi + 4);
            float el[8]; el[0] = e0[0] + b0[0]; el[1] = e0[1] + b0[1]; el[2] = e0[2] + b0[2]; el[3] = e0[3] + b0[3]; el[4] = e1[0] + b1[0]; el[5] = e1[1] + b1[1]; el[6] = e1[2] + b1[2]; el[7] = e1[3] + b1[3];
            int i1 = 0; float m1 = el[0];
#pragma unroll
            for (int j = 1; j < 8; ++j) if (el[j] > m1) { m1 = el[j]; i1 = j; }
            int i2 = -1; float m2 = -INFINITY;
#pragma unroll
            for (int j = 0; j < 8; ++j) if (j != i1 && el[j] > m2) { m2 = el[j]; i2 = j; }
            const float w1 = 1.0f / (1.0f + __expf(m2 - m1)); const float w2 = 1.0f - w1;
            const int ea = gi * 8 + i1, eb = gi * 8 + i2;
            ra = atomicAdd((unsigned*)(lds_raw) + ea, 1u); rb = atomicAdd((unsigned*)(lds_raw) + eb, 1u);
            EID[tk * 2] = ea; EID[tk * 2 + 1] = eb; WGT[tk * 2] = gwt * w1; WGT[tk * 2 + 1] = gwt * w2; eA = ea; eB = eb; tkk = tk;
        }
        __syncthreads();
        if (tid < 32) cnt[32 + t9] = __hip_atomic_fetch_add(GCNT + tid, cnt[t9], __ATOMIC_RELAXED, __HIP_MEMORY_SCOPE_AGENT);
        __syncthreads();
        if (tid < 256) { const int pa = (int)(cnt[32 + eA] + ra), pb = (int)(cnt[32 + eB] + rb);
            POS[tkk * 2] = pa; POS[tkk * 2 + 1] = pb; ELIST[(size_t)eA * NASSIGN + pa] = tkk; ELIST[(size_t)eB * NASSIGN + pb] = tkk; }
        __syncthreads();
    }
    SEAM(9);

    if (IN(11) || IN(12)) {
        LAS int* tp = (LAS int*)(lds + SCHED_OFF); LAS int* rowst = tp + 40;
        LAS int* ecnt = tp + 80;
        if (tid == 0) { int run = 0; for (int e = 0; e < 32; ++e) { const int c = (int)__hip_atomic_load(GCNT + e, __ATOMIC_RELAXED, __HIP_MEMORY_SCOPE_AGENT); ecnt[e] = c; tp[e] = run; rowst[e] = run * 256; run += (c + 255) >> 8; } tp[32] = run; }
        __syncthreads();
        const int ntile = tp[32];
        for (int rep_ = 0; rep_ < 1 + ((PROBE_REP >> 11) & 1); ++rep_) if (IN(11)) {
            pg8::USched S{}; S.nM = ntile; S.nN = 4; S.G = G; S.c = bx; S.pair = 0; S.K = 512  ; S.nseg = 32; S.A0 = (const char*)H2F8; S.A1 = S.A0; S.B0 = (const char*)W13_t; S.B1 = S.B0; S.segB = (size_t)1024 * 1024; S.tp = tp; S.rowst = rowst; S.direct = -1;
            LAS int* gidx = (LAS int*)(lds + LDSCTL_OFF + 2048);
            S.gidx = gidx;
            { pg8::Unit u; for (int i = 0; i < 12 && S.next(i, u); ++i) if (tid < 256) { const int r = u.row0 - rowst[u.seg] + tid;
                  gidx[i * 256 + tid] = (r < ecnt[u.seg]) ? ELIST[(size_t)u.seg * NASSIGN + r] : 0; } }
            __syncthreads();
            UEpi E{}; E.mode = 5; E.hh = HH8;
            pg8::gemm_phase<UEpi, pg8::USched, true>(lds, 512, S, E);
        }
        SEAM(11);
        for (int rep_ = 0; rep_ < 1 + ((PROBE_REP >> 12) & 1); ++rep_) if (IN(12)) {
            pg8::USched S{}; S.nM = ntile; S.nN = 4; S.G = G; S.c = bx; S.pair = 0; S.K = 256  ; S.nseg = 32; S.A0 = (const char*)HH8; S.A1 = S.A0; S.B0 = (const char*)W2_t; S.B1 = S.B0; S.segB = (size_t)1024 * 512; S.tp = tp; S.rowst = rowst; S.direct = -1; S.gidx = nullptr;
            UEpi E{}; E.mode = 6; E.y = (unsigned char*)YB;
            pg8::gemm_phase<UEpi, pg8::USched, true>(lds, 256, S, E);
        }
    }
    SEAM(12);

    if (IN(13)) {
        LAS int* pst = (LAS int*)(lds + SCHED_OFF);
        if (tid == 0) { int run = 0; for (int e = 0; e < 32; ++e) { pst[e] = run; run += (((int)__hip_atomic_load(GCNT + e, __ATOMIC_RELAXED, __HIP_MEMORY_SCOPE_AGENT) + 255) >> 8) << 8; } }
        __syncthreads();
        for (int row = gw; row < NTOK; row += NGW) {
            const int b = row >> 12; const float* gt = mod + (size_t)b * 6144 + 5120;
            const int p0 = pst[EID[row * 2]] + POS[row * 2], p1 = pst[EID[row * 2 + 1]] + POS[row * 2 + 1]; const float w0 = WGT[row * 2], w1 = WGT[row * 2 + 1];
            float* orow = args.out + (size_t)row * 1024;
#pragma unroll
            for (int j = 0; j < 2; ++j) { const int k = 512 * j + 8 * lane;
                const u32x2 a = *(const u32x2*)((const unsigned char*)YB + (size_t)p0 * 1024 + k), c = *(const u32x2*)((const unsigned char*)YB + (size_t)p1 * 1024 + k);
                const u32x4 xw = *(const u32x4*)(X1B + (size_t)row * 1024 + k); const f32x4 g0 = *(const f32x4*)(gt + k), g1 = *(const f32x4*)(gt + k + 4);
                f32x4 x0, x1v; x0[0] = bf2f(xw.x & 0xffffu); x0[1] = bf2f(xw.x >> 16); x0[2] = bf2f(xw.y & 0xffffu); x0[3] = bf2f(xw.y >> 16); x1v[0] = bf2f(xw.z & 0xffffu); x1v[1] = bf2f(xw.z >> 16); x1v[2] = bf2f(xw.w & 0xffffu); x1v[3] = bf2f(xw.w >> 16);
                const f32x2 a0 = __builtin_amdgcn_cvt_pk_f32_fp8((int)a.x, false), a1 = __builtin_amdgcn_cvt_pk_f32_fp8((int)a.x, true), a2 = __builtin_amdgcn_cvt_pk_f32_fp8((int)a.y, false), a3 = __builtin_amdgcn_cvt_pk_f32_fp8((int)a.y, true);
                const f32x2 c0 = __builtin_amdgcn_cvt_pk_f32_fp8((int)c.x, false), c1 = __builtin_amdgcn_cvt_pk_f32_fp8((int)c.x, true), c2 = __builtin_amdgcn_cvt_pk_f32_fp8((int)c.y, false), c3 = __builtin_amdgcn_cvt_pk_f32_fp8((int)c.y, true);
                const float w0s = w0 * (1.0f / Y8S), w1s = w1 * (1.0f / Y8S);
                f32x4 y0, y1;
                y0[0] = w0s * a0[0] + w1s * c0[0]; y0[1] = w0s * a0[1] + w1s * c0[1]; y0[2] = w0s * a1[0] + w1s * c1[0]; y0[3] = w0s * a1[1] + w1s * c1[1];
                y1[0] = w0s * a2[0] + w1s * c2[0]; y1[1] = w0s * a2[1] + w1s * c2[1]; y1[2] = w0s * a3[0] + w1s * c3[0]; y1[3] = w0s * a3[1] + w1s * c3[1];
                *(f32x4*)(orow + k) = x0 + g0 * y0; *(f32x4*)(orow + k + 4) = x1v + g1 * y1; }
        }
    }
#undef IN
#undef SEAM
}

extern "C" void kernel_launch(void* const* d_in, const int* in_sizes, int n_in, void* d_out, int out_size, void* d_ws, size_t ws_size, hipStream_t stream) {
    static int grid = 0;
    if (grid == 0) {
        if (n_in != 28 || in_sizes[0] != NTOK * DMODEL || out_size != NTOK * DMODEL || ws_size < WS_END) { fprintf(stderr, "kernel_launch: unexpected shapes (n_in %d, in0 %d, out %d, ws %zu)\n", n_in, n_in > 0 ? in_sizes[0] : -1, out_size, ws_size); grid = -1; return; }
        int dev = 0, cus = 0, per_cu = 0;
        if (hipGetDevice(&dev) != hipSuccess || hipDeviceGetAttribute(&cus, hipDeviceAttributeMultiprocessorCount, dev) != hipSuccess) { grid = -1; return; }
        if (hipFuncSetAttribute((const void*)fwd_kernel, hipFuncAttributeMaxDynamicSharedMemorySize, LDS_BYTES) != hipSuccess) { fprintf(stderr, "kernel_launch: hipFuncSetAttribute failed\n"); grid = -1; return; }
        if (hipOccupancyMaxActiveBlocksPerMultiprocessor(&per_cu, (const void*)fwd_kernel, NTHREADS, LDS_BYTES) != hipSuccess || per_cu < 1) { fprintf(stderr, "kernel_launch: occupancy query says %d blocks per CU\n", per_cu); per_cu = 1; }
        (void)hipGetLastError();
        grid = cus * 1;
        if (grid != 256) fprintf(stderr, "kernel_launch: %d CUs; this kernel is laid out for 256\n", grid);
    }
    if (grid < 0) return;
    (void)hipMemsetAsync((char*)d_ws + WS_CTL, 0, CTL_ZERO_BYTES, stream);
    Args a{};
    for (int i = 0; i < 28; ++i) a.in[i] = (const float*)d_in[i];
    a.out = (float*)d_out; a.ws = (unsigned char*)d_ws;
    constexpr int NPH = 14;
    if (MK_N_LAUNCHES == 1) { a.ph_lo = 0; a.ph_hi = NPH; a.li = 0; hipLaunchKernelGGL(fwd_kernel, dim3(grid), dim3(NTHREADS), LDS_BYTES, stream, a); }
    else { for (int p = 0; p < NPH; ++p) { a.ph_lo = p; a.ph_hi = p + 1; a.li = p; hipLaunchKernelGGL(fwd_kernel, dim3(grid), dim3(NTHREADS), LDS_BYTES, stream, a); } }
}
```

```cpp
#include <hip/hip_runtime.h>
#include <cstdio>
#include <cstdint>
#include <cmath>

#ifndef MK_N_LAUNCHES
#define MK_N_LAUNCHES 1
#endif

#ifndef STAG1
#define STAG1 0
#endif
#ifndef PROBE_REP
#define PROBE_REP 0
#endif
#define LAS __attribute__((address_space(3)))
#define GAS __attribute__((address_space(1)))
typedef unsigned short bf16_t;
typedef short bf16x8 __attribute__((ext_vector_type(8)));
typedef short s16x4 __attribute__((ext_vector_type(4)));
typedef float f32x4 __attribute__((ext_vector_type(4)));
typedef float f32x2 __attribute__((ext_vector_type(2)));
typedef float f32x16 __attribute__((ext_vector_type(16)));
typedef unsigned u32x4 __attribute__((ext_vector_type(4)));
typedef unsigned u32x2 __attribute__((ext_vector_type(2)));
typedef __bf16 bf16x2_t __attribute__((ext_vector_type(2)));

constexpr int NB = 16, SEQ = 4096, DMODEL = 1024, NTOK = NB * SEQ;
constexpr int IN_COLS = 5128, COL_FQ = 0, COL_FK = 512, COL_FV = 1024, COL_FF = 1536, COL_DQ = 1544, COL_DK = 2056, COL_DV = 2568, COL_GATE = 3080;
constexpr int NEXP = 32, DEXP = 512;
constexpr int NASSIGN = NTOK * 2;
constexpr int PADROWS = NASSIGN + NEXP * 256;
constexpr float EPS = 1e-6f;
constexpr float LOG2E = 1.4426950408889634f;
constexpr float C2 = 0.125f * LOG2E;
constexpr float LAM0 = 0.2f;

constexpr size_t MiB = 1u << 20;
constexpr size_t WS_CTL = 0, CTL_ZERO_BYTES = 128 * 1024;
constexpr size_t WS_MOD = 1 * MiB;
constexpr size_t WS_MISC = 1 * MiB + 512 * 1024;
constexpr size_t WS_GALL = 1 * MiB + 768 * 1024;
constexpr size_t WS_EID = 2 * MiB;
constexpr size_t WS_RNK = 2 * MiB + 512 * 1024;
constexpr size_t WS_WGT = 3 * MiB;
constexpr size_t WS_POS = 3 * MiB + 512 * 1024;
constexpr size_t WS_HIST = 4 * MiB;
constexpr size_t WS_ROWTOK = 4 * MiB + 256 * 1024;
constexpr size_t WS_LOGF = 5 * MiB;
constexpr size_t WS_BIAS = 7 * MiB;
constexpr size_t WS_WR = 10 * MiB;
constexpr size_t WS_LOGIT = 11 * MiB;
constexpr size_t WS_ROPE = 27 * MiB;
constexpr size_t WS_WIN = 43 * MiB;
constexpr size_t WS_WPF = 53 * MiB, WS_WPD = 54 * MiB, WS_WOUT = 55 * MiB;
constexpr size_t WS_W13 = 57 * MiB;
constexpr size_t WS_W2 = 121 * MiB;
constexpr size_t WS_H1 = 160 * MiB;
constexpr size_t WS_QF = 288 * MiB, WS_KF = 352 * MiB, WS_VF = 416 * MiB, WS_QD = 480 * MiB, WS_KD = 544 * MiB, WS_VD = 608 * MiB;
constexpr size_t WS_G = 672 * MiB;
constexpr size_t WS_OD = 928 * MiB;
constexpr size_t WS_MERGED = WS_KF;
constexpr size_t WS_H2S = WS_QD;
constexpr size_t WS_HH = 800 * MiB;
constexpr size_t WS_H2 = WS_G;
constexpr size_t WS_END = 1024 * MiB;
static_assert(WS_KF - WS_QF == 67108864 && WS_VD - WS_QF == 5 * 67108864, "six q/k/v buffers 64 MiB apart");
static_assert(WS_H2S + (size_t)PADROWS * 2048 <= WS_HH && WS_HH + (size_t)PADROWS * 1024 <= WS_END && WS_H2 + (size_t)NTOK * 2048 <= WS_HH, "ws map");

constexpr int CW_TMO = 0, CW_BAR = 4096, CW_GCNT = 16384;

constexpr int RING_BYTES = 131072, LDSCTL_OFF = RING_BYTES, MISC_OFF = LDSCTL_OFF + 320, SCHED_OFF = LDSCTL_OFF + 1024;
constexpr int LDS_BYTES = 147456;
constexpr int NWAVES = 8, NTHREADS = 512;

#define RLX_AGENT __ATOMIC_RELAXED, __HIP_MEMORY_SCOPE_AGENT
#define LDS_WAIT() asm volatile("s_waitcnt lgkmcnt(0)" ::: "memory")
#define VM_WAIT() asm volatile("s_waitcnt vmcnt(0)" ::: "memory")
__device__ __forceinline__ unsigned f2bf(float f) { unsigned u = __builtin_bit_cast(unsigned, f); return (u + 0x7fffu + ((u >> 16) & 1u)) >> 16; }
__device__ __forceinline__ unsigned pk2(float lo, float hi) { return f2bf(lo) | (f2bf(hi) << 16); }
__device__ __forceinline__ float bf2f(unsigned b) { return __builtin_bit_cast(float, b << 16); }
__device__ __forceinline__ unsigned cvtpk(float lo, float hi) { f32x2 v = {lo, hi}; bf16x2_t b = __builtin_convertvector(v, bf16x2_t); return __builtin_bit_cast(unsigned, b); }
__device__ __forceinline__ float wave_sum(float v) {
#pragma unroll
    for (int o = 1; o < 64; o <<= 1) v += __shfl_xor(v, o);
    return v;
}
__device__ __forceinline__ float wave_max(float v) {
#pragma unroll
    for (int o = 1; o < 64; o <<= 1) v = fmaxf(v, __shfl_xor(v, o));
    return v;
}
__device__ __forceinline__ unsigned pk4_fp8(float a, float b, float c, float d) {
    a = fminf(fmaxf(a, -448.f), 448.f); b = fminf(fmaxf(b, -448.f), 448.f); c = fminf(fmaxf(c, -448.f), 448.f); d = fminf(fmaxf(d, -448.f), 448.f);
    int p = __builtin_amdgcn_cvt_pk_fp8_f32(a, b, __float_as_int(a), false); p = __builtin_amdgcn_cvt_pk_fp8_f32(c, d, p, true); return (unsigned)p; }
__device__ __forceinline__ unsigned pk4_fp8_nc(float a, float b, float c, float d) { int p = __builtin_amdgcn_cvt_pk_fp8_f32(a, b, __float_as_int(a), false); p = __builtin_amdgcn_cvt_pk_fp8_f32(c, d, p, true); return (unsigned)p; }
constexpr float QS8 = 2.0f, KS8 = 0.5f;
constexpr float W8S = 64.0f, H8S = 4.0f, Y8S = 8.0f, M8S = 16.0f;
__device__ __forceinline__ float sigmoidf_(float x) { return __builtin_amdgcn_rcpf(1.0f + __builtin_amdgcn_exp2f(-LOG2E * x)); }

namespace pg8 {
constexpr int BM = 256, BK = 64, HALF = 128, HTB = HALF * BK * 2, STAGE_BYTES = 8 * HTB, NXCD = 8, WGM = 8;
__host__ __device__ __forceinline__ int lds_byte(int r, int c) { const int st = (r >> 4) * 2 + (c >> 5), rr = r & 15, cc = c & 31, ob = rr * 64 + cc * 2; return st * 1024 + (ob ^ (((ob >> 9) & 1) << 5)); }
__host__ __device__ __forceinline__ void stage_rc(int b, int& R, int& C) { const int st = b / 1024, sb = b % 1024, swz = sb ^ (((sb >> 9) & 1) << 5); R = (st >> 1) * 16 + swz / 64; C = (st & 1) * 32 + (swz % 64) / 2; }
__host__ __device__ __forceinline__ int perm32(int rho) { const int n = rho >> 4, i = rho & 15; return 8 * (i >> 2) + 4 * n + (i & 3); }

struct Unit { int row0, pn, seg, src; const char* A; const char* B; };

struct USched {
    int nM, nN, G, c, pair, K, nseg;
    const char *A0, *A1, *B0, *B1;
    size_t segB;
    const LAS int* tp;
    const LAS int* rowst;
    int direct;
    const LAS int* gidx;
    __device__ __forceinline__ bool next(int i, Unit& u) const {
        const int ii = pair ? (i >> 1) : i, src = pair ? (i & 1) : 0;
        int pm, pn;
        if (direct >= 0) { if (i > 0) return false; pm = direct; pn = 0; }
        else {
            const long L = (long)ii * G + c; const int nwg = nM * nN; if (L >= nwg) return false;
            int wgid = (int)L; { const int q = nwg / NXCD, r = nwg % NXCD, xcd = wgid % NXCD, off = wgid / NXCD; wgid = (xcd < r ? xcd * (q + 1) : r * (q + 1) + (xcd - r) * q) + off; }
            const int nig = WGM * nN, gid = wgid / nig, fm = gid * WGM, gsz = (nM - fm) < WGM ? (nM - fm) : WGM;
            pm = fm + ((wgid % nig) % gsz); pn = (wgid % nig) / gsz;
        }
        int s = 0, row0 = pm * BM;
        if (nseg > 1) { for (int j = 1; j < nseg; ++j) if (pm >= tp[j]) s = j; row0 = rowst[s] + (pm - tp[s]) * BM; }
        u.row0 = row0; u.pn = pn; u.seg = s; u.src = src;
        u.A = (src ? A1 : A0) + (gidx ? (size_t)0 : (size_t)row0 * K * 2);
        u.B = (src ? B1 : B0) + (size_t)s * segB + (size_t)pn * BM * K * 2;
        return true;
    }
    __device__ __forceinline__ unsigned a_off(int ui, int h, int R, int C) const {
        if (gidx) return (unsigned)(gidx[ui * BM + h * HALF + R] * K + C) * 2u;
        return (unsigned)((h * HALF + R) * K + C) * 2u;
    }
};

typedef int i32x8 __attribute__((ext_vector_type(8)));
typedef int i32x8a __attribute__((ext_vector_type(8), aligned(16)));
__device__ __forceinline__ i32x8 pg8_cat8(const u32x4 a, const u32x4 b) { return (i32x8){(int)a.x, (int)a.y, (int)a.z, (int)a.w, (int)b.x, (int)b.y, (int)b.z, (int)b.w}; }
template <class Epi, class Sched, bool FP8 = false>
__device__ __forceinline__ void gemm_phase(LAS unsigned char* lds, const int K, const Sched S, const Epi E, const unsigned delay_ticks = 0) {
    if (delay_ticks) { const unsigned long long t0_ = __builtin_amdgcn_s_memrealtime(); while (__builtin_amdgcn_s_memrealtime() - t0_ < delay_ticks) __builtin_amdgcn_s_sleep(16); }
    int tid_ = threadIdx.x; asm volatile("" : "+v"(tid_));
    const int tid = tid_, wid = __builtin_amdgcn_readfirstlane(tid >> 6), lane = tid & 63, wr = wid >> 2, wc = wid & 3, fr = lane & 15, fq = lane >> 4;
    const int nt = K / BK;
    unsigned voffB[2]; int RA[2], CA[2];
#pragma unroll
    for (int i = 0; i < 2; ++i) { int R, C; stage_rc(tid * 16 + i * 8192, R, C); const int Rb = (R & ~31) + perm32(R & 31);
        RA[i] = R; CA[i] = C; voffB[i] = (unsigned)(Rb * K + C) * 2u; }
    unsigned vA[2][2], nvA[2][2];
#define PG8_FILL(v, ui_) do { _Pragma("unroll") for (int _h = 0; _h < 2; ++_h) _Pragma("unroll") for (int _i = 0; _i < 2; ++_i) v[_h][_i] = S.a_off(ui_, _h, RA[_i], CA[_i]); } while (0)
    const size_t kstep = (size_t)(BK * 2);
    const size_t hstep = (size_t)HALF * K * 2;
    const unsigned ldsw = (unsigned)wid * 1024u;
    const int aoff = lds_byte(wr * 64 + fr, fq * 8);
    const int boff = lds_byte(wc * 32 + fr, fq * 8);
#define PG8_SA(b, h) (((b) * 2 + (h)) * HTB)
#define PG8_SB(b, h) ((4 + (b) * 2 + (h)) * HTB)
#define PG8_STAGE(bufoff, gbase, voff) do { _Pragma("unroll") for (int _i = 0; _i < 2; ++_i) \
        __builtin_amdgcn_global_load_lds((const unsigned*)((const char*)(gbase) + (voff)[_i]), (LAS unsigned*)(lds + (bufoff) + ldsw + _i * 8192), 16, 0, 0); } while (0)
#define PG8_RD8(p_) pg8_cat8(*(const LAS u32x4*)(p_), *(const LAS u32x4*)((p_) + 1024))
#define PG8_LDA(b, h) do { if constexpr (FP8) { _Pragma("unroll") for (int m = 0; m < 4; ++m) A8[m] = PG8_RD8(lds + PG8_SA(b, h) + aoff + m * 2048); } \
        else { _Pragma("unroll") for (int m = 0; m < 4; ++m) _Pragma("unroll") for (int k = 0; k < 2; ++k) At[m][k] = *(const LAS bf16x8*)(lds + PG8_SA(b, h) + aoff + m * 2048 + k * 1024); } } while (0)
#define PG8_LDB(dst, dst8, b, h) do { if constexpr (FP8) { _Pragma("unroll") for (int n = 0; n < 2; ++n) dst8[n] = PG8_RD8(lds + PG8_SB(b, h) + boff + n * 2048); } \
        else { _Pragma("unroll") for (int n = 0; n < 2; ++n) _Pragma("unroll") for (int k = 0; k < 2; ++k) dst[n][k] = *(const LAS bf16x8*)(lds + PG8_SB(b, h) + boff + n * 2048 + k * 1024); } } while (0)
#define PG8_MMA(ai, bj, Bt, Bt8) do { __builtin_amdgcn_s_setprio(1); \
        if constexpr (FP8) { _Pragma("unroll") for (int m = 0; m < 4; ++m) _Pragma("unroll") for (int n = 0; n < 2; ++n) \
            asm volatile("v_mfma_f32_16x16x128_f8f6f4 %0, %1, %2, %0" : "+v"(acc[ai][bj][m][n]) : "v"(Bt8[n]), "v"(A8[m])); }   \
        else { _Pragma("unroll") for (int m = 0; m < 4; ++m) _Pragma("unroll") for (int n = 0; n < 2; ++n) _Pragma("unroll") for (int k = 0; k < 2; ++k) \
            acc[ai][bj][m][n] = __builtin_amdgcn_mfma_f32_16x16x32_bf16(Bt[n][k], At[m][k], acc[ai][bj][m][n], 0, 0, 0); } \
        __builtin_amdgcn_s_setprio(0); } while (0)
#define PG8_WAIT_V(n) asm volatile("s_waitcnt vmcnt(" #n ")" ::: "memory")
#define PG8_WAIT_L(n) asm volatile("s_waitcnt lgkmcnt(" #n ")" ::: "memory")
#define PG8_BAR __builtin_amdgcn_s_barrier()
#define PG8_SCHED __builtin_amdgcn_sched_barrier(0)
    Unit cur, nxt; int ui = 0;
    if (!S.next(0, cur)) return;
    f32x4 acc[2][2][4][2];
#pragma unroll
    for (int a = 0; a < 2; ++a)
#pragma unroll
        for (int b = 0; b < 2; ++b)
#pragma unroll
            for (int m = 0; m < 4; ++m)
#pragma unroll
                for (int n = 0; n < 2; ++n) acc[a][b][m][n] = (f32x4){0.f, 0.f, 0.f, 0.f};
    bf16x8 At[4][2], B0[2][2], B1[2][2]; i32x8 A8[4], B08[2], B18[2];
    const char* cA = cur.A; const char* cB = cur.B;
    PG8_FILL(vA, 0);
    PG8_STAGE(PG8_SB(0, 0), cB, voffB); PG8_STAGE(PG8_SB(0, 1), cB + hstep, voffB); PG8_STAGE(PG8_SA(0, 0), cA, vA[0]); PG8_STAGE(PG8_SA(0, 1), cA, vA[1]);
    if (wr == 1) PG8_BAR;
    PG8_WAIT_V(2); PG8_BAR;
    PG8_STAGE(PG8_SB(1, 0), cB + kstep, voffB); PG8_STAGE(PG8_SA(1, 0), cA + kstep, vA[0]); PG8_STAGE(PG8_SB(1, 1), cB + hstep + kstep, voffB);
    PG8_WAIT_V(6); PG8_BAR;
    for (;;) {
        const bool has_next = S.next(ui + 1, nxt);
        const char* nA = has_next ? nxt.A : cA; const char* nB = has_next ? nxt.B : cB;
        if (has_next) { PG8_FILL(nvA, ui + 1); } else { nvA[0][0] = vA[0][0]; nvA[0][1] = vA[0][1]; nvA[1][0] = vA[1][0]; nvA[1][1] = vA[1][1]; }
        for (int t = 0; t < nt; t += 2) {
            const bool last = (t == nt - 2);
            const char* a1 = cA + (size_t)(t + 1) * kstep;
            const char* a2 = last ? nA : cA + (size_t)(t + 2) * kstep; const char* b2 = last ? nB : cB + (size_t)(t + 2) * kstep;
            const char* a3 = a2 + kstep; const char* b3 = b2 + kstep;
            if (E.mode == 2 && t == (nt >> 1)) E.mid(acc, cur, wr, wc, fr, fq);
            unsigned s0[2], s1[2]; s0[0] = last ? nvA[0][0] : vA[0][0]; s0[1] = last ? nvA[0][1] : vA[0][1]; s1[0] = last ? nvA[1][0] : vA[1][0]; s1[1] = last ? nvA[1][1] : vA[1][1];
            PG8_LDB(B0, B08, 0, 0); PG8_LDB(B1, B18, 0, 1); PG8_SCHED; PG8_LDA(0, 0); PG8_STAGE(PG8_SA(1, 1), a1, vA[1]);
            PG8_WAIT_V(8); PG8_WAIT_L(0); PG8_BAR; PG8_MMA(0, 0, B0, B08); PG8_MMA(0, 1, B1, B18); PG8_BAR; PG8_SCHED;
            PG8_LDA(0, 1); PG8_STAGE(PG8_SB(0, 0), b2, voffB); PG8_STAGE(PG8_SB(0, 1), b2 + hstep, voffB); PG8_STAGE(PG8_SA(0, 0), a2, s0);
            PG8_WAIT_V(8); PG8_WAIT_L(0); PG8_BAR; PG8_MMA(1, 0, B0, B08); PG8_MMA(1, 1, B1, B18); PG8_BAR; PG8_SCHED;
            PG8_LDB(B0, B08, 1, 0); PG8_LDB(B1, B18, 1, 1); PG8_SCHED; PG8_LDA(1, 0); PG8_STAGE(PG8_SA(0, 1), a2, s1);
            PG8_WAIT_V(8); PG8_WAIT_L(0); PG8_BAR; PG8_MMA(0, 0, B0, B08); PG8_MMA(0, 1, B1, B18); PG8_BAR; PG8_SCHED;
            PG8_LDA(1, 1); PG8_STAGE(PG8_SB(1, 0), b3, voffB); PG8_STAGE(PG8_SB(1, 1), b3 + hstep, voffB); PG8_STAGE(PG8_SA(1, 0), a3, s0);
            PG8_WAIT_V(8); PG8_WAIT_L(0); PG8_BAR; PG8_MMA(1, 0, B0, B08); PG8_MMA(1, 1, B1, B18); PG8_BAR; PG8_SCHED;
        }
        if (wr == 0) PG8_BAR;
        if constexpr (FP8) asm volatile("s_nop 15\n\ts_nop 7" ::: "memory");
        E(acc, cur, wr, wc, fr, fq);
        if (!has_next) break;
#pragma unroll
        for (int a = 0; a < 2; ++a)
#pragma unroll
            for (int b = 0; b < 2; ++b)
#pragma unroll
                for (int m = 0; m < 4; ++m)
#pragma unroll
                    for (int n = 0; n < 2; ++n) acc[a][b][m][n] = (f32x4){0.f, 0.f, 0.f, 0.f};
        cur = nxt; cA = nA; cB = nB; ++ui;
        vA[0][0] = nvA[0][0]; vA[0][1] = nvA[0][1]; vA[1][0] = nvA[1][0]; vA[1][1] = nvA[1][1];
        if (wr == 1) PG8_BAR;
    }
    PG8_WAIT_V(0);
    PG8_BAR;
#undef PG8_SA
#undef PG8_SB
#undef PG8_STAGE
#undef PG8_FILL
#undef PG8_RD8
#undef PG8_LDA
#undef PG8_LDB
#undef PG8_MMA
#undef PG8_WAIT_V
#undef PG8_WAIT_L
#undef PG8_BAR
#undef PG8_SCHED
}
}

struct UEpi {
    int pnoff; float ascale;
    int mode;
    bf16_t *qkv6, *gates; const float *gall; const int* pos;
    bf16_t* merged;
    const float* x; bf16_t* x1; const float* mod;
    float* logits;
    unsigned char* hh; unsigned char* y;
    __device__ __forceinline__ void mid(f32x4 (&acc)[2][2][4][2], const pg8::Unit& u, int wr, int wc, int fr, int fq) const {
        int rbase = u.row0 + wr * 64 + fr; asm volatile("" : "+v"(rbase));
        const int col0 = u.pn * 256 + wc * 32 + 8 * fq;
#define RAT_(a, b) ((float)(a) * __builtin_amdgcn_rcpf(fmaxf((float)(b), 1.0f)))
#pragma unroll
        for (int ai = 0; ai < 2; ++ai) {
            u32x2 ga[4][2], gb[4][2];
#pragma unroll
            for (int m = 0; m < 4; ++m) { const unsigned char* rp = (const unsigned char*)gates + (size_t)(rbase + ai * 128 + m * 16) * 2048 + col0;
#pragma unroll
                for (int bj = 0; bj < 2; ++bj) { ga[m][bj] = *(const u32x2*)(rp + bj * 128); gb[m][bj] = *(const u32x2*)(rp + 1024 + bj * 128); } }
#pragma unroll
            for (int m = 0; m < 4; ++m)
#pragma unroll
                for (int bj = 0; bj < 2; ++bj) { const u32x2 a = ga[m][bj], b = gb[m][bj];
                    acc[ai][bj][m][0][0] *= RAT_(a.x & 0xffu, b.x & 0xffu); acc[ai][bj][m][0][1] *= RAT_((a.x >> 8) & 0xffu, (b.x >> 8) & 0xffu);
                    acc[ai][bj][m][0][2] *= RAT_((a.x >> 16) & 0xffu, (b.x >> 16) & 0xffu); acc[ai][bj][m][0][3] *= RAT_(a.x >> 24, b.x >> 24);
                    acc[ai][bj][m][1][0] *= RAT_(a.y & 0xffu, b.y & 0xffu); acc[ai][bj][m][1][1] *= RAT_((a.y >> 8) & 0xffu, (b.y >> 8) & 0xffu);
                    acc[ai][bj][m][1][2] *= RAT_((a.y >> 16) & 0xffu, (b.y >> 16) & 0xffu); acc[ai][bj][m][1][3] *= RAT_(a.y >> 24, b.y >> 24); }
            asm volatile("" ::: "memory");
        }
#undef RAT_
    }
    __device__ __forceinline__ void operator()(const f32x4 (&acc)[2][2][4][2], const pg8::Unit& u, int wr, int wc, int fr, int fq) const {
        const int rbase = u.row0 + wr * 64 + fr;
        if (mode == 1) {
            const int pn = u.pn;
            if (pn >= 12 || pn == 4 || pn == 5 || pn == 10 || pn == 11) {
                const bool gate = pn >= 12;
                if (gate) {
                    unsigned char* gb = (unsigned char*)gates; const int col0 = (pn - 12) * 256 + wc * 32 + 8 * fq;
#pragma unroll
                    for (int ai = 0; ai < 2; ++ai)
#pragma unroll
                        for (int m = 0; m < 4; ++m) { unsigned char* rowp = gb + (size_t)(rbase + ai * 128 + m * 16) * 2048 + col0;
#pragma unroll
                            for (int bj = 0; bj < 2; ++bj) { const f32x4 v0 = acc[ai][bj][m][0], v1 = acc[ai][bj][m][1]; u32x2 w; unsigned p = 0u, q = 0u;
                                p = __builtin_amdgcn_cvt_pk_u8_f32(255.0f * sigmoidf_(v0[0] * ascale), 0, p); p = __builtin_amdgcn_cvt_pk_u8_f32(255.0f * sigmoidf_(v0[1] * ascale), 1, p);
                                p = __builtin_amdgcn_cvt_pk_u8_f32(255.0f * sigmoidf_(v0[2] * ascale), 2, p); p = __builtin_amdgcn_cvt_pk_u8_f32(255.0f * sigmoidf_(v0[3] * ascale), 3, p);
                                q = __builtin_amdgcn_cvt_pk_u8_f32(255.0f * sigmoidf_(v1[0] * ascale), 0, q); q = __builtin_amdgcn_cvt_pk_u8_f32(255.0f * sigmoidf_(v1[1] * ascale), 1, q);
                                q = __builtin_amdgcn_cvt_pk_u8_f32(255.0f * sigmoidf_(v1[2] * ascale), 2, q); q = __builtin_amdgcn_cvt_pk_u8_f32(255.0f * sigmoidf_(v1[3] * ascale), 3, q);
                                w.x = p; w.y = q; *(u32x2*)(rowp + bj * 128) = w; } }
                } else if (pn >= 10) {
                    unsigned char* vb = (unsigned char*)(qkv6 + (size_t)5 * 33554432); const int col0 = (pn & 1) * 256 + wc * 32 + 8 * fq;
#pragma unroll
                    for (int ai = 0; ai < 2; ++ai)
#pragma unroll
                        for (int m = 0; m < 4; ++m) { unsigned char* rowp = vb + (size_t)(rbase + ai * 128 + m * 16) * 512 + col0;
#pragma unroll
                            for (int bj = 0; bj < 2; ++bj) { const f32x4 v0 = acc[ai][bj][m][0], v1 = acc[ai][bj][m][1];
                                u32x2 w; w.x = pk4_fp8(v0[0] * ascale, v0[1] * ascale, v0[2] * ascale, v0[3] * ascale); w.y = pk4_fp8(v1[0] * ascale, v1[1] * ascale, v1[2] * ascale, v1[3] * ascale);
                                *(u32x2*)(rowp + bj * 128) = w; } }
                } else {
                    bf16_t* base = qkv6 + (size_t)(pn >> 1) * 33554432; const int ldc = 512, colt = (pn & 1) * 256;
                    const int col0 = colt + wc * 32 + 8 * fq;
#pragma unroll
                    for (int ai = 0; ai < 2; ++ai)
#pragma unroll
                        for (int m = 0; m < 4; ++m) { bf16_t* rowp = base + (size_t)(rbase + ai * 128 + m * 16) * ldc + col0;
#pragma unroll
                            for (int bj = 0; bj < 2; ++bj) { const f32x4 v0 = acc[ai][bj][m][0], v1 = acc[ai][bj][m][1];
                                u32x4 w; w.x = cvtpk(v0[0] * ascale, v0[1] * ascale); w.y = cvtpk(v0[2] * ascale, v0[3] * ascale); w.z = cvtpk(v1[0] * ascale, v1[1] * ascale); w.w = cvtpk(v1[2] * ascale, v1[3] * ascale);
                                *(u32x4*)(rowp + bj * 128) = w; } }
                }
            } else {
                const int sec = pn >> 1;
                bf16_t* base = qkv6 + (size_t)sec * 33554432;
                const float* g = gall + (sec - (sec >= 3 ? 1 : 0)) * 64;
                const bool dorope = sec >= 3; const float sc = (sec == 0 || sec == 3) ? C2 * QS8 : KS8;
                const int head = 4 * (pn & 1) + wc;
                f32x4 gv[2][2];
#pragma unroll
                for (int bj = 0; bj < 2; ++bj)
#pragma unroll
                    for (int n = 0; n < 2; ++n) { gv[bj][n] = *(const f32x4*)(g + 32 * bj + 8 * fq + 4 * n); gv[bj][n] = gv[bj][n] * sc; }
                f32x4 ivf[2];
#pragma unroll
                for (int n = 0; n < 2; ++n)
#pragma unroll
                    for (int e = 0; e < 4; ++e) ivf[n][e] = __builtin_amdgcn_exp2f(-(float)(8 * fq + 4 * n + e) * 0.41524101186092029f);
                const float asc2 = ascale * ascale * (1.0f / 64.0f);
#pragma unroll
                for (int ai = 0; ai < 2; ++ai)
#pragma unroll
                    for (int m = 0; m < 4; ++m) {
                        const int row = rbase + ai * 128 + m * 16;
                        f32x4 v[2][2]; float ss = 0.f;
#pragma unroll
                        for (int bj = 0; bj < 2; ++bj)
#pragma unroll
                            for (int n = 0; n < 2; ++n) { v[bj][n] = acc[ai][bj][m][n]; const f32x4 q = v[bj][n] * v[bj][n]; ss += (q[0] + q[1]) + (q[2] + q[3]); }
                        ss += __shfl_xor(ss, 16); ss += __shfl_xor(ss, 32);
                        const float rstd = __builtin_amdgcn_rsqf(ss * asc2 + EPS) * ascale;
#pragma unroll
                        for (int bj = 0; bj < 2; ++bj)
#pragma unroll
                            for (int n = 0; n < 2; ++n) v[bj][n] = v[bj][n] * rstd * gv[bj][n];
                        if (dorope) {
                            const float pr = (float)pos[row];
#pragma unroll
                            for (int n = 0; n < 2; ++n) { f32x4 cs, sn;
#pragma unroll
                                for (int e = 0; e < 4; ++e) { const float ang = pr * ivf[n][e]; const float fr_ = __builtin_amdgcn_fractf(ang * 0.15915494309189535f);
                                    cs[e] = __builtin_amdgcn_cosf(fr_); sn[e] = __builtin_amdgcn_sinf(fr_); }
                                const f32x4 x1 = v[0][n], x2 = v[1][n]; v[0][n] = x1 * cs - x2 * sn; v[1][n] = x2 * cs + x1 * sn; }
                        }
                        unsigned char* rowp = (unsigned char*)base + (size_t)row * 512 + head * 64 + 8 * fq;
#pragma unroll
                        for (int bj = 0; bj < 2; ++bj) { u32x2 w; w.x = pk4_fp8(v[bj][0][0], v[bj][0][1], v[bj][0][2], v[bj][0][3]); w.y = pk4_fp8(v[bj][1][0], v[bj][1][1], v[bj][1][2], v[bj][1][3]);
                            *(u32x2*)(rowp + bj * 32) = w; }
                    }
            }
        } else if (mode == 2) {
            const int col0 = u.pn * 256 + wc * 32 + 8 * fq;
#pragma unroll
            for (int ai = 0; ai < 2; ++ai)
#pragma unroll
                for (int m = 0; m < 4; ++m) { const size_t row = (size_t)(rbase + ai * 128 + m * 16);
#pragma unroll
                    for (int bj = 0; bj < 2; ++bj) { const int col = col0 + bj * 128;
                        const u32x2 gw = *(const u32x2*)((const unsigned char*)gates + row * 2048 + 1024 + col);
                        f32x4 v0 = acc[ai][bj][m][0], v1 = acc[ai][bj][m][1];
#define G1_(b) (fmaxf((float)(b), 1.0f) * (1.0f / 255.0f))
                        v0[0] *= G1_(gw.x & 0xffu); v0[1] *= G1_((gw.x >> 8) & 0xffu); v0[2] *= G1_((gw.x >> 16) & 0xffu); v0[3] *= G1_(gw.x >> 24);
                        v1[0] *= G1_(gw.y & 0xffu); v1[1] *= G1_((gw.y >> 8) & 0xffu); v1[2] *= G1_((gw.y >> 16) & 0xffu); v1[3] *= G1_(gw.y >> 24);
#undef G1_
                        u32x2 w; w.x = pk4_fp8(M8S * v0[0], M8S * v0[1], M8S * v0[2], M8S * v0[3]); w.y = pk4_fp8(M8S * v1[0], M8S * v1[1], M8S * v1[2], M8S * v1[3]);
                        *(u32x2*)((unsigned char*)merged + row * 1024 + col) = w; } }
        } else if (mode == 3) {
            const int col0 = u.pn * 256 + wc * 32 + 8 * fq; const int b = u.row0 >> 12;
            const float* gt = mod + (size_t)b * 6144 + 2048;
#pragma unroll
            for (int bj = 0; bj < 2; ++bj) { const int col = col0 + bj * 128; const f32x4 g0 = *(const f32x4*)(gt + col) * ascale, g1 = *(const f32x4*)(gt + col + 4) * ascale;
#pragma unroll
                for (int ai = 0; ai < 2; ++ai)
#pragma unroll
                    for (int m = 0; m < 4; ++m) { const size_t off = (size_t)(rbase + ai * 128 + m * 16) * 1024 + col;
                        const f32x4 x0 = *(const f32x4*)(x + off), xb = *(const f32x4*)(x + off + 4);
                        const f32x4 v0 = x0 + g0 * acc[ai][bj][m][0], v1 = xb + g1 * acc[ai][bj][m][1];
                        u32x4 w; w.x = cvtpk(v0[0], v0[1]); w.y = cvtpk(v0[2], v0[3]); w.z = cvtpk(v1[0], v1[1]); w.w = cvtpk(v1[2], v1[3]);
                        *(u32x4*)(x1 + off) = w; } }
        } else if (mode == 4) {
            if (wc < 2) { const int col = wc * 32 + 8 * fq;
#pragma unroll
                for (int ai = 0; ai < 2; ++ai)
#pragma unroll
                    for (int m = 0; m < 4; ++m) { float* dp = logits + (size_t)(rbase + ai * 128 + m * 16) * 64 + col;
                        *(f32x4*)dp = acc[ai][0][m][0]; *(f32x4*)(dp + 4) = acc[ai][0][m][1]; } }
        } else if (mode == 5) {
            const int col0 = u.pn * 128 + wc * 32 + 8 * fq;
#pragma unroll
            for (int ai = 0; ai < 2; ++ai)
#pragma unroll
                for (int m = 0; m < 4; ++m) { f32x4 h0, h1;
#pragma unroll
                    for (int e = 0; e < 4; ++e) { const float a0 = acc[ai][0][m][0][e] * (1.0f / W8S), a1 = acc[ai][0][m][1][e] * (1.0f / W8S);
                        h0[e] = a0 * sigmoidf_(a0) * acc[ai][1][m][0][e] * (H8S / W8S); h1[e] = a1 * sigmoidf_(a1) * acc[ai][1][m][1][e] * (H8S / W8S); }
                    u32x2 w; w.x = pk4_fp8(h0[0], h0[1], h0[2], h0[3]); w.y = pk4_fp8(h1[0], h1[1], h1[2], h1[3]);
                    *(u32x2*)(hh + (size_t)(rbase + ai * 128 + m * 16) * 512 + col0) = w; }
        } else if (mode == 6) {
            const int col0 = u.pn * 256 + wc * 32 + 8 * fq;
#pragma unroll
            for (int ai = 0; ai < 2; ++ai)
#pragma unroll
                for (int m = 0; m < 4; ++m) { unsigned char* rowp = y + (size_t)(rbase + ai * 128 + m * 16) * 1024 + col0;
#pragma unroll
                    for (int bj = 0; bj < 2; ++bj) { const f32x4 v0 = acc[ai][bj][m][0] * (Y8S / (W8S * H8S)), v1 = acc[ai][bj][m][1] * (Y8S / (W8S * H8S));
                        u32x2 w; w.x = pk4_fp8(v0[0], v0[1], v0[2], v0[3]); w.y = pk4_fp8(v1[0], v1[1], v1[2], v1[3]);
                        *(u32x2*)(rowp + bj * 128) = w; } }
        }
    }
};

namespace attn_body {
constexpr int D = 64, DM = 512;
constexpr int NW = 8, QBLK = 32, QB = QBLK * NW, KVBLK = 64;
__device__ __forceinline__ int crow(int r, int hi) { return (r & 3) + 8 * (r >> 2) + 4 * hi; }
#define SBAR() __builtin_amdgcn_sched_barrier(0)
__device__ __forceinline__ void cmask(f32x16& p0, f32x16& p1, int jb, int qrel, int hi) {
    const float NEG = -INFINITY; int kb = 64 * jb + 4 * hi;
#pragma unroll
    for (int r = 0; r < 16; ++r) { int kv = kb + (r & 3) + 8 * (r >> 2); if (kv > qrel) p0[r] = NEG; if (kv + 32 > qrel) p1[r] = NEG; }
}
__device__ __forceinline__ void maskall(f32x16& p0, f32x16& p1) {
    const float NEG = -INFINITY;
#pragma unroll
    for (int r = 0; r < 16; ++r) { p0[r] = NEG; p1[r] = NEG; }
}
constexpr int NSLOT = 3, SLOTB = 8192;
constexpr int LDS_K = 0, LDS_V = NSLOT * SLOTB, LDS_WS = 2 * NSLOT * SLOTB, LDS_OST = LDS_WS + NW * 64 * 4, LDS_BIAS = LDS_OST + NW * 4096, LDS_BYTES_A = LDS_BIAS + NSLOT * 256;
__device__ __forceinline__ void glds16(const void* gsrc, unsigned lds_dst) { unsigned keep;
    asm volatile("s_mov_b32 %0, m0\n\ts_mov_b32 m0, %2\n\ts_nop 0\n\tglobal_load_lds_dwordx4 %1, off\n\ts_mov_b32 m0, %0" : "=&s"(keep) : "v"(gsrc), "s"(lds_dst) : "memory"); }
__device__ __forceinline__ void glds4(const void* gsrc, unsigned lds_dst) { unsigned keep;
    asm volatile("s_mov_b32 %0, m0\n\ts_mov_b32 m0, %2\n\ts_nop 0\n\tglobal_load_lds_dword %1, off\n\ts_mov_b32 m0, %0" : "=&s"(keep) : "v"(gsrc), "s"(lds_dst) : "memory"); }
__device__ __forceinline__ float max3f(float a, float b, float c) { float r; asm("v_max3_f32 %0, %1, %2, %3" : "=v"(r) : "v"(a), "v"(b), "v"(c)); return r; }
__device__ __forceinline__ float max2f(float a, float b) { float r; asm("v_max_f32_e32 %0, %1, %2" : "=v"(r) : "v"(a), "v"(b)); return r; }
__device__ __forceinline__ float fadd_s(float a, float b) { float r; asm("v_add_f32_e32 %0, %1, %2" : "=v"(r) : "v"(a), "v"(b)); return r; }
__device__ __forceinline__ float fsub_s(float a, float b) { float r; asm("v_sub_f32_e32 %0, %1, %2" : "=v"(r) : "v"(a), "v"(b)); return r; }
#define WAIT_BAR(N) asm volatile("s_waitcnt vmcnt(" #N ") lgkmcnt(0)\n\ts_barrier" ::: "memory")
typedef LAS const char* lds_cptr;
typedef short v4i16_t __attribute__((ext_vector_type(4)));
typedef int i32x8 __attribute__((ext_vector_type(8)));
typedef int i32x8a __attribute__((ext_vector_type(8), aligned(16)));
#define MF8(a, b, c) __builtin_amdgcn_mfma_scale_f32_32x32x64_f8f6f4(a, b, c, 0, 0, 0, 0, 0, 0)
__device__ __forceinline__ void kload8(i32x8* kf, lds_cptr kp) { kf[0] = *(const LAS i32x8a*)(kp); kf[1] = *(const LAS i32x8a*)(kp + 1024); }
__device__ __forceinline__ void kload2(i32x8* kf, lds_cptr kp, int j) { if (j < 2) kf[j] = *(const LAS i32x8a*)(kp + j * 1024); }
__device__ __forceinline__ void qkt(f32x16& p0, f32x16& p1, lds_cptr kp, const i32x8& qr, const f32x16& negm) {
    const i32x8 k0 = *(const LAS i32x8a*)(kp), k1 = *(const LAS i32x8a*)(kp + 1024);
    p0 = MF8(k0, qr, negm); p1 = MF8(k1, qr, negm);
}
__device__ __forceinline__ void qkt(f32x16& p0, f32x16& p1, lds_cptr kp, const i32x8& qr, const f32x16& c0, const f32x16& c1) {
    const i32x8 k0 = *(const LAS i32x8a*)(kp), k1 = *(const LAS i32x8a*)(kp + 1024);
    p0 = MF8(k0, qr, c0); p1 = MF8(k1, qr, c1);
}
__device__ __forceinline__ s16x4 vtr(lds_cptr p) { return __builtin_bit_cast(s16x4, __builtin_amdgcn_ds_read_tr16_b64_v4i16((LAS v4i16_t*)p)); }
__device__ __forceinline__ float rowmax(const f32x16& p0, const f32x16& p1) {
    float a = max3f(p0[0], p0[1], p1[0]), b = max3f(p0[2], p0[3], p1[1]); a = max3f(a, p1[2], p1[3]);
#pragma unroll
    for (int r = 4; r < 16; r += 4) { a = max3f(a, p0[r], p0[r + 1]); b = max3f(b, p0[r + 2], p0[r + 3]); a = max3f(a, p1[r], p1[r + 1]); b = max3f(b, p1[r + 2], p1[r + 3]); }
    const float m = max2f(a, b);
    auto rr = __builtin_amdgcn_permlane32_swap(__float_as_uint(m), __float_as_uint(m), false, false);
    return max2f(__uint_as_float(rr[0]), __uint_as_float(rr[1]));
}
__device__ __forceinline__ void pv(f32x16* o, int vb, bf16x8 pa0, bf16x8 pa1, bf16x8 pa2, bf16x8 pa3) {
#pragma unroll
    for (int d0 = 0; d0 < 2; ++d0) { s16x4 lo[4], hi[4];
#pragma unroll
        for (int ks = 0; ks < 4; ++ks) {
            asm volatile("ds_read_b64_tr_b16 %0,%1 offset:%c2" : "=&v"(lo[ks]) : "v"(vb), "i"(d0 * 4096 + ks * 1024) : "memory");
            asm volatile("ds_read_b64_tr_b16 %0,%1 offset:%c2" : "=&v"(hi[ks]) : "v"(vb), "i"(d0 * 4096 + ks * 1024 + 512) : "memory"); }
        asm volatile("s_waitcnt lgkmcnt(0)" ::: "memory"); SBAR();
#define PK(k) (bf16x8){lo[k][0], lo[k][1], lo[k][2], lo[k][3], hi[k][0], hi[k][1], hi[k][2], hi[k][3]}
        o[d0] = __builtin_amdgcn_mfma_f32_32x32x16_bf16(pa0, PK(0), o[d0], 0, 0, 0);
        o[d0] = __builtin_amdgcn_mfma_f32_32x32x16_bf16(pa1, PK(1), o[d0], 0, 0, 0);
        o[d0] = __builtin_amdgcn_mfma_f32_32x32x16_bf16(pa2, PK(2), o[d0], 0, 0, 0);
        o[d0] = __builtin_amdgcn_mfma_f32_32x32x16_bf16(pa3, PK(3), o[d0], 0, 0, 0);
#undef PK
    }
}
__device__ __forceinline__ bf16x8 bias_frag(float b) {
    const unsigned u0 = cvtpk(b, 0.f) & 0xffffu; const float r1 = b - bf2f(u0);
    const unsigned u1 = cvtpk(r1, 0.f) & 0xffffu; const float r2 = r1 - bf2f(u1);
    const unsigned u2 = cvtpk(r2, 0.f) & 0xffffu;
    u32x4 w; w.x = u0 | (u1 << 16); w.y = u2 | 0x3F800000u; w.z = 0x3F803F80u; w.w = 0u; return __builtin_bit_cast(bf16x8, w);
}
__device__ __forceinline__ bf16x8 qext_frag(float nm, int hi) {
    const unsigned u0 = cvtpk(nm, 0.f) & 0xffffu; const float r1 = nm - bf2f(u0);
    const unsigned u1 = cvtpk(r1, 0.f) & 0xffffu; const float r2 = r1 - bf2f(u1);
    const unsigned u2 = cvtpk(r2, 0.f) & 0xffffu;
    u32x4 w; w.x = hi ? 0u : 0x3F803F80u; w.y = hi ? 0u : (0x3F80u | (u0 << 16)); w.z = hi ? 0u : (u1 | (u2 << 16)); w.w = 0u; return __builtin_bit_cast(bf16x8, w);
}

template <bool FOX, int THRL> __device__ __forceinline__ void attn_unit(long rowbase, int qcol, int vcol, int ocol, int OP, int qb, const unsigned char* Q, const unsigned char* __restrict__ K, const bf16_t* __restrict__ V, bf16_t* O,
                                                                         const float* __restrict__ bias, int t0in, float smax2, char* shm) {
    int tid_ = threadIdx.x; asm volatile("" : "+v"(tid_));
    const int tid = tid_, lane = tid & 63, r32 = lane & 31, hi = lane >> 5; const int wid = __builtin_amdgcn_readfirstlane(tid >> 6);
    const int q0 = qb * QB;
    int NT = (q0 + QB) / KVBLK; int t0 = 0;
    if (FOX) { t0 = t0in; NT -= t0; }
    const bool wlo = wid < 5;
    const unsigned char* Qw = Q + (rowbase + q0 + wid * QBLK) * 512 + qcol;
    const unsigned char* Kh = K + (rowbase + (long)t0 * KVBLK) * 512 + qcol; const bf16_t* Vh = V + (rowbase + (long)t0 * KVBLK) * DM + vcol;
    const int bofs0 = t0 * KVBLK;
    const unsigned lds0 = (unsigned)(uintptr_t)shm;
    float* wsf = (float*)(shm + LDS_WS) + wid * 64;
    const unsigned char* ksrc = Kh + (long)(32 * (wid & 1) + (lane >> 1)) * 512 + ((wid >> 1) & 1) * 32 + (lane & 1) * 16;
    const bf16_t* vsrc = Vh + (long)(16 * (wid & 3) + (lane >> 2)) * DM + (wid >> 2) * 32 + (lane & 3) * 8;
    const unsigned kdst = lds0 + LDS_K + wid * 1024, vdst = lds0 + LDS_V + wid * 1024;
    const float* bsrc = bias + bofs0 + lane;
#define DMA_K(t, slot) do { if (wid < 4) glds16(ksrc + (long)(t) * KVBLK * 512, (unsigned)__builtin_amdgcn_readfirstlane(kdst + ((slot) >> 1))); \
        else if (FOX && wid == 4) glds4(bsrc + (t) * KVBLK, (unsigned)__builtin_amdgcn_readfirstlane(lds0 + LDS_BIAS + ((slot) >> 5))); } while (0)
#define DMA_V(t, slot) glds16(vsrc + (long)(t) * KVBLK * DM, (unsigned)__builtin_amdgcn_readfirstlane(vdst + (slot)))
    const int vb0 = (int)(lds0 + LDS_V) + ((lane >> 4) & 1) * 32 + (lane & 3) * 8 + (4 * hi + ((lane & 15) >> 2)) * 64;
    i32x8 kf[2];
    const lds_cptr shm3 = (lds_cptr)shm; const lds_cptr shm3b = shm3; const lds_cptr kp0 = shm3 + LDS_K + hi * 2048 + r32 * 32; const lds_cptr vp0 = shm3 + LDS_V + ((lane >> 4) & 1) * 32 + (lane & 3) * 8 + (4 * hi + ((lane & 15) >> 2)) * 64;
    DMA_K(0, 0); DMA_V(0, 0); DMA_K(1, SLOTB);
    const i32x8 qr = *reinterpret_cast<const i32x8a*>(Qw + (long)r32 * 512 + hi * 32);
    float mhat = 0.f; if (FOX) mhat = bias[q0 + wid * QBLK + r32] + smax2;
    bf16x8 qone = qext_frag(-mhat, hi);
    f32x16 CB0 = f32x16{}, CB1 = f32x16{};
    bf16x8 kones; { u32x4 w_; w_.x = 0u; w_.y = 0x3F800000u; w_.z = 0x3F803F80u; w_.w = 0u; kones = __builtin_bit_cast(bf16x8, w_); }
    const lds_cptr bp0 = shm3b + LDS_BIAS + 16 * hi;
#define BRD4(CB, base, g) do { const f32x4 q_ = *(const LAS f32x4*)((base) + 32 * (g)); CB[4 * (g)] = q_[0]; CB[4 * (g) + 1] = q_[1]; CB[4 * (g) + 2] = q_[2]; CB[4 * (g) + 3] = q_[3]; } while (0)
    float l_reg = 0.f; f32x16 o[2]; o[0] = f32x16{}; o[1] = f32x16{}; f32x16 negm = f32x16{}; if (!FOX) asm volatile("" : "+v"(negm));
    const int qrel = wid * QBLK + r32;
#define CMASK(P0, P1, t) do { int jb_ = (t) - (NT - 4); if (jb_ >= 0) { if (FOX) { if (jb_ == (wid >> 1)) cmask(P0, P1, jb_, qrel, hi); else if (jb_ > (wid >> 1)) maskall(P0, P1); }   else if (jb_ > (wid >> 1)) maskall(P0, P1); } } while (0)
    bool resc = false;
#define START(P0, P1) do { resc = false; \
    if (!FOX) { const float rm = rowmax(P0, P1); const float dl = rm; mhat = fadd_s(mhat, dl); \
      _Pragma("unroll") for (int r = 0; r < 16; ++r) { P0[r] = fsub_s(P0[r], dl); P1[r] = fsub_s(P1[r], dl); } \
      if (FOX) { qone = qext_frag(-mhat, hi); } else { _Pragma("unroll") for (int r = 0; r < 16; ++r) negm[r] = -mhat; asm volatile("" : "+v"(negm)); } } \
    _Pragma("unroll") for (int r = 0; r < 16; ++r) P0[r] = __builtin_amdgcn_exp2f(P0[r]); } while (0)
#define RESC() do { if (resc) { asm volatile("s_waitcnt lgkmcnt(0)" ::: "memory"); \
      _Pragma("unroll") for (int d_ = 0; d_ < 2; ++d_) _Pragma("unroll") for (int r = 0; r < 16; ++r) o[d_][r] *= wsf[crow(r, hi)]; } } while (0)
    f32x16 pA0, pA1, pB0, pB1;
    int sl_prev = 0, sl_cur = 0, sl_next = SLOTB;
#define ROT() do { sl_prev = sl_cur; sl_cur = sl_next; sl_next = (sl_next == (NSLOT - 1) * SLOTB) ? 0 : sl_next + SLOTB; } while (0)
#define WB(NLO, NHI) do { if (wlo) { WAIT_BAR(NLO); } else { WAIT_BAR(NHI); } } while (0)
    DMA_K(2, 2 * SLOTB);
    WB(3, 1);
    if (FOX) { _Pragma("unroll") for (int g_ = 0; g_ < 4; ++g_) { BRD4(CB0, bp0, g_); BRD4(CB1, bp0 + 128, g_); }
               asm volatile("s_waitcnt lgkmcnt(0)" ::: "memory");
               qkt(pA0, pA1, kp0, qr, CB0, CB1);
               pA0 = __builtin_amdgcn_mfma_f32_32x32x16_bf16(kones, qone, pA0, 0, 0, 0); pA1 = __builtin_amdgcn_mfma_f32_32x32x16_bf16(kones, qone, pA1, 0, 0, 0); }
    else qkt(pA0, pA1, kp0, qr, negm);
    asm volatile("s_nop 15\n\ts_nop 7" : "+v"(pA0), "+v"(pA1)); CMASK(pA0, pA1, 0);
    START(pA0, pA1);
    _Pragma("unroll") for (int r = 0; r < 16; ++r) pA1[r] = __builtin_amdgcn_exp2f(pA1[r]);
    WAIT_BAR(0);
    DMA_K(3, 0); DMA_V(1, SLOTB);
    ROT();
    kload8(kf, kp0 + (sl_cur >> 1));
    if (FOX) { _Pragma("unroll") for (int g_ = 0; g_ < 4; ++g_) { BRD4(CB0, bp0 + (sl_cur >> 5), g_); BRD4(CB1, bp0 + (sl_cur >> 5) + 128, g_); } }
    WB(2, 1);
    s16x4 vlo[8], vhi[8]; u32x4 pw0, pw1, pw2, pw3;
#define PKW(P, B) cvtpk(P[B], P[B + 1])
#define PAF(k) __builtin_bit_cast(bf16x8, pw##k)
#define VFR(i) (bf16x8){vlo[i][0], vlo[i][1], vlo[i][2], vlo[i][3], vhi[i][0], vhi[i][1], vhi[i][2], vhi[i][3]}
#define PIN(x) asm volatile("" : "+v"(x))
#define MX3(a, b, c) __builtin_fmaxf(__builtin_fmaxf((a), (b)), (c))
#define GAPA(MF, A0, A1, A2, A3, W0, W1, PW) do { MF; sacc += A0; sacc += A1; sacc += A2; sacc += A3; PIN(sacc); W0; W1; PIN(PW); SBAR(); } while (0)
#define EX(v) __builtin_amdgcn_exp2f(v)
#define GAPB(MF, X, B) do { MF; X[B] = EX(X[B]); X[B + 1] = EX(X[B + 1]); X[B + 2] = EX(X[B + 2]); X[B + 3] = EX(X[B + 3]); PIN(X); SBAR(); } while (0)
#define VRD(i) do { vlo[i] = vtr(vp_ + (((i) >> 2) * 4096 + ((i) & 3) * 1024)); vhi[i] = vtr(vp_ + (((i) >> 2) * 4096 + ((i) & 3) * 1024 + 512)); } while (0)
#define KRD(G, j) do { if (G) { kload2(kf, kp0 + (sl_next >> 1), j); if (FOX) { BRD4(CB0, bp0 + (sl_next >> 5), j); BRD4(CB1, bp0 + (sl_next >> 5) + 128, j); } SBAR(); } } while (0)
#define STEP(C0, C1, P0, P1, t, GK, GV, GL) do { SBAR(); \
    const lds_cptr vp_ = vp0 + sl_prev; \
    VRD(0); SBAR(); float sacc = (P0[0] + P0[1]); \
    GAPA(C0 = MF8(kf[0], qr, (FOX ? CB0 : negm)), P0[2], P0[3], P0[4], P0[5],     pw0[0] = PKW(P0, 0), pw0[1] = PKW(P0, 2), pw0); \
    VRD(4); SBAR(); GAPA(C1 = MF8(kf[1], qr, (FOX ? CB1 : negm)), P0[6], P0[7], P0[8], P0[9],     pw0[2] = PKW(P0, 4), pw0[3] = PKW(P0, 6), pw0); \
    VRD(1); SBAR(); GAPA((void)0,   P0[10], P0[11], P0[12], P0[13], pw1[0] = PKW(P0, 8), pw1[1] = PKW(P0, 10), pw1); \
    VRD(5); SBAR(); GAPA((void)0,   P0[14], P0[15], P1[0], P1[1],   pw1[2] = PKW(P0, 12), pw1[3] = PKW(P0, 14), pw1); \
    VRD(2); SBAR(); GAPA((void)0,   P1[2], P1[3], P1[4], P1[5],     pw2[0] = PKW(P1, 0), pw2[1] = PKW(P1, 2), pw2); \
    VRD(6); SBAR(); GAPA((void)0,   P1[6], P1[7], P1[8], P1[9],     pw2[2] = PKW(P1, 4), pw2[3] = PKW(P1, 6), pw2); \
    VRD(3); SBAR(); GAPA((void)0,   P1[10], P1[11], P1[12], P1[13], pw3[0] = PKW(P1, 8), pw3[1] = PKW(P1, 10), pw3); \
    VRD(7); SBAR(); GAPA((void)0,   P1[14], P1[15], 0.f, 0.f,       pw3[2] = PKW(P1, 12), pw3[3] = PKW(P1, 14), pw3); \
    if (FOX) { C0 = __builtin_amdgcn_mfma_f32_32x32x16_bf16(kones, qone, C0, 0, 0, 0); C1 = __builtin_amdgcn_mfma_f32_32x32x16_bf16(kones, qone, C1, 0, 0, 0); SBAR(); } \
    l_reg += sacc; \
    if (GK) { DMA_K((t) + 3, sl_cur); } if (GV) { DMA_V((t) + 1, sl_next); } \
    CMASK(C0, C1, t); \
    if (!FOX) { float a = MX3(C0[0], C0[1], C1[0]), b = MX3(C0[2], C0[3], C1[1]); a = MX3(a, C1[2], C1[3]); \
      _Pragma("unroll") for (int r = 4; r < 16; r += 4) { a = MX3(a, C0[r], C0[r + 1]); b = MX3(b, C0[r + 2], C0[r + 3]); a = MX3(a, C1[r], C1[r + 1]); b = MX3(b, C1[r + 2], C1[r + 3]); } \
      float rm = __builtin_fmaxf(a, b); { auto rr = __builtin_amdgcn_permlane32_swap(__float_as_uint(rm), __float_as_uint(rm), false, false); rm = __builtin_fmaxf(__uint_as_float(rr[0]), __uint_as_float(rr[1])); } \
      resc = false; \
      if (__builtin_expect(__any(rm > (float)THRL), 0)) { const float dl = __builtin_fmaxf(rm, 0.f); mhat += dl; \
        _Pragma("unroll") for (int r = 0; r < 16; ++r) { C0[r] -= dl; C1[r] -= dl; } \
        if (FOX) { qone = qext_frag(-mhat, hi); } else { _Pragma("unroll") for (int r = 0; r < 16; ++r) negm[r] = -mhat; asm volatile("" : "+v"(negm)); } \
        const float f = __builtin_amdgcn_exp2f(-dl); l_reg *= f; if (hi == 0) wsf[r32] = f; resc = true; } } \
    SBAR(); \
    GAPB(o[0] = __builtin_amdgcn_mfma_f32_32x32x16_bf16(PAF(0), VFR(0), o[0], 0, 0, 0), C0, 0); \
    GAPB(o[1] = __builtin_amdgcn_mfma_f32_32x32x16_bf16(PAF(0), VFR(4), o[1], 0, 0, 0), C0, 4); \
    KRD(GL, 0); GAPB(o[0] = __builtin_amdgcn_mfma_f32_32x32x16_bf16(PAF(1), VFR(1), o[0], 0, 0, 0), C0, 8); \
    KRD(GL, 1); GAPB(o[1] = __builtin_amdgcn_mfma_f32_32x32x16_bf16(PAF(1), VFR(5), o[1], 0, 0, 0), C0, 12); \
    KRD(GL, 2); GAPB(o[0] = __builtin_amdgcn_mfma_f32_32x32x16_bf16(PAF(2), VFR(2), o[0], 0, 0, 0), C1, 0); \
    KRD(GL, 3); GAPB(o[1] = __builtin_amdgcn_mfma_f32_32x32x16_bf16(PAF(2), VFR(6), o[1], 0, 0, 0), C1, 4); \
    GAPB(o[0] = __builtin_amdgcn_mfma_f32_32x32x16_bf16(PAF(3), VFR(3), o[0], 0, 0, 0), C1, 8); \
    GAPB(o[1] = __builtin_amdgcn_mfma_f32_32x32x16_bf16(PAF(3), VFR(7), o[1], 0, 0, 0), C1, 12); \
    } while (0)
    int t = 1;
#undef CMASK
#define CMASK(P0, P1, t) do { } while (0)
    for (; t + 5 < NT; t += 2) {
        STEP(pB0, pB1, pA0, pA1, t, true, true, true);     WB(2, 1); RESC(); ROT();
        STEP(pA0, pA1, pB0, pB1, t + 1, true, true, true); WB(2, 1); RESC(); ROT();
    }
#undef CMASK
#define CMASK(P0, P1, t) do { int jb_ = (t) - (NT - 4); if (jb_ >= 0) { if (FOX) { if (jb_ == (wid >> 1)) cmask(P0, P1, jb_, qrel, hi); else if (jb_ > (wid >> 1)) maskall(P0, P1); }   else if (jb_ > (wid >> 1)) maskall(P0, P1); } } while (0)
#define ENDW(tt) do { if ((tt) + 3 < NT) { WB(2, 1); } else if ((tt) + 2 < NT) { WAIT_BAR(1); } else { WAIT_BAR(0); } } while (0)
    for (; t + 1 < NT; t += 2) {
        STEP(pB0, pB1, pA0, pA1, t, (t + 3 < NT), (t + 1 < NT), (t + 1 < NT));         ENDW(t);     RESC(); ROT();
        STEP(pA0, pA1, pB0, pB1, t + 1, (t + 4 < NT), (t + 2 < NT), (t + 2 < NT));     ENDW(t + 1); RESC(); ROT();
    }
    STEP(pB0, pB1, pA0, pA1, NT - 1, false, false, false); RESC();
    { float sacc = pB0[0] + pB0[1]; _Pragma("unroll") for (int r = 2; r < 16; ++r) sacc += pB0[r]; _Pragma("unroll") for (int r = 0; r < 16; ++r) sacc += pB1[r]; l_reg += sacc;
      pw0 = (u32x4){PKW(pB0, 0), PKW(pB0, 2), PKW(pB0, 4), PKW(pB0, 6)}; pw1 = (u32x4){PKW(pB0, 8), PKW(pB0, 10), PKW(pB0, 12), PKW(pB0, 14)}; pw2 = (u32x4){PKW(pB1, 0), PKW(pB1, 2), PKW(pB1, 4), PKW(pB1, 6)}; pw3 = (u32x4){PKW(pB1, 8), PKW(pB1, 10), PKW(pB1, 12), PKW(pB1, 14)};
      SBAR(); pv(o, vb0 + sl_cur, PAF(0), PAF(1), PAF(2), PAF(3)); }
#undef PKW
#undef PAF
#undef VFR
#undef PIN
#undef MX3
#undef GAPA
#undef GAPB
#undef EX
#undef VRD
#undef KRD
#undef BRD4
#undef STEP
#undef ENDW
#undef WB
    { auto rr = __builtin_amdgcn_permlane32_swap(__float_as_uint(l_reg), __float_as_uint(l_reg), false, false); l_reg = __uint_as_float(rr[0]) + __uint_as_float(rr[1]); }
    if (hi == 0) wsf[32 + r32] = l_reg; asm volatile("s_waitcnt lgkmcnt(0)" ::: "memory");
    float rli[16];
#pragma unroll
    for (int r = 0; r < 16; ++r) rli[r] = __builtin_amdgcn_rcpf(wsf[32 + crow(r, hi)]);
    bf16_t* Ow = O + (rowbase + q0 + wid * QBLK) * OP + ocol;
    { bf16_t* stg = (bf16_t*)(shm + LDS_OST) + wid * 2048;
#pragma unroll
      for (int r = 0; r < 16; ++r) { const int orow = crow(r, hi);
#pragma unroll
        for (int d0 = 0; d0 < 2; ++d0) stg[orow * 64 + d0 * 32 + r32] = (bf16_t)f2bf(o[d0][r] * rli[r]); }
      asm volatile("s_waitcnt lgkmcnt(0)" ::: "memory");
#pragma unroll
      for (int i = 0; i < 4; ++i) { const int row = i * 8 + (lane >> 3), ch = lane & 7; const u32x4 v = *(const u32x4*)(stg + row * 64 + ch * 8); *(u32x4*)(Ow + (long)row * OP + ch * 8) = v; } }
    asm volatile("s_waitcnt lgkmcnt(0)\n\ts_barrier" ::: "memory");
#undef DMA_K
#undef DMA_V
#undef CMASK
#undef START
#undef RESC
#undef ROT
}

constexpr int L2_K = 0, L2_V = 3 * 8192, L2_WS = L2_V + 3 * 16384, L2_OST = L2_WS + NW * 64 * 4, LDS_BYTES_D128 = L2_OST + NW * 4096;
template <int THRL, bool COMBINE> __device__ __forceinline__ void attn_unit_d128(long rowbase, int qcol, int vcol, int ocol, int OP, int qb, const unsigned char* Q, const unsigned char* __restrict__ K, const unsigned char* __restrict__ V, bf16_t* O,
                                                                                const bf16_t* O1, int o1col, float lam, const float* __restrict__ gsub, char* shm) {
    int tid_ = threadIdx.x; asm volatile("" : "+v"(tid_));
    const int tid = tid_, lane = tid & 63, r32 = lane & 31, hi = lane >> 5; const int wid = __builtin_amdgcn_readfirstlane(tid >> 6);
    const int q0 = qb * QB; const int NT = (q0 + QB) / KVBLK;
    const bool wlo = wid < 4;
    const unsigned char* Qw = Q + (rowbase + q0 + wid * QBLK) * 512 + qcol;
    const unsigned char* Kh = K + rowbase * 512 + qcol; const unsigned char* Vh = V + rowbase * 512 + vcol;
    const unsigned lds0 = (unsigned)(uintptr_t)shm;
    float* wsf = (float*)(shm + L2_WS) + wid * 64;
    const unsigned char* ksrc = Kh + (long)(32 * (wid & 1) + (lane >> 1)) * 512 + ((wid >> 1) & 1) * 32 + (lane & 1) * 16;
    const int vj_ = lane >> 1, vg_ = wid & 1; const int vkey_ = (vj_ < 16) ? crow(vj_, vg_) : 32 + crow(vj_ - 16, vg_);
    const unsigned char* vsrc = Vh + (long)vkey_ * 512 + (wid >> 1) * 32 + (lane & 1) * 16;
    const unsigned kdst = lds0 + L2_K + wid * 1024, vdst = lds0 + L2_V + wid * 1024;
#define DMA_K(t, slot) do { if (wlo) glds16(ksrc + (long)(t) * KVBLK * 512, (unsigned)__builtin_amdgcn_readfirstlane(kdst + ((slot) >> 1))); } while (0)
#define DMA_V(t, slot) glds16(vsrc + (long)(t) * KVBLK * 512, (unsigned)__builtin_amdgcn_readfirstlane(vdst + (slot)))
    i32x8 kf[2];
    const lds_cptr shm3 = (lds_cptr)shm; const lds_cptr kp0 = shm3 + L2_K + hi * 2048 + r32 * 32; const lds_cptr vp0 = shm3 + L2_V + (32 * hi + ((lane & 15) >> 1)) * 32 + ((lane >> 4) & 1) * 16 + (lane & 1) * 8;
    DMA_K(0, 0); DMA_V(0, 0); DMA_K(1, SLOTB);
    const i32x8 qr = *reinterpret_cast<const i32x8a*>(Qw + (long)r32 * 512 + hi * 32);
    float mhat = 0.f, l_reg = 0.f; f32x16 o[4]; o[0] = f32x16{}; o[1] = f32x16{}; o[2] = f32x16{}; o[3] = f32x16{}; f32x16 ol = f32x16{};
    constexpr int L2_ONES = LDS_BYTES_D128;
    if (tid == 0) { u32x4 o4_; o4_.x = o4_.y = o4_.z = o4_.w = 0x38383838u; *(u32x4*)(shm + L2_ONES) = o4_; *(u32x4*)(shm + L2_ONES + 16) = o4_; }
    i32x8 vone;
    f32x16 negm = f32x16{}; asm volatile("" : "+v"(negm));
#define CMASK(P0, P1, t) do { int jb_ = (t) - (NT - 4); if (jb_ > (wid >> 1)) maskall(P0, P1); } while (0)
    bool resc = false;
#define RESC() do { if (resc) { asm volatile("s_waitcnt lgkmcnt(0)" ::: "memory"); \
      _Pragma("unroll") for (int d_ = 0; d_ < 4; ++d_) _Pragma("unroll") for (int r = 0; r < 16; ++r) o[d_][r] *= wsf[crow(r, hi)]; \
      _Pragma("unroll") for (int r = 0; r < 16; ++r) ol[r] *= wsf[crow(r, hi)]; } } while (0)
    f32x16 C0, C1; i32x8 pwa, pwb;
    int sl_prev = 0, sl_cur = 0, sl_next = SLOTB;
#define ROT() do { sl_prev = sl_cur; sl_cur = sl_next; sl_next = (sl_next == (NSLOT - 1) * SLOTB) ? 0 : sl_next + SLOTB; } while (0)
#define WB(NLO, NHI) do { if (wlo) { WAIT_BAR(NLO); } else { WAIT_BAR(NHI); } } while (0)
    DMA_K(2, 2 * SLOTB);
    WB(3, 1);
    qkt(C0, C1, kp0, qr, negm);
    asm volatile("s_nop 15\n\ts_nop 7" : "+v"(C0), "+v"(C1)); CMASK(C0, C1, 0);
    { const float rm = rowmax(C0, C1) - 6.0f; mhat = rm;
#pragma unroll
      for (int r = 0; r < 16; ++r) { C0[r] = __builtin_amdgcn_exp2f(C0[r] - rm); C1[r] = __builtin_amdgcn_exp2f(C1[r] - rm); }
#pragma unroll
      for (int r = 0; r < 16; ++r) negm[r] = -mhat;
      asm volatile("" : "+v"(negm));
#pragma unroll
      for (int w = 0; w < 4; ++w) { pwa[w] = (int)pk4_fp8_nc(C0[4 * w], C0[4 * w + 1], C0[4 * w + 2], C0[4 * w + 3]); pwa[4 + w] = (int)pk4_fp8_nc(C1[4 * w], C1[4 * w + 1], C1[4 * w + 2], C1[4 * w + 3]); } }
    WAIT_BAR(0);
    DMA_K(3, 0); DMA_V(1, SLOTB);
    ROT();
    kload8(kf, kp0 + (sl_cur >> 1));
    WB(2, 1);
    typedef int v2i_t __attribute__((ext_vector_type(2)));
    i32x8 vf[4];
#define PIN(x) asm volatile("" : "+v"(x))
#define MX3(a, b, c) __builtin_fmaxf(__builtin_fmaxf((a), (b)), (c))
#define VTR8(p_) __builtin_amdgcn_ds_read_tr8_b64_v2i32((LAS v2i_t*)(p_))
#define VRDN(dq) do { const v2i_t a_ = VTR8(vp_ + (dq) * 2048), b_ = VTR8(vp_ + (dq) * 2048 + 256), c_ = VTR8(vp_ + (dq) * 2048 + 512), d_ = VTR8(vp_ + (dq) * 2048 + 768); \
        vf[dq] = (i32x8){a_.x, a_.y, b_.x, b_.y, c_.x, c_.y, d_.x, d_.y}; } while (0)
#define KRD(G, j) do { if (G) { kload2(kf, kp0 + (sl_next >> 1), j); } } while (0)
#define EXP4(X, B, W) do { X[B] = __builtin_amdgcn_exp2f(X[B]); X[B + 1] = __builtin_amdgcn_exp2f(X[B + 1]); X[B + 2] = __builtin_amdgcn_exp2f(X[B + 2]); X[B + 3] = __builtin_amdgcn_exp2f(X[B + 3]); \
        W = (int)pk4_fp8_nc(X[B], X[B + 1], X[B + 2], X[B + 3]); PIN(W); } while (0)
#define STEPD(CU, NX, t, GK, GV, GL) do { SBAR(); \
    const lds_cptr vp_ = vp0 + sl_prev; \
    C0 = MF8(kf[0], qr, negm); SBAR(); \
    VRDN(0); VRDN(1); SBAR(); \
    C1 = MF8(kf[1], qr, negm); SBAR(); \
    VRDN(2); VRDN(3); vone = *(const LAS i32x8a*)(shm3 + L2_ONES); SBAR(); \
    if (GK) { DMA_K((t) + 3, sl_cur); } if (GV) { DMA_V((t) + 1, sl_next); } \
    CMASK(C0, C1, t); \
    { float a = MX3(C0[0], C0[1], C1[0]), b = MX3(C0[2], C0[3], C1[1]); a = MX3(a, C1[2], C1[3]); \
      _Pragma("unroll") for (int r = 4; r < 16; r += 4) { a = MX3(a, C0[r], C0[r + 1]); b = MX3(b, C0[r + 2], C0[r + 3]); a = MX3(a, C1[r], C1[r + 1]); b = MX3(b, C1[r + 2], C1[r + 3]); } \
      float rm = __builtin_fmaxf(a, b); { auto rr = __builtin_amdgcn_permlane32_swap(__float_as_uint(rm), __float_as_uint(rm), false, false); rm = __builtin_fmaxf(__uint_as_float(rr[0]), __uint_as_float(rr[1])); } \
      resc = false; \
      if (__builtin_expect(__any(rm > (float)THRL), 0)) { const float dl = __builtin_fmaxf(rm - 6.0f, 0.f); mhat += dl; \
        _Pragma("unroll") for (int r = 0; r < 16; ++r) { C0[r] -= dl; C1[r] -= dl; } \
        _Pragma("unroll") for (int r = 0; r < 16; ++r) negm[r] = -mhat; asm volatile("" : "+v"(negm)); \
        const float f = __builtin_amdgcn_exp2f(-dl); if (hi == 0) wsf[r32] = f; resc = true; } } \
    SBAR(); \
    ol = MF8(CU, vone, ol); SBAR(); \
    o[0] = MF8(CU, vf[0], o[0]); EXP4(C0, 0, NX[0]); EXP4(C0, 4, NX[1]); SBAR(); \
    o[1] = MF8(CU, vf[1], o[1]); EXP4(C0, 8, NX[2]); EXP4(C0, 12, NX[3]); SBAR(); \
    KRD(GL, 0); o[2] = MF8(CU, vf[2], o[2]); EXP4(C1, 0, NX[4]); EXP4(C1, 4, NX[5]); SBAR(); \
    KRD(GL, 1); o[3] = MF8(CU, vf[3], o[3]); EXP4(C1, 8, NX[6]); EXP4(C1, 12, NX[7]); SBAR(); \
    } while (0)
#define STEP_AB(t, GK, GV, GL) STEPD(pwa, pwb, t, GK, GV, GL)
#define STEP_BA(t, GK, GV, GL) STEPD(pwb, pwa, t, GK, GV, GL)
    int t = 1;
#undef CMASK
#define CMASK(P0, P1, t) do { } while (0)
    for (; t + 5 < NT; t += 2) {
        STEP_AB(t, true, true, true);     WB(2, 1); RESC(); ROT();
        STEP_BA(t + 1, true, true, true); WB(2, 1); RESC(); ROT();
    }
#undef CMASK
#define CMASK(P0, P1, t) do { int jb_ = (t) - (NT - 4); if (jb_ > (wid >> 1)) maskall(P0, P1); } while (0)
#define ENDW(tt) do { if ((tt) + 3 < NT) { WB(2, 1); } else if ((tt) + 2 < NT) { WAIT_BAR(1); } else { WAIT_BAR(0); } } while (0)
    for (; t + 1 < NT; t += 2) {
        STEP_AB(t, (t + 3 < NT), (t + 1 < NT), (t + 1 < NT));         ENDW(t);     RESC(); ROT();
        STEP_BA(t + 1, (t + 4 < NT), (t + 2 < NT), (t + 2 < NT));     ENDW(t + 1); RESC(); ROT();
    }
    STEP_AB(NT - 1, false, false, false); RESC();
    { const lds_cptr vp_ = vp0 + sl_cur; SBAR(); VRDN(0); VRDN(1); VRDN(2); VRDN(3); vone = *(const LAS i32x8a*)(shm3 + L2_ONES);
      ol = MF8(pwb, vone, ol); o[0] = MF8(pwb, vf[0], o[0]); o[1] = MF8(pwb, vf[1], o[1]); o[2] = MF8(pwb, vf[2], o[2]); o[3] = MF8(pwb, vf[3], o[3]); }
#undef PIN
#undef MX3
#undef VTR8
#undef VRDN
#undef KRD
#undef EXP4
#undef STEPD
#undef STEP_AB
#undef STEP_BA
#undef ENDW
#undef WB
    float rli[16];
#pragma unroll
    for (int r = 0; r < 16; ++r) rli[r] = __builtin_amdgcn_rcpf(ol[r]);
    bf16_t* Ow = O + (rowbase + q0 + wid * QBLK) * OP + ocol;
    if (!COMBINE) {
        bf16_t* stg = (bf16_t*)(shm + L2_OST) + wid * 2048;
#pragma unroll
        for (int p = 0; p < 2; ++p) {
#pragma unroll
            for (int r = 0; r < 16; ++r) { const int orow = crow(r, hi);
#pragma unroll
                for (int dd = 0; dd < 2; ++dd) stg[orow * 64 + dd * 32 + r32] = (bf16_t)f2bf(o[2 * p + dd][r] * rli[r]); }
            asm volatile("s_waitcnt lgkmcnt(0)" ::: "memory");
#pragma unroll
            for (int i = 0; i < 4; ++i) { const int row = i * 8 + (lane >> 3), ch = lane & 7; const u32x4 v = *(const u32x4*)(stg + row * 64 + ch * 8); *(u32x4*)(Ow + (long)row * OP + p * 64 + ch * 8) = v; }
            asm volatile("s_waitcnt lgkmcnt(0)" ::: "memory");
        }
    } else {
        asm volatile("s_waitcnt lgkmcnt(0)\n\ts_barrier" ::: "memory");
        constexpr int SROW = 136;
        bf16_t* stg = (bf16_t*)shm + wid * (32 * SROW);
#pragma unroll
        for (int r = 0; r < 16; ++r) { const int orow = crow(r, hi);
#pragma unroll
            for (int dq = 0; dq < 4; ++dq) stg[orow * SROW + dq * 32 + r32] = (bf16_t)f2bf(o[dq][r] * rli[r]); }
        asm volatile("s_waitcnt vmcnt(0) lgkmcnt(0)" ::: "memory");
        const int row = lane >> 1, hf = lane & 1;
        const bf16_t* o1p = O1 + (rowbase + q0 + wid * QBLK + row) * 512 + o1col + hf * 64;
        const bf16_t* o2p = stg + row * SROW + hf * 64;
        float d[64]; float ss = 0.f;
#pragma unroll
        for (int i = 0; i < 8; ++i) { const u32x4 a = *(const u32x4*)(o1p + 8 * i), c = *(const u32x4*)(o2p + 8 * i);
            d[8 * i + 0] = bf2f(a.x & 0xffffu) - lam * bf2f(c.x & 0xffffu); d[8 * i + 1] = bf2f(a.x >> 16) - lam * bf2f(c.x >> 16);
            d[8 * i + 2] = bf2f(a.y & 0xffffu) - lam * bf2f(c.y & 0xffffu); d[8 * i + 3] = bf2f(a.y >> 16) - lam * bf2f(c.y >> 16);
            d[8 * i + 4] = bf2f(a.z & 0xffffu) - lam * bf2f(c.z & 0xffffu); d[8 * i + 5] = bf2f(a.z >> 16) - lam * bf2f(c.z >> 16);
            d[8 * i + 6] = bf2f(a.w & 0xffffu) - lam * bf2f(c.w & 0xffffu); d[8 * i + 7] = bf2f(a.w >> 16) - lam * bf2f(c.w >> 16);
#pragma unroll
            for (int e = 0; e < 8; ++e) ss += d[8 * i + e] * d[8 * i + e]; }
        ss += __shfl_xor(ss, 1);
        const float rs = (1.0f - LAM0) * __builtin_amdgcn_rsqf(ss * (1.0f / 128.0f) + EPS);
        bf16_t* op = Ow + (long)row * OP + hf * 64;
#pragma unroll
        for (int i = 0; i < 8; ++i) { const f32x4 g0 = *(const f32x4*)(gsub + hf * 64 + 8 * i), g1 = *(const f32x4*)(gsub + hf * 64 + 8 * i + 4);
            u32x4 w; w.x = cvtpk(d[8 * i] * rs * g0[0], d[8 * i + 1] * rs * g0[1]); w.y = cvtpk(d[8 * i + 2] * rs * g0[2], d[8 * i + 3] * rs * g0[3]);
            w.z = cvtpk(d[8 * i + 4] * rs * g1[0], d[8 * i + 5] * rs * g1[1]); w.w = cvtpk(d[8 * i + 6] * rs * g1[2], d[8 * i + 7] * rs * g1[3]);
            *(u32x4*)(op + 8 * i) = w; }
    }
    asm volatile("s_waitcnt lgkmcnt(0)\n\ts_barrier" ::: "memory");
#undef DMA_K
#undef DMA_V
#undef CMASK
#undef RESC
#undef ROT
}
#undef SBAR
#undef WAIT_BAR
}

typedef GAS unsigned gu32;
#define XB_TMO      128
#define XB_XCNT(j)  (256  + 64 * (j))
#define XB_XSUB(j)  (1280 + 64 * (j))
#define XB_XGEN(j)  (2304 + 64 * (j))
#define XB_TOP      3328
#define XB_TOPGEN   3392
#define XCD_BAR_WORDS 3456
#define XB_SPIN_CAP (1u << 19)
__device__ __forceinline__ unsigned xb_ld(unsigned* p)              { return __hip_atomic_load(p, __ATOMIC_RELAXED, __HIP_MEMORY_SCOPE_AGENT); }
__device__ __forceinline__ unsigned xb_add(unsigned* p, unsigned v) { return __hip_atomic_fetch_add(p, v, __ATOMIC_RELAXED, __HIP_MEMORY_SCOPE_AGENT); }
__device__ __forceinline__ unsigned xb_xcc_id() { return (unsigned)__builtin_amdgcn_s_getreg((3 << 11) | 20) & 0xFu; }
#define XB_SPIN(cond, bar) do { unsigned _sp = 0; while (cond) { __builtin_amdgcn_s_sleep(1); \
    if ((++_sp & 255u) == 0u) { if (xb_ld(&(bar)[XB_TMO])) break; if (_sp > XB_SPIN_CAP) { atomicAdd(&(bar)[XB_TMO], 1u); break; } } } } while (0)
struct XcdBarrier { unsigned* bar; unsigned x; volatile LAS unsigned* st; };
__device__ __forceinline__ XcdBarrier xcd_barrier_post(unsigned* bar, volatile LAS unsigned* st) {
    XcdBarrier b; b.bar = bar; b.x = xb_xcc_id(); b.st = st;
    if (threadIdx.x == 0) (void)xb_add(&bar[XB_XCNT(b.x)], 1u);
    return b;
}
__device__ __forceinline__ void xcd_barrier_complete(unsigned* bar, unsigned x, unsigned& nloc, unsigned& nx) {
    const unsigned G = gridDim.x * gridDim.y * gridDim.z;
    unsigned sum, cnt, mine, sp = 0u;
    for (;;) {
        sum = 0u; cnt = 0u; mine = 0u;
#pragma unroll
        for (unsigned j = 0; j < 16; ++j) { const unsigned c = xb_ld(&bar[XB_XCNT(j)]); sum += c; cnt += (c > 0u) ? 1u : 0u; mine = (j == x) ? c : mine; }
        if (sum == G) break;
        __builtin_amdgcn_s_sleep(1);
        if ((++sp & 255u) == 0u) { if (xb_ld(&bar[XB_TMO])) break; if (sp > XB_SPIN_CAP) { atomicAdd(&bar[XB_TMO], 1u); break; } }
    }
    nloc = mine > 0u ? mine : 1u; nx = cnt > 0u ? cnt : 1u;
}
__device__ __forceinline__ void xcd_barrier(const XcdBarrier& b) {
    asm volatile("s_waitcnt vmcnt(0)" ::: "memory");
    __syncthreads();
    if (threadIdx.x == 0) {
        unsigned* bar = b.bar;
        __builtin_amdgcn_s_waitcnt(0);
        unsigned nloc = b.st[0], nx = b.st[1];
        if (nloc == 0u) { xcd_barrier_complete(bar, b.x, nloc, nx); b.st[0] = nloc; b.st[1] = nx; }
        const unsigned old = xb_add(&bar[XB_XSUB(b.x)], 1u);
        const unsigned gen = old / nloc;
        if (old + 1u == (gen + 1u) * nloc) {
            __builtin_amdgcn_fence(__ATOMIC_RELEASE, "agent");
            asm volatile("s_waitcnt vmcnt(0)" ::: "memory");
            const unsigned og = xb_add(&bar[XB_TOP], 1u);
            const unsigned tg = og / nx;
            if (og + 1u == (tg + 1u) * nx) xb_add(&bar[XB_TOPGEN], 1u);
            else XB_SPIN(xb_ld(&bar[XB_TOPGEN]) == tg, bar);
            xb_add(&bar[XB_XGEN(b.x)], 1u);
            __builtin_amdgcn_fence(__ATOMIC_ACQUIRE, "agent");
            asm volatile("s_waitcnt vmcnt(0)" ::: "memory");
        } else {
            XB_SPIN(xb_ld(&bar[XB_XGEN(b.x)]) == gen, bar);
            __builtin_amdgcn_fence(__ATOMIC_ACQUIRE, "agent");
            asm volatile("s_waitcnt vmcnt(0)" ::: "memory");
        }
    }
    __syncthreads();
}

struct Args {
    const float* in[28]; float* out; unsigned char* ws; int ph_lo, ph_hi, li, pad;
};
enum { I_X = 0, I_C, I_POS, I_WADA, I_BADA, I_GN1, I_WIN, I_BF, I_GQF, I_GKF, I_GQD, I_GKD, I_LQ1, I_LK1, I_LQ2, I_LK2, I_GSUB, I_WPF, I_WPD, I_WOUT, I_GN2, I_WRG, I_BRG, I_WRE, I_BRE, I_W1, I_W3, I_W2 };

template <bool F8 = false> __device__ __forceinline__ void transpose_item(const float* W, size_t ldw, int col0, int k0, bf16_t* WT, int drow, int Kd, LAS float* scr, int lane, int kd0 = 0) {
    float v[32];
    const float* wp = W + (size_t)(k0 + (lane >> 5)) * ldw + col0 + (lane & 31);
#pragma unroll
    for (int i = 0; i < 32; ++i) v[i] = wp[(size_t)(2 * i) * ldw];
#pragma unroll
    for (int i = 0; i < 32; ++i) scr[(2 * i + (lane >> 5)) * 33 + (lane & 31)] = v[i];
    LDS_WAIT(); asm volatile("" ::: "memory");
    const int c = lane & 7;
#pragma unroll
    for (int j = 0; j < 4; ++j) { const int n = (lane >> 3) + 8 * j; const LAS float* s = scr + (8 * c) * 33 + n;
        u32x4 o; o.x = pk2(s[0 * 33], s[1 * 33]); o.y = pk2(s[2 * 33], s[3 * 33]); o.z = pk2(s[4 * 33], s[5 * 33]); o.w = pk2(s[6 * 33], s[7 * 33]);
        if (F8) { u32x2 o8; o8.x = pk4_fp8(W8S * s[0 * 33], W8S * s[1 * 33], W8S * s[2 * 33], W8S * s[3 * 33]); o8.y = pk4_fp8(W8S * s[4 * 33], W8S * s[5 * 33], W8S * s[6 * 33], W8S * s[7 * 33]);
                  *(u32x2*)((unsigned char*)WT + (size_t)(drow + n) * Kd + kd0 + k0 + 8 * c) = o8; }
        else *(u32x4*)(WT + (size_t)(drow + n) * Kd + kd0 + k0 + 8 * c) = o; }
    LDS_WAIT(); asm volatile("" ::: "memory");
}

__global__ void __launch_bounds__(NTHREADS, 2) fwd_kernel(Args args) {
    extern __shared__ __attribute__((aligned(16))) unsigned char lds_raw[];
    LAS unsigned char* lds = (LAS unsigned char*)lds_raw;
    volatile LAS unsigned* MISC = (volatile LAS unsigned*)(lds + MISC_OFF);
    const int tid = threadIdx.x, lane = tid & 63, wave = __builtin_amdgcn_readfirstlane(tid >> 6);
    const int G = gridDim.x; const int bx = blockIdx.x; const int vcu = (G % 8 == 0) ? (bx % 8) * (G / 8) + bx / 8 : bx;
    unsigned char* ws = args.ws;
    gu32* ctl = (gu32*)(ws + WS_CTL);
    const int gw = vcu * NWAVES + wave, NGW = G * NWAVES;

    for (int u = tid; u < (LDS_BYTES - LDSCTL_OFF) / 4; u += NTHREADS) ((LAS unsigned*)(lds + LDSCTL_OFF))[u] = 0u;
    __syncthreads();
    XcdBarrier bar; bar.bar = (unsigned*)(ctl + CW_BAR); bar.x = 0; bar.st = nullptr;
    const bool one_launch = (args.ph_hi - args.ph_lo) > 1;
    if (one_launch) bar = xcd_barrier_post((unsigned*)(ctl + CW_BAR), MISC + 8);
    const int lo = args.ph_lo, hi = args.ph_hi;
#ifdef ONLYP
#define IN(k) ((k) == ONLYP && lo <= (k) && (k) < hi)
#else
#define IN(k) (lo <= (k) && (k) < hi)
#endif
#define SEAM(k) do { if (IN(k) && IN((k) + 1)) xcd_barrier(bar); } while (0)

    float* mod = (float*)(ws + WS_MOD);
    float* logf = (float*)(ws + WS_LOGF);
    float* biasb = (float*)(ws + WS_BIAS);
    bf16_t* Win_t = (bf16_t*)(ws + WS_WIN); bf16_t* Wpf_t = (bf16_t*)(ws + WS_WPF); bf16_t* Wpd_t = (bf16_t*)(ws + WS_WPD); bf16_t* Wout_t = (bf16_t*)(ws + WS_WOUT);
    bf16_t* W13_t = (bf16_t*)(ws + WS_W13); bf16_t* W2_t = (bf16_t*)(ws + WS_W2); bf16_t* Wr_t = (bf16_t*)(ws + WS_WR);
    bf16_t* H1 = (bf16_t*)(ws + WS_H1); bf16_t* OCAT = H1;     bf16_t* X1B = H1; bf16_t* H2 = (bf16_t*)(ws + WS_H2);
    bf16_t* QF = (bf16_t*)(ws + WS_QF); bf16_t* KF = (bf16_t*)(ws + WS_KF); bf16_t* VF = (bf16_t*)(ws + WS_VF);
    bf16_t* QD = (bf16_t*)(ws + WS_QD); bf16_t* KD = (bf16_t*)(ws + WS_KD); bf16_t* VD = (bf16_t*)(ws + WS_VD);
    bf16_t* GT = (bf16_t*)(ws + WS_G); bf16_t* O1T = (bf16_t*)(ws + WS_OD);     bf16_t* MERGED = (bf16_t*)(ws + WS_MERGED);
    bf16_t* H2S = (bf16_t*)(ws + WS_H2S); bf16_t* YB = H2S; unsigned char* HH8 = (unsigned char*)(ws + WS_HH);
    unsigned char* H1F8 = (unsigned char*)(ws + WS_OD);
    unsigned char* WG8 = (unsigned char*)(ws + WS_W13 + 32 * MiB);
    unsigned char* H2F8 = (unsigned char*)(ws + WS_QF);
    float* LOGIT = (float*)(ws + WS_LOGIT);
    int* EID = (int*)(ws + WS_EID); int* RNK = (int*)(ws + WS_RNK); float* WGT = (float*)(ws + WS_WGT); int* POS = (int*)(ws + WS_POS);
    int* HIST = (int*)(ws + WS_HIST); int* ELIST = (int*)(ws + WS_ROPE);
    unsigned* GCNT = (unsigned*)(ctl + CW_GCNT); float* gall = (float*)(ws + WS_GALL);
    const float* x = args.in[I_X];

    for (int rep_ = 0; rep_ < 1 + ((PROBE_REP >> 0) & 1); ++rep_) if (IN(0)) {
        if (vcu < 96) {
            LAS float* sl = (LAS float*)lds;
            LAS float* red = (LAS float*)(lds + 65536);
            const float* c = args.in[I_C];
            for (int i = tid; i < 16 * 1024; i += NTHREADS) { const int b = i >> 10, k = i & 1023; const float v = c[i]; sl[k * 16 + b] = v / (1.0f + __expf(-v)); }
            __syncthreads();
            const float* wa = args.in[I_WADA] + vcu * 64 + lane;
            float a[16];
#pragma unroll
            for (int b = 0; b < 16; ++b) a[b] = 0.f;
            for (int k = wave * 128; k < wave * 128 + 128; k += 16) {
                float w[16];
#pragma unroll
                for (int q = 0; q < 16; ++q) w[q] = wa[(size_t)(k + q) * 6144];
#pragma unroll
                for (int q = 0; q < 16; ++q) {
                    const LAS f32x4* sp = (const LAS f32x4*)(sl + (k + q) * 16);
#pragma unroll
                    for (int b4 = 0; b4 < 4; ++b4) { const f32x4 s = sp[b4]; a[4 * b4 + 0] += s[0] * w[q]; a[4 * b4 + 1] += s[1] * w[q]; a[4 * b4 + 2] += s[2] * w[q]; a[4 * b4 + 3] += s[3] * w[q]; }
                    __builtin_amdgcn_sched_barrier(0);
                }
            }
#pragma unroll
            for (int b = 0; b < 16; ++b) red[(wave * 16 + b) * 64 + lane] = a[b];
            __syncthreads();
            for (int i = tid; i < 1024; i += NTHREADS) { const int b = i >> 6, cc = i & 63; float s = 0.f;
#pragma unroll
                for (int w = 0; w < 8; ++w) s += red[(w * 16 + b) * 64 + cc];
                mod[b * 6144 + vcu * 64 + cc] = s + args.in[I_BADA][vcu * 64 + cc]; }
            __syncthreads();
        }
        if (vcu == 100 && tid < 256) gall[tid] = args.in[I_GQF + (tid >> 6)][tid & 63];
        for (int i = gw * 64 + lane; i < 256 * 1024; i += NGW * 64) { const int r = i >> 10, k = i & 1023; float v = 0.f;
            if (r < 4) v = args.in[I_WRG][k * 4 + r]; else if (r < 36) v = args.in[I_WRE][k * 32 + (r - 4)];
            Wr_t[i] = (bf16_t)f2bf(v); }
        { LAS float* scr = (LAS float*)(lds + wave * 16384);
          constexpr int I_IN = 160 * 16, I_PF = 32 * 8, I_PD = 32 * 8, I_OUT = 32 * 16, I_13 = 32 * 2 * 16 * 16, I_2 = 32 * 32 * 8;
          constexpr int NITEMS = I_IN + I_PF + I_PD + I_OUT + I_13 + I_2;
          constexpr int NADA = 96 * NWAVES, ITA = 11 * NADA;
          const bool ada_ = (G == 256) && (vcu < 96);
          const int it0 = (G != 256) ? gw : (ada_ ? vcu * NWAVES + wave : ITA + (vcu - 96) * NWAVES + wave), it1 = (G != 256) ? NITEMS : (ada_ ? ITA : NITEMS), its = (G != 256) ? NGW : (ada_ ? NADA : NGW - NADA);
          for (int it = it0; it < it1; it += its) {
              int r = it;
              if (r < I_IN) { const int nb = r % 160, kb = r / 160; const int pn = nb >> 3, c0 = (nb & 7) * 32, bj = c0 >> 7, wc = (c0 & 127) >> 5; int col0;
                  if (pn >= 12) col0 = COL_GATE + (pn - 12) * 256 + c0;
                  else { const int sec = pn >> 1, pl = pn & 1; const int sb = sec == 0 ? COL_FQ : sec == 1 ? COL_FK : sec == 2 ? COL_FV : sec == 3 ? COL_DQ : sec == 4 ? COL_DK : COL_DV;
                      if (sec == 2 || sec == 5) col0 = sb + pl * 256 + c0; else col0 = sb + (4 * pl + wc) * 64 + 32 * bj; }
                  transpose_item<true>(args.in[I_WIN], IN_COLS, col0, kb * 64, (bf16_t*)WG8, nb * 32, 1024, scr, lane);
                  continue; } r -= I_IN;
              if (r < I_PF) { const int nb = r % 32, kb = r / 32; transpose_item(args.in[I_WPF], 1024, nb * 32, kb * 64, Wpf_t, nb * 32, 1024, scr, lane, 0); continue; } r -= I_PF;
              if (r < I_PD) { const int nb = r % 32, kb = r / 32; transpose_item(args.in[I_WPD], 1024, nb * 32, kb * 64, Wpf_t, nb * 32, 1024, scr, lane, 512); continue; } r -= I_PD;
              if (r < I_OUT) { const int nb = r % 32, kb = r / 32; transpose_item<true>(args.in[I_WOUT], 1024, nb * 32, kb * 64, Wout_t, nb * 32, 1024, scr, lane); continue; }     r -= I_OUT;
              if (r < I_13) { const int nb = r % 16, kb = (r / 16) % 16, sr = (r / 256) % 2, e = r / 512; const int n0 = nb * 32, ct = n0 >> 7;
                  transpose_item<true>(args.in[sr ? I_W3 : I_W1] + (size_t)e * 1024 * 512, 512, n0, kb * 64, W13_t, e * 1024 + ct * 256 + 128 * sr + (n0 - ct * 128), 1024, scr, lane); continue; } r -= I_13;
              { const int nb = r % 32, kb = (r / 32) % 8, e = r / 256;
                  transpose_item<true>(args.in[I_W2] + (size_t)e * 512 * 1024, 1024, nb * 32, kb * 64, W2_t, e * 1024 + nb * 32, 512, scr, lane); }
          } }
    }
    SEAM(0);

    for (int rep_ = 0; rep_ < 1 + ((PROBE_REP >> 1) & 1); ++rep_) if (IN(1)) {
        LAS float* wff = (LAS float*)lds;
        for (int i = tid; i < 8 * 1024; i += NTHREADS) { const int k = i >> 3, q = i & 7; wff[q * 1024 + k] = args.in[I_WIN][(size_t)k * IN_COLS + COL_FF + q]; }
        __syncthreads();
        const int b = gw >> 7;
        const float* mb = mod + (size_t)b * 6144;
        f32x4 gm[4], sh[4];
#pragma unroll
        for (int j = 0; j < 4; ++j) { const int k = 256 * j + 4 * lane; const f32x4 g = *(const f32x4*)(args.in[I_GN1] + k), sc = *(const f32x4*)(mb + 1024 + k); sh[j] = *(const f32x4*)(mb + k); gm[j] = g * (1.0f + sc); }
        const float bfv = (lane < 8) ? args.in[I_BF][lane] : 0.f;
        for (int r = 0; r < 32; ++r) {
            const int row = gw * 32 + r;
            const f32x4* xr = (const f32x4*)(x + (size_t)row * 1024) + lane;
            f32x4 v[4]; float ss = 0.f;
#pragma unroll
            for (int j = 0; j < 4; ++j) { v[j] = xr[64 * j]; ss += (v[j][0] * v[j][0] + v[j][1] * v[j][1]) + (v[j][2] * v[j][2] + v[j][3] * v[j][3]); }
            const float rstd = 1.0f / sqrtf(wave_sum(ss) * (1.0f / 1024.0f) + EPS);
            unsigned long long* o8 = (unsigned long long*)(H1 + (size_t)row * 1024) + lane;
            float zf[8];
#pragma unroll
            for (int q = 0; q < 8; ++q) zf[q] = 0.f;
#pragma unroll
            for (int j = 0; j < 4; ++j) { v[j] = v[j] * rstd * gm[j] + sh[j];
                *((unsigned*)(H1F8 + (size_t)row * 1024 + 256 * j) + lane) = pk4_fp8(v[j][0], v[j][1], v[j][2], v[j][3]);
#pragma unroll
                for (int q = 0; q < 8; ++q) { const f32x4 w = *(const LAS f32x4*)(wff + q * 1024 + 256 * j + 4 * lane); zf[q] += (v[j][0] * w[0] + v[j][1] * w[1]) + (v[j][2] * w[2] + v[j][3] * w[3]); } }
            float mine = 0.f;
#pragma unroll
            for (int q = 0; q < 8; ++q) { const float s = wave_sum(zf[q]); if (lane == q) mine = s; }
            if (lane < 8) { const float z = mine + bfv; const float lf = fminf(z, 0.f) - log1pf(__expf(-fabsf(z)));
                logf[(size_t)(b * 8 + lane) * SEQ + (row & (SEQ - 1))] = lf; }
        }
    }
    SEAM(1);

    for (int rep_ = 0; rep_ < 1 + ((PROBE_REP >> 2) & 1); ++rep_) if (IN(2)) {
        if (vcu < 128 && wave == 0) {
            const float* lp = logf + (size_t)vcu * SEQ + 64 * lane; float v[64]; float run = 0.f;
#pragma unroll
            for (int i = 0; i < 16; ++i) { const f32x4 q = *(const f32x4*)(lp + 4 * i); v[4 * i] = q[0]; v[4 * i + 1] = q[1]; v[4 * i + 2] = q[2]; v[4 * i + 3] = q[3]; }
#pragma unroll
            for (int i = 0; i < 64; ++i) { run += v[i]; v[i] = run; }
            float incl = run;
#pragma unroll
            for (int o = 1; o < 64; o <<= 1) { const float t = __shfl_up(incl, o); if (lane >= o) incl += t; }
            const float excl = incl - run;
            float* bp = biasb + (size_t)vcu * SEQ + 64 * lane;
#pragma unroll
            for (int i = 0; i < 16; ++i) { f32x4 q; q[0] = -(excl + v[4 * i]) * LOG2E; q[1] = -(excl + v[4 * i + 1]) * LOG2E; q[2] = -(excl + v[4 * i + 2]) * LOG2E; q[3] = -(excl + v[4 * i + 3]) * LOG2E; *(f32x4*)(bp + 4 * i) = q; }
        }
        { pg8::USched S{}; S.nM = NTOK / 256; S.nN = 20; S.G = G; S.c = bx; S.pair = 0; S.K = 512  ; S.nseg = 1; S.A0 = (const char*)H1F8; S.A1 = S.A0; S.B0 = (const char*)WG8; S.B1 = S.B0; S.segB = 0; S.tp = nullptr; S.rowst = nullptr; S.direct = -1; S.gidx = nullptr;
          UEpi E{}; E.mode = (((PROBE_REP >> 21) & 1) && rep_) ? 99 : 1; E.pnoff = 12; E.ascale = 1.0f / W8S; E.qkv6 = QF; E.gates = GT; E.gall = gall; E.pos = (const int*)args.in[I_POS];
          pg8::gemm_phase<UEpi, pg8::USched, true>(lds, 512, S, E); }
    }
    SEAM(2);

    if (IN(3)) {
        float bound2;
        float smax2;
        { const float gq = fabsf(args.in[I_GQF][lane]), gk = fabsf(args.in[I_GKF][lane]); const float smax = 8.0f * wave_max(gq) * wave_max(gk); bound2 = (2.0f * smax + 19.5f) * LOG2E; smax2 = smax * LOG2E * 1.02f + 0.5f; }
        const int grp = vcu >> 3, s8 = vcu & 7;
        float lam;
        { const float a = wave_sum(args.in[I_LQ1][lane] * args.in[I_LK1][lane]), c = wave_sum(args.in[I_LQ2][lane] * args.in[I_LK2][lane]); lam = __expf(a) - __expf(c) + LAM0; }
        LAS int* t0tab = (LAS int*)(lds + LDSCTL_OFF + 768);
        { const int i = wave; const int stream = (i >> 1) * 32 + grp; const int sr = (s8 + 2 * (i >> 1)) & 7; const int qb = (i & 1) ? 15 - sr : sr;
          const int b = stream >> 3, h = ((stream & 7) + (b & 3) + 2 * (i >> 1)) & 7;
          const float* bias = biasb + (size_t)(b * 8 + h) * SEQ; const int q0 = qb * 256, NT0 = (q0 + 256) / 64;
          const float bq = bias[q0]; const int j = lane; float bj = 0.f; if (j < NT0 - 4) bj = bias[64 * j + 63];
          const unsigned long long bal = __ballot((j < NT0 - 4) && (bj < bq - bound2));
          const int t0 = __builtin_popcountll(bal) & ~1; if (lane == 0) t0tab[i] = t0; }
        __syncthreads();
        for (int rep_ = 0; rep_ < 1 + (((PROBE_REP >> 20) | (PROBE_REP >> 22)) & 1); ++rep_)
        for (int i = (rep_ && ((PROBE_REP >> 20) & 1)) ? 8 : 0; i < ((rep_ && ((PROBE_REP >> 22) & 1)) ? 8 : 16); ++i) {
            if (i >= 8) {
                if (G != 256) break;
                const int u4 = (i - 8) & 3, ps = ((i - 8) >> 2) * 32 + grp; const int b = ps >> 2, hd = ps & 3, m = u4 & 1, qb2 = (u4 >> 1) ? 15 - s8 : s8; const int hm = hd * 2 + m;
                if (m == 0) attn_body::attn_unit_d128<8, false>((long)b * SEQ, hm * 64, hd * 128, hd * 128, 512, qb2, (const unsigned char*)QD, (const unsigned char*)KD, (const unsigned char*)VD, O1T, nullptr, 0, 0.f, nullptr, (char*)lds_raw);
                else        attn_body::attn_unit_d128<8, true>((long)b * SEQ, hm * 64, hd * 128, 512 + hd * 128, 1024, qb2, (const unsigned char*)QD, (const unsigned char*)KD, (const unsigned char*)VD, OCAT, O1T, hd * 128, lam, args.in[I_GSUB], (char*)lds_raw);
                continue;
            }
            const int stream = (i >> 1) * 32 + grp; const int sr = (s8 + 2 * (i >> 1)) & 7; const int qb = (i & 1) ? 15 - sr : sr;
            if (G != 256) break;
#ifndef NO_FOX
            if (stream < 128) { const int b = stream >> 3, h = ((stream & 7) + (b & 3) + 2 * (i >> 1)) & 7;
                attn_body::attn_unit<true, 8>((long)b * SEQ, h * 64, h * 64, h * 64, 1024, qb, (const unsigned char*)QF, (const unsigned char*)KF, VF, OCAT, biasb + (size_t)(b * 8 + h) * SEQ, __builtin_amdgcn_readfirstlane(t0tab[i]), smax2, (char*)lds_raw);
            }
#endif
#ifndef NO_DIFF
            if (stream >= 128) {   }
#endif
        }
    }
    SEAM(3);


    for (int rep_ = 0; rep_ < 1 + ((PROBE_REP >> 5) & 1); ++rep_) if (IN(5)) {
        pg8::USched S{}; S.nM = NTOK / 256; S.nN = 4; S.G = G; S.c = bx; S.pair = 0; S.K = 1024; S.nseg = 1; S.A0 = (const char*)OCAT; S.A1 = S.A0; S.B0 = (const char*)Wpf_t; S.B1 = S.B0; S.segB = 0; S.tp = nullptr; S.rowst = nullptr; S.direct = -1; S.gidx = nullptr;
        UEpi E{}; E.mode = 2; E.gates = GT; E.merged = MERGED;
        pg8::gemm_phase<UEpi, pg8::USched>(lds, 1024, S, E);
    }
    SEAM(5);

    for (int rep_ = 0; rep_ < 1 + ((PROBE_REP >> 6) & 1); ++rep_) if (IN(6)) {
        pg8::USched S{}; S.nM = NTOK / 256; S.nN = 4; S.G = G; S.c = bx; S.pair = 0; S.K = 512  ; S.nseg = 1; S.A0 = (const char*)MERGED; S.A1 = S.A0; S.B0 = (const char*)Wout_t; S.B1 = S.B0; S.segB = 0; S.tp = nullptr; S.rowst = nullptr; S.direct = -1; S.gidx = nullptr;
        UEpi E{}; E.mode = 3; E.x = x; E.x1 = X1B; E.mod = mod; E.ascale = 1.0f / (W8S * M8S);
        pg8::gemm_phase<UEpi, pg8::USched, true>(lds, 512, S, E);
    }
    SEAM(6);

    for (int rep_ = 0; rep_ < 1 + ((PROBE_REP >> 7) & 1); ++rep_) if (IN(7)) {
        int t7 = threadIdx.x; asm volatile("" : "+v"(t7));
        const int l7 = t7 & 63, r7 = l7 & 15, kg = l7 >> 4;
        constexpr int WRP = 2064;
        LAS unsigned char* wr48 = lds; LAS float* gmt = (LAS float*)(lds + 48 * WRP); LAS float* sht = gmt + 1024;
        for (int i = t7; i < 48 * 128; i += NTHREADS) { const int n = i >> 7, c = i & 127; *(LAS u32x4*)(wr48 + n * WRP + c * 16) = *(const u32x4*)((const char*)Wr_t + (size_t)n * 2048 + c * 16); }
        { const int b = vcu >> 4; const float* mb = mod + (size_t)b * 6144;
          for (int k = t7; k < 1024; k += NTHREADS) { gmt[k] = args.in[I_GN2][k] * (1.0f + mb[4096 + k]); sht[k] = mb[3072 + k]; } }
        __syncthreads();
        for (int g = 0; g < 2; ++g) {
            const int row0 = gw * 32 + g * 16;
            const u32x4* xp = (const u32x4*)(X1B + (size_t)(row0 + r7) * 1024 + 8 * kg);
            float ss = 0.f;
#pragma unroll
            for (int q_ = 0; q_ < 2; ++q_) { u32x4 t_[16];
#pragma unroll
                for (int j_ = 0; j_ < 16; ++j_) t_[j_] = xp[4 * (16 * q_ + j_)];
#pragma unroll
                for (int j_ = 0; j_ < 16; ++j_) { const u32x4 w = t_[j_];
                    const float a0 = bf2f(w.x & 0xffffu), a1 = bf2f(w.x >> 16), a2 = bf2f(w.y & 0xffffu), a3 = bf2f(w.y >> 16), a4 = bf2f(w.z & 0xffffu), a5 = bf2f(w.z >> 16), a6 = bf2f(w.w & 0xffffu), a7 = bf2f(w.w >> 16);
                    ss += ((a0 * a0 + a1 * a1) + (a2 * a2 + a3 * a3)) + ((a4 * a4 + a5 * a5) + (a6 * a6 + a7 * a7)); }
                __builtin_amdgcn_sched_barrier(0); }
            ss += __shfl_xor(ss, 16); ss += __shfl_xor(ss, 32);
            const float rstd = 1.0f / sqrtf(ss * (1.0f / 1024.0f) + EPS);
            u32x4 win[16];
#pragma unroll
            for (int j_ = 0; j_ < 16; ++j_) win[j_] = xp[4 * j_];
            f32x4 lacc[3]; lacc[0] = (f32x4){0.f, 0.f, 0.f, 0.f}; lacc[1] = lacc[0]; lacc[2] = lacc[0];
            unsigned char* h8 = H2F8 + (size_t)(row0 + r7) * 1024 + 8 * kg;
#pragma unroll
            for (int s_ = 0; s_ < 32; ++s_) { const u32x4 w = win[s_ & 15]; if (s_ + 16 < 32) win[s_ & 15] = xp[4 * (s_ + 16)]; const int k0 = 32 * s_ + 8 * kg;
                const f32x4 g0 = *(const LAS f32x4*)(gmt + k0), g1 = *(const LAS f32x4*)(gmt + k0 + 4), s0 = *(const LAS f32x4*)(sht + k0), s1 = *(const LAS f32x4*)(sht + k0 + 4);
                f32x4 h0, h1;
                h0[0] = bf2f(w.x & 0xffffu) * rstd * g0[0] + s0[0]; h0[1] = bf2f(w.x >> 16) * rstd * g0[1] + s0[1]; h0[2] = bf2f(w.y & 0xffffu) * rstd * g0[2] + s0[2]; h0[3] = bf2f(w.y >> 16) * rstd * g0[3] + s0[3];
                h1[0] = bf2f(w.z & 0xffffu) * rstd * g1[0] + s1[0]; h1[1] = bf2f(w.z >> 16) * rstd * g1[1] + s1[1]; h1[2] = bf2f(w.w & 0xffffu) * rstd * g1[2] + s1[2]; h1[3] = bf2f(w.w >> 16) * rstd * g1[3] + s1[3];
                u32x2 w8; w8.x = pk4_fp8(h0[0], h0[1], h0[2], h0[3]); w8.y = pk4_fp8(h1[0], h1[1], h1[2], h1[3]);
                *(u32x2*)(h8 + 32 * s_) = w8;
                u32x4 aw; aw.x = cvtpk(h0[0], h0[1]); aw.y = cvtpk(h0[2], h0[3]); aw.z = cvtpk(h1[0], h1[1]); aw.w = cvtpk(h1[2], h1[3]);
                const bf16x8 af = __builtin_bit_cast(bf16x8, aw);
#pragma unroll
                for (int blk = 0; blk < 3; ++blk) { const bf16x8 bfr = *(const LAS bf16x8*)(wr48 + (blk * 16 + r7) * WRP + k0 * 2);
                    lacc[blk] = __builtin_amdgcn_mfma_f32_16x16x32_bf16(af, bfr, lacc[blk], 0, 0, 0); }
                __builtin_amdgcn_sched_barrier(0); }
#pragma unroll
            for (int blk = 0; blk < 3; ++blk)
#pragma unroll
                for (int i = 0; i < 4; ++i) LOGIT[(size_t)(row0 + 4 * kg + i) * 64 + blk * 16 + r7] = lacc[blk][i];
        }
    }
    if (IN(7) && IN(9)) { VM_WAIT(); __syncthreads(); }

    for (int rep_ = 0; rep_ < 1 + ((PROBE_REP >> 9) & 1); ++rep_) if (IN(9)) {
        LAS unsigned* cnt = (LAS unsigned*)lds;
        int t9 = threadIdx.x; asm volatile("" : "+v"(t9));
        if (tid < 32) cnt[t9] = 0u;
        __syncthreads();
        unsigned ra = 0, rb = 0; int eA = 0, eB = 0, tkk = 0;
        if (tid < 256) {
            const int tk = vcu * 256 + tid; const float* lp = LOGIT + (size_t)tk * 64;
            const f32x4 g = *(const f32x4*)lp;
            float gl[4]; gl[0] = g[0] + args.in[I_BRG][0]; gl[1] = g[1] + args.in[I_BRG][1]; gl[2] = g[2] + args.in[I_BRG][2]; gl[3] = g[3] + args.in[I_BRG][3];
            int gi = 0; float gmx = gl[0];
#pragma unroll
            for (int j = 1; j < 4; ++j) if (gl[j] > gmx) { gmx = gl[j]; gi = j; }
            float gs = 0.f;
#pragma unroll
            for (int j = 0; j < 4; ++j) gs += __expf(gl[j] - gmx);
            const float gwt = 1.0f / gs;
            const f32x4 e0 = *(const f32x4*)(lp + 4 + 8 * gi), e1 = *(const f32x4*)(lp + 8 + 8 * gi);
            const f32x4 b0 = *(const f32x4*)(args.in[I_BRE] + 8 * gi), b1 = *(const f32x4*)(args.in[I_BRE] + 8 * gi + 4);
            float el[8]; el[0] = e0[0] + b0[0]; el[1] = e0[1] + b0[1]; el[2] = e0[2] + b0[2]; el[3] = e0[3] + b0[3]; el[4] = e1[0] + b1[0]; el[5] = e1[1] + b1[1]; el[6] = e1[2] + b1[2]; el[7] = e1[3] + b1[3];
            int i1 = 0; float m1 = el[0];
#pragma unroll
            for (int j = 1; j < 8; ++j) if (el[j] > m1) { m1 = el[j]; i1 = j; }
            int i2 = -1; float m2 = -INFINITY;
#pragma unroll
            for (int j = 0; j < 8; ++j) if (j != i1 && el[j] > m2) { m2 = el[j]; i2 = j; }
            const float w1 = 1.0f / (1.0f + __expf(m2 - m1)); const float w2 = 1.0f - w1;
            const int ea = gi * 8 + i1, eb = gi * 8 + i2;
            ra = atomicAdd((unsigned*)(lds_raw) + ea, 1u); rb = atomicAdd((unsigned*)(lds_raw) + eb, 1u);
            EID[tk * 2] = ea; EID[tk * 2 + 1] = eb; WGT[tk * 2] = gwt * w1; WGT[tk * 2 + 1] = gwt * w2; eA = ea; eB = eb; tkk = tk;
        }
        __syncthreads();
        if (tid < 32) cnt[32 + t9] = __hip_atomic_fetch_add(GCNT + tid, cnt[t9], __ATOMIC_RELAXED, __HIP_MEMORY_SCOPE_AGENT);
        __syncthreads();
        if (tid < 256) { const int pa = (int)(cnt[32 + eA] + ra), pb = (int)(cnt[32 + eB] + rb);
            POS[tkk * 2] = pa; POS[tkk * 2 + 1] = pb; ELIST[(size_t)eA * NASSIGN + pa] = tkk; ELIST[(size_t)eB * NASSIGN + pb] = tkk; }
        __syncthreads();
    }
    SEAM(9);

    if (IN(11) || IN(12)) {
        LAS int* tp = (LAS int*)(lds + SCHED_OFF); LAS int* rowst = tp + 40;
        LAS int* ecnt = tp + 80;
        if (tid == 0) { int run = 0; for (int e = 0; e < 32; ++e) { const int c = (int)__hip_atomic_load(GCNT + e, __ATOMIC_RELAXED, __HIP_MEMORY_SCOPE_AGENT); ecnt[e] = c; tp[e] = run; rowst[e] = run * 256; run += (c + 255) >> 8; } tp[32] = run; }
        __syncthreads();
        const int ntile = tp[32];
        for (int rep_ = 0; rep_ < 1 + ((PROBE_REP >> 11) & 1); ++rep_) if (IN(11)) {
            pg8::USched S{}; S.nM = ntile; S.nN = 4; S.G = G; S.c = bx; S.pair = 0; S.K = 512  ; S.nseg = 32; S.A0 = (const char*)H2F8; S.A1 = S.A0; S.B0 = (const char*)W13_t; S.B1 = S.B0; S.segB = (size_t)1024 * 1024; S.tp = tp; S.rowst = rowst; S.direct = -1;
            LAS int* gidx = (LAS int*)(lds + LDSCTL_OFF + 2048);
            S.gidx = gidx;
            { pg8::Unit u; for (int i = 0; i < 12 && S.next(i, u); ++i) if (tid < 256) { const int r = u.row0 - rowst[u.seg] + tid;
                  gidx[i * 256 + tid] = (r < ecnt[u.seg]) ? ELIST[(size_t)u.seg * NASSIGN + r] : 0; } }
            __syncthreads();
            UEpi E{}; E.mode = 5; E.hh = HH8;
            pg8::gemm_phase<UEpi, pg8::USched, true>(lds, 512, S, E);
        }
        SEAM(11);
        for (int rep_ = 0; rep_ < 1 + ((PROBE_REP >> 12) & 1); ++rep_) if (IN(12)) {
            pg8::USched S{}; S.nM = ntile; S.nN = 4; S.G = G; S.c = bx; S.pair = 0; S.K = 256  ; S.nseg = 32; S.A0 = (const char*)HH8; S.A1 = S.A0; S.B0 = (const char*)W2_t; S.B1 = S.B0; S.segB = (size_t)1024 * 512; S.tp = tp; S.rowst = rowst; S.direct = -1; S.gidx = nullptr;
            UEpi E{}; E.mode = 6; E.y = (unsigned char*)YB;
            pg8::gemm_phase<UEpi, pg8::USched, true>(lds, 256, S, E);
        }
    }
    SEAM(12);

    if (IN(13)) {
        LAS int* pst = (LAS int*)(lds + SCHED_OFF);
        if (tid == 0) { int run = 0; for (int e = 0; e < 32; ++e) { pst[e] = run; run += (((int)__hip_atomic_load(GCNT + e, __ATOMIC_RELAXED, __HIP_MEMORY_SCOPE_AGENT) + 255) >> 8) << 8; } }
        __syncthreads();
        for (int row = gw; row < NTOK; row += NGW) {
            const int b = row >> 12; const float* gt = mod + (size_t)b * 6144 + 5120;
            const int p0 = pst[EID[row * 2]] + POS[row * 2], p1 = pst[EID[row * 2 + 1]] + POS[row * 2 + 1]; const float w0 = WGT[row * 2], w1 = WGT[row * 2 + 1];
            float* orow = args.out + (size_t)row * 1024;
#pragma unroll
            for (int j = 0; j < 2; ++j) { const int k = 512 * j + 8 * lane;
                const u32x2 a = *(const u32x2*)((const unsigned char*)YB + (size_t)p0 * 1024 + k), c = *(const u32x2*)((const unsigned char*)YB + (size_t)p1 * 1024 + k);
                const u32x4 xw = *(const u32x4*)(X1B + (size_t)row * 1024 + k); const f32x4 g0 = *(const f32x4*)(gt + k), g1 = *(const f32x4*)(gt + k + 4);
                f32x4 x0, x1v; x0[0] = bf2f(xw.x & 0xffffu); x0[1] = bf2f(xw.x >> 16); x0[2] = bf2f(xw.y & 0xffffu); x0[3] = bf2f(xw.y >> 16); x1v[0] = bf2f(xw.z & 0xffffu); x1v[1] = bf2f(xw.z >> 16); x1v[2] = bf2f(xw.w & 0xffffu); x1v[3] = bf2f(xw.w >> 16);
                const f32x2 a0 = __builtin_amdgcn_cvt_pk_f32_fp8((int)a.x, false), a1 = __builtin_amdgcn_cvt_pk_f32_fp8((int)a.x, true), a2 = __builtin_amdgcn_cvt_pk_f32_fp8((int)a.y, false), a3 = __builtin_amdgcn_cvt_pk_f32_fp8((int)a.y, true);
                const f32x2 c0 = __builtin_amdgcn_cvt_pk_f32_fp8((int)c.x, false), c1 = __builtin_amdgcn_cvt_pk_f32_fp8((int)c.x, true), c2 = __builtin_amdgcn_cvt_pk_f32_fp8((int)c.y, false), c3 = __builtin_amdgcn_cvt_pk_f32_fp8((int)c.y, true);
                const float w0s = w0 * (1.0f / Y8S), w1s = w1 * (1.0f / Y8S);
                f32x4 y0, y1;
                y0[0] = w0s * a0[0] + w1s * c0[0]; y0[1] = w0s * a0[1] + w1s * c0[1]; y0[2] = w0s * a1[0] + w1s * c1[0]; y0[3] = w0s * a1[1] + w1s * c1[1];
                y1[0] = w0s * a2[0] + w1s * c2[0]; y1[1] = w0s * a2[1] + w1s * c2[1]; y1[2] = w0s * a3[0] + w1s * c3[0]; y1[3] = w0s * a3[1] + w1s * c3[1];
                *(f32x4*)(orow + k) = x0 + g0 * y0; *(f32x4*)(orow + k + 4) = x1v + g1 * y1; }
        }
    }
#undef IN
#undef SEAM
}

extern "C" void kernel_launch(void* const* d_in, const int* in_sizes, int n_in, void* d_out, int out_size, void* d_ws, size_t ws_size, hipStream_t stream) {
    static int grid = 0;
    if (grid == 0) {
        if (n_in != 28 || in_sizes[0] != NTOK * DMODEL || out_size != NTOK * DMODEL || ws_size < WS_END) { fprintf(stderr, "kernel_launch: unexpected shapes (n_in %d, in0 %d, out %d, ws %zu)\n", n_in, n_in > 0 ? in_sizes[0] : -1, out_size, ws_size); grid = -1; return; }
        int dev = 0, cus = 0, per_cu = 0;
        if (hipGetDevice(&dev) != hipSuccess || hipDeviceGetAttribute(&cus, hipDeviceAttributeMultiprocessorCount, dev) != hipSuccess) { grid = -1; return; }
        if (hipFuncSetAttribute((const void*)fwd_kernel, hipFuncAttributeMaxDynamicSharedMemorySize, LDS_BYTES) != hipSuccess) { fprintf(stderr, "kernel_launch: hipFuncSetAttribute failed\n"); grid = -1; return; }
        if (hipOccupancyMaxActiveBlocksPerMultiprocessor(&per_cu, (const void*)fwd_kernel, NTHREADS, LDS_BYTES) != hipSuccess || per_cu < 1) { fprintf(stderr, "kernel_launch: occupancy query says %d blocks per CU\n", per_cu); per_cu = 1; }
        (void)hipGetLastError();
        grid = cus * 1;
        if (grid != 256) fprintf(stderr, "kernel_launch: %d CUs; this kernel is laid out for 256\n", grid);
    }
    if (grid < 0) return;
    (void)hipMemsetAsync((char*)d_ws + WS_CTL, 0, CTL_ZERO_BYTES, stream);
    Args a{};
    for (int i = 0; i < 28; ++i) a.in[i] = (const float*)d_in[i];
    a.out = (float*)d_out; a.ws = (unsigned char*)d_ws;
    constexpr int NPH = 14;
    if (MK_N_LAUNCHES == 1) { a.ph_lo = 0; a.ph_hi = NPH; a.li = 0; hipLaunchKernelGGL(fwd_kernel, dim3(grid), dim3(NTHREADS), LDS_BYTES, stream, a); }
    else { for (int p = 0; p < NPH; ++p) { a.ph_lo = p; a.ph_hi = p + 1; a.li = p; hipLaunchKernelGGL(fwd_kernel, dim3(grid), dim3(NTHREADS), LDS_BYTES, stream, a); } }
}
```

```cpp
#include <hip/hip_runtime.h>
#include <cstdio>
#include <cstdint>
#include <cmath>

#ifndef MK_N_LAUNCHES
#define MK_N_LAUNCHES 1
#endif

#ifndef STAG1
#define STAG1 0
#endif
#ifndef PROBE_REP
#define PROBE_REP 0
#endif
#define LAS __attribute__((address_space(3)))
#define GAS __attribute__((address_space(1)))
typedef unsigned short bf16_t;
typedef short bf16x8 __attribute__((ext_vector_type(8)));
typedef short s16x4 __attribute__((ext_vector_type(4)));
typedef float f32x4 __attribute__((ext_vector_type(4)));
typedef float f32x2 __attribute__((ext_vector_type(2)));
typedef float f32x16 __attribute__((ext_vector_type(16)));
typedef unsigned u32x4 __attribute__((ext_vector_type(4)));
typedef unsigned u32x2 __attribute__((ext_vector_type(2)));
typedef __bf16 bf16x2_t __attribute__((ext_vector_type(2)));

constexpr int NB = 16, SEQ = 4096, DMODEL = 1024, NTOK = NB * SEQ;
constexpr int IN_COLS = 5128, COL_FQ = 0, COL_FK = 512, COL_FV = 1024, COL_FF = 1536, COL_DQ = 1544, COL_DK = 2056, COL_DV = 2568, COL_GATE = 3080;
constexpr int NEXP = 32, DEXP = 512;
constexpr int NASSIGN = NTOK * 2;
constexpr int PADROWS = NASSIGN + NEXP * 256;
constexpr float EPS = 1e-6f;
constexpr float LOG2E = 1.4426950408889634f;
constexpr float C2 = 0.125f * LOG2E;
constexpr float LAM0 = 0.2f;

constexpr size_t MiB = 1u << 20;
constexpr size_t WS_CTL = 0, CTL_ZERO_BYTES = 128 * 1024;
constexpr size_t WS_MOD = 1 * MiB;
constexpr size_t WS_MISC = 1 * MiB + 512 * 1024;
constexpr size_t WS_GALL = 1 * MiB + 768 * 1024;
constexpr size_t WS_EID = 2 * MiB;
constexpr size_t WS_RNK = 2 * MiB + 512 * 1024;
constexpr size_t WS_WGT = 3 * MiB;
constexpr size_t WS_POS = 3 * MiB + 512 * 1024;
constexpr size_t WS_HIST = 4 * MiB;
constexpr size_t WS_ROWTOK = 4 * MiB + 256 * 1024;
constexpr size_t WS_LOGF = 5 * MiB;
constexpr size_t WS_BIAS = 7 * MiB;
constexpr size_t WS_WR = 10 * MiB;
constexpr size_t WS_LOGIT = 11 * MiB;
constexpr size_t WS_ROPE = 27 * MiB;
constexpr size_t WS_WIN = 43 * MiB;
constexpr size_t WS_WPF = 53 * MiB, WS_WPD = 54 * MiB, WS_WOUT = 55 * MiB;
constexpr size_t WS_W13 = 57 * MiB;
constexpr size_t WS_W2 = 121 * MiB;
constexpr size_t WS_H1 = 160 * MiB;
constexpr size_t WS_QF = 288 * MiB, WS_KF = 352 * MiB, WS_VF = 416 * MiB, WS_QD = 480 * MiB, WS_KD = 544 * MiB, WS_VD = 608 * MiB;
constexpr size_t WS_G = 672 * MiB;
constexpr size_t WS_OD = 928 * MiB;
constexpr size_t WS_MERGED = WS_KF;
constexpr size_t WS_H2S = WS_QD;
constexpr size_t WS_HH = 800 * MiB;
constexpr size_t WS_H2 = WS_G;
constexpr size_t WS_END = 1024 * MiB;
static_assert(WS_KF - WS_QF == 67108864 && WS_VD - WS_QF == 5 * 67108864, "six q/k/v buffers 64 MiB apart");
static_assert(WS_H2S + (size_t)PADROWS * 2048 <= WS_HH && WS_HH + (size_t)PADROWS * 1024 <= WS_END && WS_H2 + (size_t)NTOK * 2048 <= WS_HH, "ws map");

constexpr int CW_TMO = 0, CW_BAR = 4096, CW_GCNT = 16384;

constexpr int RING_BYTES = 131072, LDSCTL_OFF = RING_BYTES, MISC_OFF = LDSCTL_OFF + 320, SCHED_OFF = LDSCTL_OFF + 1024;
constexpr int LDS_BYTES = 147456;
constexpr int NWAVES = 8, NTHREADS = 512;

#define RLX_AGENT __ATOMIC_RELAXED, __HIP_MEMORY_SCOPE_AGENT
#define LDS_WAIT() asm volatile("s_waitcnt lgkmcnt(0)" ::: "memory")
#define VM_WAIT() asm volatile("s_waitcnt vmcnt(0)" ::: "memory")
__device__ __forceinline__ unsigned f2bf(float f) { unsigned u = __builtin_bit_cast(unsigned, f); return (u + 0x7fffu + ((u >> 16) & 1u)) >> 16; }
__device__ __forceinline__ unsigned pk2(float lo, float hi) { return f2bf(lo) | (f2bf(hi) << 16); }
__device__ __forceinline__ float bf2f(unsigned b) { return __builtin_bit_cast(float, b << 16); }
__device__ __forceinline__ unsigned cvtpk(float lo, float hi) { f32x2 v = {lo, hi}; bf16x2_t b = __builtin_convertvector(v, bf16x2_t); return __builtin_bit_cast(unsigned, b); }
__device__ __forceinline__ float wave_sum(float v) {
#pragma unroll
    for (int o = 1; o < 64; o <<= 1) v += __shfl_xor(v, o);
    return v;
}
__device__ __forceinline__ float wave_max(float v) {
#pragma unroll
    for (int o = 1; o < 64; o <<= 1) v = fmaxf(v, __shfl_xor(v, o));
    return v;
}
__device__ __forceinline__ unsigned pk4_fp8(float a, float b, float c, float d) {
    a = fminf(fmaxf(a, -448.f), 448.f); b = fminf(fmaxf(b, -448.f), 448.f); c = fminf(fmaxf(c, -448.f), 448.f); d = fminf(fmaxf(d, -448.f), 448.f);
    int p = __builtin_amdgcn_cvt_pk_fp8_f32(a, b, __float_as_int(a), false); p = __builtin_amdgcn_cvt_pk_fp8_f32(c, d, p, true); return (unsigned)p; }
__device__ __forceinline__ unsigned pk4_fp8_nc(float a, float b, float c, float d) { int p = __builtin_amdgcn_cvt_pk_fp8_f32(a, b, __float_as_int(a), false); p = __builtin_amdgcn_cvt_pk_fp8_f32(c, d, p, true); return (unsigned)p; }
constexpr float QS8 = 2.0f, KS8 = 0.5f;
constexpr float W8S = 64.0f, H8S = 4.0f, Y8S = 8.0f, M8S = 16.0f, O8S = 8.0f;     constexpr float ZZ8_ = 0.0f;
__device__ __forceinline__ float sigmoidf_(float x) { return __builtin_amdgcn_rcpf(1.0f + __builtin_amdgcn_exp2f(-LOG2E * x)); }

namespace pg8 {
constexpr int BM = 256, BK = 64, HALF = 128, HTB = HALF * BK * 2, STAGE_BYTES = 8 * HTB, NXCD = 8, WGM = 8;
__host__ __device__ __forceinline__ int lds_byte(int r, int c) { const int st = (r >> 4) * 2 + (c >> 5), rr = r & 15, cc = c & 31, ob = rr * 64 + cc * 2; return st * 1024 + (ob ^ (((ob >> 9) & 1) << 5)); }
__host__ __device__ __forceinline__ void stage_rc(int b, int& R, int& C) { const int st = b / 1024, sb = b % 1024, swz = sb ^ (((sb >> 9) & 1) << 5); R = (st >> 1) * 16 + swz / 64; C = (st & 1) * 32 + (swz % 64) / 2; }
__host__ __device__ __forceinline__ int perm32(int rho) { const int n = rho >> 4, i = rho & 15; return 8 * (i >> 2) + 4 * n + (i & 3); }

struct Unit { int row0, pn, seg, src; const char* A; const char* B; };

struct USched {
    int nM, nN, G, c, pair, K, nseg;
    const char *A0, *A1, *B0, *B1;
    size_t segB;
    const LAS int* tp;
    const LAS int* rowst;
    int direct;
    const LAS int* gidx;
    __device__ __forceinline__ bool next(int i, Unit& u) const {
        const int ii = pair ? (i >> 1) : i, src = pair ? (i & 1) : 0;
        int pm, pn;
        if (direct >= 0) { if (i > 0) return false; pm = direct; pn = 0; }
        else {
            const long L = (long)ii * G + c; const int nwg = nM * nN; if (L >= nwg) return false;
            int wgid = (int)L; { const int q = nwg / NXCD, r = nwg % NXCD, xcd = wgid % NXCD, off = wgid / NXCD; wgid = (xcd < r ? xcd * (q + 1) : r * (q + 1) + (xcd - r) * q) + off; }
            const int nig = WGM * nN, gid = wgid / nig, fm = gid * WGM, gsz = (nM - fm) < WGM ? (nM - fm) : WGM;
            pm = fm + ((wgid % nig) % gsz); pn = (wgid % nig) / gsz;
        }
        int s = 0, row0 = pm * BM;
        if (nseg > 1) { for (int j = 1; j < nseg; ++j) if (pm >= tp[j]) s = j; row0 = rowst[s] + (pm - tp[s]) * BM; }
        u.row0 = row0; u.pn = pn; u.seg = s; u.src = src;
        u.A = (src ? A1 : A0) + (gidx ? (size_t)0 : (size_t)row0 * K * 2);
        u.B = (src ? B1 : B0) + (size_t)s * segB + (size_t)pn * BM * K * 2;
        return true;
    }
    __device__ __forceinline__ unsigned a_off(int ui, int h, int R, int C) const {
        if (gidx) return (unsigned)(gidx[ui * BM + h * HALF + R] * K + C) * 2u;
        return (unsigned)((h * HALF + R) * K + C) * 2u;
    }
};

typedef int i32x8 __attribute__((ext_vector_type(8)));
typedef int i32x8a __attribute__((ext_vector_type(8), aligned(16)));
__device__ __forceinline__ i32x8 pg8_cat8(const u32x4 a, const u32x4 b) { return (i32x8){(int)a.x, (int)a.y, (int)a.z, (int)a.w, (int)b.x, (int)b.y, (int)b.z, (int)b.w}; }
template <class Epi, class Sched, bool FP8 = false>
__device__ __forceinline__ void gemm_phase(LAS unsigned char* lds, const int K, const Sched S, const Epi E, const unsigned delay_ticks = 0) {
    if (delay_ticks) { const unsigned long long t0_ = __builtin_amdgcn_s_memrealtime(); while (__builtin_amdgcn_s_memrealtime() - t0_ < delay_ticks) __builtin_amdgcn_s_sleep(16); }
    int tid_ = threadIdx.x; asm volatile("" : "+v"(tid_));
    const int tid = tid_, wid = __builtin_amdgcn_readfirstlane(tid >> 6), lane = tid & 63, wr = wid >> 2, wc = wid & 3, fr = lane & 15, fq = lane >> 4;
    const int nt = K / BK;
    unsigned voffB[2]; int RA[2], CA[2];
#pragma unroll
    for (int i = 0; i < 2; ++i) { int R, C; stage_rc(tid * 16 + i * 8192, R, C); const int Rb = (R & ~31) + perm32(R & 31);
        RA[i] = R; CA[i] = C; voffB[i] = (unsigned)(Rb * K + C) * 2u; }
    unsigned vA[2][2], nvA[2][2];
#define PG8_FILL(v, ui_) do { _Pragma("unroll") for (int _h = 0; _h < 2; ++_h) _Pragma("unroll") for (int _i = 0; _i < 2; ++_i) v[_h][_i] = S.a_off(ui_, _h, RA[_i], CA[_i]); } while (0)
    const size_t kstep = (size_t)(BK * 2);
    const size_t hstep = (size_t)HALF * K * 2;
    const unsigned ldsw = (unsigned)wid * 1024u;
    const int aoff = lds_byte(wr * 64 + fr, fq * 8);
    const int boff = lds_byte(wc * 32 + fr, fq * 8);
#define PG8_SA(b, h) (((b) * 2 + (h)) * HTB)
#define PG8_SB(b, h) ((4 + (b) * 2 + (h)) * HTB)
#define PG8_STAGE(bufoff, gbase, voff) do { _Pragma("unroll") for (int _i = 0; _i < 2; ++_i) \
        __builtin_amdgcn_global_load_lds((const unsigned*)((const char*)(gbase) + (voff)[_i]), (LAS unsigned*)(lds + (bufoff) + ldsw + _i * 8192), 16, 0, 0); } while (0)
#define PG8_RD8(p_) pg8_cat8(*(const LAS u32x4*)(p_), *(const LAS u32x4*)((p_) + 1024))
#define PG8_LDA(b, h) do { if constexpr (FP8) { _Pragma("unroll") for (int m = 0; m < 4; ++m) A8[m] = PG8_RD8(lds + PG8_SA(b, h) + aoff + m * 2048); } \
        else { _Pragma("unroll") for (int m = 0; m < 4; ++m) _Pragma("unroll") for (int k = 0; k < 2; ++k) At[m][k] = *(const LAS bf16x8*)(lds + PG8_SA(b, h) + aoff + m * 2048 + k * 1024); } } while (0)
#define PG8_LDB(dst, dst8, b, h) do { if constexpr (FP8) { _Pragma("unroll") for (int n = 0; n < 2; ++n) dst8[n] = PG8_RD8(lds + PG8_SB(b, h) + boff + n * 2048); } \
        else { _Pragma("unroll") for (int n = 0; n < 2; ++n) _Pragma("unroll") for (int k = 0; k < 2; ++k) dst[n][k] = *(const LAS bf16x8*)(lds + PG8_SB(b, h) + boff + n * 2048 + k * 1024); } } while (0)
#define PG8_MMA(ai, bj, Bt, Bt8) do { __builtin_amdgcn_s_setprio(1); \
        if constexpr (FP8) { _Pragma("unroll") for (int m = 0; m < 4; ++m) _Pragma("unroll") for (int n = 0; n < 2; ++n) \
            asm volatile("v_mfma_f32_16x16x128_f8f6f4 %0, %1, %2, %0" : "+v"(acc[ai][bj][m][n]) : "v"(Bt8[n]), "v"(A8[m])); }   \
        else { _Pragma("unroll") for (int m = 0; m < 4; ++m) _Pragma("unroll") for (int n = 0; n < 2; ++n) _Pragma("unroll") for (int k = 0; k < 2; ++k) \
            acc[ai][bj][m][n] = __builtin_amdgcn_mfma_f32_16x16x32_bf16(Bt[n][k], At[m][k], acc[ai][bj][m][n], 0, 0, 0); } \
        __builtin_amdgcn_s_setprio(0); } while (0)
#define PG8_WAIT_V(n) asm volatile("s_waitcnt vmcnt(" #n ")" ::: "memory")
#define PG8_WAIT_L(n) asm volatile("s_waitcnt lgkmcnt(" #n ")" ::: "memory")
#define PG8_BAR __builtin_amdgcn_s_barrier()
#define PG8_SCHED __builtin_amdgcn_sched_barrier(0)
    Unit cur, nxt; int ui = 0;
    if (!S.next(0, cur)) return;
    f32x4 acc[2][2][4][2];
#pragma unroll
    for (int a = 0; a < 2; ++a)
#pragma unroll
        for (int b = 0; b < 2; ++b)
#pragma unroll
            for (int m = 0; m < 4; ++m)
#pragma unroll
                for (int n = 0; n < 2; ++n) acc[a][b][m][n] = (f32x4){0.f, 0.f, 0.f, 0.f};
    bf16x8 At[4][2], B0[2][2], B1[2][2]; i32x8 A8[4], B08[2], B18[2];
    const char* cA = cur.A; const char* cB = cur.B;
    PG8_FILL(vA, 0);
    PG8_STAGE(PG8_SB(0, 0), cB, voffB); PG8_STAGE(PG8_SB(0, 1), cB + hstep, voffB); PG8_STAGE(PG8_SA(0, 0), cA, vA[0]); PG8_STAGE(PG8_SA(0, 1), cA, vA[1]);
    if (wr == 1) PG8_BAR;
    PG8_WAIT_V(2); PG8_BAR;
    PG8_STAGE(PG8_SB(1, 0), cB + kstep, voffB); PG8_STAGE(PG8_SA(1, 0), cA + kstep, vA[0]); PG8_STAGE(PG8_SB(1, 1), cB + hstep + kstep, voffB);
    PG8_WAIT_V(6); PG8_BAR;
    for (;;) {
        const bool has_next = S.next(ui + 1, nxt);
        const char* nA = has_next ? nxt.A : cA; const char* nB = has_next ? nxt.B : cB;
        if (has_next) { PG8_FILL(nvA, ui + 1); } else { nvA[0][0] = vA[0][0]; nvA[0][1] = vA[0][1]; nvA[1][0] = vA[1][0]; nvA[1][1] = vA[1][1]; }
        for (int t = 0; t < nt; t += 2) {
            const bool last = (t == nt - 2);
            const char* a1 = cA + (size_t)(t + 1) * kstep;
            const char* a2 = last ? nA : cA + (size_t)(t + 2) * kstep; const char* b2 = last ? nB : cB + (size_t)(t + 2) * kstep;
            const char* a3 = a2 + kstep; const char* b3 = b2 + kstep;
            if (E.mode == 2 && t == (nt >> 1)) E.mid(acc, cur, wr, wc, fr, fq);
            unsigned s0[2], s1[2]; s0[0] = last ? nvA[0][0] : vA[0][0]; s0[1] = last ? nvA[0][1] : vA[0][1]; s1[0] = last ? nvA[1][0] : vA[1][0]; s1[1] = last ? nvA[1][1] : vA[1][1];
            PG8_LDB(B0, B08, 0, 0); PG8_LDB(B1, B18, 0, 1); PG8_SCHED; PG8_LDA(0, 0); PG8_STAGE(PG8_SA(1, 1), a1, vA[1]);
            PG8_WAIT_V(8); PG8_WAIT_L(0); PG8_BAR; PG8_MMA(0, 0, B0, B08); PG8_MMA(0, 1, B1, B18); PG8_BAR; PG8_SCHED;
            PG8_LDA(0, 1); PG8_STAGE(PG8_SB(0, 0), b2, voffB); PG8_STAGE(PG8_SB(0, 1), b2 + hstep, voffB); PG8_STAGE(PG8_SA(0, 0), a2, s0);
            PG8_WAIT_V(8); PG8_WAIT_L(0); PG8_BAR; PG8_MMA(1, 0, B0, B08); PG8_MMA(1, 1, B1, B18); PG8_BAR; PG8_SCHED;
            PG8_LDB(B0, B08, 1, 0); PG8_LDB(B1, B18, 1, 1); PG8_SCHED; PG8_LDA(1, 0); PG8_STAGE(PG8_SA(0, 1), a2, s1);
            PG8_WAIT_V(8); PG8_WAIT_L(0); PG8_BAR; PG8_MMA(0, 0, B0, B08); PG8_MMA(0, 1, B1, B18); PG8_BAR; PG8_SCHED;
            PG8_LDA(1, 1); PG8_STAGE(PG8_SB(1, 0), b3, voffB); PG8_STAGE(PG8_SB(1, 1), b3 + hstep, voffB); PG8_STAGE(PG8_SA(1, 0), a3, s0);
            PG8_WAIT_V(8); PG8_WAIT_L(0); PG8_BAR; PG8_MMA(1, 0, B0, B08); PG8_MMA(1, 1, B1, B18); PG8_BAR; PG8_SCHED;
        }
        if (wr == 0) PG8_BAR;
        if constexpr (FP8) asm volatile("s_nop 15\n\ts_nop 7" ::: "memory");
        E(acc, cur, wr, wc, fr, fq);
        if (!has_next) break;
#pragma unroll
        for (int a = 0; a < 2; ++a)
#pragma unroll
            for (int b = 0; b < 2; ++b)
#pragma unroll
                for (int m = 0; m < 4; ++m)
#pragma unroll
                    for (int n = 0; n < 2; ++n) acc[a][b][m][n] = (f32x4){0.f, 0.f, 0.f, 0.f};
        cur = nxt; cA = nA; cB = nB; ++ui;
        vA[0][0] = nvA[0][0]; vA[0][1] = nvA[0][1]; vA[1][0] = nvA[1][0]; vA[1][1] = nvA[1][1];
        if (wr == 1) PG8_BAR;
    }
    PG8_WAIT_V(0);
    PG8_BAR;
#undef PG8_SA
#undef PG8_SB
#undef PG8_STAGE
#undef PG8_FILL
#undef PG8_RD8
#undef PG8_LDA
#undef PG8_LDB
#undef PG8_MMA
#undef PG8_WAIT_V
#undef PG8_WAIT_L
#undef PG8_BAR
#undef PG8_SCHED
}
}

struct UEpi {
    int pnoff; float ascale;
    int mode;
    bf16_t *qkv6, *gates; const float *gall; const int* pos;
    bf16_t* merged;
    const float* x; bf16_t* x1; const float* mod;
    float* logits;
    unsigned char* hh; unsigned char* y;
    __device__ __forceinline__ void mid(f32x4 (&acc)[2][2][4][2], const pg8::Unit& u, int wr, int wc, int fr, int fq) const {
        int rbase = u.row0 + wr * 64 + fr; asm volatile("" : "+v"(rbase));
        const int col0 = u.pn * 256 + wc * 32 + 8 * fq;
#define RAT_(a, b) ((float)(a) * __builtin_amdgcn_rcpf(fmaxf((float)(b), 1.0f)))
#pragma unroll
        for (int ai = 0; ai < 2; ++ai) {
            u32x2 ga[4][2], gb[4][2];
#pragma unroll
            for (int m = 0; m < 4; ++m) { const unsigned char* rp = (const unsigned char*)gates + (size_t)(rbase + ai * 128 + m * 16) * 2048 + col0;
#pragma unroll
                for (int bj = 0; bj < 2; ++bj) { ga[m][bj] = *(const u32x2*)(rp + bj * 128); gb[m][bj] = *(const u32x2*)(rp + 1024 + bj * 128); } }
#pragma unroll
            for (int m = 0; m < 4; ++m)
#pragma unroll
                for (int bj = 0; bj < 2; ++bj) { const u32x2 a = ga[m][bj], b = gb[m][bj];
                    acc[ai][bj][m][0][0] *= RAT_(a.x & 0xffu, b.x & 0xffu); acc[ai][bj][m][0][1] *= RAT_((a.x >> 8) & 0xffu, (b.x >> 8) & 0xffu);
                    acc[ai][bj][m][0][2] *= RAT_((a.x >> 16) & 0xffu, (b.x >> 16) & 0xffu); acc[ai][bj][m][0][3] *= RAT_(a.x >> 24, b.x >> 24);
                    acc[ai][bj][m][1][0] *= RAT_(a.y & 0xffu, b.y & 0xffu); acc[ai][bj][m][1][1] *= RAT_((a.y >> 8) & 0xffu, (b.y >> 8) & 0xffu);
                    acc[ai][bj][m][1][2] *= RAT_((a.y >> 16) & 0xffu, (b.y >> 16) & 0xffu); acc[ai][bj][m][1][3] *= RAT_(a.y >> 24, b.y >> 24); }
            asm volatile("" ::: "memory");
        }
#undef RAT_
    }
    __device__ __forceinline__ void operator()(const f32x4 (&acc)[2][2][4][2], const pg8::Unit& u, int wr, int wc, int fr, int fq) const {
        const int rbase = u.row0 + wr * 64 + fr;
        if (mode == 1) {
            const int pn = u.pn;
            if (pn >= 12 || pn == 4 || pn == 5 || pn == 10 || pn == 11) {
                const bool gate = pn >= 12;
                if (gate) {
                    unsigned char* gb = (unsigned char*)gates; const int col0 = (pn - 12) * 256 + wc * 32 + 8 * fq;
#pragma unroll
                    for (int ai = 0; ai < 2; ++ai)
#pragma unroll
                        for (int m = 0; m < 4; ++m) { unsigned char* rowp = gb + (size_t)(rbase + ai * 128 + m * 16) * 2048 + col0;
#pragma unroll
                            for (int bj = 0; bj < 2; ++bj) { const f32x4 v0 = acc[ai][bj][m][0], v1 = acc[ai][bj][m][1]; u32x2 w; unsigned p = 0u, q = 0u;
                                p = __builtin_amdgcn_cvt_pk_u8_f32(255.0f * sigmoidf_(v0[0] * ascale), 0, p); p = __builtin_amdgcn_cvt_pk_u8_f32(255.0f * sigmoidf_(v0[1] * ascale), 1, p);
                                p = __builtin_amdgcn_cvt_pk_u8_f32(255.0f * sigmoidf_(v0[2] * ascale), 2, p); p = __builtin_amdgcn_cvt_pk_u8_f32(255.0f * sigmoidf_(v0[3] * ascale), 3, p);
                                q = __builtin_amdgcn_cvt_pk_u8_f32(255.0f * sigmoidf_(v1[0] * ascale), 0, q); q = __builtin_amdgcn_cvt_pk_u8_f32(255.0f * sigmoidf_(v1[1] * ascale), 1, q);
                                q = __builtin_amdgcn_cvt_pk_u8_f32(255.0f * sigmoidf_(v1[2] * ascale), 2, q); q = __builtin_amdgcn_cvt_pk_u8_f32(255.0f * sigmoidf_(v1[3] * ascale), 3, q);
                                w.x = p; w.y = q; *(u32x2*)(rowp + bj * 128) = w; } }
                } else if (pn >= 10) {
                    unsigned char* vb = (unsigned char*)(qkv6 + (size_t)5 * 33554432); const int col0 = (pn & 1) * 256 + wc * 32 + 8 * fq;
#pragma unroll
                    for (int ai = 0; ai < 2; ++ai)
#pragma unroll
                        for (int m = 0; m < 4; ++m) { unsigned char* rowp = vb + (size_t)(rbase + ai * 128 + m * 16) * 512 + col0;
#pragma unroll
                            for (int bj = 0; bj < 2; ++bj) { const f32x4 v0 = acc[ai][bj][m][0], v1 = acc[ai][bj][m][1];
                                u32x2 w; w.x = pk4_fp8(v0[0] * ascale, v0[1] * ascale, v0[2] * ascale, v0[3] * ascale); w.y = pk4_fp8(v1[0] * ascale, v1[1] * ascale, v1[2] * ascale, v1[3] * ascale);
                                *(u32x2*)(rowp + bj * 128) = w; } }
                } else {
                    bf16_t* base = qkv6 + (size_t)(pn >> 1) * 33554432; const int ldc = 512, colt = (pn & 1) * 256;
                    const int col0 = colt + wc * 32 + 8 * fq;
#pragma unroll
                    for (int ai = 0; ai < 2; ++ai)
#pragma unroll
                        for (int m = 0; m < 4; ++m) { bf16_t* rowp = base + (size_t)(rbase + ai * 128 + m * 16) * ldc + col0;
#pragma unroll
                            for (int bj = 0; bj < 2; ++bj) { const f32x4 v0 = acc[ai][bj][m][0], v1 = acc[ai][bj][m][1];
                                u32x4 w; w.x = cvtpk(v0[0] * ascale, v0[1] * ascale); w.y = cvtpk(v0[2] * ascale, v0[3] * ascale); w.z = cvtpk(v1[0] * ascale, v1[1] * ascale); w.w = cvtpk(v1[2] * ascale, v1[3] * ascale);
                                *(u32x4*)(rowp + bj * 128) = w; } }
                }
            } else {
                const int sec = pn >> 1;
                bf16_t* base = qkv6 + (size_t)sec * 33554432;
                const float* g = gall + (sec - (sec >= 3 ? 1 : 0)) * 64;
                const bool dorope = sec >= 3; const float sc = (sec == 0 || sec == 3) ? C2 * QS8 : KS8;
                const int head = 4 * (pn & 1) + wc;
                f32x4 gv[2][2];
#pragma unroll
                for (int bj = 0; bj < 2; ++bj)
#pragma unroll
                    for (int n = 0; n < 2; ++n) { gv[bj][n] = *(const f32x4*)(g + 32 * bj + 8 * fq + 4 * n); gv[bj][n] = gv[bj][n] * sc; }
                f32x4 ivf[2];
#pragma unroll
                for (int n = 0; n < 2; ++n)
#pragma unroll
                    for (int e = 0; e < 4; ++e) ivf[n][e] = __builtin_amdgcn_exp2f(-(float)(8 * fq + 4 * n + e) * 0.41524101186092029f);
                const float asc2 = ascale * ascale * (1.0f / 64.0f);
#pragma unroll
                for (int ai = 0; ai < 2; ++ai)
#pragma unroll
                    for (int m = 0; m < 4; ++m) {
                        const int row = rbase + ai * 128 + m * 16;
                        f32x4 v[2][2]; float ss = 0.f;
#pragma unroll
                        for (int bj = 0; bj < 2; ++bj)
#pragma unroll
                            for (int n = 0; n < 2; ++n) { v[bj][n] = acc[ai][bj][m][n]; const f32x4 q = v[bj][n] * v[bj][n]; ss += (q[0] + q[1]) + (q[2] + q[3]); }
                        ss += __shfl_xor(ss, 16); ss += __shfl_xor(ss, 32);
                        const float rstd = __builtin_amdgcn_rsqf(ss * asc2 + EPS) * ascale;
#pragma unroll
                        for (int bj = 0; bj < 2; ++bj)
#pragma unroll
                            for (int n = 0; n < 2; ++n) v[bj][n] = v[bj][n] * rstd * gv[bj][n];
                        if (dorope) {
                            const float pr = (float)pos[row];
#pragma unroll
                            for (int n = 0; n < 2; ++n) { f32x4 cs, sn;
#pragma unroll
                                for (int e = 0; e < 4; ++e) { const float ang = pr * ivf[n][e]; const float fr_ = __builtin_amdgcn_fractf(ang * 0.15915494309189535f);
                                    cs[e] = __builtin_amdgcn_cosf(fr_); sn[e] = __builtin_amdgcn_sinf(fr_); }
                                const f32x4 x1 = v[0][n], x2 = v[1][n]; v[0][n] = x1 * cs - x2 * sn; v[1][n] = x2 * cs + x1 * sn; }
                        }
                        unsigned char* rowp = (unsigned char*)base + (size_t)row * 512 + head * 64 + 8 * fq;
#pragma unroll
                        for (int bj = 0; bj < 2; ++bj) { u32x2 w; w.x = pk4_fp8(v[bj][0][0], v[bj][0][1], v[bj][0][2], v[bj][0][3]); w.y = pk4_fp8(v[bj][1][0], v[bj][1][1], v[bj][1][2], v[bj][1][3]);
                            *(u32x2*)(rowp + bj * 32) = w; }
                    }
            }
        } else if (mode == 2) {
            const int col0 = u.pn * 256 + wc * 32 + 8 * fq;
#pragma unroll
            for (int ai = 0; ai < 2; ++ai)
#pragma unroll
                for (int m = 0; m < 4; ++m) { const size_t row = (size_t)(rbase + ai * 128 + m * 16);
#pragma unroll
                    for (int bj = 0; bj < 2; ++bj) { const int col = col0 + bj * 128;
                        const u32x2 gw = *(const u32x2*)((const unsigned char*)gates + row * 2048 + 1024 + col);
                        f32x4 v0 = acc[ai][bj][m][0], v1 = acc[ai][bj][m][1];
#define G1_(b) (fmaxf((float)(b), 1.0f) * (1.0f / (255.0f * O8S * W8S)))
                        v0[0] *= G1_(gw.x & 0xffu); v0[1] *= G1_((gw.x >> 8) & 0xffu); v0[2] *= G1_((gw.x >> 16) & 0xffu); v0[3] *= G1_(gw.x >> 24);
                        v1[0] *= G1_(gw.y & 0xffu); v1[1] *= G1_((gw.y >> 8) & 0xffu); v1[2] *= G1_((gw.y >> 16) & 0xffu); v1[3] *= G1_(gw.y >> 24);
#undef G1_
                        u32x2 w; w.x = pk4_fp8(M8S * v0[0], M8S * v0[1], M8S * v0[2], M8S * v0[3]); w.y = pk4_fp8(M8S * v1[0], M8S * v1[1], M8S * v1[2], M8S * v1[3]);
                        *(u32x2*)((unsigned char*)merged + row * 1024 + col) = w; } }
        } else if (mode == 3) {
            const int col0 = u.pn * 256 + wc * 32 + 8 * fq; const int b = u.row0 >> 12;
            const float* gt = mod + (size_t)b * 6144 + 2048;
#pragma unroll
            for (int bj = 0; bj < 2; ++bj) { const int col = col0 + bj * 128; const f32x4 g0 = *(const f32x4*)(gt + col) * ascale, g1 = *(const f32x4*)(gt + col + 4) * ascale;
#pragma unroll
                for (int ai = 0; ai < 2; ++ai)
#pragma unroll
                    for (int m = 0; m < 4; ++m) { const size_t off = (size_t)(rbase + ai * 128 + m * 16) * 1024 + col;
                        const f32x4 x0 = *(const f32x4*)(x + off), xb = *(const f32x4*)(x + off + 4);
                        const f32x4 v0 = x0 + g0 * acc[ai][bj][m][0], v1 = xb + g1 * acc[ai][bj][m][1];
                        u32x4 w; w.x = cvtpk(v0[0], v0[1]); w.y = cvtpk(v0[2], v0[3]); w.z = cvtpk(v1[0], v1[1]); w.w = cvtpk(v1[2], v1[3]);
                        *(u32x4*)(x1 + off) = w; } }
        } else if (mode == 4) {
            if (wc < 2) { const int col = wc * 32 + 8 * fq;
#pragma unroll
                for (int ai = 0; ai < 2; ++ai)
#pragma unroll
                    for (int m = 0; m < 4; ++m) { float* dp = logits + (size_t)(rbase + ai * 128 + m * 16) * 64 + col;
                        *(f32x4*)dp = acc[ai][0][m][0]; *(f32x4*)(dp + 4) = acc[ai][0][m][1]; } }
        } else if (mode == 5) {
            const int col0 = u.pn * 128 + wc * 32 + 8 * fq;
#pragma unroll
            for (int ai = 0; ai < 2; ++ai)
#pragma unroll
                for (int m = 0; m < 4; ++m) { f32x4 h0, h1;
#pragma unroll
                    for (int e = 0; e < 4; ++e) { const float a0 = acc[ai][0][m][0][e] * (1.0f / W8S), a1 = acc[ai][0][m][1][e] * (1.0f / W8S);
                        h0[e] = a0 * sigmoidf_(a0) * acc[ai][1][m][0][e] * (H8S / W8S); h1[e] = a1 * sigmoidf_(a1) * acc[ai][1][m][1][e] * (H8S / W8S); }
                    u32x2 w; w.x = pk4_fp8(h0[0], h0[1], h0[2], h0[3]); w.y = pk4_fp8(h1[0], h1[1], h1[2], h1[3]);
                    *(u32x2*)(hh + (size_t)(rbase + ai * 128 + m * 16) * 512 + col0) = w; }
        } else if (mode == 6) {
            const int col0 = u.pn * 256 + wc * 32 + 8 * fq;
#pragma unroll
            for (int ai = 0; ai < 2; ++ai)
#pragma unroll
                for (int m = 0; m < 4; ++m) { unsigned char* rowp = y + (size_t)(rbase + ai * 128 + m * 16) * 1024 + col0;
#pragma unroll
                    for (int bj = 0; bj < 2; ++bj) { const f32x4 v0 = acc[ai][bj][m][0] * (Y8S / (W8S * H8S)), v1 = acc[ai][bj][m][1] * (Y8S / (W8S * H8S));
                        u32x2 w; w.x = pk4_fp8(v0[0], v0[1], v0[2], v0[3]); w.y = pk4_fp8(v1[0], v1[1], v1[2], v1[3]);
                        *(u32x2*)(rowp + bj * 128) = w; } }
        }
    }
};

namespace attn_body {
constexpr int D = 64, DM = 512;
constexpr int NW = 8, QBLK = 32, QB = QBLK * NW, KVBLK = 64;
__device__ __forceinline__ int crow(int r, int hi) { return (r & 3) + 8 * (r >> 2) + 4 * hi; }
#define SBAR() __builtin_amdgcn_sched_barrier(0)
__device__ __forceinline__ void cmask(f32x16& p0, f32x16& p1, int jb, int qrel, int hi) {
    const float NEG = -INFINITY; int kb = 64 * jb + 4 * hi;
#pragma unroll
    for (int r = 0; r < 16; ++r) { int kv = kb + (r & 3) + 8 * (r >> 2); if (kv > qrel) p0[r] = NEG; if (kv + 32 > qrel) p1[r] = NEG; }
}
__device__ __forceinline__ void maskall(f32x16& p0, f32x16& p1) {
    const float NEG = -INFINITY;
#pragma unroll
    for (int r = 0; r < 16; ++r) { p0[r] = NEG; p1[r] = NEG; }
}
constexpr int NSLOT = 3, SLOTB = 8192;
constexpr int LDS_K = 0, LDS_V = NSLOT * SLOTB, LDS_WS = 2 * NSLOT * SLOTB, LDS_OST = LDS_WS + NW * 64 * 4, LDS_BIAS = LDS_OST + NW * 4096, LDS_BYTES_A = LDS_BIAS + NSLOT * 256;
__device__ __forceinline__ void glds16(const void* gsrc, unsigned lds_dst) { unsigned keep;
    asm volatile("s_mov_b32 %0, m0\n\ts_mov_b32 m0, %2\n\ts_nop 0\n\tglobal_load_lds_dwordx4 %1, off\n\ts_mov_b32 m0, %0" : "=&s"(keep) : "v"(gsrc), "s"(lds_dst) : "memory"); }
__device__ __forceinline__ void glds4(const void* gsrc, unsigned lds_dst) { unsigned keep;
    asm volatile("s_mov_b32 %0, m0\n\ts_mov_b32 m0, %2\n\ts_nop 0\n\tglobal_load_lds_dword %1, off\n\ts_mov_b32 m0, %0" : "=&s"(keep) : "v"(gsrc), "s"(lds_dst) : "memory"); }
__device__ __forceinline__ float max3f(float a, float b, float c) { float r; asm("v_max3_f32 %0, %1, %2, %3" : "=v"(r) : "v"(a), "v"(b), "v"(c)); return r; }
__device__ __forceinline__ float max2f(float a, float b) { float r; asm("v_max_f32_e32 %0, %1, %2" : "=v"(r) : "v"(a), "v"(b)); return r; }
__device__ __forceinline__ float fadd_s(float a, float b) { float r; asm("v_add_f32_e32 %0, %1, %2" : "=v"(r) : "v"(a), "v"(b)); return r; }
__device__ __forceinline__ float fsub_s(float a, float b) { float r; asm("v_sub_f32_e32 %0, %1, %2" : "=v"(r) : "v"(a), "v"(b)); return r; }
#define WAIT_BAR(N) asm volatile("s_waitcnt vmcnt(" #N ") lgkmcnt(0)\n\ts_barrier" ::: "memory")
typedef LAS const char* lds_cptr;
typedef short v4i16_t __attribute__((ext_vector_type(4)));
typedef int i32x8 __attribute__((ext_vector_type(8)));
typedef int i32x8a __attribute__((ext_vector_type(8), aligned(16)));
#define MF8(a, b, c) __builtin_amdgcn_mfma_scale_f32_32x32x64_f8f6f4(a, b, c, 0, 0, 0, 0, 0, 0)
__device__ __forceinline__ void kload8(i32x8* kf, lds_cptr kp) { kf[0] = *(const LAS i32x8a*)(kp); kf[1] = *(const LAS i32x8a*)(kp + 1024); }
__device__ __forceinline__ void kload2(i32x8* kf, lds_cptr kp, int j) { if (j < 2) kf[j] = *(const LAS i32x8a*)(kp + j * 1024); }
__device__ __forceinline__ void qkt(f32x16& p0, f32x16& p1, lds_cptr kp, const i32x8& qr, const f32x16& negm) {
    const i32x8 k0 = *(const LAS i32x8a*)(kp), k1 = *(const LAS i32x8a*)(kp + 1024);
    p0 = MF8(k0, qr, negm); p1 = MF8(k1, qr, negm);
}
__device__ __forceinline__ void qkt(f32x16& p0, f32x16& p1, lds_cptr kp, const i32x8& qr, const f32x16& c0, const f32x16& c1) {
    const i32x8 k0 = *(const LAS i32x8a*)(kp), k1 = *(const LAS i32x8a*)(kp + 1024);
    p0 = MF8(k0, qr, c0); p1 = MF8(k1, qr, c1);
}
__device__ __forceinline__ s16x4 vtr(lds_cptr p) { return __builtin_bit_cast(s16x4, __builtin_amdgcn_ds_read_tr16_b64_v4i16((LAS v4i16_t*)p)); }
__device__ __forceinline__ float rowmax(const f32x16& p0, const f32x16& p1) {
    float a = max3f(p0[0], p0[1], p1[0]), b = max3f(p0[2], p0[3], p1[1]); a = max3f(a, p1[2], p1[3]);
#pragma unroll
    for (int r = 4; r < 16; r += 4) { a = max3f(a, p0[r], p0[r + 1]); b = max3f(b, p0[r + 2], p0[r + 3]); a = max3f(a, p1[r], p1[r + 1]); b = max3f(b, p1[r + 2], p1[r + 3]); }
    const float m = max2f(a, b);
    auto rr = __builtin_amdgcn_permlane32_swap(__float_as_uint(m), __float_as_uint(m), false, false);
    return max2f(__uint_as_float(rr[0]), __uint_as_float(rr[1]));
}
__device__ __forceinline__ void pv(f32x16* o, int vb, bf16x8 pa0, bf16x8 pa1, bf16x8 pa2, bf16x8 pa3) {
#pragma unroll
    for (int d0 = 0; d0 < 2; ++d0) { s16x4 lo[4], hi[4];
#pragma unroll
        for (int ks = 0; ks < 4; ++ks) {
            asm volatile("ds_read_b64_tr_b16 %0,%1 offset:%c2" : "=&v"(lo[ks]) : "v"(vb), "i"(d0 * 4096 + ks * 1024) : "memory");
            asm volatile("ds_read_b64_tr_b16 %0,%1 offset:%c2" : "=&v"(hi[ks]) : "v"(vb), "i"(d0 * 4096 + ks * 1024 + 512) : "memory"); }
        asm volatile("s_waitcnt lgkmcnt(0)" ::: "memory"); SBAR();
#define PK(k) (bf16x8){lo[k][0], lo[k][1], lo[k][2], lo[k][3], hi[k][0], hi[k][1], hi[k][2], hi[k][3]}
        o[d0] = __builtin_amdgcn_mfma_f32_32x32x16_bf16(pa0, PK(0), o[d0], 0, 0, 0);
        o[d0] = __builtin_amdgcn_mfma_f32_32x32x16_bf16(pa1, PK(1), o[d0], 0, 0, 0);
        o[d0] = __builtin_amdgcn_mfma_f32_32x32x16_bf16(pa2, PK(2), o[d0], 0, 0, 0);
        o[d0] = __builtin_amdgcn_mfma_f32_32x32x16_bf16(pa3, PK(3), o[d0], 0, 0, 0);
#undef PK
    }
}
__device__ __forceinline__ bf16x8 bias_frag(float b) {
    const unsigned u0 = cvtpk(b, 0.f) & 0xffffu; const float r1 = b - bf2f(u0);
    const unsigned u1 = cvtpk(r1, 0.f) & 0xffffu; const float r2 = r1 - bf2f(u1);
    const unsigned u2 = cvtpk(r2, 0.f) & 0xffffu;
    u32x4 w; w.x = u0 | (u1 << 16); w.y = u2 | 0x3F800000u; w.z = 0x3F803F80u; w.w = 0u; return __builtin_bit_cast(bf16x8, w);
}
__device__ __forceinline__ bf16x8 qext_frag(float nm, int hi) {
    const unsigned u0 = cvtpk(nm, 0.f) & 0xffffu; const float r1 = nm - bf2f(u0);
    const unsigned u1 = cvtpk(r1, 0.f) & 0xffffu; const float r2 = r1 - bf2f(u1);
    const unsigned u2 = cvtpk(r2, 0.f) & 0xffffu;
    u32x4 w; w.x = hi ? 0u : 0x3F803F80u; w.y = hi ? 0u : (0x3F80u | (u0 << 16)); w.z = hi ? 0u : (u1 | (u2 << 16)); w.w = 0u; return __builtin_bit_cast(bf16x8, w);
}

template <bool FOX, int THRL> __device__ __forceinline__ void attn_unit(long rowbase, int qcol, int vcol, int ocol, int OP, int qb, const unsigned char* Q, const unsigned char* __restrict__ K, const bf16_t* __restrict__ V, bf16_t* O,
                                                                         const float* __restrict__ bias, int t0in, float smax2, char* shm) {
    int tid_ = threadIdx.x; asm volatile("" : "+v"(tid_));
    const int tid = tid_, lane = tid & 63, r32 = lane & 31, hi = lane >> 5; const int wid = __builtin_amdgcn_readfirstlane(tid >> 6);
    const int q0 = qb * QB;
    int NT = (q0 + QB) / KVBLK; int t0 = 0;
    if (FOX) { t0 = t0in; NT -= t0; }
    const bool wlo = wid < 5;
    const unsigned char* Qw = Q + (rowbase + q0 + wid * QBLK) * 512 + qcol;
    const unsigned char* Kh = K + (rowbase + (long)t0 * KVBLK) * 512 + qcol; const bf16_t* Vh = V + (rowbase + (long)t0 * KVBLK) * DM + vcol;
    const int bofs0 = t0 * KVBLK;
    const unsigned lds0 = (unsigned)(uintptr_t)shm;
    float* wsf = (float*)(shm + LDS_WS) + wid * 64;
    const unsigned char* ksrc = Kh + (long)(32 * (wid & 1) + (lane >> 1)) * 512 + ((wid >> 1) & 1) * 32 + (lane & 1) * 16;
    const bf16_t* vsrc = Vh + (long)(16 * (wid & 3) + (lane >> 2)) * DM + (wid >> 2) * 32 + (lane & 3) * 8;
    const unsigned kdst = lds0 + LDS_K + wid * 1024, vdst = lds0 + LDS_V + wid * 1024;
    const float* bsrc = bias + bofs0 + lane;
#define DMA_K(t, slot) do { if (wid < 4) glds16(ksrc + (long)(t) * KVBLK * 512, (unsigned)__builtin_amdgcn_readfirstlane(kdst + ((slot) >> 1))); \
        else if (FOX && wid == 4) glds4(bsrc + (t) * KVBLK, (unsigned)__builtin_amdgcn_readfirstlane(lds0 + LDS_BIAS + ((slot) >> 5))); } while (0)
#define DMA_V(t, slot) glds16(vsrc + (long)(t) * KVBLK * DM, (unsigned)__builtin_amdgcn_readfirstlane(vdst + (slot)))
    const int vb0 = (int)(lds0 + LDS_V) + ((lane >> 4) & 1) * 32 + (lane & 3) * 8 + (4 * hi + ((lane & 15) >> 2)) * 64;
    i32x8 kf[2];
    const lds_cptr shm3 = (lds_cptr)shm; const lds_cptr shm3b = shm3; const lds_cptr kp0 = shm3 + LDS_K + hi * 2048 + r32 * 32; const lds_cptr vp0 = shm3 + LDS_V + ((lane >> 4) & 1) * 32 + (lane & 3) * 8 + (4 * hi + ((lane & 15) >> 2)) * 64;
    DMA_K(0, 0); DMA_V(0, 0); DMA_K(1, SLOTB);
    const i32x8 qr = *reinterpret_cast<const i32x8a*>(Qw + (long)r32 * 512 + hi * 32);
    float mhat = 0.f; if (FOX) mhat = bias[q0 + wid * QBLK + r32] + smax2;
    bf16x8 qone = qext_frag(-mhat, hi);
    f32x16 CB0 = f32x16{}, CB1 = f32x16{};
    bf16x8 kones; { u32x4 w_; w_.x = 0u; w_.y = 0x3F800000u; w_.z = 0x3F803F80u; w_.w = 0u; kones = __builtin_bit_cast(bf16x8, w_); }
    const lds_cptr bp0 = shm3b + LDS_BIAS + 16 * hi;
#define BRD4(CB, base, g) do { const f32x4 q_ = *(const LAS f32x4*)((base) + 32 * (g)); CB[4 * (g)] = q_[0]; CB[4 * (g) + 1] = q_[1]; CB[4 * (g) + 2] = q_[2]; CB[4 * (g) + 3] = q_[3]; } while (0)
    float l_reg = 0.f; f32x16 o[2]; o[0] = f32x16{}; o[1] = f32x16{}; f32x16 negm = f32x16{}; if (!FOX) asm volatile("" : "+v"(negm));
    const int qrel = wid * QBLK + r32;
#define CMASK(P0, P1, t) do { int jb_ = (t) - (NT - 4); if (jb_ >= 0) { if (FOX) cmask(P0, P1, jb_, qrel, hi); else if (jb_ > (wid >> 1)) maskall(P0, P1); } } while (0)
    bool resc = false;
#define START(P0, P1) do { resc = false; \
    if (!FOX) { const float rm = rowmax(P0, P1); const float dl = rm; mhat = fadd_s(mhat, dl); \
      _Pragma("unroll") for (int r = 0; r < 16; ++r) { P0[r] = fsub_s(P0[r], dl); P1[r] = fsub_s(P1[r], dl); } \
      if (FOX) { qone = qext_frag(-mhat, hi); } else { _Pragma("unroll") for (int r = 0; r < 16; ++r) negm[r] = -mhat; asm volatile("" : "+v"(negm)); } } \
    _Pragma("unroll") for (int r = 0; r < 16; ++r) P0[r] = __builtin_amdgcn_exp2f(P0[r]); } while (0)
#define RESC() do { if (resc) { asm volatile("s_waitcnt lgkmcnt(0)" ::: "memory"); \
      _Pragma("unroll") for (int d_ = 0; d_ < 2; ++d_) _Pragma("unroll") for (int r = 0; r < 16; ++r) o[d_][r] *= wsf[crow(r, hi)]; } } while (0)
    f32x16 pA0, pA1, pB0, pB1;
    int sl_prev = 0, sl_cur = 0, sl_next = SLOTB;
#define ROT() do { sl_prev = sl_cur; sl_cur = sl_next; sl_next = (sl_next == (NSLOT - 1) * SLOTB) ? 0 : sl_next + SLOTB; } while (0)
#define WB(NLO, NHI) do { if (wlo) { WAIT_BAR(NLO); } else { WAIT_BAR(NHI); } } while (0)
    DMA_K(2, 2 * SLOTB);
    WB(3, 1);
    if (FOX) { _Pragma("unroll") for (int g_ = 0; g_ < 4; ++g_) { BRD4(CB0, bp0, g_); BRD4(CB1, bp0 + 128, g_); }
               asm volatile("s_waitcnt lgkmcnt(0)" ::: "memory");
               qkt(pA0, pA1, kp0, qr, CB0, CB1);
               pA0 = __builtin_amdgcn_mfma_f32_32x32x16_bf16(kones, qone, pA0, 0, 0, 0); pA1 = __builtin_amdgcn_mfma_f32_32x32x16_bf16(kones, qone, pA1, 0, 0, 0); }
    else qkt(pA0, pA1, kp0, qr, negm);
    asm volatile("s_nop 15\n\ts_nop 7" : "+v"(pA0), "+v"(pA1)); CMASK(pA0, pA1, 0);
    START(pA0, pA1);
    _Pragma("unroll") for (int r = 0; r < 16; ++r) pA1[r] = __builtin_amdgcn_exp2f(pA1[r]);
    WAIT_BAR(0);
    DMA_K(3, 0); DMA_V(1, SLOTB);
    ROT();
    kload8(kf, kp0 + (sl_cur >> 1));
    if (FOX) { _Pragma("unroll") for (int g_ = 0; g_ < 4; ++g_) { BRD4(CB0, bp0 + (sl_cur >> 5), g_); BRD4(CB1, bp0 + (sl_cur >> 5) + 128, g_); } }
    WB(2, 1);
    s16x4 vlo[8], vhi[8]; u32x4 pw0, pw1, pw2, pw3;
#define PKW(P, B) cvtpk(P[B], P[B + 1])
#define PAF(k) __builtin_bit_cast(bf16x8, pw##k)
#define VFR(i) (bf16x8){vlo[i][0], vlo[i][1], vlo[i][2], vlo[i][3], vhi[i][0], vhi[i][1], vhi[i][2], vhi[i][3]}
#define PIN(x) asm volatile("" : "+v"(x))
#define MX3(a, b, c) __builtin_fmaxf(__builtin_fmaxf((a), (b)), (c))
#define GAPA(MF, A0, A1, A2, A3, W0, W1, PW) do { MF; sacc += A0; sacc += A1; sacc += A2; sacc += A3; PIN(sacc); W0; W1; PIN(PW); SBAR(); } while (0)
#define EX(v) __builtin_amdgcn_exp2f(v)
#define GAPB(MF, X, B) do { MF; X[B] = EX(X[B]); X[B + 1] = EX(X[B + 1]); X[B + 2] = EX(X[B + 2]); X[B + 3] = EX(X[B + 3]); PIN(X); SBAR(); } while (0)
#define VRD(i) do { vlo[i] = vtr(vp_ + (((i) >> 2) * 4096 + ((i) & 3) * 1024)); vhi[i] = vtr(vp_ + (((i) >> 2) * 4096 + ((i) & 3) * 1024 + 512)); } while (0)
#define KRD(G, j) do { if (G) { kload2(kf, kp0 + (sl_next >> 1), j); if (FOX) { BRD4(CB0, bp0 + (sl_next >> 5), j); BRD4(CB1, bp0 + (sl_next >> 5) + 128, j); } SBAR(); } } while (0)
#define STEP(C0, C1, P0, P1, t, GK, GV, GL) do { SBAR(); \
    const lds_cptr vp_ = vp0 + sl_prev; \
    VRD(0); SBAR(); float sacc = (P0[0] + P0[1]); \
    GAPA(C0 = MF8(kf[0], qr, (FOX ? CB0 : negm)), P0[2], P0[3], P0[4], P0[5],     pw0[0] = PKW(P0, 0), pw0[1] = PKW(P0, 2), pw0); \
    VRD(4); SBAR(); GAPA(C1 = MF8(kf[1], qr, (FOX ? CB1 : negm)), P0[6], P0[7], P0[8], P0[9],     pw0[2] = PKW(P0, 4), pw0[3] = PKW(P0, 6), pw0); \
    VRD(1); SBAR(); GAPA((void)0,   P0[10], P0[11], P0[12], P0[13], pw1[0] = PKW(P0, 8), pw1[1] = PKW(P0, 10), pw1); \
    VRD(5); SBAR(); GAPA((void)0,   P0[14], P0[15], P1[0], P1[1],   pw1[2] = PKW(P0, 12), pw1[3] = PKW(P0, 14), pw1); \
    VRD(2); SBAR(); GAPA((void)0,   P1[2], P1[3], P1[4], P1[5],     pw2[0] = PKW(P1, 0), pw2[1] = PKW(P1, 2), pw2); \
    VRD(6); SBAR(); GAPA((void)0,   P1[6], P1[7], P1[8], P1[9],     pw2[2] = PKW(P1, 4), pw2[3] = PKW(P1, 6), pw2); \
    VRD(3); SBAR(); GAPA((void)0,   P1[10], P1[11], P1[12], P1[13], pw3[0] = PKW(P1, 8), pw3[1] = PKW(P1, 10), pw3); \
    VRD(7); SBAR(); GAPA((void)0,   P1[14], P1[15], 0.f, 0.f,       pw3[2] = PKW(P1, 12), pw3[3] = PKW(P1, 14), pw3); \
    if (FOX) { C0 = __builtin_amdgcn_mfma_f32_32x32x16_bf16(kones, qone, C0, 0, 0, 0); C1 = __builtin_amdgcn_mfma_f32_32x32x16_bf16(kones, qone, C1, 0, 0, 0); SBAR(); } \
    l_reg += sacc; \
    if (GK) { DMA_K((t) + 3, sl_cur); } if (GV) { DMA_V((t) + 1, sl_next); } \
    CMASK(C0, C1, t); \
    if (!FOX) { float a = MX3(C0[0], C0[1], C1[0]), b = MX3(C0[2], C0[3], C1[1]); a = MX3(a, C1[2], C1[3]); \
      _Pragma("unroll") for (int r = 4; r < 16; r += 4) { a = MX3(a, C0[r], C0[r + 1]); b = MX3(b, C0[r + 2], C0[r + 3]); a = MX3(a, C1[r], C1[r + 1]); b = MX3(b, C1[r + 2], C1[r + 3]); } \
      float rm = __builtin_fmaxf(a, b); { auto rr = __builtin_amdgcn_permlane32_swap(__float_as_uint(rm), __float_as_uint(rm), false, false); rm = __builtin_fmaxf(__uint_as_float(rr[0]), __uint_as_float(rr[1])); } \
      resc = false; \
      if (__builtin_expect(__any(rm > (float)THRL), 0)) { const float dl = __builtin_fmaxf(rm, 0.f); mhat += dl; \
        _Pragma("unroll") for (int r = 0; r < 16; ++r) { C0[r] -= dl; C1[r] -= dl; } \
        if (FOX) { qone = qext_frag(-mhat, hi); } else { _Pragma("unroll") for (int r = 0; r < 16; ++r) negm[r] = -mhat; asm volatile("" : "+v"(negm)); } \
        const float f = __builtin_amdgcn_exp2f(-dl); l_reg *= f; if (hi == 0) wsf[r32] = f; resc = true; } } \
    SBAR(); \
    GAPB(o[0] = __builtin_amdgcn_mfma_f32_32x32x16_bf16(PAF(0), VFR(0), o[0], 0, 0, 0), C0, 0); \
    GAPB(o[1] = __builtin_amdgcn_mfma_f32_32x32x16_bf16(PAF(0), VFR(4), o[1], 0, 0, 0), C0, 4); \
    KRD(GL, 0); GAPB(o[0] = __builtin_amdgcn_mfma_f32_32x32x16_bf16(PAF(1), VFR(1), o[0], 0, 0, 0), C0, 8); \
    KRD(GL, 1); GAPB(o[1] = __builtin_amdgcn_mfma_f32_32x32x16_bf16(PAF(1), VFR(5), o[1], 0, 0, 0), C0, 12); \
    KRD(GL, 2); GAPB(o[0] = __builtin_amdgcn_mfma_f32_32x32x16_bf16(PAF(2), VFR(2), o[0], 0, 0, 0), C1, 0); \
    KRD(GL, 3); GAPB(o[1] = __builtin_amdgcn_mfma_f32_32x32x16_bf16(PAF(2), VFR(6), o[1], 0, 0, 0), C1, 4); \
    GAPB(o[0] = __builtin_amdgcn_mfma_f32_32x32x16_bf16(PAF(3), VFR(3), o[0], 0, 0, 0), C1, 8); \
    GAPB(o[1] = __builtin_amdgcn_mfma_f32_32x32x16_bf16(PAF(3), VFR(7), o[1], 0, 0, 0), C1, 12); \
    } while (0)
    int t = 1;
#undef CMASK
#define CMASK(P0, P1, t) do { } while (0)
    for (; t + 5 < NT; t += 2) {
        STEP(pB0, pB1, pA0, pA1, t, true, true, true);     WB(2, 1); RESC(); ROT();
        STEP(pA0, pA1, pB0, pB1, t + 1, true, true, true); WB(2, 1); RESC(); ROT();
    }
#undef CMASK
#define CMASK(P0, P1, t) do { int jb_ = (t) - (NT - 4); if (jb_ >= 0) { if (FOX) cmask(P0, P1, jb_, qrel, hi); else if (jb_ > (wid >> 1)) maskall(P0, P1); } } while (0)
#define ENDW(tt) do { if ((tt) + 3 < NT) { WB(2, 1); } else if ((tt) + 2 < NT) { WAIT_BAR(1); } else { WAIT_BAR(0); } } while (0)
    for (; t + 1 < NT; t += 2) {
        STEP(pB0, pB1, pA0, pA1, t, (t + 3 < NT), (t + 1 < NT), (t + 1 < NT));         ENDW(t);     RESC(); ROT();
        STEP(pA0, pA1, pB0, pB1, t + 1, (t + 4 < NT), (t + 2 < NT), (t + 2 < NT));     ENDW(t + 1); RESC(); ROT();
    }
    STEP(pB0, pB1, pA0, pA1, NT - 1, false, false, false); RESC();
    { float sacc = pB0[0] + pB0[1]; _Pragma("unroll") for (int r = 2; r < 16; ++r) sacc += pB0[r]; _Pragma("unroll") for (int r = 0; r < 16; ++r) sacc += pB1[r]; l_reg += sacc;
      pw0 = (u32x4){PKW(pB0, 0), PKW(pB0, 2), PKW(pB0, 4), PKW(pB0, 6)}; pw1 = (u32x4){PKW(pB0, 8), PKW(pB0, 10), PKW(pB0, 12), PKW(pB0, 14)}; pw2 = (u32x4){PKW(pB1, 0), PKW(pB1, 2), PKW(pB1, 4), PKW(pB1, 6)}; pw3 = (u32x4){PKW(pB1, 8), PKW(pB1, 10), PKW(pB1, 12), PKW(pB1, 14)};
      SBAR(); pv(o, vb0 + sl_cur, PAF(0), PAF(1), PAF(2), PAF(3)); }
#undef PKW
#undef PAF
#undef VFR
#undef PIN
#undef MX3
#undef GAPA
#undef GAPB
#undef EX
#undef VRD
#undef KRD
#undef BRD4
#undef STEP
#undef ENDW
#undef WB
    { auto rr = __builtin_amdgcn_permlane32_swap(__float_as_uint(l_reg), __float_as_uint(l_reg), false, false); l_reg = __uint_as_float(rr[0]) + __uint_as_float(rr[1]); }
    if (hi == 0) wsf[32 + r32] = l_reg; asm volatile("s_waitcnt lgkmcnt(0)" ::: "memory");
    float rli[16];
#pragma unroll
    for (int r = 0; r < 16; ++r) rli[r] = __builtin_amdgcn_rcpf(wsf[32 + crow(r, hi)]);
    bf16_t* Ow = O + (rowbase + q0 + wid * QBLK) * OP + ocol;
    { bf16_t* stg = (bf16_t*)(shm + LDS_OST) + wid * 2048;
#pragma unroll
      for (int r = 0; r < 16; ++r) { const int orow = crow(r, hi);
#pragma unroll
        for (int d0 = 0; d0 < 2; ++d0) stg[orow * 64 + d0 * 32 + r32] = (bf16_t)f2bf(o[d0][r] * rli[r]); }
      asm volatile("s_waitcnt lgkmcnt(0)" ::: "memory");
#pragma unroll
      for (int i = 0; i < 4; ++i) { const int row = i * 8 + (lane >> 3), ch = lane & 7; const u32x4 v = *(const u32x4*)(stg + row * 64 + ch * 8);
          u32x2 w8; w8.x = pk4_fp8(O8S * bf2f(v.x & 0xffffu), O8S * bf2f(v.x >> 16), O8S * bf2f(v.y & 0xffffu), O8S * bf2f(v.y >> 16)); w8.y = pk4_fp8(O8S * bf2f(v.z & 0xffffu), O8S * bf2f(v.z >> 16), O8S * bf2f(v.w & 0xffffu), O8S * bf2f(v.w >> 16));
          *(u32x2*)((unsigned char*)O + ((rowbase + q0 + wid * QBLK + row) * (long)OP + ocol + ch * 8)) = w8; } }
    asm volatile("s_waitcnt lgkmcnt(0)\n\ts_barrier" ::: "memory");
#undef DMA_K
#undef DMA_V
#undef CMASK
#undef START
#undef RESC
#undef ROT
}

constexpr int L2_K = 0, L2_V = 3 * 8192, L2_WS = L2_V + 3 * 16384, L2_OST = L2_WS + NW * 64 * 4, LDS_BYTES_D128 = L2_OST + NW * 4096;
template <int THRL, bool COMBINE> __device__ __forceinline__ void attn_unit_d128(long rowbase, int qcol, int vcol, int ocol, int OP, int qb, const unsigned char* Q, const unsigned char* __restrict__ K, const unsigned char* __restrict__ V, bf16_t* O,
                                                                                const bf16_t* O1, int o1col, float lam, const float* __restrict__ gsub, char* shm) {
    int tid_ = threadIdx.x; asm volatile("" : "+v"(tid_));
    const int tid = tid_, lane = tid & 63, r32 = lane & 31, hi = lane >> 5; const int wid = __builtin_amdgcn_readfirstlane(tid >> 6);
    const int q0 = qb * QB; const int NT = (q0 + QB) / KVBLK;
    const bool wlo = wid < 4;
    const unsigned char* Qw = Q + (rowbase + q0 + wid * QBLK) * 512 + qcol;
    const unsigned char* Kh = K + rowbase * 512 + qcol; const unsigned char* Vh = V + rowbase * 512 + vcol;
    const unsigned lds0 = (unsigned)(uintptr_t)shm;
    float* wsf = (float*)(shm + L2_WS) + wid * 64;
    const unsigned char* ksrc = Kh + (long)(32 * (wid & 1) + (lane >> 1)) * 512 + ((wid >> 1) & 1) * 32 + (lane & 1) * 16;
    const int vj_ = lane >> 1, vg_ = wid & 1; const int vkey_ = (vj_ < 16) ? crow(vj_, vg_) : 32 + crow(vj_ - 16, vg_);
    const unsigned char* vsrc = Vh + (long)vkey_ * 512 + (wid >> 1) * 32 + (lane & 1) * 16;
    const unsigned kdst = lds0 + L2_K + wid * 1024, vdst = lds0 + L2_V + wid * 1024;
#define DMA_K(t, slot) do { if (wlo) glds16(ksrc + (long)(t) * KVBLK * 512, (unsigned)__builtin_amdgcn_readfirstlane(kdst + ((slot) >> 1))); } while (0)
#define DMA_V(t, slot) glds16(vsrc + (long)(t) * KVBLK * 512, (unsigned)__builtin_amdgcn_readfirstlane(vdst + (slot)))
    i32x8 kf[2];
    const lds_cptr shm3 = (lds_cptr)shm; const lds_cptr kp0 = shm3 + L2_K + hi * 2048 + r32 * 32; const lds_cptr vp0 = shm3 + L2_V + (32 * hi + ((lane & 15) >> 1)) * 32 + ((lane >> 4) & 1) * 16 + (lane & 1) * 8;
    DMA_K(0, 0); DMA_V(0, 0); DMA_K(1, SLOTB);
    const i32x8 qr = *reinterpret_cast<const i32x8a*>(Qw + (long)r32 * 512 + hi * 32);
    float mhat = 0.f, l_reg = 0.f; f32x16 o[4]; o[0] = f32x16{}; o[1] = f32x16{}; o[2] = f32x16{}; o[3] = f32x16{}; f32x16 ol = f32x16{};
    constexpr int L2_ONES = LDS_BYTES_D128;
    if (tid == 0) { u32x4 o4_; o4_.x = o4_.y = o4_.z = o4_.w = 0x38383838u; *(u32x4*)(shm + L2_ONES) = o4_; *(u32x4*)(shm + L2_ONES + 16) = o4_; }
    i32x8 vone;
    f32x16 negm = f32x16{}; asm volatile("" : "+v"(negm));
#define CMASK(P0, P1, t) do { int jb_ = (t) - (NT - 4); if (jb_ > (wid >> 1)) maskall(P0, P1); } while (0)
    bool resc = false;
#define RESC() do { if (resc) { asm volatile("s_waitcnt lgkmcnt(0)" ::: "memory"); \
      _Pragma("unroll") for (int d_ = 0; d_ < 4; ++d_) _Pragma("unroll") for (int r = 0; r < 16; ++r) o[d_][r] *= wsf[crow(r, hi)]; \
      _Pragma("unroll") for (int r = 0; r < 16; ++r) ol[r] *= wsf[crow(r, hi)]; } } while (0)
    f32x16 C0, C1; i32x8 pwa, pwb;
    int sl_prev = 0, sl_cur = 0, sl_next = SLOTB;
#define ROT() do { sl_prev = sl_cur; sl_cur = sl_next; sl_next = (sl_next == (NSLOT - 1) * SLOTB) ? 0 : sl_next + SLOTB; } while (0)
#define WB(NLO, NHI) do { if (wlo) { WAIT_BAR(NLO); } else { WAIT_BAR(NHI); } } while (0)
    DMA_K(2, 2 * SLOTB);
    WB(3, 1);
    qkt(C0, C1, kp0, qr, negm);
    asm volatile("s_nop 15\n\ts_nop 7" : "+v"(C0), "+v"(C1)); CMASK(C0, C1, 0);
    { const float rm = rowmax(C0, C1) - 6.0f; mhat = rm;
#pragma unroll
      for (int r = 0; r < 16; ++r) { C0[r] = __builtin_amdgcn_exp2f(C0[r] - rm); C1[r] = __builtin_amdgcn_exp2f(C1[r] - rm); }
#pragma unroll
      for (int r = 0; r < 16; ++r) negm[r] = -mhat;
      asm volatile("" : "+v"(negm));
#pragma unroll
      for (int w = 0; w < 4; ++w) { pwa[w] = (int)pk4_fp8_nc(C0[4 * w], C0[4 * w + 1], C0[4 * w + 2], C0[4 * w + 3]); pwa[4 + w] = (int)pk4_fp8_nc(C1[4 * w], C1[4 * w + 1], C1[4 * w + 2], C1[4 * w + 3]); } }
    WAIT_BAR(0);
    DMA_K(3, 0); DMA_V(1, SLOTB);
    ROT();
    kload8(kf, kp0 + (sl_cur >> 1));
    WB(2, 1);
    typedef int v2i_t __attribute__((ext_vector_type(2)));
    i32x8 vf[4];
#define PIN(x) asm volatile("" : "+v"(x))
#define MX3(a, b, c) __builtin_fmaxf(__builtin_fmaxf((a), (b)), (c))
#define VTR8(p_) __builtin_amdgcn_ds_read_tr8_b64_v2i32((LAS v2i_t*)(p_))
#define VRDN(dq) do { const v2i_t a_ = VTR8(vp_ + (dq) * 2048), b_ = VTR8(vp_ + (dq) * 2048 + 256), c_ = VTR8(vp_ + (dq) * 2048 + 512), d_ = VTR8(vp_ + (dq) * 2048 + 768); \
        vf[dq] = (i32x8){a_.x, a_.y, b_.x, b_.y, c_.x, c_.y, d_.x, d_.y}; } while (0)
#define KRD(G, j) do { if (G) { kload2(kf, kp0 + (sl_next >> 1), j); } } while (0)
#define EXP4(X, B, W) do { X[B] = __builtin_amdgcn_exp2f(X[B]); X[B + 1] = __builtin_amdgcn_exp2f(X[B + 1]); X[B + 2] = __builtin_amdgcn_exp2f(X[B + 2]); X[B + 3] = __builtin_amdgcn_exp2f(X[B + 3]); \
        W = (int)pk4_fp8_nc(X[B], X[B + 1], X[B + 2], X[B + 3]); PIN(W); } while (0)
#define STEPD(CU, NX, t, GK, GV, GL) do { SBAR(); \
    const lds_cptr vp_ = vp0 + sl_prev; \
    C0 = MF8(kf[0], qr, negm); SBAR(); \
    VRDN(0); VRDN(1); SBAR(); \
    C1 = MF8(kf[1], qr, negm); SBAR(); \
    VRDN(2); VRDN(3); vone = *(const LAS i32x8a*)(shm3 + L2_ONES); SBAR(); \
    if (GK) { DMA_K((t) + 3, sl_cur); } if (GV) { DMA_V((t) + 1, sl_next); } \
    CMASK(C0, C1, t); \
    { float a = MX3(C0[0], C0[1], C1[0]), b = MX3(C0[2], C0[3], C1[1]); a = MX3(a, C1[2], C1[3]); \
      _Pragma("unroll") for (int r = 4; r < 16; r += 4) { a = MX3(a, C0[r], C0[r + 1]); b = MX3(b, C0[r + 2], C0[r + 3]); a = MX3(a, C1[r], C1[r + 1]); b = MX3(b, C1[r + 2], C1[r + 3]); } \
      float rm = __builtin_fmaxf(a, b); { auto rr = __builtin_amdgcn_permlane32_swap(__float_as_uint(rm), __float_as_uint(rm), false, false); rm = __builtin_fmaxf(__uint_as_float(rr[0]), __uint_as_float(rr[1])); } \
      resc = false; \
      if (__builtin_expect(__any(rm > (float)THRL), 0)) { const float dl = __builtin_fmaxf(rm - 6.0f, 0.f); mhat += dl; \
        _Pragma("unroll") for (int r = 0; r < 16; ++r) { C0[r] -= dl; C1[r] -= dl; } \
        _Pragma("unroll") for (int r = 0; r < 16; ++r) negm[r] = -mhat; asm volatile("" : "+v"(negm)); \
        const float f = __builtin_amdgcn_exp2f(-dl); if (hi == 0) wsf[r32] = f; resc = true; } } \
    SBAR(); \
    ol = MF8(CU, vone, ol); SBAR(); \
    o[0] = MF8(CU, vf[0], o[0]); EXP4(C0, 0, NX[0]); EXP4(C0, 4, NX[1]); SBAR(); \
    o[1] = MF8(CU, vf[1], o[1]); EXP4(C0, 8, NX[2]); EXP4(C0, 12, NX[3]); SBAR(); \
    KRD(GL, 0); o[2] = MF8(CU, vf[2], o[2]); EXP4(C1, 0, NX[4]); EXP4(C1, 4, NX[5]); SBAR(); \
    KRD(GL, 1); o[3] = MF8(CU, vf[3], o[3]); EXP4(C1, 8, NX[6]); EXP4(C1, 12, NX[7]); SBAR(); \
    } while (0)
#define STEP_AB(t, GK, GV, GL) STEPD(pwa, pwb, t, GK, GV, GL)
#define STEP_BA(t, GK, GV, GL) STEPD(pwb, pwa, t, GK, GV, GL)
    int t = 1;
#undef CMASK
#define CMASK(P0, P1, t) do { } while (0)
    for (; t + 5 < NT; t += 2) {
        STEP_AB(t, true, true, true);     WB(2, 1); RESC(); ROT();
        STEP_BA(t + 1, true, true, true); WB(2, 1); RESC(); ROT();
    }
#undef CMASK
#define CMASK(P0, P1, t) do { int jb_ = (t) - (NT - 4); if (jb_ > (wid >> 1)) maskall(P0, P1); } while (0)
#define ENDW(tt) do { if ((tt) + 3 < NT) { WB(2, 1); } else if ((tt) + 2 < NT) { WAIT_BAR(1); } else { WAIT_BAR(0); } } while (0)
    for (; t + 1 < NT; t += 2) {
        STEP_AB(t, (t + 3 < NT), (t + 1 < NT), (t + 1 < NT));         ENDW(t);     RESC(); ROT();
        STEP_BA(t + 1, (t + 4 < NT), (t + 2 < NT), (t + 2 < NT));     ENDW(t + 1); RESC(); ROT();
    }
    STEP_AB(NT - 1, false, false, false); RESC();
    { const lds_cptr vp_ = vp0 + sl_cur; SBAR(); VRDN(0); VRDN(1); VRDN(2); VRDN(3); vone = *(const LAS i32x8a*)(shm3 + L2_ONES);
      ol = MF8(pwb, vone, ol); o[0] = MF8(pwb, vf[0], o[0]); o[1] = MF8(pwb, vf[1], o[1]); o[2] = MF8(pwb, vf[2], o[2]); o[3] = MF8(pwb, vf[3], o[3]); }
#undef PIN
#undef MX3
#undef VTR8
#undef VRDN
#undef KRD
#undef EXP4
#undef STEPD
#undef STEP_AB
#undef STEP_BA
#undef ENDW
#undef WB
    float rli[16];
#pragma unroll
    for (int r = 0; r < 16; ++r) rli[r] = __builtin_amdgcn_rcpf(ol[r]);
    bf16_t* Ow = O + (rowbase + q0 + wid * QBLK) * OP + ocol;
    if (!COMBINE) {
        bf16_t* stg = (bf16_t*)(shm + L2_OST) + wid * 2048;
#pragma unroll
        for (int p = 0; p < 2; ++p) {
#pragma unroll
            for (int r = 0; r < 16; ++r) { const int orow = crow(r, hi);
#pragma unroll
                for (int dd = 0; dd < 2; ++dd) stg[orow * 64 + dd * 32 + r32] = (bf16_t)f2bf(o[2 * p + dd][r] * rli[r]); }
            asm volatile("s_waitcnt lgkmcnt(0)" ::: "memory");
#pragma unroll
            for (int i = 0; i < 4; ++i) { const int row = i * 8 + (lane >> 3), ch = lane & 7; const u32x4 v = *(const u32x4*)(stg + row * 64 + ch * 8); *(u32x4*)(Ow + (long)row * OP + p * 64 + ch * 8) = v; }
            asm volatile("s_waitcnt lgkmcnt(0)" ::: "memory");
        }
    } else {
        asm volatile("s_waitcnt lgkmcnt(0)\n\ts_barrier" ::: "memory");
        constexpr int SROW = 136;
        bf16_t* stg = (bf16_t*)shm + wid * (32 * SROW);
#pragma unroll
        for (int r = 0; r < 16; ++r) { const int orow = crow(r, hi);
#pragma unroll
            for (int dq = 0; dq < 4; ++dq) stg[orow * SROW + dq * 32 + r32] = (bf16_t)f2bf(o[dq][r] * rli[r]); }
        asm volatile("s_waitcnt vmcnt(0) lgkmcnt(0)" ::: "memory");
        const int row = lane >> 1, hf = lane & 1;
        const bf16_t* o1p = O1 + (rowbase + q0 + wid * QBLK + row) * 512 + o1col + hf * 64;
        const bf16_t* o2p = stg + row * SROW + hf * 64;
        float d[64]; float ss = 0.f;
#pragma unroll
        for (int i = 0; i < 8; ++i) { const u32x4 a = *(const u32x4*)(o1p + 8 * i), c = *(const u32x4*)(o2p + 8 * i);
            d[8 * i + 0] = bf2f(a.x & 0xffffu) - lam * bf2f(c.x & 0xffffu); d[8 * i + 1] = bf2f(a.x >> 16) - lam * bf2f(c.x >> 16);
            d[8 * i + 2] = bf2f(a.y & 0xffffu) - lam * bf2f(c.y & 0xffffu); d[8 * i + 3] = bf2f(a.y >> 16) - lam * bf2f(c.y >> 16);
            d[8 * i + 4] = bf2f(a.z & 0xffffu) - lam * bf2f(c.z & 0xffffu); d[8 * i + 5] = bf2f(a.z >> 16) - lam * bf2f(c.z >> 16);
            d[8 * i + 6] = bf2f(a.w & 0xffffu) - lam * bf2f(c.w & 0xffffu); d[8 * i + 7] = bf2f(a.w >> 16) - lam * bf2f(c.w >> 16);
#pragma unroll
            for (int e = 0; e < 8; ++e) ss += d[8 * i + e] * d[8 * i + e]; }
        ss += __shfl_xor(ss, 1);
        const float rs = (1.0f - LAM0) * __builtin_amdgcn_rsqf(ss * (1.0f / 128.0f) + EPS);
#pragma unroll
        for (int i = 0; i < 8; ++i) { const f32x4 g0 = *(const f32x4*)(gsub + hf * 64 + 8 * i), g1 = *(const f32x4*)(gsub + hf * 64 + 8 * i + 4);
            const float r8 = rs * O8S; u32x2 w; w.x = pk4_fp8(d[8 * i] * r8 * g0[0], d[8 * i + 1] * r8 * g0[1], d[8 * i + 2] * r8 * g0[2], d[8 * i + 3] * r8 * g0[3]);
            w.y = pk4_fp8(d[8 * i + 4] * r8 * g1[0], d[8 * i + 5] * r8 * g1[1], d[8 * i + 6] * r8 * g1[2], d[8 * i + 7] * r8 * g1[3]);
            *(u32x2*)((unsigned char*)O + ((rowbase + q0 + wid * QBLK + row) * (long)OP + ocol + hf * 64 + 8 * i)) = w; }
    }
    asm volatile("s_waitcnt lgkmcnt(0)\n\ts_barrier" ::: "memory");
#undef DMA_K
#undef DMA_V
#undef CMASK
#undef RESC
#undef ROT
}
#undef SBAR
#undef WAIT_BAR
}

typedef GAS unsigned gu32;
#define XB_TMO      128
#define XB_XCNT(j)  (256  + 64 * (j))
#define XB_XSUB(j)  (1280 + 64 * (j))
#define XB_XGEN(j)  (2304 + 64 * (j))
#define XB_TOP      3328
#define XB_TOPGEN   3392
#define XCD_BAR_WORDS 3456
#define XB_SPIN_CAP (1u << 19)
__device__ __forceinline__ unsigned xb_ld(unsigned* p)              { return __hip_atomic_load(p, __ATOMIC_RELAXED, __HIP_MEMORY_SCOPE_AGENT); }
__device__ __forceinline__ unsigned xb_add(unsigned* p, unsigned v) { return __hip_atomic_fetch_add(p, v, __ATOMIC_RELAXED, __HIP_MEMORY_SCOPE_AGENT); }
__device__ __forceinline__ unsigned xb_xcc_id() { return (unsigned)__builtin_amdgcn_s_getreg((3 << 11) | 20) & 0xFu; }
#define XB_SPIN(cond, bar) do { unsigned _sp = 0; while (cond) { __builtin_amdgcn_s_sleep(1); \
    if ((++_sp & 255u) == 0u) { if (xb_ld(&(bar)[XB_TMO])) break; if (_sp > XB_SPIN_CAP) { atomicAdd(&(bar)[XB_TMO], 1u); break; } } } } while (0)
struct XcdBarrier { unsigned* bar; unsigned x; volatile LAS unsigned* st; };
__device__ __forceinline__ XcdBarrier xcd_barrier_post(unsigned* bar, volatile LAS unsigned* st) {
    XcdBarrier b; b.bar = bar; b.x = xb_xcc_id(); b.st = st;
    if (threadIdx.x == 0) (void)xb_add(&bar[XB_XCNT(b.x)], 1u);
    return b;
}
__device__ __forceinline__ void xcd_barrier_complete(unsigned* bar, unsigned x, unsigned& nloc, unsigned& nx) {
    const unsigned G = gridDim.x * gridDim.y * gridDim.z;
    unsigned sum, cnt, mine, sp = 0u;
    for (;;) {
        sum = 0u; cnt = 0u; mine = 0u;
#pragma unroll
        for (unsigned j = 0; j < 16; ++j) { const unsigned c = xb_ld(&bar[XB_XCNT(j)]); sum += c; cnt += (c > 0u) ? 1u : 0u; mine = (j == x) ? c : mine; }
        if (sum == G) break;
        __builtin_amdgcn_s_sleep(1);
        if ((++sp & 255u) == 0u) { if (xb_ld(&bar[XB_TMO])) break; if (sp > XB_SPIN_CAP) { atomicAdd(&bar[XB_TMO], 1u); break; } }
    }
    nloc = mine > 0u ? mine : 1u; nx = cnt > 0u ? cnt : 1u;
}
__device__ __forceinline__ void xcd_barrier(const XcdBarrier& b) {
    asm volatile("s_waitcnt vmcnt(0)" ::: "memory");
    __syncthreads();
    if (threadIdx.x == 0) {
        unsigned* bar = b.bar;
        __builtin_amdgcn_s_waitcnt(0);
        unsigned nloc = b.st[0], nx = b.st[1];
        if (nloc == 0u) { xcd_barrier_complete(bar, b.x, nloc, nx); b.st[0] = nloc; b.st[1] = nx; }
        const unsigned old = xb_add(&bar[XB_XSUB(b.x)], 1u);
        const unsigned gen = old / nloc;
        if (old + 1u == (gen + 1u) * nloc) {
            __builtin_amdgcn_fence(__ATOMIC_RELEASE, "agent");
            asm volatile("s_waitcnt vmcnt(0)" ::: "memory");
            const unsigned og = xb_add(&bar[XB_TOP], 1u);
            const unsigned tg = og / nx;
            if (og + 1u == (tg + 1u) * nx) xb_add(&bar[XB_TOPGEN], 1u);
            else XB_SPIN(xb_ld(&bar[XB_TOPGEN]) == tg, bar);
            xb_add(&bar[XB_XGEN(b.x)], 1u);
            __builtin_amdgcn_fence(__ATOMIC_ACQUIRE, "agent");
            asm volatile("s_waitcnt vmcnt(0)" ::: "memory");
        } else {
            XB_SPIN(xb_ld(&bar[XB_XGEN(b.x)]) == gen, bar);
            __builtin_amdgcn_fence(__ATOMIC_ACQUIRE, "agent");
            asm volatile("s_waitcnt vmcnt(0)" ::: "memory");
        }
    }
    __syncthreads();
}

struct Args {
    const float* in[28]; float* out; unsigned char* ws; int ph_lo, ph_hi, li, pad;
};
enum { I_X = 0, I_C, I_POS, I_WADA, I_BADA, I_GN1, I_WIN, I_BF, I_GQF, I_GKF, I_GQD, I_GKD, I_LQ1, I_LK1, I_LQ2, I_LK2, I_GSUB, I_WPF, I_WPD, I_WOUT, I_GN2, I_WRG, I_BRG, I_WRE, I_BRE, I_W1, I_W3, I_W2 };

template <bool F8 = false> __device__ __forceinline__ void transpose_item(const float* W, size_t ldw, int col0, int k0, bf16_t* WT, int drow, int Kd, LAS float* scr, int lane, int kd0 = 0) {
    float v[32];
    const float* wp = W + (size_t)(k0 + (lane >> 5)) * ldw + col0 + (lane & 31);
#pragma unroll
    for (int i = 0; i < 32; ++i) v[i] = wp[(size_t)(2 * i) * ldw];
#pragma unroll
    for (int i = 0; i < 32; ++i) scr[(2 * i + (lane >> 5)) * 33 + (lane & 31)] = v[i];
    LDS_WAIT(); asm volatile("" ::: "memory");
    const int c = lane & 7;
#pragma unroll
    for (int j = 0; j < 4; ++j) { const int n = (lane >> 3) + 8 * j; const LAS float* s = scr + (8 * c) * 33 + n;
        u32x4 o; o.x = pk2(s[0 * 33], s[1 * 33]); o.y = pk2(s[2 * 33], s[3 * 33]); o.z = pk2(s[4 * 33], s[5 * 33]); o.w = pk2(s[6 * 33], s[7 * 33]);
        if (F8) { u32x2 o8; o8.x = pk4_fp8(W8S * s[0 * 33], W8S * s[1 * 33], W8S * s[2 * 33], W8S * s[3 * 33]); o8.y = pk4_fp8(W8S * s[4 * 33], W8S * s[5 * 33], W8S * s[6 * 33], W8S * s[7 * 33]);
                  *(u32x2*)((unsigned char*)WT + (size_t)(drow + n) * Kd + kd0 + k0 + 8 * c) = o8; }
        else *(u32x4*)(WT + (size_t)(drow + n) * Kd + kd0 + k0 + 8 * c) = o; }
    LDS_WAIT(); asm volatile("" ::: "memory");
}

__global__ void __launch_bounds__(NTHREADS, 2) fwd_kernel(Args args) {
    extern __shared__ __attribute__((aligned(16))) unsigned char lds_raw[];
    LAS unsigned char* lds = (LAS unsigned char*)lds_raw;
    volatile LAS unsigned* MISC = (volatile LAS unsigned*)(lds + MISC_OFF);
    const int tid = threadIdx.x, lane = tid & 63, wave = __builtin_amdgcn_readfirstlane(tid >> 6);
    const int G = gridDim.x; const int bx = blockIdx.x; const int vcu = (G % 8 == 0) ? (bx % 8) * (G / 8) + bx / 8 : bx;
    unsigned char* ws = args.ws;
    gu32* ctl = (gu32*)(ws + WS_CTL);
    const int gw = vcu * NWAVES + wave, NGW = G * NWAVES;

    for (int u = tid; u < (LDS_BYTES - LDSCTL_OFF) / 4; u += NTHREADS) ((LAS unsigned*)(lds + LDSCTL_OFF))[u] = 0u;
    __syncthreads();
    XcdBarrier bar; bar.bar = (unsigned*)(ctl + CW_BAR); bar.x = 0; bar.st = nullptr;
    const bool one_launch = (args.ph_hi - args.ph_lo) > 1;
    if (one_launch) bar = xcd_barrier_post((unsigned*)(ctl + CW_BAR), MISC + 8);
    const int lo = args.ph_lo, hi = args.ph_hi;
#ifdef ONLYP
#define IN(k) ((k) == ONLYP && lo <= (k) && (k) < hi)
#else
#define IN(k) (lo <= (k) && (k) < hi)
#endif
#define SEAM(k) do { if (IN(k) && IN((k) + 1)) xcd_barrier(bar); } while (0)

    float* mod = (float*)(ws + WS_MOD);
    float* logf = (float*)(ws + WS_LOGF);
    float* biasb = (float*)(ws + WS_BIAS);
    bf16_t* Win_t = (bf16_t*)(ws + WS_WIN); bf16_t* Wpf_t = (bf16_t*)(ws + WS_WPF); bf16_t* Wpd_t = (bf16_t*)(ws + WS_WPD); bf16_t* Wout_t = (bf16_t*)(ws + WS_WOUT);
    bf16_t* W13_t = (bf16_t*)(ws + WS_W13); bf16_t* W2_t = (bf16_t*)(ws + WS_W2); bf16_t* Wr_t = (bf16_t*)(ws + WS_WR);
    bf16_t* H1 = (bf16_t*)(ws + WS_H1); bf16_t* OCAT = H1;     bf16_t* X1B = H1; bf16_t* H2 = (bf16_t*)(ws + WS_H2);
    bf16_t* QF = (bf16_t*)(ws + WS_QF); bf16_t* KF = (bf16_t*)(ws + WS_KF); bf16_t* VF = (bf16_t*)(ws + WS_VF);
    bf16_t* QD = (bf16_t*)(ws + WS_QD); bf16_t* KD = (bf16_t*)(ws + WS_KD); bf16_t* VD = (bf16_t*)(ws + WS_VD);
    bf16_t* GT = (bf16_t*)(ws + WS_G); bf16_t* O1T = (bf16_t*)(ws + WS_OD);     bf16_t* MERGED = (bf16_t*)(ws + WS_MERGED);
    bf16_t* H2S = (bf16_t*)(ws + WS_H2S); bf16_t* YB = H2S; unsigned char* HH8 = (unsigned char*)(ws + WS_HH);
    unsigned char* H1F8 = (unsigned char*)(ws + WS_OD);
    unsigned char* WG8 = (unsigned char*)(ws + WS_W13 + 32 * MiB);
    unsigned char* H2F8 = (unsigned char*)(ws + WS_QF);
    float* LOGIT = (float*)(ws + WS_LOGIT);
    int* EID = (int*)(ws + WS_EID); int* RNK = (int*)(ws + WS_RNK); float* WGT = (float*)(ws + WS_WGT); int* POS = (int*)(ws + WS_POS);
    int* HIST = (int*)(ws + WS_HIST); int* ELIST = (int*)(ws + WS_ROPE);
    unsigned* GCNT = (unsigned*)(ctl + CW_GCNT); float* gall = (float*)(ws + WS_GALL);
    const float* x = args.in[I_X];

    for (int rep_ = 0; rep_ < 1 + ((PROBE_REP >> 0) & 1); ++rep_) if (IN(0)) {
        if (vcu < 96) {
            LAS float* sl = (LAS float*)lds;
            LAS float* red = (LAS float*)(lds + 65536);
            const float* c = args.in[I_C];
            for (int i = tid; i < 16 * 1024; i += NTHREADS) { const int b = i >> 10, k = i & 1023; const float v = c[i]; sl[k * 16 + b] = v / (1.0f + __expf(-v)); }
            __syncthreads();
            const float* wa = args.in[I_WADA] + vcu * 64 + lane;
            float a[16];
#pragma unroll
            for (int b = 0; b < 16; ++b) a[b] = 0.f;
            for (int k = wave * 128; k < wave * 128 + 128; k += 16) {
                float w[16];
#pragma unroll
                for (int q = 0; q < 16; ++q) w[q] = wa[(size_t)(k + q) * 6144];
#pragma unroll
                for (int q = 0; q < 16; ++q) {
                    const LAS f32x4* sp = (const LAS f32x4*)(sl + (k + q) * 16);
#pragma unroll
                    for (int b4 = 0; b4 < 4; ++b4) { const f32x4 s = sp[b4]; a[4 * b4 + 0] += s[0] * w[q]; a[4 * b4 + 1] += s[1] * w[q]; a[4 * b4 + 2] += s[2] * w[q]; a[4 * b4 + 3] += s[3] * w[q]; }
                    __builtin_amdgcn_sched_barrier(0);
                }
            }
#pragma unroll
            for (int b = 0; b < 16; ++b) red[(wave * 16 + b) * 64 + lane] = a[b];
            __syncthreads();
            for (int i = tid; i < 1024; i += NTHREADS) { const int b = i >> 6, cc = i & 63; float s = 0.f;
#pragma unroll
                for (int w = 0; w < 8; ++w) s += red[(w * 16 + b) * 64 + cc];
                mod[b * 6144 + vcu * 64 + cc] = s + args.in[I_BADA][vcu * 64 + cc]; }
            __syncthreads();
        }
        if (vcu == 100 && tid < 256) gall[tid] = args.in[I_GQF + (tid >> 6)][tid & 63];
        for (int i = gw * 64 + lane; i < 256 * 1024; i += NGW * 64) { const int r = i >> 10, k = i & 1023; float v = 0.f;
            if (r < 4) v = args.in[I_WRG][k * 4 + r]; else if (r < 36) v = args.in[I_WRE][k * 32 + (r - 4)];
            Wr_t[i] = (bf16_t)f2bf(v); }
        { LAS float* scr = (LAS float*)(lds + wave * 16384);
          constexpr int I_IN = 160 * 16, I_PF = 32 * 8, I_PD = 32 * 8, I_OUT = 32 * 16, I_13 = 32 * 2 * 16 * 16, I_2 = 32 * 32 * 8;
          constexpr int NITEMS = I_IN + I_PF + I_PD + I_OUT + I_13 + I_2;
          constexpr int NADA = 96 * NWAVES, ITA = 11 * NADA;
          const bool ada_ = (G == 256) && (vcu < 96);
          const int it0 = (G != 256) ? gw : (ada_ ? vcu * NWAVES + wave : ITA + (vcu - 96) * NWAVES + wave), it1 = (G != 256) ? NITEMS : (ada_ ? ITA : NITEMS), its = (G != 256) ? NGW : (ada_ ? NADA : NGW - NADA);
          for (int it = it0; it < it1; it += its) {
              int r = it;
              if (r < I_IN) { const int nb = r % 160, kb = r / 160; const int pn = nb >> 3, c0 = (nb & 7) * 32, bj = c0 >> 7, wc = (c0 & 127) >> 5; int col0;
                  if (pn >= 12) col0 = COL_GATE + (pn - 12) * 256 + c0;
                  else { const int sec = pn >> 1, pl = pn & 1; const int sb = sec == 0 ? COL_FQ : sec == 1 ? COL_FK : sec == 2 ? COL_FV : sec == 3 ? COL_DQ : sec == 4 ? COL_DK : COL_DV;
                      if (sec == 2 || sec == 5) col0 = sb + pl * 256 + c0; else col0 = sb + (4 * pl + wc) * 64 + 32 * bj; }
                  transpose_item<true>(args.in[I_WIN], IN_COLS, col0, kb * 64, (bf16_t*)WG8, nb * 32, 1024, scr, lane);
                  continue; } r -= I_IN;
              if (r < I_PF) { const int nb = r % 32, kb = r / 32; transpose_item<true>(args.in[I_WPF], 1024, nb * 32, kb * 64, Wpf_t, nb * 32, 1024, scr, lane, 0); continue; } r -= I_PF;
              if (r < I_PD) { const int nb = r % 32, kb = r / 32; transpose_item<true>(args.in[I_WPD], 1024, nb * 32, kb * 64, Wpf_t, nb * 32, 1024, scr, lane, 512); continue; } r -= I_PD;
              if (r < I_OUT) { const int nb = r % 32, kb = r / 32; transpose_item<true>(args.in[I_WOUT], 1024, nb * 32, kb * 64, Wout_t, nb * 32, 1024, scr, lane); continue; }     r -= I_OUT;
              if (r < I_13) { const int nb = r % 16, kb = (r / 16) % 16, sr = (r / 256) % 2, e = r / 512; const int n0 = nb * 32, ct = n0 >> 7;
                  transpose_item<true>(args.in[sr ? I_W3 : I_W1] + (size_t)e * 1024 * 512, 512, n0, kb * 64, W13_t, e * 1024 + ct * 256 + 128 * sr + (n0 - ct * 128), 1024, scr, lane); continue; } r -= I_13;
              { const int nb = r % 32, kb = (r / 32) % 8, e = r / 256;
                  transpose_item<true>(args.in[I_W2] + (size_t)e * 512 * 1024, 1024, nb * 32, kb * 64, W2_t, e * 1024 + nb * 32, 512, scr, lane); }
          } }
    }
    SEAM(0);

    for (int rep_ = 0; rep_ < 1 + ((PROBE_REP >> 1) & 1); ++rep_) if (IN(1)) {
        LAS float* wff = (LAS float*)lds;
        for (int i = tid; i < 8 * 1024; i += NTHREADS) { const int k = i >> 3, q = i & 7; wff[q * 1024 + k] = args.in[I_WIN][(size_t)k * IN_COLS + COL_FF + q]; }
        __syncthreads();
        const int b = gw >> 7;
        const float* mb = mod + (size_t)b * 6144;
        f32x4 gm[4], sh[4];
#pragma unroll
        for (int j = 0; j < 4; ++j) { const int k = 256 * j + 4 * lane; const f32x4 g = *(const f32x4*)(args.in[I_GN1] + k), sc = *(const f32x4*)(mb + 1024 + k); sh[j] = *(const f32x4*)(mb + k); gm[j] = g * (1.0f + sc); }
        const float bfv = (lane < 8) ? args.in[I_BF][lane] : 0.f;
        for (int r = 0; r < 32; ++r) {
            const int row = gw * 32 + r;
            const f32x4* xr = (const f32x4*)(x + (size_t)row * 1024) + lane;
            f32x4 v[4]; float ss = 0.f;
#pragma unroll
            for (int j = 0; j < 4; ++j) { v[j] = xr[64 * j]; ss += (v[j][0] * v[j][0] + v[j][1] * v[j][1]) + (v[j][2] * v[j][2] + v[j][3] * v[j][3]); }
            const float rstd = 1.0f / sqrtf(wave_sum(ss) * (1.0f / 1024.0f) + EPS);
            unsigned long long* o8 = (unsigned long long*)(H1 + (size_t)row * 1024) + lane;
            float zf[8];
#pragma unroll
            for (int q = 0; q < 8; ++q) zf[q] = 0.f;
#pragma unroll
            for (int j = 0; j < 4; ++j) { v[j] = v[j] * rstd * gm[j] + sh[j];
                *((unsigned*)(H1F8 + (size_t)row * 1024 + 256 * j) + lane) = pk4_fp8(v[j][0], v[j][1], v[j][2], v[j][3]);
#pragma unroll
                for (int q = 0; q < 8; ++q) { const f32x4 w = *(const LAS f32x4*)(wff + q * 1024 + 256 * j + 4 * lane); zf[q] += (v[j][0] * w[0] + v[j][1] * w[1]) + (v[j][2] * w[2] + v[j][3] * w[3]); } }
            float mine = 0.f;
#pragma unroll
            for (int q = 0; q < 8; ++q) { const float s = wave_sum(zf[q]); if (lane == q) mine = s; }
            if (lane < 8) { const float z = mine + bfv; const float lf = fminf(z, 0.f) - log1pf(__expf(-fabsf(z)));
                logf[(size_t)(b * 8 + lane) * SEQ + (row & (SEQ - 1))] = lf; }
        }
    }
    SEAM(1);

    for (int rep_ = 0; rep_ < 1 + ((PROBE_REP >> 2) & 1); ++rep_) if (IN(2)) {
        if (vcu < 128 && wave == 0) {
            const float* lp = logf + (size_t)vcu * SEQ + 64 * lane; float v[64]; float run = 0.f;
#pragma unroll
            for (int i = 0; i < 16; ++i) { const f32x4 q = *(const f32x4*)(lp + 4 * i); v[4 * i] = q[0]; v[4 * i + 1] = q[1]; v[4 * i + 2] = q[2]; v[4 * i + 3] = q[3]; }
#pragma unroll
            for (int i = 0; i < 64; ++i) { run += v[i]; v[i] = run; }
            float incl = run;
#pragma unroll
            for (int o = 1; o < 64; o <<= 1) { const float t = __shfl_up(incl, o); if (lane >= o) incl += t; }
            const float excl = incl - run;
            float* bp = biasb + (size_t)vcu * SEQ + 64 * lane;
#pragma unroll
            for (int i = 0; i < 16; ++i) { f32x4 q; q[0] = -(excl + v[4 * i]) * LOG2E; q[1] = -(excl + v[4 * i + 1]) * LOG2E; q[2] = -(excl + v[4 * i + 2]) * LOG2E; q[3] = -(excl + v[4 * i + 3]) * LOG2E; *(f32x4*)(bp + 4 * i) = q; }
        }
        { pg8::USched S{}; S.nM = NTOK / 256; S.nN = 20; S.G = G; S.c = bx; S.pair = 0; S.K = 512  ; S.nseg = 1; S.A0 = (const char*)H1F8; S.A1 = S.A0; S.B0 = (const char*)WG8; S.B1 = S.B0; S.segB = 0; S.tp = nullptr; S.rowst = nullptr; S.direct = -1; S.gidx = nullptr;
          UEpi E{}; E.mode = (((PROBE_REP >> 21) & 1) && rep_) ? 99 : 1; E.pnoff = 12; E.ascale = 1.0f / W8S; E.qkv6 = QF; E.gates = GT; E.gall = gall; E.pos = (const int*)args.in[I_POS];
          pg8::gemm_phase<UEpi, pg8::USched, true>(lds, 512, S, E); }
    }
    SEAM(2);

    if (IN(3)) {
        float bound2;
        float smax2;
        { const float gq = fabsf(args.in[I_GQF][lane]), gk = fabsf(args.in[I_GKF][lane]); const float smax = 8.0f * wave_max(gq) * wave_max(gk); bound2 = (2.0f * smax + 19.5f) * LOG2E; smax2 = smax * LOG2E * 1.02f + 0.5f; }
        const int grp = vcu >> 3, s8 = vcu & 7;
        float lam;
        { const float a = wave_sum(args.in[I_LQ1][lane] * args.in[I_LK1][lane]), c = wave_sum(args.in[I_LQ2][lane] * args.in[I_LK2][lane]); lam = __expf(a) - __expf(c) + LAM0; }
        LAS int* t0tab = (LAS int*)(lds + LDSCTL_OFF + 768);
        { const int i = wave; const int stream = (i >> 1) * 32 + grp; const int sr = (s8 + 2 * (i >> 1)) & 7; const int qb = (i & 1) ? 15 - sr : sr;
          const int b = stream >> 3, h = ((stream & 7) + (b & 3) + 2 * (i >> 1)) & 7;
          const float* bias = biasb + (size_t)(b * 8 + h) * SEQ; const int q0 = qb * 256, NT0 = (q0 + 256) / 64;
          const float bq = bias[q0]; const int j = lane; float bj = 0.f; if (j < NT0 - 4) bj = bias[64 * j + 63];
          const unsigned long long bal = __ballot((j < NT0 - 4) && (bj < bq - bound2));
          const int t0 = __builtin_popcountll(bal) & ~1; if (lane == 0) t0tab[i] = t0; }
        __syncthreads();
        for (int rep_ = 0; rep_ < 1 + (((PROBE_REP >> 20) | (PROBE_REP >> 22)) & 1); ++rep_)
        for (int i = (rep_ && ((PROBE_REP >> 20) & 1)) ? 8 : 0; i < ((rep_ && ((PROBE_REP >> 22) & 1)) ? 8 : 16); ++i) {
            if (i >= 8) {
                if (G != 256) break;
                const int u4 = (i - 8) & 3, ps = ((i - 8) >> 2) * 32 + grp; const int b = ps >> 2, hd = ps & 3, m = u4 & 1, qb2 = (u4 >> 1) ? 15 - s8 : s8; const int hm = hd * 2 + m;
                if (m == 0) attn_body::attn_unit_d128<8, false>((long)b * SEQ, hm * 64, hd * 128, hd * 128, 512, qb2, (const unsigned char*)QD, (const unsigned char*)KD, (const unsigned char*)VD, O1T, nullptr, 0, 0.f, nullptr, (char*)lds_raw);
                else        attn_body::attn_unit_d128<8, true>((long)b * SEQ, hm * 64, hd * 128, 512 + hd * 128, 1024, qb2, (const unsigned char*)QD, (const unsigned char*)KD, (const unsigned char*)VD, OCAT, O1T, hd * 128, lam, args.in[I_GSUB], (char*)lds_raw);
                continue;
            }
            const int stream = (i >> 1) * 32 + grp; const int sr = (s8 + 2 * (i >> 1)) & 7; const int qb = (i & 1) ? 15 - sr : sr;
            if (G != 256) break;
#ifndef NO_FOX
            if (stream < 128) { const int b = stream >> 3, h = ((stream & 7) + (b & 3) + 2 * (i >> 1)) & 7;
                attn_body::attn_unit<true, 8>((long)b * SEQ, h * 64, h * 64, h * 64, 1024, qb, (const unsigned char*)QF, (const unsigned char*)KF, VF, OCAT, biasb + (size_t)(b * 8 + h) * SEQ, __builtin_amdgcn_readfirstlane(t0tab[i]), smax2, (char*)lds_raw);
            }
#endif
#ifndef NO_DIFF
            if (stream >= 128) {   }
#endif
        }
    }
    SEAM(3);


    for (int rep_ = 0; rep_ < 1 + ((PROBE_REP >> 5) & 1); ++rep_) if (IN(5)) {
        pg8::USched S{}; S.nM = NTOK / 256; S.nN = 4; S.G = G; S.c = bx; S.pair = 0; S.K = 512  ; S.nseg = 1; S.A0 = (const char*)OCAT; S.A1 = S.A0; S.B0 = (const char*)Wpf_t; S.B1 = S.B0; S.segB = 0; S.tp = nullptr; S.rowst = nullptr; S.direct = -1; S.gidx = nullptr;
        UEpi E{}; E.mode = 2; E.gates = GT; E.merged = MERGED;
        pg8::gemm_phase<UEpi, pg8::USched, true>(lds, 512, S, E);
    }
    SEAM(5);

    for (int rep_ = 0; rep_ < 1 + ((PROBE_REP >> 6) & 1); ++rep_) if (IN(6)) {
        pg8::USched S{}; S.nM = NTOK / 256; S.nN = 4; S.G = G; S.c = bx; S.pair = 0; S.K = 512  ; S.nseg = 1; S.A0 = (const char*)MERGED; S.A1 = S.A0; S.B0 = (const char*)Wout_t; S.B1 = S.B0; S.segB = 0; S.tp = nullptr; S.rowst = nullptr; S.direct = -1; S.gidx = nullptr;
        UEpi E{}; E.mode = 3; E.x = x; E.x1 = X1B; E.mod = mod; E.ascale = 1.0f / (W8S * M8S);
        pg8::gemm_phase<UEpi, pg8::USched, true>(lds, 512, S, E);
    }
    SEAM(6);

    for (int rep_ = 0; rep_ < 1 + ((PROBE_REP >> 7) & 1); ++rep_) if (IN(7)) {
        int t7 = threadIdx.x; asm volatile("" : "+v"(t7));
        const int l7 = t7 & 63, r7 = l7 & 15, kg = l7 >> 4;
        constexpr int WRP = 2064;
        LAS unsigned char* wr48 = lds; LAS float* gmt = (LAS float*)(lds + 48 * WRP); LAS float* sht = gmt + 1024;
        for (int i = t7; i < 48 * 128; i += NTHREADS) { const int n = i >> 7, c = i & 127; *(LAS u32x4*)(wr48 + n * WRP + c * 16) = *(const u32x4*)((const char*)Wr_t + (size_t)n * 2048 + c * 16); }
        { const int b = vcu >> 4; const float* mb = mod + (size_t)b * 6144;
          for (int k = t7; k < 1024; k += NTHREADS) { gmt[k] = args.in[I_GN2][k] * (1.0f + mb[4096 + k]); sht[k] = mb[3072 + k]; } }
        __syncthreads();
        for (int g = 0; g < 2; ++g) {
            const int row0 = gw * 32 + g * 16;
            const u32x4* xp = (const u32x4*)(X1B + (size_t)(row0 + r7) * 1024 + 8 * kg);
            float ss = 0.f;
#pragma unroll
            for (int q_ = 0; q_ < 2; ++q_) { u32x4 t_[16];
#pragma unroll
                for (int j_ = 0; j_ < 16; ++j_) t_[j_] = xp[4 * (16 * q_ + j_)];
#pragma unroll
                for (int j_ = 0; j_ < 16; ++j_) { const u32x4 w = t_[j_];
                    const float a0 = bf2f(w.x & 0xffffu), a1 = bf2f(w.x >> 16), a2 = bf2f(w.y & 0xffffu), a3 = bf2f(w.y >> 16), a4 = bf2f(w.z & 0xffffu), a5 = bf2f(w.z >> 16), a6 = bf2f(w.w & 0xffffu), a7 = bf2f(w.w >> 16);
                    ss += ((a0 * a0 + a1 * a1) + (a2 * a2 + a3 * a3)) + ((a4 * a4 + a5 * a5) + (a6 * a6 + a7 * a7)); }
                __builtin_amdgcn_sched_barrier(0); }
            ss += __shfl_xor(ss, 16); ss += __shfl_xor(ss, 32);
            const float rstd = 1.0f / sqrtf(ss * (1.0f / 1024.0f) + EPS);
            u32x4 win[16];
#pragma unroll
            for (int j_ = 0; j_ < 16; ++j_) win[j_] = xp[4 * j_];
            f32x4 lacc[3]; lacc[0] = (f32x4){0.f, 0.f, 0.f, 0.f}; lacc[1] = lacc[0]; lacc[2] = lacc[0];
            unsigned char* h8 = H2F8 + (size_t)(row0 + r7) * 1024 + 8 * kg;
#pragma unroll
            for (int s_ = 0; s_ < 32; ++s_) { const u32x4 w = win[s_ & 15]; if (s_ + 16 < 32) win[s_ & 15] = xp[4 * (s_ + 16)]; const int k0 = 32 * s_ + 8 * kg;
                const f32x4 g0 = *(const LAS f32x4*)(gmt + k0), g1 = *(const LAS f32x4*)(gmt + k0 + 4), s0 = *(const LAS f32x4*)(sht + k0), s1 = *(const LAS f32x4*)(sht + k0 + 4);
                f32x4 h0, h1;
                h0[0] = bf2f(w.x & 0xffffu) * rstd * g0[0] + s0[0]; h0[1] = bf2f(w.x >> 16) * rstd * g0[1] + s0[1]; h0[2] = bf2f(w.y & 0xffffu) * rstd * g0[2] + s0[2]; h0[3] = bf2f(w.y >> 16) * rstd * g0[3] + s0[3];
                h1[0] = bf2f(w.z & 0xffffu) * rstd * g1[0] + s1[0]; h1[1] = bf2f(w.z >> 16) * rstd * g1[1] + s1[1]; h1[2] = bf2f(w.w & 0xffffu) * rstd * g1[2] + s1[2]; h1[3] = bf2f(w.w >> 16) * rstd * g1[3] + s1[3];
                u32x2 w8; w8.x = pk4_fp8(h0[0], h0[1], h0[2], h0[3]); w8.y = pk4_fp8(h1[0], h1[1], h1[2], h1[3]);
                *(u32x2*)(h8 + 32 * s_) = w8;
                u32x4 aw; aw.x = cvtpk(h0[0], h0[1]); aw.y = cvtpk(h0[2], h0[3]); aw.z = cvtpk(h1[0], h1[1]); aw.w = cvtpk(h1[2], h1[3]);
                const bf16x8 af = __builtin_bit_cast(bf16x8, aw);
#pragma unroll
                for (int blk = 0; blk < 3; ++blk) { const bf16x8 bfr = *(const LAS bf16x8*)(wr48 + (blk * 16 + r7) * WRP + k0 * 2);
                    lacc[blk] = __builtin_amdgcn_mfma_f32_16x16x32_bf16(af, bfr, lacc[blk], 0, 0, 0); }
                __builtin_amdgcn_sched_barrier(0); }
#pragma unroll
            for (int blk = 0; blk < 3; ++blk)
#pragma unroll
                for (int i = 0; i < 4; ++i) LOGIT[(size_t)(row0 + 4 * kg + i) * 64 + blk * 16 + r7] = lacc[blk][i];
        }
    }
    if (IN(7) && IN(9)) { VM_WAIT(); __syncthreads(); }

    for (int rep_ = 0; rep_ < 1 + ((PROBE_REP >> 9) & 1); ++rep_) if (IN(9)) {
        LAS unsigned* cnt = (LAS unsigned*)lds;
        int t9 = threadIdx.x; asm volatile("" : "+v"(t9));
        if (tid < 32) cnt[t9] = 0u;
        __syncthreads();
        unsigned ra = 0, rb = 0; int eA = 0, eB = 0, tkk = 0;
        if (tid < 256) {
            const int tk = vcu * 256 + tid; const float* lp = LOGIT + (size_t)tk * 64;
            const f32x4 g = *(const f32x4*)lp;
            float gl[4]; gl[0] = g[0] + args.in[I_BRG][0]; gl[1] = g[1] + args.in[I_BRG][1]; gl[2] = g[2] + args.in[I_BRG][2]; gl[3] = g[3] + args.in[I_BRG][3];
            int gi = 0; float gmx = gl[0];
#pragma unroll
            for (int j = 1; j < 4; ++j) if (gl[j] > gmx) { gmx = gl[j]; gi = j; }
            float gs = 0.f;
#pragma unroll
            for (int j = 0; j < 4; ++j) gs += __expf(gl[j] - gmx);
            const float gwt = 1.0f / gs;
            const f32x4 e0 = *(const f32x4*)(lp + 4 + 8 * gi), e1 = *(const f32x4*)(lp + 8 + 8 * gi);
            const f32x4 b0 = *(const f32x4*)(args.in[I_BRE] + 8 * gi), b1 = *(const f32x4*)(args.in[I_BRE] + 8 * gi + 4);
            float el[8]; el[0] = e0[0] + b0[0]; el[1] = e0[1] + b0[1]; el[2] = e0[2] + b0[2]; el[3] = e0[3] + b0[3]; el[4] = e1[0] + b1[0]; el[5] = e1[1] + b1[1]; el[6] = e1[2] + b1[2]; el[7] = e1[3] + b1[3];
            int i1 = 0; float m1 = el[0];
#pragma unroll
            for (int j = 1; j < 8; ++j) if (el[j] > m1) { m1 = el[j]; i1 = j; }
            int i2 = -1; float m2 = -INFINITY;
#pragma unroll
            for (int j = 0; j < 8; ++j) if (j != i1 && el[j] > m2) { m2 = el[j]; i2 = j; }
            const float w1 = 1.0f / (1.0f + __expf(m2 - m1)); const float w2 = 1.0f - w1;
            const int ea = gi * 8 + i1, eb = gi * 8 + i2;
            ra = atomicAdd((unsigned*)(lds_raw) + ea, 1u); rb = atomicAdd((unsigned*)(lds_raw) + eb, 1u);
            EID[tk * 2] = ea; EID[tk * 2 + 1] = eb; WGT[tk * 2] = gwt * w1; WGT[tk * 2 + 1] = gwt * w2; eA = ea; eB = eb; tkk = tk;
        }
        __syncthreads();
        if (tid < 32) cnt[32 + t9] = __hip_atomic_fetch_add(GCNT + tid, cnt[t9], __ATOMIC_RELAXED, __HIP_MEMORY_SCOPE_AGENT);
        __syncthreads();
        if (tid < 256) { const int pa = (int)(cnt[32 + eA] + ra), pb = (int)(cnt[32 + eB] + rb);
            POS[tkk * 2] = pa; POS[tkk * 2 + 1] = pb; ELIST[(size_t)eA * NASSIGN + pa] = tkk; ELIST[(size_t)eB * NASSIGN + pb] = tkk; }
        __syncthreads();
    }
    SEAM(9);

    if (IN(11) || IN(12)) {
        LAS int* tp = (LAS int*)(lds + SCHED_OFF); LAS int* rowst = tp + 40;
        LAS int* ecnt = tp + 80;
        if (tid == 0) { int run = 0; for (int e = 0; e < 32; ++e) { const int c = (int)__hip_atomic_load(GCNT + e, __ATOMIC_RELAXED, __HIP_MEMORY_SCOPE_AGENT); ecnt[e] = c; tp[e] = run; rowst[e] = run * 256; run += (c + 255) >> 8; } tp[32] = run; }
        __syncthreads();
        const int ntile = tp[32];
        for (int rep_ = 0; rep_ < 1 + ((PROBE_REP >> 11) & 1); ++rep_) if (IN(11)) {
            pg8::USched S{}; S.nM = ntile; S.nN = 4; S.G = G; S.c = bx; S.pair = 0; S.K = 512  ; S.nseg = 32; S.A0 = (const char*)H2F8; S.A1 = S.A0; S.B0 = (const char*)W13_t; S.B1 = S.B0; S.segB = (size_t)1024 * 1024; S.tp = tp; S.rowst = rowst; S.direct = -1;
            LAS int* gidx = (LAS int*)(lds + LDSCTL_OFF + 2048);
            S.gidx = gidx;
            { pg8::Unit u; for (int i = 0; i < 12 && S.next(i, u); ++i) if (tid < 256) { const int r = u.row0 - rowst[u.seg] + tid;
                  gidx[i * 256 + tid] = (r < ecnt[u.seg]) ? ELIST[(size_t)u.seg * NASSIGN + r] : 0; } }
            __syncthreads();
            UEpi E{}; E.mode = 5; E.hh = HH8;
            pg8::gemm_phase<UEpi, pg8::USched, true>(lds, 512, S, E);
        }
        SEAM(11);
        for (int rep_ = 0; rep_ < 1 + ((PROBE_REP >> 12) & 1); ++rep_) if (IN(12)) {
            pg8::USched S{}; S.nM = ntile; S.nN = 4; S.G = G; S.c = bx; S.pair = 0; S.K = 256  ; S.nseg = 32; S.A0 = (const char*)HH8; S.A1 = S.A0; S.B0 = (const char*)W2_t; S.B1 = S.B0; S.segB = (size_t)1024 * 512; S.tp = tp; S.rowst = rowst; S.direct = -1; S.gidx = nullptr;
            UEpi E{}; E.mode = 6; E.y = (unsigned char*)YB;
            pg8::gemm_phase<UEpi, pg8::USched, true>(lds, 256, S, E);
        }
    }
    SEAM(12);

    if (IN(13)) {
        LAS int* pst = (LAS int*)(lds + SCHED_OFF);
        if (tid == 0) { int run = 0; for (int e = 0; e < 32; ++e) { pst[e] = run; run += (((int)__hip_atomic_load(GCNT + e, __ATOMIC_RELAXED, __HIP_MEMORY_SCOPE_AGENT) + 255) >> 8) << 8; } }
        __syncthreads();
        for (int row = gw; row < NTOK; row += NGW) {
            const int b = row >> 12; const float* gt = mod + (size_t)b * 6144 + 5120;
            const int p0 = pst[EID[row * 2]] + POS[row * 2], p1 = pst[EID[row * 2 + 1]] + POS[row * 2 + 1]; const float w0 = WGT[row * 2], w1 = WGT[row * 2 + 1];
            float* orow = args.out + (size_t)row * 1024;
#pragma unroll
            for (int j = 0; j < 2; ++j) { const int k = 512 * j + 8 * lane;
                const u32x2 a = *(const u32x2*)((const unsigned char*)YB + (size_t)p0 * 1024 + k), c = *(const u32x2*)((const unsigned char*)YB + (size_t)p1 * 1024 + k);
                const u32x4 xw = *(const u32x4*)(X1B + (size_t)row * 1024 + k); const f32x4 g0 = *(const f32x4*)(gt + k), g1 = *(const f32x4*)(gt + k + 4);
                f32x4 x0, x1v; x0[0] = bf2f(xw.x & 0xffffu); x0[1] = bf2f(xw.x >> 16); x0[2] = bf2f(xw.y & 0xffffu); x0[3] = bf2f(xw.y >> 16); x1v[0] = bf2f(xw.z & 0xffffu); x1v[1] = bf2f(xw.z >> 16); x1v[2] = bf2f(xw.w & 0xffffu); x1v[3] = bf2f(xw.w >> 16);
                const f32x2 a0 = __builtin_amdgcn_cvt_pk_f32_fp8((int)a.x, false), a1 = __builtin_amdgcn_cvt_pk_f32_fp8((int)a.x, true), a2 = __builtin_amdgcn_cvt_pk_f32_fp8((int)a.y, false), a3 = __builtin_amdgcn_cvt_pk_f32_fp8((int)a.y, true);
                const f32x2 c0 = __builtin_amdgcn_cvt_pk_f32_fp8((int)c.x, false), c1 = __builtin_amdgcn_cvt_pk_f32_fp8((int)c.x, true), c2 = __builtin_amdgcn_cvt_pk_f32_fp8((int)c.y, false), c3 = __builtin_amdgcn_cvt_pk_f32_fp8((int)c.y, true);
                const float w0s = w0 * (1.0f / Y8S), w1s = w1 * (1.0f / Y8S);
                f32x4 y0, y1;
                y0[0] = w0s * a0[0] + w1s * c0[0]; y0[1] = w0s * a0[1] + w1s * c0[1]; y0[2] = w0s * a1[0] + w1s * c1[0]; y0[3] = w0s * a1[1] + w1s * c1[1];
                y1[0] = w0s * a2[0] + w1s * c2[0]; y1[1] = w0s * a2[1] + w1s * c2[1]; y1[2] = w0s * a3[0] + w1s * c3[0]; y1[3] = w0s * a3[1] + w1s * c3[1];
                *(f32x4*)(orow + k) = x0 + g0 * y0; *(f32x4*)(orow + k + 4) = x1v + g1 * y1; }
        }
    }
#undef IN
#undef SEAM
}

extern "C" void kernel_launch(void* const* d_in, const int* in_sizes, int n_in, void* d_out, int out_size, void* d_ws, size_t ws_size, hipStream_t stream) {
    static int grid = 0;
    if (grid == 0) {
        if (n_in != 28 || in_sizes[0] != NTOK * DMODEL || out_size != NTOK * DMODEL || ws_size < WS_END) { fprintf(stderr, "kernel_launch: unexpected shapes (n_in %d, in0 %d, out %d, ws %zu)\n", n_in, n_in > 0 ? in_sizes[0] : -1, out_size, ws_size); grid = -1; return; }
        int dev = 0, cus = 0, per_cu = 0;
        if (hipGetDevice(&dev) != hipSuccess || hipDeviceGetAttribute(&cus, hipDeviceAttributeMultiprocessorCount, dev) != hipSuccess) { grid = -1; return; }
        if (hipFuncSetAttribute((const void*)fwd_kernel, hipFuncAttributeMaxDynamicSharedMemorySize, LDS_BYTES) != hipSuccess) { fprintf(stderr, "kernel_launch: hipFuncSetAttribute failed\n"); grid = -1; return; }
        if (hipOccupancyMaxActiveBlocksPerMultiprocessor(&per_cu, (const void*)fwd_kernel, NTHREADS, LDS_BYTES) != hipSuccess || per_cu < 1) { fprintf(stderr, "kernel_launch: occupancy query says %d blocks per CU\n", per_cu); per_cu = 1; }
        (void)hipGetLastError();
        grid = cus * 1;
        if (grid != 256) fprintf(stderr, "kernel_launch: %d CUs; this kernel is laid out for 256\n", grid);
    }
    if (grid < 0) return;
    (void)hipMemsetAsync((char*)d_ws + WS_CTL, 0, CTL_ZERO_BYTES, stream);
    Args a{};
    for (int i = 0; i < 28; ++i) a.in[i] = (const float*)d_in[i];
    a.out = (float*)d_out; a.ws = (unsigned char*)d_ws;
    constexpr int NPH = 14;
    if (MK_N_LAUNCHES == 1) { a.ph_lo = 0; a.ph_hi = NPH; a.li = 0; hipLaunchKernelGGL(fwd_kernel, dim3(grid), dim3(NTHREADS), LDS_BYTES, stream, a); }
    else { for (int p = 0; p < NPH; ++p) { a.ph_lo = p; a.ph_hi = p + 1; a.li = p; hipLaunchKernelGGL(fwd_kernel, dim3(grid), dim3(NTHREADS), LDS_BYTES, stream, a); } }
}
```

```cpp
#include <hip/hip_runtime.h>
#include <cstdio>
#include <cstdint>
#include <cmath>

#ifndef MK_N_LAUNCHES
#define MK_N_LAUNCHES 1
#endif

#ifndef STAG1
#define STAG1 0
#endif
#ifndef PROBE_REP
#define PROBE_REP 0
#endif
#define LAS __attribute__((address_space(3)))
#define GAS __attribute__((address_space(1)))
typedef unsigned short bf16_t;
typedef short bf16x8 __attribute__((ext_vector_type(8)));
typedef short s16x4 __attribute__((ext_vector_type(4)));
typedef float f32x4 __attribute__((ext_vector_type(4)));
typedef float f32x2 __attribute__((ext_vector_type(2)));
typedef float f32x16 __attribute__((ext_vector_type(16)));
typedef unsigned u32x4 __attribute__((ext_vector_type(4)));
typedef unsigned u32x2 __attribute__((ext_vector_type(2)));
typedef __bf16 bf16x2_t __attribute__((ext_vector_type(2)));

constexpr int NB = 16, SEQ = 4096, DMODEL = 1024, NTOK = NB * SEQ;
constexpr int IN_COLS = 5128, COL_FQ = 0, COL_FK = 512, COL_FV = 1024, COL_FF = 1536, COL_DQ = 1544, COL_DK = 2056, COL_DV = 2568, COL_GATE = 3080;
constexpr int NEXP = 32, DEXP = 512;
constexpr int NASSIGN = NTOK * 2;
constexpr int PADROWS = NASSIGN + NEXP * 256;
constexpr float EPS = 1e-6f;
constexpr float LOG2E = 1.4426950408889634f;
constexpr float C2 = 0.125f * LOG2E;
constexpr float LAM0 = 0.2f;

constexpr size_t MiB = 1u << 20;
constexpr size_t WS_CTL = 0, CTL_ZERO_BYTES = 128 * 1024;
constexpr size_t WS_MOD = 1 * MiB;
constexpr size_t WS_MISC = 1 * MiB + 512 * 1024;
constexpr size_t WS_GALL = 1 * MiB + 768 * 1024;
constexpr size_t WS_EID = 2 * MiB;
constexpr size_t WS_RNK = 2 * MiB + 512 * 1024;
constexpr size_t WS_WGT = 3 * MiB;
constexpr size_t WS_POS = 3 * MiB + 512 * 1024;
constexpr size_t WS_HIST = 4 * MiB;
constexpr size_t WS_ROWTOK = 4 * MiB + 256 * 1024;
constexpr size_t WS_LOGF = 5 * MiB;
constexpr size_t WS_BIAS = 7 * MiB;
constexpr size_t WS_WR = 10 * MiB;
constexpr size_t WS_LOGIT = 11 * MiB;
constexpr size_t WS_ROPE = 27 * MiB;
constexpr size_t WS_WIN = 43 * MiB;
constexpr size_t WS_WPF = 53 * MiB, WS_WPD = 54 * MiB, WS_WOUT = 55 * MiB;
constexpr size_t WS_W13 = 57 * MiB;
constexpr size_t WS_W2 = 121 * MiB;
constexpr size_t WS_H1 = 160 * MiB;
constexpr size_t WS_QF = 288 * MiB, WS_KF = 352 * MiB, WS_VF = 416 * MiB, WS_QD = 480 * MiB, WS_KD = 544 * MiB, WS_VD = 608 * MiB;
constexpr size_t WS_G = 672 * MiB;
constexpr size_t WS_OD = 928 * MiB;
constexpr size_t WS_MERGED = WS_KF;
constexpr size_t WS_H2S = WS_QD;
constexpr size_t WS_HH = 800 * MiB;
constexpr size_t WS_H2 = WS_G;
constexpr size_t WS_END = 1024 * MiB;
static_assert(WS_KF - WS_QF == 67108864 && WS_VD - WS_QF == 5 * 67108864, "six q/k/v buffers 64 MiB apart");
static_assert(WS_H2S + (size_t)PADROWS * 2048 <= WS_HH && WS_HH + (size_t)PADROWS * 1024 <= WS_END && WS_H2 + (size_t)NTOK * 2048 <= WS_HH, "ws map");

constexpr int CW_TMO = 0, CW_BAR = 4096, CW_GCNT = 16384;

constexpr int RING_BYTES = 131072, LDSCTL_OFF = RING_BYTES, MISC_OFF = LDSCTL_OFF + 320, SCHED_OFF = LDSCTL_OFF + 1024;
constexpr int LDS_BYTES = 147456;
constexpr int NWAVES = 8, NTHREADS = 512;

#define RLX_AGENT __ATOMIC_RELAXED, __HIP_MEMORY_SCOPE_AGENT
#define LDS_WAIT() asm volatile("s_waitcnt lgkmcnt(0)" ::: "memory")
#define VM_WAIT() asm volatile("s_waitcnt vmcnt(0)" ::: "memory")
__device__ __forceinline__ unsigned f2bf(float f) { unsigned u = __builtin_bit_cast(unsigned, f); return (u + 0x7fffu + ((u >> 16) & 1u)) >> 16; }
__device__ __forceinline__ unsigned pk2(float lo, float hi) { return f2bf(lo) | (f2bf(hi) << 16); }
__device__ __forceinline__ float bf2f(unsigned b) { return __builtin_bit_cast(float, b << 16); }
__device__ __forceinline__ unsigned cvtpk(float lo, float hi) { f32x2 v = {lo, hi}; bf16x2_t b = __builtin_convertvector(v, bf16x2_t); return __builtin_bit_cast(unsigned, b); }
__device__ __forceinline__ float wave_sum(float v) {
#pragma unroll
    for (int o = 1; o < 64; o <<= 1) v += __shfl_xor(v, o);
    return v;
}
__device__ __forceinline__ float wave_max(float v) {
#pragma unroll
    for (int o = 1; o < 64; o <<= 1) v = fmaxf(v, __shfl_xor(v, o));
    return v;
}
__device__ __forceinline__ unsigned pk4_fp8(float a, float b, float c, float d) {
    a = fminf(fmaxf(a, -448.f), 448.f); b = fminf(fmaxf(b, -448.f), 448.f); c = fminf(fmaxf(c, -448.f), 448.f); d = fminf(fmaxf(d, -448.f), 448.f);
    int p = __builtin_amdgcn_cvt_pk_fp8_f32(a, b, __float_as_int(a), false); p = __builtin_amdgcn_cvt_pk_fp8_f32(c, d, p, true); return (unsigned)p; }
__device__ __forceinline__ unsigned pk4_fp8_nc(float a, float b, float c, float d) { int p = __builtin_amdgcn_cvt_pk_fp8_f32(a, b, __float_as_int(a), false); p = __builtin_amdgcn_cvt_pk_fp8_f32(c, d, p, true); return (unsigned)p; }
constexpr float QS8 = 2.0f, KS8 = 0.5f;
constexpr float W8S = 64.0f, H8S = 4.0f, Y8S = 8.0f, M8S = 16.0f, O8S = 8.0f;
__device__ __forceinline__ float sigmoidf_(float x) { return __builtin_amdgcn_rcpf(1.0f + __builtin_amdgcn_exp2f(-LOG2E * x)); }

namespace pg8 {
constexpr int BM = 256, BK = 64, HALF = 128, HTB = HALF * BK * 2, STAGE_BYTES = 8 * HTB, NXCD = 8, WGM = 8;
__host__ __device__ __forceinline__ int lds_byte(int r, int c) { const int st = (r >> 4) * 2 + (c >> 5), rr = r & 15, cc = c & 31, ob = rr * 64 + cc * 2; return st * 1024 + (ob ^ (((ob >> 9) & 1) << 5)); }
__host__ __device__ __forceinline__ void stage_rc(int b, int& R, int& C) { const int st = b / 1024, sb = b % 1024, swz = sb ^ (((sb >> 9) & 1) << 5); R = (st >> 1) * 16 + swz / 64; C = (st & 1) * 32 + (swz % 64) / 2; }
__host__ __device__ __forceinline__ int perm32(int rho) { const int n = rho >> 4, i = rho & 15; return 8 * (i >> 2) + 4 * n + (i & 3); }

struct Unit { int row0, pn, seg, src; const char* A; const char* B; };

struct USched {
    int nM, nN, G, c, pair, K, nseg;
    const char *A0, *A1, *B0, *B1;
    size_t segB;
    const LAS int* tp;
    const LAS int* rowst;
    int direct;
    const LAS int* gidx;
    __device__ __forceinline__ bool next(int i, Unit& u) const {
        const int ii = pair ? (i >> 1) : i, src = pair ? (i & 1) : 0;
        int pm, pn;
        if (direct >= 0) { if (i > 0) return false; pm = direct; pn = 0; }
        else {
            const long L = (long)ii * G + c; const int nwg = nM * nN; if (L >= nwg) return false;
            int wgid = (int)L; { const int q = nwg / NXCD, r = nwg % NXCD, xcd = wgid % NXCD, off = wgid / NXCD; wgid = (xcd < r ? xcd * (q + 1) : r * (q + 1) + (xcd - r) * q) + off; }
            const int nig = WGM * nN, gid = wgid / nig, fm = gid * WGM, gsz = (nM - fm) < WGM ? (nM - fm) : WGM;
            pm = fm + ((wgid % nig) % gsz); pn = (wgid % nig) / gsz;
        }
        int s = 0, row0 = pm * BM;
        if (nseg > 1) { for (int j = 1; j < nseg; ++j) if (pm >= tp[j]) s = j; row0 = rowst[s] + (pm - tp[s]) * BM; }
        u.row0 = row0; u.pn = pn; u.seg = s; u.src = src;
        u.A = (src ? A1 : A0) + (gidx ? (size_t)0 : (size_t)row0 * K * 2);
        u.B = (src ? B1 : B0) + (size_t)s * segB + (size_t)pn * BM * K * 2;
        return true;
    }
    __device__ __forceinline__ unsigned a_off(int ui, int h, int R, int C) const {
        if (gidx) return (unsigned)(gidx[ui * BM + h * HALF + R] * K + C) * 2u;
        return (unsigned)((h * HALF + R) * K + C) * 2u;
    }
};

typedef int i32x8 __attribute__((ext_vector_type(8)));
typedef int i32x8a __attribute__((ext_vector_type(8), aligned(16)));
__device__ __forceinline__ i32x8 pg8_cat8(const u32x4 a, const u32x4 b) { return (i32x8){(int)a.x, (int)a.y, (int)a.z, (int)a.w, (int)b.x, (int)b.y, (int)b.z, (int)b.w}; }
template <class Epi, class Sched, bool FP8 = false>
__device__ __forceinline__ void gemm_phase(LAS unsigned char* lds, const int K, const Sched S, const Epi E, const unsigned delay_ticks = 0) {
    if (delay_ticks) { const unsigned long long t0_ = __builtin_amdgcn_s_memrealtime(); while (__builtin_amdgcn_s_memrealtime() - t0_ < delay_ticks) __builtin_amdgcn_s_sleep(16); }
    int tid_ = threadIdx.x; asm volatile("" : "+v"(tid_));
    const int tid = tid_, wid = __builtin_amdgcn_readfirstlane(tid >> 6), lane = tid & 63, wr = wid >> 2, wc = wid & 3, fr = lane & 15, fq = lane >> 4;
    const int nt = K / BK;
    unsigned voffB[2]; int RA[2], CA[2];
#pragma unroll
    for (int i = 0; i < 2; ++i) { int R, C; stage_rc(tid * 16 + i * 8192, R, C); const int Rb = (R & ~31) + perm32(R & 31);
        RA[i] = R; CA[i] = C; voffB[i] = (unsigned)(Rb * K + C) * 2u; }
    unsigned vA[2][2], nvA[2][2];
#define PG8_FILL(v, ui_) do { _Pragma("unroll") for (int _h = 0; _h < 2; ++_h) _Pragma("unroll") for (int _i = 0; _i < 2; ++_i) v[_h][_i] = S.a_off(ui_, _h, RA[_i], CA[_i]); } while (0)
    const size_t kstep = (size_t)(BK * 2);
    const size_t hstep = (size_t)HALF * K * 2;
    const unsigned ldsw = (unsigned)wid * 1024u;
    const int aoff = lds_byte(wr * 64 + fr, fq * 8);
    const int boff = lds_byte(wc * 32 + fr, fq * 8);
#define PG8_SA(b, h) (((b) * 2 + (h)) * HTB)
#define PG8_SB(b, h) ((4 + (b) * 2 + (h)) * HTB)
#define PG8_STAGE(bufoff, gbase, voff) do { _Pragma("unroll") for (int _i = 0; _i < 2; ++_i) \
        __builtin_amdgcn_global_load_lds((const unsigned*)((const char*)(gbase) + (voff)[_i]), (LAS unsigned*)(lds + (bufoff) + ldsw + _i * 8192), 16, 0, 0); } while (0)
#define PG8_RD8(p_) pg8_cat8(*(const LAS u32x4*)(p_), *(const LAS u32x4*)((p_) + 1024))
#define PG8_LDA(b, h) do { if constexpr (FP8) { _Pragma("unroll") for (int m = 0; m < 4; ++m) A8[m] = PG8_RD8(lds + PG8_SA(b, h) + aoff + m * 2048); } \
        else { _Pragma("unroll") for (int m = 0; m < 4; ++m) _Pragma("unroll") for (int k = 0; k < 2; ++k) At[m][k] = *(const LAS bf16x8*)(lds + PG8_SA(b, h) + aoff + m * 2048 + k * 1024); } } while (0)
#define PG8_LDB(dst, dst8, b, h) do { if constexpr (FP8) { _Pragma("unroll") for (int n = 0; n < 2; ++n) dst8[n] = PG8_RD8(lds + PG8_SB(b, h) + boff + n * 2048); } \
        else { _Pragma("unroll") for (int n = 0; n < 2; ++n) _Pragma("unroll") for (int k = 0; k < 2; ++k) dst[n][k] = *(const LAS bf16x8*)(lds + PG8_SB(b, h) + boff + n * 2048 + k * 1024); } } while (0)
#define PG8_MMA(ai, bj, Bt, Bt8) do { __builtin_amdgcn_s_setprio(1); \
        if constexpr (FP8) { _Pragma("unroll") for (int m = 0; m < 4; ++m) _Pragma("unroll") for (int n = 0; n < 2; ++n) \
            asm volatile("v_mfma_f32_16x16x128_f8f6f4 %0, %1, %2, %0" : "+v"(acc[ai][bj][m][n]) : "v"(Bt8[n]), "v"(A8[m])); }   \
        else { _Pragma("unroll") for (int m = 0; m < 4; ++m) _Pragma("unroll") for (int n = 0; n < 2; ++n) _Pragma("unroll") for (int k = 0; k < 2; ++k) \
            acc[ai][bj][m][n] = __builtin_amdgcn_mfma_f32_16x16x32_bf16(Bt[n][k], At[m][k], acc[ai][bj][m][n], 0, 0, 0); } \
        __builtin_amdgcn_s_setprio(0); } while (0)
#define PG8_WAIT_V(n) asm volatile("s_waitcnt vmcnt(" #n ")" ::: "memory")
#define PG8_WAIT_L(n) asm volatile("s_waitcnt lgkmcnt(" #n ")" ::: "memory")
#define PG8_BAR __builtin_amdgcn_s_barrier()
#define PG8_SCHED __builtin_amdgcn_sched_barrier(0)
    Unit cur, nxt; int ui = 0;
    if (!S.next(0, cur)) return;
    f32x4 acc[2][2][4][2];
#pragma unroll
    for (int a = 0; a < 2; ++a)
#pragma unroll
        for (int b = 0; b < 2; ++b)
#pragma unroll
            for (int m = 0; m < 4; ++m)
#pragma unroll
                for (int n = 0; n < 2; ++n) acc[a][b][m][n] = (f32x4){0.f, 0.f, 0.f, 0.f};
    bf16x8 At[4][2], B0[2][2], B1[2][2]; i32x8 A8[4], B08[2], B18[2];
    const char* cA = cur.A; const char* cB = cur.B;
    PG8_FILL(vA, 0);
    PG8_STAGE(PG8_SB(0, 0), cB, voffB); PG8_STAGE(PG8_SB(0, 1), cB + hstep, voffB); PG8_STAGE(PG8_SA(0, 0), cA, vA[0]); PG8_STAGE(PG8_SA(0, 1), cA, vA[1]);
    if (wr == 1) PG8_BAR;
    PG8_WAIT_V(2); PG8_BAR;
    PG8_STAGE(PG8_SB(1, 0), cB + kstep, voffB); PG8_STAGE(PG8_SA(1, 0), cA + kstep, vA[0]); PG8_STAGE(PG8_SB(1, 1), cB + hstep + kstep, voffB);
    PG8_WAIT_V(6); PG8_BAR;
    for (;;) {
        const bool has_next = S.next(ui + 1, nxt);
        const char* nA = has_next ? nxt.A : cA; const char* nB = has_next ? nxt.B : cB;
        if (has_next) { PG8_FILL(nvA, ui + 1); } else { nvA[0][0] = vA[0][0]; nvA[0][1] = vA[0][1]; nvA[1][0] = vA[1][0]; nvA[1][1] = vA[1][1]; }
        for (int t = 0; t < nt; t += 2) {
            const bool last = (t == nt - 2);
            const char* a1 = cA + (size_t)(t + 1) * kstep;
            const char* a2 = last ? nA : cA + (size_t)(t + 2) * kstep; const char* b2 = last ? nB : cB + (size_t)(t + 2) * kstep;
            const char* a3 = a2 + kstep; const char* b3 = b2 + kstep;
            if (E.mode == 2 && t == (nt >> 1)) E.mid(acc, cur, wr, wc, fr, fq);
            unsigned s0[2], s1[2]; s0[0] = last ? nvA[0][0] : vA[0][0]; s0[1] = last ? nvA[0][1] : vA[0][1]; s1[0] = last ? nvA[1][0] : vA[1][0]; s1[1] = last ? nvA[1][1] : vA[1][1];
            PG8_LDB(B0, B08, 0, 0); PG8_LDB(B1, B18, 0, 1); PG8_SCHED; PG8_LDA(0, 0); PG8_STAGE(PG8_SA(1, 1), a1, vA[1]);
            PG8_WAIT_V(8); PG8_WAIT_L(0); PG8_BAR; PG8_MMA(0, 0, B0, B08); PG8_MMA(0, 1, B1, B18); PG8_BAR; PG8_SCHED;
            PG8_LDA(0, 1); PG8_STAGE(PG8_SB(0, 0), b2, voffB); PG8_STAGE(PG8_SB(0, 1), b2 + hstep, voffB); PG8_STAGE(PG8_SA(0, 0), a2, s0);
            PG8_WAIT_V(8); PG8_WAIT_L(0); PG8_BAR; PG8_MMA(1, 0, B0, B08); PG8_MMA(1, 1, B1, B18); PG8_BAR; PG8_SCHED;
            PG8_LDB(B0, B08, 1, 0); PG8_LDB(B1, B18, 1, 1); PG8_SCHED; PG8_LDA(1, 0); PG8_STAGE(PG8_SA(0, 1), a2, s1);
            PG8_WAIT_V(8); PG8_WAIT_L(0); PG8_BAR; PG8_MMA(0, 0, B0, B08); PG8_MMA(0, 1, B1, B18); PG8_BAR; PG8_SCHED;
            PG8_LDA(1, 1); PG8_STAGE(PG8_SB(1, 0), b3, voffB); PG8_STAGE(PG8_SB(1, 1), b3 + hstep, voffB); PG8_STAGE(PG8_SA(1, 0), a3, s0);
            PG8_WAIT_V(8); PG8_WAIT_L(0); PG8_BAR; PG8_MMA(1, 0, B0, B08); PG8_MMA(1, 1, B1, B18); PG8_BAR; PG8_SCHED;
        }
        if (wr == 0) PG8_BAR;
        if constexpr (FP8) asm volatile("s_nop 15\n\ts_nop 7" ::: "memory");
        E(acc, cur, wr, wc, fr, fq);
        if (!has_next) break;
#pragma unroll
        for (int a = 0; a < 2; ++a)
#pragma unroll
            for (int b = 0; b < 2; ++b)
#pragma unroll
                for (int m = 0; m < 4; ++m)
#pragma unroll
                    for (int n = 0; n < 2; ++n) acc[a][b][m][n] = (f32x4){0.f, 0.f, 0.f, 0.f};
        cur = nxt; cA = nA; cB = nB; ++ui;
        vA[0][0] = nvA[0][0]; vA[0][1] = nvA[0][1]; vA[1][0] = nvA[1][0]; vA[1][1] = nvA[1][1];
        if (wr == 1) PG8_BAR;
    }
    PG8_WAIT_V(0);
    PG8_BAR;
#undef PG8_SA
#undef PG8_SB
#undef PG8_STAGE
#undef PG8_FILL
#undef PG8_RD8
#undef PG8_LDA
#undef PG8_LDB
#undef PG8_MMA
#undef PG8_WAIT_V
#undef PG8_WAIT_L
#undef PG8_BAR
#undef PG8_SCHED
}
}

struct UEpi {
    int pnoff; float ascale;
    int mode;
    bf16_t *qkv6, *gates; const float *gall; const int* pos;
    bf16_t* merged;
    const float* x; bf16_t* x1; const float* mod;
    float* logits;
    unsigned char* hh; unsigned char* y;
    __device__ __forceinline__ void mid(f32x4 (&acc)[2][2][4][2], const pg8::Unit& u, int wr, int wc, int fr, int fq) const {
        int rbase = u.row0 + wr * 64 + fr; asm volatile("" : "+v"(rbase));
        const int col0 = u.pn * 256 + wc * 32 + 8 * fq;
#define RAT_(a, b) ((float)(a) * __builtin_amdgcn_rcpf(fmaxf((float)(b), 1.0f)))
#pragma unroll
        for (int ai = 0; ai < 2; ++ai) {
            u32x2 ga[4][2], gb[4][2];
#pragma unroll
            for (int m = 0; m < 4; ++m) { const unsigned char* rp = (const unsigned char*)gates + (size_t)(rbase + ai * 128 + m * 16) * 2048 + col0;
#pragma unroll
                for (int bj = 0; bj < 2; ++bj) { ga[m][bj] = *(const u32x2*)(rp + bj * 128); gb[m][bj] = *(const u32x2*)(rp + 1024 + bj * 128); } }
#pragma unroll
            for (int m = 0; m < 4; ++m)
#pragma unroll
                for (int bj = 0; bj < 2; ++bj) { const u32x2 a = ga[m][bj], b = gb[m][bj];
                    acc[ai][bj][m][0][0] *= RAT_(a.x & 0xffu, b.x & 0xffu); acc[ai][bj][m][0][1] *= RAT_((a.x >> 8) & 0xffu, (b.x >> 8) & 0xffu);
                    acc[ai][bj][m][0][2] *= RAT_((a.x >> 16) & 0xffu, (b.x >> 16) & 0xffu); acc[ai][bj][m][0][3] *= RAT_(a.x >> 24, b.x >> 24);
                    acc[ai][bj][m][1][0] *= RAT_(a.y & 0xffu, b.y & 0xffu); acc[ai][bj][m][1][1] *= RAT_((a.y >> 8) & 0xffu, (b.y >> 8) & 0xffu);
                    acc[ai][bj][m][1][2] *= RAT_((a.y >> 16) & 0xffu, (b.y >> 16) & 0xffu); acc[ai][bj][m][1][3] *= RAT_(a.y >> 24, b.y >> 24); }
            asm volatile("" ::: "memory");
        }
#undef RAT_
    }
    __device__ __forceinline__ void operator()(const f32x4 (&acc)[2][2][4][2], const pg8::Unit& u, int wr, int wc, int fr, int fq) const {
        const int rbase = u.row0 + wr * 64 + fr;
        if (mode == 1) {
            const int pn = u.pn;
            if (pn >= 12 || pn == 4 || pn == 5 || pn == 10 || pn == 11) {
                const bool gate = pn >= 12;
                if (gate) {
                    unsigned char* gb = (unsigned char*)gates; const int col0 = (pn - 12) * 256 + wc * 32 + 8 * fq;
#pragma unroll
                    for (int ai = 0; ai < 2; ++ai)
#pragma unroll
                        for (int m = 0; m < 4; ++m) { unsigned char* rowp = gb + (size_t)(rbase + ai * 128 + m * 16) * 2048 + col0;
#pragma unroll
                            for (int bj = 0; bj < 2; ++bj) { const f32x4 v0 = acc[ai][bj][m][0], v1 = acc[ai][bj][m][1]; u32x2 w; unsigned p = 0u, q = 0u;
                                p = __builtin_amdgcn_cvt_pk_u8_f32(255.0f * sigmoidf_(v0[0] * ascale), 0, p); p = __builtin_amdgcn_cvt_pk_u8_f32(255.0f * sigmoidf_(v0[1] * ascale), 1, p);
                                p = __builtin_amdgcn_cvt_pk_u8_f32(255.0f * sigmoidf_(v0[2] * ascale), 2, p); p = __builtin_amdgcn_cvt_pk_u8_f32(255.0f * sigmoidf_(v0[3] * ascale), 3, p);
                                q = __builtin_amdgcn_cvt_pk_u8_f32(255.0f * sigmoidf_(v1[0] * ascale), 0, q); q = __builtin_amdgcn_cvt_pk_u8_f32(255.0f * sigmoidf_(v1[1] * ascale), 1, q);
                                q = __builtin_amdgcn_cvt_pk_u8_f32(255.0f * sigmoidf_(v1[2] * ascale), 2, q); q = __builtin_amdgcn_cvt_pk_u8_f32(255.0f * sigmoidf_(v1[3] * ascale), 3, q);
                                w.x = p; w.y = q; *(u32x2*)(rowp + bj * 128) = w; } }
                } else if (pn >= 10) {
                    unsigned char* vb = (unsigned char*)(qkv6 + (size_t)5 * 33554432); const int col0 = (pn & 1) * 256 + wc * 32 + 8 * fq;
#pragma unroll
                    for (int ai = 0; ai < 2; ++ai)
#pragma unroll
                        for (int m = 0; m < 4; ++m) { unsigned char* rowp = vb + (size_t)(rbase + ai * 128 + m * 16) * 512 + col0;
#pragma unroll
                            for (int bj = 0; bj < 2; ++bj) { const f32x4 v0 = acc[ai][bj][m][0], v1 = acc[ai][bj][m][1];
                                u32x2 w; w.x = pk4_fp8(v0[0] * ascale, v0[1] * ascale, v0[2] * ascale, v0[3] * ascale); w.y = pk4_fp8(v1[0] * ascale, v1[1] * ascale, v1[2] * ascale, v1[3] * ascale);
                                *(u32x2*)(rowp + bj * 128) = w; } }
                } else {
                    bf16_t* base = qkv6 + (size_t)(pn >> 1) * 33554432; const int ldc = 512, colt = (pn & 1) * 256;
                    const int col0 = colt + wc * 32 + 8 * fq;
#pragma unroll
                    for (int ai = 0; ai < 2; ++ai)
#pragma unroll
                        for (int m = 0; m < 4; ++m) { bf16_t* rowp = base + (size_t)(rbase + ai * 128 + m * 16) * ldc + col0;
#pragma unroll
                            for (int bj = 0; bj < 2; ++bj) { const f32x4 v0 = acc[ai][bj][m][0], v1 = acc[ai][bj][m][1];
                                u32x4 w; w.x = cvtpk(v0[0] * ascale, v0[1] * ascale); w.y = cvtpk(v0[2] * ascale, v0[3] * ascale); w.z = cvtpk(v1[0] * ascale, v1[1] * ascale); w.w = cvtpk(v1[2] * ascale, v1[3] * ascale);
                                *(u32x4*)(rowp + bj * 128) = w; } }
                }
            } else {
                const int sec = pn >> 1;
                bf16_t* base = qkv6 + (size_t)sec * 33554432;
                const float* g = gall + (sec - (sec >= 3 ? 1 : 0)) * 64;
                const bool dorope = sec >= 3; const float sc = (sec == 0 || sec == 3) ? C2 * QS8 : KS8;
                const int head = 4 * (pn & 1) + wc;
                f32x4 gv[2][2];
#pragma unroll
                for (int bj = 0; bj < 2; ++bj)
#pragma unroll
                    for (int n = 0; n < 2; ++n) { gv[bj][n] = *(const f32x4*)(g + 32 * bj + 8 * fq + 4 * n); gv[bj][n] = gv[bj][n] * sc; }
                f32x4 ivf[2];
#pragma unroll
                for (int n = 0; n < 2; ++n)
#pragma unroll
                    for (int e = 0; e < 4; ++e) ivf[n][e] = __builtin_amdgcn_exp2f(-(float)(8 * fq + 4 * n + e) * 0.41524101186092029f);
                const float asc2 = ascale * ascale * (1.0f / 64.0f);
#pragma unroll
                for (int ai = 0; ai < 2; ++ai)
#pragma unroll
                    for (int m = 0; m < 4; ++m) {
                        const int row = rbase + ai * 128 + m * 16;
                        f32x4 v[2][2]; float ss = 0.f;
#pragma unroll
                        for (int bj = 0; bj < 2; ++bj)
#pragma unroll
                            for (int n = 0; n < 2; ++n) { v[bj][n] = acc[ai][bj][m][n]; const f32x4 q = v[bj][n] * v[bj][n]; ss += (q[0] + q[1]) + (q[2] + q[3]); }
                        ss += __shfl_xor(ss, 16); ss += __shfl_xor(ss, 32);
                        const float rstd = __builtin_amdgcn_rsqf(ss * asc2 + EPS) * ascale;
#pragma unroll
                        for (int bj = 0; bj < 2; ++bj)
#pragma unroll
                            for (int n = 0; n < 2; ++n) v[bj][n] = v[bj][n] * rstd * gv[bj][n];
                        if (dorope) {
                            const float pr = (float)pos[row];
#pragma unroll
                            for (int n = 0; n < 2; ++n) { f32x4 cs, sn;
#pragma unroll
                                for (int e = 0; e < 4; ++e) { const float ang = pr * ivf[n][e]; const float fr_ = __builtin_amdgcn_fractf(ang * 0.15915494309189535f);
                                    cs[e] = __builtin_amdgcn_cosf(fr_); sn[e] = __builtin_amdgcn_sinf(fr_); }
                                const f32x4 x1 = v[0][n], x2 = v[1][n]; v[0][n] = x1 * cs - x2 * sn; v[1][n] = x2 * cs + x1 * sn; }
                        }
                        unsigned char* rowp = (unsigned char*)base + (size_t)row * 512 + head * 64 + 8 * fq;
#pragma unroll
                        for (int bj = 0; bj < 2; ++bj) { u32x2 w; w.x = pk4_fp8(v[bj][0][0], v[bj][0][1], v[bj][0][2], v[bj][0][3]); w.y = pk4_fp8(v[bj][1][0], v[bj][1][1], v[bj][1][2], v[bj][1][3]);
                            *(u32x2*)(rowp + bj * 32) = w; }
                    }
            }
        } else if (mode == 2) {
            const int col0 = u.pn * 256 + wc * 32 + 8 * fq;
#pragma unroll
            for (int ai = 0; ai < 2; ++ai)
#pragma unroll
                for (int m = 0; m < 4; ++m) { const size_t row = (size_t)(rbase + ai * 128 + m * 16);
#pragma unroll
                    for (int bj = 0; bj < 2; ++bj) { const int col = col0 + bj * 128;
                        const u32x2 gw = *(const u32x2*)((const unsigned char*)gates + row * 2048 + 1024 + col);
                        f32x4 v0 = acc[ai][bj][m][0], v1 = acc[ai][bj][m][1];
#define G1_(b) (fmaxf((float)(b), 1.0f) * (1.0f / (255.0f * O8S * W8S)))
                        v0[0] *= G1_(gw.x & 0xffu); v0[1] *= G1_((gw.x >> 8) & 0xffu); v0[2] *= G1_((gw.x >> 16) & 0xffu); v0[3] *= G1_(gw.x >> 24);
                        v1[0] *= G1_(gw.y & 0xffu); v1[1] *= G1_((gw.y >> 8) & 0xffu); v1[2] *= G1_((gw.y >> 16) & 0xffu); v1[3] *= G1_(gw.y >> 24);
#undef G1_
                        u32x2 w; w.x = pk4_fp8(M8S * v0[0], M8S * v0[1], M8S * v0[2], M8S * v0[3]); w.y = pk4_fp8(M8S * v1[0], M8S * v1[1], M8S * v1[2], M8S * v1[3]);
                        *(u32x2*)((unsigned char*)merged + row * 1024 + col) = w; } }
        } else if (mode == 3) {
            const int col0 = u.pn * 256 + wc * 32 + 8 * fq; const int b = u.row0 >> 12;
            const float* gt = mod + (size_t)b * 6144 + 2048;
#pragma unroll
            for (int bj = 0; bj < 2; ++bj) { const int col = col0 + bj * 128; const f32x4 g0 = *(const f32x4*)(gt + col) * ascale, g1 = *(const f32x4*)(gt + col + 4) * ascale;
#pragma unroll
                for (int ai = 0; ai < 2; ++ai)
#pragma unroll
                    for (int m = 0; m < 4; ++m) { const size_t off = (size_t)(rbase + ai * 128 + m * 16) * 1024 + col;
                        const f32x4 x0 = *(const f32x4*)(x + off), xb = *(const f32x4*)(x + off + 4);
                        const f32x4 v0 = x0 + g0 * acc[ai][bj][m][0], v1 = xb + g1 * acc[ai][bj][m][1];
                        u32x4 w; w.x = cvtpk(v0[0], v0[1]); w.y = cvtpk(v0[2], v0[3]); w.z = cvtpk(v1[0], v1[1]); w.w = cvtpk(v1[2], v1[3]);
                        *(u32x4*)(x1 + off) = w; } }
        } else if (mode == 4) {
            if (wc < 2) { const int col = wc * 32 + 8 * fq;
#pragma unroll
                for (int ai = 0; ai < 2; ++ai)
#pragma unroll
                    for (int m = 0; m < 4; ++m) { float* dp = logits + (size_t)(rbase + ai * 128 + m * 16) * 64 + col;
                        *(f32x4*)dp = acc[ai][0][m][0]; *(f32x4*)(dp + 4) = acc[ai][0][m][1]; } }
        } else if (mode == 5) {
            const int col0 = u.pn * 128 + wc * 32 + 8 * fq;
#pragma unroll
            for (int ai = 0; ai < 2; ++ai)
#pragma unroll
                for (int m = 0; m < 4; ++m) { f32x4 h0, h1;
#pragma unroll
                    for (int e = 0; e < 4; ++e) { const float a0 = acc[ai][0][m][0][e] * (1.0f / W8S), a1 = acc[ai][0][m][1][e] * (1.0f / W8S);
                        h0[e] = a0 * sigmoidf_(a0) * acc[ai][1][m][0][e] * (H8S / W8S); h1[e] = a1 * sigmoidf_(a1) * acc[ai][1][m][1][e] * (H8S / W8S); }
                    u32x2 w; w.x = pk4_fp8(h0[0], h0[1], h0[2], h0[3]); w.y = pk4_fp8(h1[0], h1[1], h1[2], h1[3]);
                    *(u32x2*)(hh + (size_t)(rbase + ai * 128 + m * 16) * 512 + col0) = w; }
        } else if (mode == 6) {
            const int col0 = u.pn * 256 + wc * 32 + 8 * fq;
#pragma unroll
            for (int ai = 0; ai < 2; ++ai)
#pragma unroll
                for (int m = 0; m < 4; ++m) { unsigned char* rowp = y + (size_t)(rbase + ai * 128 + m * 16) * 1024 + col0;
#pragma unroll
                    for (int bj = 0; bj < 2; ++bj) { const f32x4 v0 = acc[ai][bj][m][0] * (Y8S / (W8S * H8S)), v1 = acc[ai][bj][m][1] * (Y8S / (W8S * H8S));
                        u32x2 w; w.x = pk4_fp8(v0[0], v0[1], v0[2], v0[3]); w.y = pk4_fp8(v1[0], v1[1], v1[2], v1[3]);
                        *(u32x2*)(rowp + bj * 128) = w; } }
        }
    }
};

namespace attn_body {
constexpr int D = 64, DM = 512;
constexpr int NW = 8, QBLK = 32, QB = QBLK * NW, KVBLK = 64;
__device__ __forceinline__ int crow(int r, int hi) { return (r & 3) + 8 * (r >> 2) + 4 * hi; }
#define SBAR() __builtin_amdgcn_sched_barrier(0)
__device__ __forceinline__ void cmask(f32x16& p0, f32x16& p1, int jb, int qrel, int hi) {
    const float NEG = -INFINITY; int kb = 64 * jb + 4 * hi;
#pragma unroll
    for (int r = 0; r < 16; ++r) { int kv = kb + (r & 3) + 8 * (r >> 2); if (kv > qrel) p0[r] = NEG; if (kv + 32 > qrel) p1[r] = NEG; }
}
__device__ __forceinline__ void maskall(f32x16& p0, f32x16& p1) {
    const float NEG = -INFINITY;
#pragma unroll
    for (int r = 0; r < 16; ++r) { p0[r] = NEG; p1[r] = NEG; }
}
constexpr int NSLOT = 3, SLOTB = 8192;
constexpr int LDS_K = 0, LDS_V = NSLOT * SLOTB, LDS_WS = 2 * NSLOT * SLOTB, LDS_OST = LDS_WS + NW * 64 * 4, LDS_BIAS = LDS_OST + NW * 4096, LDS_BYTES_A = LDS_BIAS + NSLOT * 256;
__device__ __forceinline__ void glds16(const void* gsrc, unsigned lds_dst) { unsigned keep;
    asm volatile("s_mov_b32 %0, m0\n\ts_mov_b32 m0, %2\n\ts_nop 0\n\tglobal_load_lds_dwordx4 %1, off\n\ts_mov_b32 m0, %0" : "=&s"(keep) : "v"(gsrc), "s"(lds_dst) : "memory"); }
__device__ __forceinline__ void glds4(const void* gsrc, unsigned lds_dst) { unsigned keep;
    asm volatile("s_mov_b32 %0, m0\n\ts_mov_b32 m0, %2\n\ts_nop 0\n\tglobal_load_lds_dword %1, off\n\ts_mov_b32 m0, %0" : "=&s"(keep) : "v"(gsrc), "s"(lds_dst) : "memory"); }
__device__ __forceinline__ float max3f(float a, float b, float c) { float r; asm("v_max3_f32 %0, %1, %2, %3" : "=v"(r) : "v"(a), "v"(b), "v"(c)); return r; }
__device__ __forceinline__ float max2f(float a, float b) { float r; asm("v_max_f32_e32 %0, %1, %2" : "=v"(r) : "v"(a), "v"(b)); return r; }
__device__ __forceinline__ float fadd_s(float a, float b) { float r; asm("v_add_f32_e32 %0, %1, %2" : "=v"(r) : "v"(a), "v"(b)); return r; }
__device__ __forceinline__ float fsub_s(float a, float b) { float r; asm("v_sub_f32_e32 %0, %1, %2" : "=v"(r) : "v"(a), "v"(b)); return r; }
#define WAIT_BAR(N) asm volatile("s_waitcnt vmcnt(" #N ") lgkmcnt(0)\n\ts_barrier" ::: "memory")
typedef LAS const char* lds_cptr;
typedef short v4i16_t __attribute__((ext_vector_type(4)));
typedef int i32x8 __attribute__((ext_vector_type(8)));
typedef int i32x8a __attribute__((ext_vector_type(8), aligned(16)));
#define MF8(a, b, c) __builtin_amdgcn_mfma_scale_f32_32x32x64_f8f6f4(a, b, c, 0, 0, 0, 0, 0, 0)
__device__ __forceinline__ void kload8(i32x8* kf, lds_cptr kp) { kf[0] = *(const LAS i32x8a*)(kp); kf[1] = *(const LAS i32x8a*)(kp + 1024); }
__device__ __forceinline__ void kload2(i32x8* kf, lds_cptr kp, int j) { if (j < 2) kf[j] = *(const LAS i32x8a*)(kp + j * 1024); }
__device__ __forceinline__ void qkt(f32x16& p0, f32x16& p1, lds_cptr kp, const i32x8& qr, const f32x16& negm) {
    const i32x8 k0 = *(const LAS i32x8a*)(kp), k1 = *(const LAS i32x8a*)(kp + 1024);
    p0 = MF8(k0, qr, negm); p1 = MF8(k1, qr, negm);
}
__device__ __forceinline__ void qkt(f32x16& p0, f32x16& p1, lds_cptr kp, const i32x8& qr, const f32x16& c0, const f32x16& c1) {
    const i32x8 k0 = *(const LAS i32x8a*)(kp), k1 = *(const LAS i32x8a*)(kp + 1024);
    p0 = MF8(k0, qr, c0); p1 = MF8(k1, qr, c1);
}
__device__ __forceinline__ s16x4 vtr(lds_cptr p) { return __builtin_bit_cast(s16x4, __builtin_amdgcn_ds_read_tr16_b64_v4i16((LAS v4i16_t*)p)); }
__device__ __forceinline__ float rowmax(const f32x16& p0, const f32x16& p1) {
    float a = max3f(p0[0], p0[1], p1[0]), b = max3f(p0[2], p0[3], p1[1]); a = max3f(a, p1[2], p1[3]);
#pragma unroll
    for (int r = 4; r < 16; r += 4) { a = max3f(a, p0[r], p0[r + 1]); b = max3f(b, p0[r + 2], p0[r + 3]); a = max3f(a, p1[r], p1[r + 1]); b = max3f(b, p1[r + 2], p1[r + 3]); }
    const float m = max2f(a, b);
    auto rr = __builtin_amdgcn_permlane32_swap(__float_as_uint(m), __float_as_uint(m), false, false);
    return max2f(__uint_as_float(rr[0]), __uint_as_float(rr[1]));
}
__device__ __forceinline__ void pv(f32x16* o, int vb, bf16x8 pa0, bf16x8 pa1, bf16x8 pa2, bf16x8 pa3) {
#pragma unroll
    for (int d0 = 0; d0 < 2; ++d0) { s16x4 lo[4], hi[4];
#pragma unroll
        for (int ks = 0; ks < 4; ++ks) {
            asm volatile("ds_read_b64_tr_b16 %0,%1 offset:%c2" : "=&v"(lo[ks]) : "v"(vb), "i"(d0 * 4096 + ks * 1024) : "memory");
            asm volatile("ds_read_b64_tr_b16 %0,%1 offset:%c2" : "=&v"(hi[ks]) : "v"(vb), "i"(d0 * 4096 + ks * 1024 + 512) : "memory"); }
        asm volatile("s_waitcnt lgkmcnt(0)" ::: "memory"); SBAR();
#define PK(k) (bf16x8){lo[k][0], lo[k][1], lo[k][2], lo[k][3], hi[k][0], hi[k][1], hi[k][2], hi[k][3]}
        o[d0] = __builtin_amdgcn_mfma_f32_32x32x16_bf16(pa0, PK(0), o[d0], 0, 0, 0);
        o[d0] = __builtin_amdgcn_mfma_f32_32x32x16_bf16(pa1, PK(1), o[d0], 0, 0, 0);
        o[d0] = __builtin_amdgcn_mfma_f32_32x32x16_bf16(pa2, PK(2), o[d0], 0, 0, 0);
        o[d0] = __builtin_amdgcn_mfma_f32_32x32x16_bf16(pa3, PK(3), o[d0], 0, 0, 0);
#undef PK
    }
}
__device__ __forceinline__ bf16x8 bias_frag(float b) {
    const unsigned u0 = cvtpk(b, 0.f) & 0xffffu; const float r1 = b - bf2f(u0);
    const unsigned u1 = cvtpk(r1, 0.f) & 0xffffu; const float r2 = r1 - bf2f(u1);
    const unsigned u2 = cvtpk(r2, 0.f) & 0xffffu;
    u32x4 w; w.x = u0 | (u1 << 16); w.y = u2 | 0x3F800000u; w.z = 0x3F803F80u; w.w = 0u; return __builtin_bit_cast(bf16x8, w);
}
__device__ __forceinline__ bf16x8 qext_frag(float nm, int hi) {
    const unsigned u0 = cvtpk(nm, 0.f) & 0xffffu; const float r1 = nm - bf2f(u0);
    const unsigned u1 = cvtpk(r1, 0.f) & 0xffffu; const float r2 = r1 - bf2f(u1);
    const unsigned u2 = cvtpk(r2, 0.f) & 0xffffu;
    u32x4 w; w.x = hi ? 0u : 0x3F803F80u; w.y = hi ? 0u : (0x3F80u | (u0 << 16)); w.z = hi ? 0u : (u1 | (u2 << 16)); w.w = 0u; return __builtin_bit_cast(bf16x8, w);
}

template <bool FOX, int THRL> __device__ __forceinline__ void attn_unit(long rowbase, int qcol, int vcol, int ocol, int OP, int qb, const unsigned char* Q, const unsigned char* __restrict__ K, const bf16_t* __restrict__ V, bf16_t* O,
                                                                         const float* __restrict__ bias, int t0in, float smax2, char* shm) {
    int tid_ = threadIdx.x; asm volatile("" : "+v"(tid_));
    const int tid = tid_, lane = tid & 63, r32 = lane & 31, hi = lane >> 5; const int wid = __builtin_amdgcn_readfirstlane(tid >> 6);
    const int q0 = qb * QB;
    int NT = (q0 + QB) / KVBLK; int t0 = 0;
    if (FOX) { t0 = t0in; NT -= t0; }
    const bool wlo = wid < 5;
    const unsigned char* Qw = Q + (rowbase + q0 + wid * QBLK) * 512 + qcol;
    const unsigned char* Kh = K + (rowbase + (long)t0 * KVBLK) * 512 + qcol; const bf16_t* Vh = V + (rowbase + (long)t0 * KVBLK) * DM + vcol;
    const int bofs0 = t0 * KVBLK;
    const unsigned lds0 = (unsigned)(uintptr_t)shm;
    float* wsf = (float*)(shm + LDS_WS) + wid * 64;
    const unsigned char* ksrc = Kh + (long)(32 * (wid & 1) + (lane >> 1)) * 512 + ((wid >> 1) & 1) * 32 + (lane & 1) * 16;
    const bf16_t* vsrc = Vh + (long)(16 * (wid & 3) + (lane >> 2)) * DM + (wid >> 2) * 32 + (lane & 3) * 8;
    const unsigned kdst = lds0 + LDS_K + wid * 1024, vdst = lds0 + LDS_V + wid * 1024;
    const float* bsrc = bias + bofs0 + lane;
#define DMA_K(t, slot) do { if (wid < 4) glds16(ksrc + (long)(t) * KVBLK * 512, (unsigned)__builtin_amdgcn_readfirstlane(kdst + ((slot) >> 1))); \
        else if (FOX && wid == 4) glds4(bsrc + (t) * KVBLK, (unsigned)__builtin_amdgcn_readfirstlane(lds0 + LDS_BIAS + ((slot) >> 5))); } while (0)
#define DMA_V(t, slot) glds16(vsrc + (long)(t) * KVBLK * DM, (unsigned)__builtin_amdgcn_readfirstlane(vdst + (slot)))
    const int vb0 = (int)(lds0 + LDS_V) + ((lane >> 4) & 1) * 32 + (lane & 3) * 8 + (4 * hi + ((lane & 15) >> 2)) * 64;
    i32x8 kf[2];
    const lds_cptr shm3 = (lds_cptr)shm; const lds_cptr shm3b = shm3; const lds_cptr kp0 = shm3 + LDS_K + hi * 2048 + r32 * 32; const lds_cptr vp0 = shm3 + LDS_V + ((lane >> 4) & 1) * 32 + (lane & 3) * 8 + (4 * hi + ((lane & 15) >> 2)) * 64;
    DMA_K(0, 0); DMA_V(0, 0); DMA_K(1, SLOTB);
    const i32x8 qr = *reinterpret_cast<const i32x8a*>(Qw + (long)r32 * 512 + hi * 32);
    float mhat = 0.f; if (FOX) mhat = bias[q0 + wid * QBLK + r32] + smax2;
    bf16x8 qone = qext_frag(-mhat, hi);
    f32x16 CB0 = f32x16{}, CB1 = f32x16{};
    bf16x8 kones; { u32x4 w_; w_.x = 0u; w_.y = 0x3F800000u; w_.z = 0x3F803F80u; w_.w = 0u; kones = __builtin_bit_cast(bf16x8, w_); }
    const lds_cptr bp0 = shm3b + LDS_BIAS + 16 * hi;
#define BRD4(CB, base, g) do { const f32x4 q_ = *(const LAS f32x4*)((base) + 32 * (g)); CB[4 * (g)] = q_[0]; CB[4 * (g) + 1] = q_[1]; CB[4 * (g) + 2] = q_[2]; CB[4 * (g) + 3] = q_[3]; } while (0)
    float l_reg = 0.f; f32x16 o[2]; o[0] = f32x16{}; o[1] = f32x16{}; f32x16 negm = f32x16{}; if (!FOX) asm volatile("" : "+v"(negm));
    const int qrel = wid * QBLK + r32;
#define CMASK(P0, P1, t) do { int jb_ = (t) - (NT - 4); if (jb_ >= 0) { if (FOX) cmask(P0, P1, jb_, qrel, hi); else if (jb_ > (wid >> 1)) maskall(P0, P1); } } while (0)
    bool resc = false;
#define START(P0, P1) do { resc = false; \
    if (!FOX) { const float rm = rowmax(P0, P1); const float dl = rm; mhat = fadd_s(mhat, dl); \
      _Pragma("unroll") for (int r = 0; r < 16; ++r) { P0[r] = fsub_s(P0[r], dl); P1[r] = fsub_s(P1[r], dl); } \
      if (FOX) { qone = qext_frag(-mhat, hi); } else { _Pragma("unroll") for (int r = 0; r < 16; ++r) negm[r] = -mhat; asm volatile("" : "+v"(negm)); } } \
    _Pragma("unroll") for (int r = 0; r < 16; ++r) P0[r] = __builtin_amdgcn_exp2f(P0[r]); } while (0)
#define RESC() do { if (resc) { asm volatile("s_waitcnt lgkmcnt(0)" ::: "memory"); \
      _Pragma("unroll") for (int d_ = 0; d_ < 2; ++d_) _Pragma("unroll") for (int r = 0; r < 16; ++r) o[d_][r] *= wsf[crow(r, hi)]; } } while (0)
    f32x16 pA0, pA1, pB0, pB1;
    int sl_prev = 0, sl_cur = 0, sl_next = SLOTB;
#define ROT() do { sl_prev = sl_cur; sl_cur = sl_next; sl_next = (sl_next == (NSLOT - 1) * SLOTB) ? 0 : sl_next + SLOTB; } while (0)
#define WB(NLO, NHI) do { if (wlo) { WAIT_BAR(NLO); } else { WAIT_BAR(NHI); } } while (0)
    DMA_K(2, 2 * SLOTB);
    WB(3, 1);
    if (FOX) { _Pragma("unroll") for (int g_ = 0; g_ < 4; ++g_) { BRD4(CB0, bp0, g_); BRD4(CB1, bp0 + 128, g_); }
               asm volatile("s_waitcnt lgkmcnt(0)" ::: "memory");
               qkt(pA0, pA1, kp0, qr, CB0, CB1);
               pA0 = __builtin_amdgcn_mfma_f32_32x32x16_bf16(kones, qone, pA0, 0, 0, 0); pA1 = __builtin_amdgcn_mfma_f32_32x32x16_bf16(kones, qone, pA1, 0, 0, 0); }
    else qkt(pA0, pA1, kp0, qr, negm);
    asm volatile("s_nop 15\n\ts_nop 7" : "+v"(pA0), "+v"(pA1)); CMASK(pA0, pA1, 0);
    START(pA0, pA1);
    _Pragma("unroll") for (int r = 0; r < 16; ++r) pA1[r] = __builtin_amdgcn_exp2f(pA1[r]);
    WAIT_BAR(0);
    DMA_K(3, 0); DMA_V(1, SLOTB);
    ROT();
    kload8(kf, kp0 + (sl_cur >> 1));
    if (FOX) { _Pragma("unroll") for (int g_ = 0; g_ < 4; ++g_) { BRD4(CB0, bp0 + (sl_cur >> 5), g_); BRD4(CB1, bp0 + (sl_cur >> 5) + 128, g_); } }
    WB(2, 1);
    s16x4 vlo[8], vhi[8]; u32x4 pw0, pw1, pw2, pw3;
#define PKW(P, B) cvtpk(P[B], P[B + 1])
#define PAF(k) __builtin_bit_cast(bf16x8, pw##k)
#define VFR(i) (bf16x8){vlo[i][0], vlo[i][1], vlo[i][2], vlo[i][3], vhi[i][0], vhi[i][1], vhi[i][2], vhi[i][3]}
#define PIN(x) asm volatile("" : "+v"(x))
#define MX3(a, b, c) __builtin_fmaxf(__builtin_fmaxf((a), (b)), (c))
#define GAPA(MF, A0, A1, A2, A3, W0, W1, PW) do { MF; sacc += A0; sacc += A1; sacc += A2; sacc += A3; PIN(sacc); W0; W1; PIN(PW); SBAR(); } while (0)
#define EX(v) __builtin_amdgcn_exp2f(v)
#define GAPB(MF, X, B) do { MF; X[B] = EX(X[B]); X[B + 1] = EX(X[B + 1]); X[B + 2] = EX(X[B + 2]); X[B + 3] = EX(X[B + 3]); PIN(X); SBAR(); } while (0)
#define VRD(i) do { vlo[i] = vtr(vp_ + (((i) >> 2) * 4096 + ((i) & 3) * 1024)); vhi[i] = vtr(vp_ + (((i) >> 2) * 4096 + ((i) & 3) * 1024 + 512)); } while (0)
#define KRD(G, j) do { if (G) { kload2(kf, kp0 + (sl_next >> 1), j); if (FOX) { BRD4(CB0, bp0 + (sl_next >> 5), j); BRD4(CB1, bp0 + (sl_next >> 5) + 128, j); } SBAR(); } } while (0)
#define STEP(C0, C1, P0, P1, t, GK, GV, GL) do { SBAR(); \
    const lds_cptr vp_ = vp0 + sl_prev; \
    VRD(0); SBAR(); float sacc = (P0[0] + P0[1]); \
    GAPA(C0 = MF8(kf[0], qr, (FOX ? CB0 : negm)), P0[2], P0[3], P0[4], P0[5],     pw0[0] = PKW(P0, 0), pw0[1] = PKW(P0, 2), pw0); \
    VRD(4); SBAR(); GAPA(C1 = MF8(kf[1], qr, (FOX ? CB1 : negm)), P0[6], P0[7], P0[8], P0[9],     pw0[2] = PKW(P0, 4), pw0[3] = PKW(P0, 6), pw0); \
    VRD(1); SBAR(); GAPA((void)0,   P0[10], P0[11], P0[12], P0[13], pw1[0] = PKW(P0, 8), pw1[1] = PKW(P0, 10), pw1); \
    VRD(5); SBAR(); GAPA((void)0,   P0[14], P0[15], P1[0], P1[1],   pw1[2] = PKW(P0, 12), pw1[3] = PKW(P0, 14), pw1); \
    VRD(2); SBAR(); GAPA((void)0,   P1[2], P1[3], P1[4], P1[5],     pw2[0] = PKW(P1, 0), pw2[1] = PKW(P1, 2), pw2); \
    VRD(6); SBAR(); GAPA((void)0,   P1[6], P1[7], P1[8], P1[9],     pw2[2] = PKW(P1, 4), pw2[3] = PKW(P1, 6), pw2); \
    VRD(3); SBAR(); GAPA((void)0,   P1[10], P1[11], P1[12], P1[13], pw3[0] = PKW(P1, 8), pw3[1] = PKW(P1, 10), pw3); \
    VRD(7); SBAR(); GAPA((void)0,   P1[14], P1[15], 0.f, 0.f,       pw3[2] = PKW(P1, 12), pw3[3] = PKW(P1, 14), pw3); \
    if (FOX) { C0 = __builtin_amdgcn_mfma_f32_32x32x16_bf16(kones, qone, C0, 0, 0, 0); C1 = __builtin_amdgcn_mfma_f32_32x32x16_bf16(kones, qone, C1, 0, 0, 0); SBAR(); } \
    l_reg += sacc; \
    if (GK) { DMA_K((t) + 3, sl_cur); } if (GV) { DMA_V((t) + 1, sl_next); } \
    CMASK(C0, C1, t); \
    if (!FOX) { float a = MX3(C0[0], C0[1], C1[0]), b = MX3(C0[2], C0[3], C1[1]); a = MX3(a, C1[2], C1[3]); \
      _Pragma("unroll") for (int r = 4; r < 16; r += 4) { a = MX3(a, C0[r], C0[r + 1]); b = MX3(b, C0[r + 2], C0[r + 3]); a = MX3(a, C1[r], C1[r + 1]); b = MX3(b, C1[r + 2], C1[r + 3]); } \
      float rm = __builtin_fmaxf(a, b); { auto rr = __builtin_amdgcn_permlane32_swap(__float_as_uint(rm), __float_as_uint(rm), false, false); rm = __builtin_fmaxf(__uint_as_float(rr[0]), __uint_as_float(rr[1])); } \
      resc = false; \
      if (__builtin_expect(__any(rm > (float)THRL), 0)) { const float dl = __builtin_fmaxf(rm, 0.f); mhat += dl; \
        _Pragma("unroll") for (int r = 0; r < 16; ++r) { C0[r] -= dl; C1[r] -= dl; } \
        if (FOX) { qone = qext_frag(-mhat, hi); } else { _Pragma("unroll") for (int r = 0; r < 16; ++r) negm[r] = -mhat; asm volatile("" : "+v"(negm)); } \
        const float f = __builtin_amdgcn_exp2f(-dl); l_reg *= f; if (hi == 0) wsf[r32] = f; resc = true; } } \
    SBAR(); \
    GAPB(o[0] = __builtin_amdgcn_mfma_f32_32x32x16_bf16(PAF(0), VFR(0), o[0], 0, 0, 0), C0, 0); \
    GAPB(o[1] = __builtin_amdgcn_mfma_f32_32x32x16_bf16(PAF(0), VFR(4), o[1], 0, 0, 0), C0, 4); \
    KRD(GL, 0); GAPB(o[0] = __builtin_amdgcn_mfma_f32_32x32x16_bf16(PAF(1), VFR(1), o[0], 0, 0, 0), C0, 8); \
    KRD(GL, 1); GAPB(o[1] = __builtin_amdgcn_mfma_f32_32x32x16_bf16(PAF(1), VFR(5), o[1], 0, 0, 0), C0, 12); \
    KRD(GL, 2); GAPB(o[0] = __builtin_amdgcn_mfma_f32_32x32x16_bf16(PAF(2), VFR(2), o[0], 0, 0, 0), C1, 0); \
    KRD(GL, 3); GAPB(o[1] = __builtin_amdgcn_mfma_f32_32x32x16_bf16(PAF(2), VFR(6), o[1], 0, 0, 0), C1, 4); \
    GAPB(o[0] = __builtin_amdgcn_mfma_f32_32x32x16_bf16(PAF(3), VFR(3), o[0], 0, 0, 0), C1, 8); \
    GAPB(o[1] = __builtin_amdgcn_mfma_f32_32x32x16_bf16(PAF(3), VFR(7), o[1], 0, 0, 0), C1, 12); \
    } while (0)
    int t = 1;
#undef CMASK
#define CMASK(P0, P1, t) do { } while (0)
    for (; t + 5 < NT; t += 2) {
        STEP(pB0, pB1, pA0, pA1, t, true, true, true);     WB(2, 1); RESC(); ROT();
        STEP(pA0, pA1, pB0, pB1, t + 1, true, true, true); WB(2, 1); RESC(); ROT();
    }
#undef CMASK
#define CMASK(P0, P1, t) do { int jb_ = (t) - (NT - 4); if (jb_ >= 0) { if (FOX) cmask(P0, P1, jb_, qrel, hi); else if (jb_ > (wid >> 1)) maskall(P0, P1); } } while (0)
#define ENDW(tt) do { if ((tt) + 3 < NT) { WB(2, 1); } else if ((tt) + 2 < NT) { WAIT_BAR(1); } else { WAIT_BAR(0); } } while (0)
    for (; t + 1 < NT; t += 2) {
        STEP(pB0, pB1, pA0, pA1, t, (t + 3 < NT), (t + 1 < NT), (t + 1 < NT));         ENDW(t);     RESC(); ROT();
        STEP(pA0, pA1, pB0, pB1, t + 1, (t + 4 < NT), (t + 2 < NT), (t + 2 < NT));     ENDW(t + 1); RESC(); ROT();
    }
    STEP(pB0, pB1, pA0, pA1, NT - 1, false, false, false); RESC();
    { float sacc = pB0[0] + pB0[1]; _Pragma("unroll") for (int r = 2; r < 16; ++r) sacc += pB0[r]; _Pragma("unroll") for (int r = 0; r < 16; ++r) sacc += pB1[r]; l_reg += sacc;
      pw0 = (u32x4){PKW(pB0, 0), PKW(pB0, 2), PKW(pB0, 4), PKW(pB0, 6)}; pw1 = (u32x4){PKW(pB0, 8), PKW(pB0, 10), PKW(pB0, 12), PKW(pB0, 14)}; pw2 = (u32x4){PKW(pB1, 0), PKW(pB1, 2), PKW(pB1, 4), PKW(pB1, 6)}; pw3 = (u32x4){PKW(pB1, 8), PKW(pB1, 10), PKW(pB1, 12), PKW(pB1, 14)};
      SBAR(); pv(o, vb0 + sl_cur, PAF(0), PAF(1), PAF(2), PAF(3)); }
#undef PKW
#undef PAF
#undef VFR
#undef PIN
#undef MX3
#undef GAPA
#undef GAPB
#undef EX
#undef VRD
#undef KRD
#undef BRD4
#undef STEP
#undef ENDW
#undef WB
    { auto rr = __builtin_amdgcn_permlane32_swap(__float_as_uint(l_reg), __float_as_uint(l_reg), false, false); l_reg = __uint_as_float(rr[0]) + __uint_as_float(rr[1]); }
    if (hi == 0) wsf[32 + r32] = l_reg; asm volatile("s_waitcnt lgkmcnt(0)" ::: "memory");
    float rli[16];
#pragma unroll
    for (int r = 0; r < 16; ++r) rli[r] = __builtin_amdgcn_rcpf(wsf[32 + crow(r, hi)]);
    bf16_t* Ow = O + (rowbase + q0 + wid * QBLK) * OP + ocol;
    { bf16_t* stg = (bf16_t*)(shm + LDS_OST) + wid * 2048;
#pragma unroll
      for (int r = 0; r < 16; ++r) { const int orow = crow(r, hi);
#pragma unroll
        for (int d0 = 0; d0 < 2; ++d0) stg[orow * 64 + d0 * 32 + r32] = (bf16_t)f2bf(o[d0][r] * rli[r]); }
      asm volatile("s_waitcnt lgkmcnt(0)" ::: "memory");
#pragma unroll
      for (int i = 0; i < 4; ++i) { const int row = i * 8 + (lane >> 3), ch = lane & 7; const u32x4 v = *(const u32x4*)(stg + row * 64 + ch * 8);
          u32x2 w8; w8.x = pk4_fp8(O8S * bf2f(v.x & 0xffffu), O8S * bf2f(v.x >> 16), O8S * bf2f(v.y & 0xffffu), O8S * bf2f(v.y >> 16)); w8.y = pk4_fp8(O8S * bf2f(v.z & 0xffffu), O8S * bf2f(v.z >> 16), O8S * bf2f(v.w & 0xffffu), O8S * bf2f(v.w >> 16));
          *(u32x2*)((unsigned char*)O + ((rowbase + q0 + wid * QBLK + row) * (long)OP + ocol + ch * 8)) = w8; } }
    asm volatile("s_waitcnt lgkmcnt(0)\n\ts_barrier" ::: "memory");
#undef DMA_K
#undef DMA_V
#undef CMASK
#undef START
#undef RESC
#undef ROT
}

constexpr int L2_K = 0, L2_V = 3 * 8192, L2_WS = L2_V + 3 * 16384, L2_OST = L2_WS + NW * 64 * 4, LDS_BYTES_D128 = L2_OST + NW * 4096;
template <int THRL, bool COMBINE> __device__ __forceinline__ void attn_unit_d128(long rowbase, int qcol, int vcol, int ocol, int OP, int qb, const unsigned char* Q, const unsigned char* __restrict__ K, const unsigned char* __restrict__ V, bf16_t* O,
                                                                                const bf16_t* O1, int o1col, float lam, const float* __restrict__ gsub, char* shm) {
    int tid_ = threadIdx.x; asm volatile("" : "+v"(tid_));
    const int tid = tid_, lane = tid & 63, r32 = lane & 31, hi = lane >> 5; const int wid = __builtin_amdgcn_readfirstlane(tid >> 6);
    const int q0 = qb * QB; const int NT = (q0 + QB) / KVBLK;
    const bool wlo = wid < 4;
    const unsigned char* Qw = Q + (rowbase + q0 + wid * QBLK) * 512 + qcol;
    const unsigned char* Kh = K + rowbase * 512 + qcol; const unsigned char* Vh = V + rowbase * 512 + vcol;
    const unsigned lds0 = (unsigned)(uintptr_t)shm;
    float* wsf = (float*)(shm + L2_WS) + wid * 64;
    const unsigned char* ksrc = Kh + (long)(32 * (wid & 1) + (lane >> 1)) * 512 + ((wid >> 1) & 1) * 32 + (lane & 1) * 16;
    const int vj_ = lane >> 1, vg_ = wid & 1; const int vkey_ = (vj_ < 16) ? crow(vj_, vg_) : 32 + crow(vj_ - 16, vg_);
    const unsigned char* vsrc = Vh + (long)vkey_ * 512 + (wid >> 1) * 32 + (lane & 1) * 16;
    const unsigned kdst = lds0 + L2_K + wid * 1024, vdst = lds0 + L2_V + wid * 1024;
#define DMA_K(t, slot) do { if (wlo) glds16(ksrc + (long)(t) * KVBLK * 512, (unsigned)__builtin_amdgcn_readfirstlane(kdst + ((slot) >> 1))); } while (0)
#define DMA_V(t, slot) glds16(vsrc + (long)(t) * KVBLK * 512, (unsigned)__builtin_amdgcn_readfirstlane(vdst + (slot)))
    i32x8 kf[2];
    const lds_cptr shm3 = (lds_cptr)shm; const lds_cptr kp0 = shm3 + L2_K + hi * 2048 + r32 * 32; const lds_cptr vp0 = shm3 + L2_V + (32 * hi + ((lane & 15) >> 1)) * 32 + ((lane >> 4) & 1) * 16 + (lane & 1) * 8;
    DMA_K(0, 0); DMA_V(0, 0); DMA_K(1, SLOTB);
    const i32x8 qr = *reinterpret_cast<const i32x8a*>(Qw + (long)r32 * 512 + hi * 32);
    float mhat = 0.f, l_reg = 0.f; f32x16 o[4]; o[0] = f32x16{}; o[1] = f32x16{}; o[2] = f32x16{}; o[3] = f32x16{}; f32x16 ol = f32x16{};
    constexpr int L2_ONES = LDS_BYTES_D128;
    if (tid == 0) { u32x4 o4_; o4_.x = o4_.y = o4_.z = o4_.w = 0x38383838u; *(u32x4*)(shm + L2_ONES) = o4_; *(u32x4*)(shm + L2_ONES + 16) = o4_; }
    i32x8 vone;
    f32x16 negm = f32x16{}; asm volatile("" : "+v"(negm));
#define CMASK(P0, P1, t) do { int jb_ = (t) - (NT - 4); if (jb_ > (wid >> 1)) maskall(P0, P1); } while (0)
    bool resc = false;
#define RESC() do { if (resc) { asm volatile("s_waitcnt lgkmcnt(0)" ::: "memory"); \
      _Pragma("unroll") for (int d_ = 0; d_ < 4; ++d_) _Pragma("unroll") for (int r = 0; r < 16; ++r) o[d_][r] *= wsf[crow(r, hi)]; \
      _Pragma("unroll") for (int r = 0; r < 16; ++r) ol[r] *= wsf[crow(r, hi)]; } } while (0)
    f32x16 C0, C1; i32x8 pwa, pwb;
    int sl_prev = 0, sl_cur = 0, sl_next = SLOTB;
#define ROT() do { sl_prev = sl_cur; sl_cur = sl_next; sl_next = (sl_next == (NSLOT - 1) * SLOTB) ? 0 : sl_next + SLOTB; } while (0)
#define WB(NLO, NHI) do { if (wlo) { WAIT_BAR(NLO); } else { WAIT_BAR(NHI); } } while (0)
    DMA_K(2, 2 * SLOTB);
    WB(3, 1);
    qkt(C0, C1, kp0, qr, negm);
    asm volatile("s_nop 15\n\ts_nop 7" : "+v"(C0), "+v"(C1)); CMASK(C0, C1, 0);
    { const float rm = rowmax(C0, C1) - 6.0f; mhat = rm;
#pragma unroll
      for (int r = 0; r < 16; ++r) { C0[r] = __builtin_amdgcn_exp2f(C0[r] - rm); C1[r] = __builtin_amdgcn_exp2f(C1[r] - rm); }
#pragma unroll
      for (int r = 0; r < 16; ++r) negm[r] = -mhat;
      asm volatile("" : "+v"(negm));
#pragma unroll
      for (int w = 0; w < 4; ++w) { pwa[w] = (int)pk4_fp8_nc(C0[4 * w], C0[4 * w + 1], C0[4 * w + 2], C0[4 * w + 3]); pwa[4 + w] = (int)pk4_fp8_nc(C1[4 * w], C1[4 * w + 1], C1[4 * w + 2], C1[4 * w + 3]); } }
    WAIT_BAR(0);
    DMA_K(3, 0); DMA_V(1, SLOTB);
    ROT();
    kload8(kf, kp0 + (sl_cur >> 1));
    WB(2, 1);
    typedef int v2i_t __attribute__((ext_vector_type(2)));
    i32x8 vf[4];
#define PIN(x) asm volatile("" : "+v"(x))
#define MX3(a, b, c) __builtin_fmaxf(__builtin_fmaxf((a), (b)), (c))
#define VTR8(p_) __builtin_amdgcn_ds_read_tr8_b64_v2i32((LAS v2i_t*)(p_))
#define VRDN(dq) do { const v2i_t a_ = VTR8(vp_ + (dq) * 2048), b_ = VTR8(vp_ + (dq) * 2048 + 256), c_ = VTR8(vp_ + (dq) * 2048 + 512), d_ = VTR8(vp_ + (dq) * 2048 + 768); \
        vf[dq] = (i32x8){a_.x, a_.y, b_.x, b_.y, c_.x, c_.y, d_.x, d_.y}; } while (0)
#define KRD(G, j) do { if (G) { kload2(kf, kp0 + (sl_next >> 1), j); } } while (0)
#define EXP4(X, B, W) do { X[B] = __builtin_amdgcn_exp2f(X[B]); X[B + 1] = __builtin_amdgcn_exp2f(X[B + 1]); X[B + 2] = __builtin_amdgcn_exp2f(X[B + 2]); X[B + 3] = __builtin_amdgcn_exp2f(X[B + 3]); \
        W = (int)pk4_fp8_nc(X[B], X[B + 1], X[B + 2], X[B + 3]); PIN(W); } while (0)
#define STEPD(CU, NX, t, GK, GV, GL) do { SBAR(); \
    const lds_cptr vp_ = vp0 + sl_prev; \
    C0 = MF8(kf[0], qr, negm); SBAR(); \
    VRDN(0); VRDN(1); SBAR(); \
    C1 = MF8(kf[1], qr, negm); SBAR(); \
    VRDN(2); VRDN(3); vone = *(const LAS i32x8a*)(shm3 + L2_ONES); SBAR(); \
    if (GK) { DMA_K((t) + 3, sl_cur); } if (GV) { DMA_V((t) + 1, sl_next); } \
    CMASK(C0, C1, t); \
    { float a = MX3(C0[0], C0[1], C1[0]), b = MX3(C0[2], C0[3], C1[1]); a = MX3(a, C1[2], C1[3]); \
      _Pragma("unroll") for (int r = 4; r < 16; r += 4) { a = MX3(a, C0[r], C0[r + 1]); b = MX3(b, C0[r + 2], C0[r + 3]); a = MX3(a, C1[r], C1[r + 1]); b = MX3(b, C1[r + 2], C1[r + 3]); } \
      float rm = __builtin_fmaxf(a, b); { auto rr = __builtin_amdgcn_permlane32_swap(__float_as_uint(rm), __float_as_uint(rm), false, false); rm = __builtin_fmaxf(__uint_as_float(rr[0]), __uint_as_float(rr[1])); } \
      resc = false; \
      if (__builtin_expect(__any(rm > (float)THRL), 0)) { const float dl = __builtin_fmaxf(rm - 6.0f, 0.f); mhat += dl; \
        _Pragma("unroll") for (int r = 0; r < 16; ++r) { C0[r] -= dl; C1[r] -= dl; } \
        _Pragma("unroll") for (int r = 0; r < 16; ++r) negm[r] = -mhat; asm volatile("" : "+v"(negm)); \
        const float f = __builtin_amdgcn_exp2f(-dl); if (hi == 0) wsf[r32] = f; resc = true; } } \
    SBAR(); \
    ol = MF8(CU, vone, ol); SBAR(); \
    o[0] = MF8(CU, vf[0], o[0]); EXP4(C0, 0, NX[0]); EXP4(C0, 4, NX[1]); SBAR(); \
    o[1] = MF8(CU, vf[1], o[1]); EXP4(C0, 8, NX[2]); EXP4(C0, 12, NX[3]); SBAR(); \
    KRD(GL, 0); o[2] = MF8(CU, vf[2], o[2]); EXP4(C1, 0, NX[4]); EXP4(C1, 4, NX[5]); SBAR(); \
    KRD(GL, 1); o[3] = MF8(CU, vf[3], o[3]); EXP4(C1, 8, NX[6]); EXP4(C1, 12, NX[7]); SBAR(); \
    } while (0)
#define STEP_AB(t, GK, GV, GL) STEPD(pwa, pwb, t, GK, GV, GL)
#define STEP_BA(t, GK, GV, GL) STEPD(pwb, pwa, t, GK, GV, GL)
    int t = 1;
#undef CMASK
#define CMASK(P0, P1, t) do { } while (0)
    for (; t + 5 < NT; t += 2) {
        STEP_AB(t, true, true, true);     WB(2, 1); RESC(); ROT();
        STEP_BA(t + 1, true, true, true); WB(2, 1); RESC(); ROT();
    }
#undef CMASK
#define CMASK(P0, P1, t) do { int jb_ = (t) - (NT - 4); if (jb_ > (wid >> 1)) maskall(P0, P1); } while (0)
#define ENDW(tt) do { if ((tt) + 3 < NT) { WB(2, 1); } else if ((tt) + 2 < NT) { WAIT_BAR(1); } else { WAIT_BAR(0); } } while (0)
    for (; t + 1 < NT; t += 2) {
        STEP_AB(t, (t + 3 < NT), (t + 1 < NT), (t + 1 < NT));         ENDW(t);     RESC(); ROT();
        STEP_BA(t + 1, (t + 4 < NT), (t + 2 < NT), (t + 2 < NT));     ENDW(t + 1); RESC(); ROT();
    }
    STEP_AB(NT - 1, false, false, false); RESC();
    { const lds_cptr vp_ = vp0 + sl_cur; SBAR(); VRDN(0); VRDN(1); VRDN(2); VRDN(3); vone = *(const LAS i32x8a*)(shm3 + L2_ONES);
      ol = MF8(pwb, vone, ol); o[0] = MF8(pwb, vf[0], o[0]); o[1] = MF8(pwb, vf[1], o[1]); o[2] = MF8(pwb, vf[2], o[2]); o[3] = MF8(pwb, vf[3], o[3]); }
#undef PIN
#undef MX3
#undef VTR8
#undef VRDN
#undef KRD
#undef EXP4
#undef STEPD
#undef STEP_AB
#undef STEP_BA
#undef ENDW
#undef WB
    float rli[16];
#pragma unroll
    for (int r = 0; r < 16; ++r) rli[r] = __builtin_amdgcn_rcpf(ol[r]);
    bf16_t* Ow = O + (rowbase + q0 + wid * QBLK) * OP + ocol;
    if (!COMBINE) {
        bf16_t* stg = (bf16_t*)(shm + L2_OST) + wid * 2048;
#pragma unroll
        for (int p = 0; p < 2; ++p) {
#pragma unroll
            for (int r = 0; r < 16; ++r) { const int orow = crow(r, hi);
#pragma unroll
                for (int dd = 0; dd < 2; ++dd) stg[orow * 64 + dd * 32 + r32] = (bf16_t)f2bf(o[2 * p + dd][r] * rli[r]); }
            asm volatile("s_waitcnt lgkmcnt(0)" ::: "memory");
#pragma unroll
            for (int i = 0; i < 4; ++i) { const int row = i * 8 + (lane >> 3), ch = lane & 7; const u32x4 v = *(const u32x4*)(stg + row * 64 + ch * 8); *(u32x4*)(Ow + (long)row * OP + p * 64 + ch * 8) = v; }
            asm volatile("s_waitcnt lgkmcnt(0)" ::: "memory");
        }
    } else {
        asm volatile("s_waitcnt lgkmcnt(0)\n\ts_barrier" ::: "memory");
        constexpr int SROW = 136;
        bf16_t* stg = (bf16_t*)shm + wid * (32 * SROW);
#pragma unroll
        for (int r = 0; r < 16; ++r) { const int orow = crow(r, hi);
#pragma unroll
            for (int dq = 0; dq < 4; ++dq) stg[orow * SROW + dq * 32 + r32] = (bf16_t)f2bf(o[dq][r] * rli[r]); }
        asm volatile("s_waitcnt vmcnt(0) lgkmcnt(0)" ::: "memory");
        const int row = lane >> 1, hf = lane & 1;
        const bf16_t* o1p = O1 + (rowbase + q0 + wid * QBLK + row) * 512 + o1col + hf * 64;
        const bf16_t* o2p = stg + row * SROW + hf * 64;
        float d[64]; float ss = 0.f;
#pragma unroll
        for (int i = 0; i < 8; ++i) { const u32x4 a = *(const u32x4*)(o1p + 8 * i), c = *(const u32x4*)(o2p + 8 * i);
            d[8 * i + 0] = bf2f(a.x & 0xffffu) - lam * bf2f(c.x & 0xffffu); d[8 * i + 1] = bf2f(a.x >> 16) - lam * bf2f(c.x >> 16);
            d[8 * i + 2] = bf2f(a.y & 0xffffu) - lam * bf2f(c.y & 0xffffu); d[8 * i + 3] = bf2f(a.y >> 16) - lam * bf2f(c.y >> 16);
            d[8 * i + 4] = bf2f(a.z & 0xffffu) - lam * bf2f(c.z & 0xffffu); d[8 * i + 5] = bf2f(a.z >> 16) - lam * bf2f(c.z >> 16);
            d[8 * i + 6] = bf2f(a.w & 0xffffu) - lam * bf2f(c.w & 0xffffu); d[8 * i + 7] = bf2f(a.w >> 16) - lam * bf2f(c.w >> 16);
#pragma unroll
            for (int e = 0; e < 8; ++e) ss += d[8 * i + e] * d[8 * i + e]; }
        ss += __shfl_xor(ss, 1);
        const float rs = (1.0f - LAM0) * __builtin_amdgcn_rsqf(ss * (1.0f / 128.0f) + EPS);
#pragma unroll
        for (int i = 0; i < 8; ++i) { const f32x4 g0 = *(const f32x4*)(gsub + hf * 64 + 8 * i), g1 = *(const f32x4*)(gsub + hf * 64 + 8 * i + 4);
            const float r8 = rs * O8S; u32x2 w; w.x = pk4_fp8(d[8 * i] * r8 * g0[0], d[8 * i + 1] * r8 * g0[1], d[8 * i + 2] * r8 * g0[2], d[8 * i + 3] * r8 * g0[3]);
            w.y = pk4_fp8(d[8 * i + 4] * r8 * g1[0], d[8 * i + 5] * r8 * g1[1], d[8 * i + 6] * r8 * g1[2], d[8 * i + 7] * r8 * g1[3]);
            *(u32x2*)((unsigned char*)O + ((rowbase + q0 + wid * QBLK + row) * (long)OP + ocol + hf * 64 + 8 * i)) = w; }
    }
    asm volatile("s_waitcnt lgkmcnt(0)\n\ts_barrier" ::: "memory");
#undef DMA_K
#undef DMA_V
#undef CMASK
#undef RESC
#undef ROT
}
#undef SBAR
#undef WAIT_BAR
}

typedef GAS unsigned gu32;
#define XB_TMO      128
#define XB_XCNT(j)  (256  + 64 * (j))
#define XB_XSUB(j)  (1280 + 64 * (j))
#define XB_XGEN(j)  (2304 + 64 * (j))
#define XB_TOP      3328
#define XB_TOPGEN   3392
#define XCD_BAR_WORDS 3456
#define XB_SPIN_CAP (1u << 19)
__device__ __forceinline__ unsigned xb_ld(unsigned* p)              { return __hip_atomic_load(p, __ATOMIC_RELAXED, __HIP_MEMORY_SCOPE_AGENT); }
__device__ __forceinline__ unsigned xb_add(unsigned* p, unsigned v) { return __hip_atomic_fetch_add(p, v, __ATOMIC_RELAXED, __HIP_MEMORY_SCOPE_AGENT); }
__device__ __forceinline__ unsigned xb_xcc_id() { return (unsigned)__builtin_amdgcn_s_getreg((3 << 11) | 20) & 0xFu; }
#define XB_SPIN(cond, bar) do { unsigned _sp = 0; while (cond) { __builtin_amdgcn_s_sleep(1); \
    if ((++_sp & 255u) == 0u) { if (xb_ld(&(bar)[XB_TMO])) break; if (_sp > XB_SPIN_CAP) { atomicAdd(&(bar)[XB_TMO], 1u); break; } } } } while (0)
struct XcdBarrier { unsigned* bar; unsigned x; volatile LAS unsigned* st; };
__device__ __forceinline__ XcdBarrier xcd_barrier_post(unsigned* bar, volatile LAS unsigned* st) {
    XcdBarrier b; b.bar = bar; b.x = xb_xcc_id(); b.st = st;
    if (threadIdx.x == 0) (void)xb_add(&bar[XB_XCNT(b.x)], 1u);
    return b;
}
__device__ __forceinline__ void xcd_barrier_complete(unsigned* bar, unsigned x, unsigned& nloc, unsigned& nx) {
    const unsigned G = gridDim.x * gridDim.y * gridDim.z;
    unsigned sum, cnt, mine, sp = 0u;
    for (;;) {
        sum = 0u; cnt = 0u; mine = 0u;
#pragma unroll
        for (unsigned j = 0; j < 16; ++j) { const unsigned c = xb_ld(&bar[XB_XCNT(j)]); sum += c; cnt += (c > 0u) ? 1u : 0u; mine = (j == x) ? c : mine; }
        if (sum == G) break;
        __builtin_amdgcn_s_sleep(1);
        if ((++sp & 255u) == 0u) { if (xb_ld(&bar[XB_TMO])) break; if (sp > XB_SPIN_CAP) { atomicAdd(&bar[XB_TMO], 1u); break; } }
    }
    nloc = mine > 0u ? mine : 1u; nx = cnt > 0u ? cnt : 1u;
}
__device__ __forceinline__ void xcd_barrier(const XcdBarrier& b) {
    asm volatile("s_waitcnt vmcnt(0)" ::: "memory");
    __syncthreads();
    if (threadIdx.x == 0) {
        unsigned* bar = b.bar;
        __builtin_amdgcn_s_waitcnt(0);
        unsigned nloc = b.st[0], nx = b.st[1];
        if (nloc == 0u) { xcd_barrier_complete(bar, b.x, nloc, nx); b.st[0] = nloc; b.st[1] = nx; }
        const unsigned old = xb_add(&bar[XB_XSUB(b.x)], 1u);
        const unsigned gen = old / nloc;
        if (old + 1u == (gen + 1u) * nloc) {
            __builtin_amdgcn_fence(__ATOMIC_RELEASE, "agent");
            asm volatile("s_waitcnt vmcnt(0)" ::: "memory");
            const unsigned og = xb_add(&bar[XB_TOP], 1u);
            const unsigned tg = og / nx;
            if (og + 1u == (tg + 1u) * nx) xb_add(&bar[XB_TOPGEN], 1u);
            else XB_SPIN(xb_ld(&bar[XB_TOPGEN]) == tg, bar);
            xb_add(&bar[XB_XGEN(b.x)], 1u);
            __builtin_amdgcn_fence(__ATOMIC_ACQUIRE, "agent");
            asm volatile("s_waitcnt vmcnt(0)" ::: "memory");
        } else {
            XB_SPIN(xb_ld(&bar[XB_XGEN(b.x)]) == gen, bar);
            __builtin_amdgcn_fence(__ATOMIC_ACQUIRE, "agent");
            asm volatile("s_waitcnt vmcnt(0)" ::: "memory");
        }
    }
    __syncthreads();
}

struct Args {
    const float* in[28]; float* out; unsigned char* ws; int ph_lo, ph_hi, li, pad;
};
enum { I_X = 0, I_C, I_POS, I_WADA, I_BADA, I_GN1, I_WIN, I_BF, I_GQF, I_GKF, I_GQD, I_GKD, I_LQ1, I_LK1, I_LQ2, I_LK2, I_GSUB, I_WPF, I_WPD, I_WOUT, I_GN2, I_WRG, I_BRG, I_WRE, I_BRE, I_W1, I_W3, I_W2 };

template <bool F8 = false> __device__ __forceinline__ void transpose_item(const float* W, size_t ldw, int col0, int k0, bf16_t* WT, int drow, int Kd, LAS float* scr, int lane, int kd0 = 0) {
    float v[32];
    const float* wp = W + (size_t)(k0 + (lane >> 5)) * ldw + col0 + (lane & 31);
#pragma unroll
    for (int i = 0; i < 32; ++i) v[i] = wp[(size_t)(2 * i) * ldw];
#pragma unroll
    for (int i = 0; i < 32; ++i) scr[(2 * i + (lane >> 5)) * 33 + (lane & 31)] = v[i];
    LDS_WAIT(); asm volatile("" ::: "memory");
    const int c = lane & 7;
#pragma unroll
    for (int j = 0; j < 4; ++j) { const int n = (lane >> 3) + 8 * j; const LAS float* s = scr + (8 * c) * 33 + n;
        u32x4 o; o.x = pk2(s[0 * 33], s[1 * 33]); o.y = pk2(s[2 * 33], s[3 * 33]); o.z = pk2(s[4 * 33], s[5 * 33]); o.w = pk2(s[6 * 33], s[7 * 33]);
        if (F8) { u32x2 o8; o8.x = pk4_fp8(W8S * s[0 * 33], W8S * s[1 * 33], W8S * s[2 * 33], W8S * s[3 * 33]); o8.y = pk4_fp8(W8S * s[4 * 33], W8S * s[5 * 33], W8S * s[6 * 33], W8S * s[7 * 33]);
                  *(u32x2*)((unsigned char*)WT + (size_t)(drow + n) * Kd + kd0 + k0 + 8 * c) = o8; }
        else *(u32x4*)(WT + (size_t)(drow + n) * Kd + kd0 + k0 + 8 * c) = o; }
    LDS_WAIT(); asm volatile("" ::: "memory");
}

__global__ void __launch_bounds__(NTHREADS, 2) fwd_kernel(Args args) {
    extern __shared__ __attribute__((aligned(16))) unsigned char lds_raw[];
    LAS unsigned char* lds = (LAS unsigned char*)lds_raw;
    volatile LAS unsigned* MISC = (volatile LAS unsigned*)(lds + MISC_OFF);
    const int tid = threadIdx.x, lane = tid & 63, wave = __builtin_amdgcn_readfirstlane(tid >> 6);
    const int G = gridDim.x; const int bx = blockIdx.x; const int vcu = (G % 8 == 0) ? (bx % 8) * (G / 8) + bx / 8 : bx;
    unsigned char* ws = args.ws;
    gu32* ctl = (gu32*)(ws + WS_CTL);
    const int gw = vcu * NWAVES + wave, NGW = G * NWAVES;

    for (int u = tid; u < (LDS_BYTES - LDSCTL_OFF) / 4; u += NTHREADS) ((LAS unsigned*)(lds + LDSCTL_OFF))[u] = 0u;
    __syncthreads();
    XcdBarrier bar; bar.bar = (unsigned*)(ctl + CW_BAR); bar.x = 0; bar.st = nullptr;
    const bool one_launch = (args.ph_hi - args.ph_lo) > 1;
    if (one_launch) bar = xcd_barrier_post((unsigned*)(ctl + CW_BAR), MISC + 8);
    const int lo = args.ph_lo, hi = args.ph_hi;
#ifdef ONLYP
#define IN(k) ((k) == ONLYP && lo <= (k) && (k) < hi)
#else
#define IN(k) (lo <= (k) && (k) < hi)
#endif
#define SEAM(k) do { if (IN(k) && IN((k) + 1)) xcd_barrier(bar); } while (0)

    float* mod = (float*)(ws + WS_MOD);
    float* logf = (float*)(ws + WS_LOGF);
    float* biasb = (float*)(ws + WS_BIAS);
    bf16_t* Win_t = (bf16_t*)(ws + WS_WIN); bf16_t* Wpf_t = (bf16_t*)(ws + WS_WPF); bf16_t* Wpd_t = (bf16_t*)(ws + WS_WPD); bf16_t* Wout_t = (bf16_t*)(ws + WS_WOUT);
    bf16_t* W13_t = (bf16_t*)(ws + WS_W13); bf16_t* W2_t = (bf16_t*)(ws + WS_W2); bf16_t* Wr_t = (bf16_t*)(ws + WS_WR);
    bf16_t* H1 = (bf16_t*)(ws + WS_H1); bf16_t* OCAT = H1;     bf16_t* X1B = H1; bf16_t* H2 = (bf16_t*)(ws + WS_H2);
    bf16_t* QF = (bf16_t*)(ws + WS_QF); bf16_t* KF = (bf16_t*)(ws + WS_KF); bf16_t* VF = (bf16_t*)(ws + WS_VF);
    bf16_t* QD = (bf16_t*)(ws + WS_QD); bf16_t* KD = (bf16_t*)(ws + WS_KD); bf16_t* VD = (bf16_t*)(ws + WS_VD);
    bf16_t* GT = (bf16_t*)(ws + WS_G); bf16_t* O1T = (bf16_t*)(ws + WS_OD);     bf16_t* MERGED = (bf16_t*)(ws + WS_MERGED);
    bf16_t* H2S = (bf16_t*)(ws + WS_H2S); bf16_t* YB = H2S; unsigned char* HH8 = (unsigned char*)(ws + WS_HH);
    unsigned char* H1F8 = (unsigned char*)(ws + WS_OD);
    unsigned char* WG8 = (unsigned char*)(ws + WS_W13 + 32 * MiB);
    unsigned char* H2F8 = (unsigned char*)(ws + WS_QF);
    float* LOGIT = (float*)(ws + WS_LOGIT);
    int* EID = (int*)(ws + WS_EID); int* RNK = (int*)(ws + WS_RNK); float* WGT = (float*)(ws + WS_WGT); int* POS = (int*)(ws + WS_POS);
    int* HIST = (int*)(ws + WS_HIST); int* ELIST = (int*)(ws + WS_ROPE);
    unsigned* GCNT = (unsigned*)(ctl + CW_GCNT); float* gall = (float*)(ws + WS_GALL);
    const float* x = args.in[I_X];

    for (int rep_ = 0; rep_ < 1 + ((PROBE_REP >> 0) & 1); ++rep_) if (IN(0)) {
        if (vcu < 96) {
            LAS float* sl = (LAS float*)lds;
            LAS float* red = (LAS float*)(lds + 65536);
            const float* c = args.in[I_C];
            for (int i = tid; i < 16 * 1024; i += NTHREADS) { const int b = i >> 10, k = i & 1023; const float v = c[i]; sl[k * 16 + b] = v / (1.0f + __expf(-v)); }
            __syncthreads();
            const float* wa = args.in[I_WADA] + vcu * 64 + lane;
            float a[16];
#pragma unroll
            for (int b = 0; b < 16; ++b) a[b] = 0.f;
            for (int k = wave * 128; k < wave * 128 + 128; k += 16) {
                float w[16];
#pragma unroll
                for (int q = 0; q < 16; ++q) w[q] = wa[(size_t)(k + q) * 6144];
#pragma unroll
                for (int q = 0; q < 16; ++q) {
                    const LAS f32x4* sp = (const LAS f32x4*)(sl + (k + q) * 16);
#pragma unroll
                    for (int b4 = 0; b4 < 4; ++b4) { const f32x4 s = sp[b4]; a[4 * b4 + 0] += s[0] * w[q]; a[4 * b4 + 1] += s[1] * w[q]; a[4 * b4 + 2] += s[2] * w[q]; a[4 * b4 + 3] += s[3] * w[q]; }
                    __builtin_amdgcn_sched_barrier(0);
                }
            }
#pragma unroll
            for (int b = 0; b < 16; ++b) red[(wave * 16 + b) * 64 + lane] = a[b];
            __syncthreads();
            for (int i = tid; i < 1024; i += NTHREADS) { const int b = i >> 6, cc = i & 63; float s = 0.f;
#pragma unroll
                for (int w = 0; w < 8; ++w) s += red[(w * 16 + b) * 64 + cc];
                mod[b * 6144 + vcu * 64 + cc] = s + args.in[I_BADA][vcu * 64 + cc]; }
            __syncthreads();
        }
        if (vcu == 100 && tid < 256) gall[tid] = args.in[I_GQF + (tid >> 6)][tid & 63];
        for (int i = gw * 64 + lane; i < 256 * 1024; i += NGW * 64) { const int r = i >> 10, k = i & 1023; float v = 0.f;
            if (r < 4) v = args.in[I_WRG][k * 4 + r]; else if (r < 36) v = args.in[I_WRE][k * 32 + (r - 4)];
            Wr_t[i] = (bf16_t)f2bf(v); }
        { LAS float* scr = (LAS float*)(lds + wave * 16384);
          constexpr int I_IN = 160 * 16, I_PF = 32 * 8, I_PD = 32 * 8, I_OUT = 32 * 16, I_13 = 32 * 2 * 16 * 16, I_2 = 32 * 32 * 8;
          constexpr int NITEMS = I_IN + I_PF + I_PD + I_OUT + I_13 + I_2;
          constexpr int NADA = 96 * NWAVES, ITA = 11 * NADA;
          const bool ada_ = (G == 256) && (vcu < 96);
          const int it0 = (G != 256) ? gw : (ada_ ? vcu * NWAVES + wave : ITA + (vcu - 96) * NWAVES + wave), it1 = (G != 256) ? NITEMS : (ada_ ? ITA : NITEMS), its = (G != 256) ? NGW : (ada_ ? NADA : NGW - NADA);
          for (int it = it0; it < it1; it += its) {
              int r = it;
              if (r < I_IN) { const int nb = r % 160, kb = r / 160; const int pn = nb >> 3, c0 = (nb & 7) * 32, bj = c0 >> 7, wc = (c0 & 127) >> 5; int col0;
                  if (pn >= 12) col0 = COL_GATE + (pn - 12) * 256 + c0;
                  else { const int sec = pn >> 1, pl = pn & 1; const int sb = sec == 0 ? COL_FQ : sec == 1 ? COL_FK : sec == 2 ? COL_FV : sec == 3 ? COL_DQ : sec == 4 ? COL_DK : COL_DV;
                      if (sec == 2 || sec == 5) col0 = sb + pl * 256 + c0; else col0 = sb + (4 * pl + wc) * 64 + 32 * bj; }
                  transpose_item<true>(args.in[I_WIN], IN_COLS, col0, kb * 64, (bf16_t*)WG8, nb * 32, 1024, scr, lane);
                  continue; } r -= I_IN;
              if (r < I_PF) { const int nb = r % 32, kb = r / 32; transpose_item<true>(args.in[I_WPF], 1024, nb * 32, kb * 64, Wpf_t, nb * 32, 1024, scr, lane, 0); continue; } r -= I_PF;
              if (r < I_PD) { const int nb = r % 32, kb = r / 32; transpose_item<true>(args.in[I_WPD], 1024, nb * 32, kb * 64, Wpf_t, nb * 32, 1024, scr, lane, 512); continue; } r -= I_PD;
              if (r < I_OUT) { const int nb = r % 32, kb = r / 32; transpose_item<true>(args.in[I_WOUT], 1024, nb * 32, kb * 64, Wout_t, nb * 32, 1024, scr, lane); continue; }     r -= I_OUT;
              if (r < I_13) { const int nb = r % 16, kb = (r / 16) % 16, sr = (r / 256) % 2, e = r / 512; const int n0 = nb * 32, ct = n0 >> 7;
                  transpose_item<true>(args.in[sr ? I_W3 : I_W1] + (size_t)e * 1024 * 512, 512, n0, kb * 64, W13_t, e * 1024 + ct * 256 + 128 * sr + (n0 - ct * 128), 1024, scr, lane); continue; } r -= I_13;
              { const int nb = r % 32, kb = (r / 32) % 8, e = r / 256;
                  transpose_item<true>(args.in[I_W2] + (size_t)e * 512 * 1024, 1024, nb * 32, kb * 64, W2_t, e * 1024 + nb * 32, 512, scr, lane); }
          } }
    }
    SEAM(0);

    for (int rep_ = 0; rep_ < 1 + ((PROBE_REP >> 1) & 1); ++rep_) if (IN(1)) {
        LAS float* wff = (LAS float*)lds;
        for (int i = tid; i < 8 * 1024; i += NTHREADS) { const int k = i >> 3, q = i & 7; wff[q * 1024 + k] = args.in[I_WIN][(size_t)k * IN_COLS + COL_FF + q]; }
        __syncthreads();
        const int b = gw >> 7;
        const float* mb = mod + (size_t)b * 6144;
        f32x4 gm[4], sh[4];
#pragma unroll
        for (int j = 0; j < 4; ++j) { const int k = 256 * j + 4 * lane; const f32x4 g = *(const f32x4*)(args.in[I_GN1] + k), sc = *(const f32x4*)(mb + 1024 + k); sh[j] = *(const f32x4*)(mb + k); gm[j] = g * (1.0f + sc); }
        const float bfv = (lane < 8) ? args.in[I_BF][lane] : 0.f;
        for (int r = 0; r < 32; ++r) {
            const int row = gw * 32 + r;
            const f32x4* xr = (const f32x4*)(x + (size_t)row * 1024) + lane;
            f32x4 v[4]; float ss = 0.f;
#pragma unroll
            for (int j = 0; j < 4; ++j) { v[j] = xr[64 * j]; ss += (v[j][0] * v[j][0] + v[j][1] * v[j][1]) + (v[j][2] * v[j][2] + v[j][3] * v[j][3]); }
            const float rstd = 1.0f / sqrtf(wave_sum(ss) * (1.0f / 1024.0f) + EPS);
            unsigned long long* o8 = (unsigned long long*)(H1 + (size_t)row * 1024) + lane;
            float zf[8];
#pragma unroll
            for (int q = 0; q < 8; ++q) zf[q] = 0.f;
#pragma unroll
            for (int j = 0; j < 4; ++j) { v[j] = v[j] * rstd * gm[j] + sh[j];
                *((unsigned*)(H1F8 + (size_t)row * 1024 + 256 * j) + lane) = pk4_fp8(v[j][0], v[j][1], v[j][2], v[j][3]);
#pragma unroll
                for (int q = 0; q < 8; ++q) { const f32x4 w = *(const LAS f32x4*)(wff + q * 1024 + 256 * j + 4 * lane); zf[q] += (v[j][0] * w[0] + v[j][1] * w[1]) + (v[j][2] * w[2] + v[j][3] * w[3]); } }
            float mine = 0.f;
#pragma unroll
            for (int q = 0; q < 8; ++q) { const float s = wave_sum(zf[q]); if (lane == q) mine = s; }
            if (lane < 8) { const float z = mine + bfv; const float lf = fminf(z, 0.f) - log1pf(__expf(-fabsf(z)));
                logf[(size_t)(b * 8 + lane) * SEQ + (row & (SEQ - 1))] = lf; }
        }
    }
    SEAM(1);

    for (int rep_ = 0; rep_ < 1 + ((PROBE_REP >> 2) & 1); ++rep_) if (IN(2)) {
        if (vcu < 128 && wave == 0) {
            const float* lp = logf + (size_t)vcu * SEQ + 64 * lane; float v[64]; float run = 0.f;
#pragma unroll
            for (int i = 0; i < 16; ++i) { const f32x4 q = *(const f32x4*)(lp + 4 * i); v[4 * i] = q[0]; v[4 * i + 1] = q[1]; v[4 * i + 2] = q[2]; v[4 * i + 3] = q[3]; }
#pragma unroll
            for (int i = 0; i < 64; ++i) { run += v[i]; v[i] = run; }
            float incl = run;
#pragma unroll
            for (int o = 1; o < 64; o <<= 1) { const float t = __shfl_up(incl, o); if (lane >= o) incl += t; }
            const float excl = incl - run;
            float* bp = biasb + (size_t)vcu * SEQ + 64 * lane;
#pragma unroll
            for (int i = 0; i < 16; ++i) { f32x4 q; q[0] = -(excl + v[4 * i]) * LOG2E; q[1] = -(excl + v[4 * i + 1]) * LOG2E; q[2] = -(excl + v[4 * i + 2]) * LOG2E; q[3] = -(excl + v[4 * i + 3]) * LOG2E; *(f32x4*)(bp + 4 * i) = q; }
        }
        { pg8::USched S{}; S.nM = NTOK / 256; S.nN = 20; S.G = G; S.c = bx; S.pair = 0; S.K = 512  ; S.nseg = 1; S.A0 = (const char*)H1F8; S.A1 = S.A0; S.B0 = (const char*)WG8; S.B1 = S.B0; S.segB = 0; S.tp = nullptr; S.rowst = nullptr; S.direct = -1; S.gidx = nullptr;
          UEpi E{}; E.mode = (((PROBE_REP >> 21) & 1) && rep_) ? 99 : 1; E.pnoff = 12; E.ascale = 1.0f / W8S; E.qkv6 = QF; E.gates = GT; E.gall = gall; E.pos = (const int*)args.in[I_POS];
          pg8::gemm_phase<UEpi, pg8::USched, true>(lds, 512, S, E); }
    }
    SEAM(2);

    if (IN(3)) {
        float bound2;
        float smax2;
        { const float gq = fabsf(args.in[I_GQF][lane]), gk = fabsf(args.in[I_GKF][lane]); const float smax = 8.0f * wave_max(gq) * wave_max(gk); bound2 = (2.0f * smax + 19.5f) * LOG2E; smax2 = smax * LOG2E * 1.02f + 0.5f; }
        const int grp = vcu >> 3, s8 = vcu & 7;
        float lam;
        { const float a = wave_sum(args.in[I_LQ1][lane] * args.in[I_LK1][lane]), c = wave_sum(args.in[I_LQ2][lane] * args.in[I_LK2][lane]); lam = __expf(a) - __expf(c) + LAM0; }
        LAS int* t0tab = (LAS int*)(lds + LDSCTL_OFF + 768);
        { const int i = wave; const int stream = (i >> 1) * 32 + grp; const int sr = (s8 + 2 * (i >> 1)) & 7; const int qb = (i & 1) ? 15 - sr : sr;
          const int b = stream >> 3, h = ((stream & 7) + (b & 3) + 2 * (i >> 1)) & 7;
          const float* bias = biasb + (size_t)(b * 8 + h) * SEQ; const int q0 = qb * 256, NT0 = (q0 + 256) / 64;
          const float bq = bias[q0]; const int j = lane; float bj = 0.f; if (j < NT0 - 4) bj = bias[64 * j + 63];
          const unsigned long long bal = __ballot((j < NT0 - 4) && (bj < bq - bound2));
          const int t0 = __builtin_popcountll(bal) & ~1; if (lane == 0) t0tab[i] = t0; }
        __syncthreads();
        for (int rep_ = 0; rep_ < 1 + (((PROBE_REP >> 20) | (PROBE_REP >> 22)) & 1); ++rep_)
        for (int i = (rep_ && ((PROBE_REP >> 20) & 1)) ? 8 : 0; i < ((rep_ && ((PROBE_REP >> 22) & 1)) ? 8 : 16); ++i) {
            if (i >= 8) {
                if (G != 256) break;
                const int u4 = (i - 8) & 3, ps = ((i - 8) >> 2) * 32 + grp; const int b = ps >> 2, hd = ps & 3, m = u4 & 1, qb2 = (u4 >> 1) ? 15 - s8 : s8; const int hm = hd * 2 + m;
                if (m == 0) attn_body::attn_unit_d128<8, false>((long)b * SEQ, hm * 64, hd * 128, hd * 128, 512, qb2, (const unsigned char*)QD, (const unsigned char*)KD, (const unsigned char*)VD, O1T, nullptr, 0, 0.f, nullptr, (char*)lds_raw);
                else        attn_body::attn_unit_d128<8, true>((long)b * SEQ, hm * 64, hd * 128, 512 + hd * 128, 1024, qb2, (const unsigned char*)QD, (const unsigned char*)KD, (const unsigned char*)VD, OCAT, O1T, hd * 128, lam, args.in[I_GSUB], (char*)lds_raw);
                continue;
            }
            const int stream = (i >> 1) * 32 + grp; const int sr = (s8 + 2 * (i >> 1)) & 7; const int qb = (i & 1) ? 15 - sr : sr;
            if (G != 256) break;
#ifndef NO_FOX
            if (stream < 128) { const int b = stream >> 3, h = ((stream & 7) + (b & 3) + 2 * (i >> 1)) & 7;
                attn_body::attn_unit<true, 8>((long)b * SEQ, h * 64, h * 64, h * 64, 1024, qb, (const unsigned char*)QF, (const unsigned char*)KF, VF, OCAT, biasb + (size_t)(b * 8 + h) * SEQ, __builtin_amdgcn_readfirstlane(t0tab[i]), smax2, (char*)lds_raw);
            }
#endif
#ifndef NO_DIFF
            if (stream >= 128) {   }
#endif
        }
    }
    SEAM(3);


    for (int rep_ = 0; rep_ < 1 + ((PROBE_REP >> 5) & 1); ++rep_) if (IN(5)) {
        pg8::USched S{}; S.nM = NTOK / 256; S.nN = 4; S.G = G; S.c = bx; S.pair = 0; S.K = 512  ; S.nseg = 1; S.A0 = (const char*)OCAT; S.A1 = S.A0; S.B0 = (const char*)Wpf_t; S.B1 = S.B0; S.segB = 0; S.tp = nullptr; S.rowst = nullptr; S.direct = -1; S.gidx = nullptr;
        UEpi E{}; E.mode = 2; E.gates = GT; E.merged = MERGED;
        pg8::gemm_phase<UEpi, pg8::USched, true>(lds, 512, S, E);
    }
    SEAM(5);

    for (int rep_ = 0; rep_ < 1 + ((PROBE_REP >> 6) & 1); ++rep_) if (IN(6)) {
        pg8::USched S{}; S.nM = NTOK / 256; S.nN = 4; S.G = G; S.c = bx; S.pair = 0; S.K = 512  ; S.nseg = 1; S.A0 = (const char*)MERGED; S.A1 = S.A0; S.B0 = (const char*)Wout_t; S.B1 = S.B0; S.segB = 0; S.tp = nullptr; S.rowst = nullptr; S.direct = -1; S.gidx = nullptr;
        UEpi E{}; E.mode = 3; E.x = x; E.x1 = X1B; E.mod = mod; E.ascale = 1.0f / (W8S * M8S);
        pg8::gemm_phase<UEpi, pg8::USched, true>(lds, 512, S, E);
    }
    SEAM(6);

    for (int rep_ = 0; rep_ < 1 + ((PROBE_REP >> 7) & 1); ++rep_) if (IN(7)) {
        int t7 = threadIdx.x; asm volatile("" : "+v"(t7));
        const int l7 = t7 & 63, r7 = l7 & 15, kg = l7 >> 4;
        constexpr int WRP = 2064;
        LAS unsigned char* wr48 = lds; LAS float* gmt = (LAS float*)(lds + 48 * WRP); LAS float* sht = gmt + 1024;
        for (int i = t7; i < 48 * 128; i += NTHREADS) { const int n = i >> 7, c = i & 127; *(LAS u32x4*)(wr48 + n * WRP + c * 16) = *(const u32x4*)((const char*)Wr_t + (size_t)n * 2048 + c * 16); }
        { const int b = vcu >> 4; const float* mb = mod + (size_t)b * 6144;
          for (int k = t7; k < 1024; k += NTHREADS) { gmt[k] = args.in[I_GN2][k] * (1.0f + mb[4096 + k]); sht[k] = mb[3072 + k]; } }
        __syncthreads();
        for (int g = 0; g < 2; ++g) {
            const int row0 = gw * 32 + g * 16;
            const u32x4* xp = (const u32x4*)(X1B + (size_t)(row0 + r7) * 1024 + 8 * kg);
            float ss = 0.f;
#pragma unroll
            for (int q_ = 0; q_ < 2; ++q_) { u32x4 t_[16];
#pragma unroll
                for (int j_ = 0; j_ < 16; ++j_) t_[j_] = xp[4 * (16 * q_ + j_)];
#pragma unroll
                for (int j_ = 0; j_ < 16; ++j_) { const u32x4 w = t_[j_];
                    const float a0 = bf2f(w.x & 0xffffu), a1 = bf2f(w.x >> 16), a2 = bf2f(w.y & 0xffffu), a3 = bf2f(w.y >> 16), a4 = bf2f(w.z & 0xffffu), a5 = bf2f(w.z >> 16), a6 = bf2f(w.w & 0xffffu), a7 = bf2f(w.w >> 16);
                    ss += ((a0 * a0 + a1 * a1) + (a2 * a2 + a3 * a3)) + ((a4 * a4 + a5 * a5) + (a6 * a6 + a7 * a7)); }
                __builtin_amdgcn_sched_barrier(0); }
            ss += __shfl_xor(ss, 16); ss += __shfl_xor(ss, 32);
            const float rstd = 1.0f / sqrtf(ss * (1.0f / 1024.0f) + EPS);
            u32x4 win[16];
#pragma unroll
            for (int j_ = 0; j_ < 16; ++j_) win[j_] = xp[4 * j_];
            f32x4 lacc[3]; lacc[0] = (f32x4){0.f, 0.f, 0.f, 0.f}; lacc[1] = lacc[0]; lacc[2] = lacc[0];
            unsigned char* h8 = H2F8 + (size_t)(row0 + r7) * 1024 + 8 * kg;
#pragma unroll
            for (int s_ = 0; s_ < 32; ++s_) { const u32x4 w = win[s_ & 15]; if (s_ + 16 < 32) win[s_ & 15] = xp[4 * (s_ + 16)]; const int k0 = 32 * s_ + 8 * kg;
                const f32x4 g0 = *(const LAS f32x4*)(gmt + k0), g1 = *(const LAS f32x4*)(gmt + k0 + 4), s0 = *(const LAS f32x4*)(sht + k0), s1 = *(const LAS f32x4*)(sht + k0 + 4);
                f32x4 h0, h1;
                h0[0] = bf2f(w.x & 0xffffu) * rstd * g0[0] + s0[0]; h0[1] = bf2f(w.x >> 16) * rstd * g0[1] + s0[1]; h0[2] = bf2f(w.y & 0xffffu) * rstd * g0[2] + s0[2]; h0[3] = bf2f(w.y >> 16) * rstd * g0[3] + s0[3];
                h1[0] = bf2f(w.z & 0xffffu) * rstd * g1[0] + s1[0]; h1[1] = bf2f(w.z >> 16) * rstd * g1[1] + s1[1]; h1[2] = bf2f(w.w & 0xffffu) * rstd * g1[2] + s1[2]; h1[3] = bf2f(w.w >> 16) * rstd * g1[3] + s1[3];
                u32x2 w8; w8.x = pk4_fp8(h0[0], h0[1], h0[2], h0[3]); w8.y = pk4_fp8(h1[0], h1[1], h1[2], h1[3]);
                *(u32x2*)(h8 + 32 * s_) = w8;
                u32x4 aw; aw.x = cvtpk(h0[0], h0[1]); aw.y = cvtpk(h0[2], h0[3]); aw.z = cvtpk(h1[0], h1[1]); aw.w = cvtpk(h1[2], h1[3]);
                const bf16x8 af = __builtin_bit_cast(bf16x8, aw);
#pragma unroll
                for (int blk = 0; blk < 3; ++blk) { const bf16x8 bfr = *(const LAS bf16x8*)(wr48 + (blk * 16 + r7) * WRP + k0 * 2);
                    lacc[blk] = __builtin_amdgcn_mfma_f32_16x16x32_bf16(af, bfr, lacc[blk], 0, 0, 0); }
                __builtin_amdgcn_sched_barrier(0); }
#pragma unroll
            for (int blk = 0; blk < 3; ++blk)
#pragma unroll
                for (int i = 0; i < 4; ++i) LOGIT[(size_t)(row0 + 4 * kg + i) * 64 + blk * 16 + r7] = lacc[blk][i];
        }
    }
    if (IN(7) && IN(9)) { VM_WAIT(); __syncthreads(); }

    for (int rep_ = 0; rep_ < 1 + ((PROBE_REP >> 9) & 1); ++rep_) if (IN(9)) {
        LAS unsigned* cnt = (LAS unsigned*)lds;
        int t9 = threadIdx.x; asm volatile("" : "+v"(t9));
        if (tid < 32) cnt[t9] = 0u;
        __syncthreads();
        unsigned ra = 0, rb = 0; int eA = 0, eB = 0, tkk = 0;
        if (tid < 256) {
            const int tk = vcu * 256 + tid; const float* lp = LOGIT + (size_t)tk * 64;
            const f32x4 g = *(const f32x4*)lp;
            float gl[4]; gl[0] = g[0] + args.in[I_BRG][0]; gl[1] = g[1] + args.in[I_BRG][1]; gl[2] = g[2] + args.in[I_BRG][2]; gl[3] = g[3] + args.in[I_BRG][3];
            int gi = 0; float gmx = gl[0];
#pragma unroll
            for (int j = 1; j < 4; ++j) if (gl[j] > gmx) { gmx = gl[j]; gi = j; }
            float gs = 0.f;
#pragma unroll
            for (int j = 0; j < 4; ++j) gs += __expf(gl[j] - gmx);
            const float gwt = 1.0f / gs;
            const f32x4 e0 = *(const f32x4*)(lp + 4 + 8 * gi), e1 = *(const f32x4*)(lp + 8 + 8 * gi);
            const f32x4 b0 = *(const f32x4*)(args.in[I_BRE] + 8 * gi), b1 = *(const f32x4*)(args.in[I_BRE] + 8 * gi + 4);
            float el[8]; el[0] = e0[0] + b0[0]; el[1] = e0[1] + b0[1]; el[2] = e0[2] + b0[2]; el[3] = e0[3] + b0[3]; el[4] = e1[0] + b1[0]; el[5] = e1[1] + b1[1]; el[6] = e1[2] + b1[2]; el[7] = e1[3] + b1[3];
            int i1 = 0; float m1 = el[0];
#pragma unroll
            for (int j = 1; j < 8; ++j) if (el[j] > m1) { m1 = el[j]; i1 = j; }
            int i2 = -1; float m2 = -INFINITY;
#pragma unroll
            for (int j = 0; j < 8; ++j) if (j != i1 && el[j] > m2) { m2 = el[j]; i2 = j; }
            const float w1 = 1.0f / (1.0f + __expf(m2 - m1)); const float w2 = 1.0f - w1;
            const int ea = gi * 8 + i1, eb = gi * 8 + i2;
            ra = atomicAdd((unsigned*)(lds_raw) + ea, 1u); rb = atomicAdd((unsigned*)(lds_raw) + eb, 1u);
            EID[tk * 2] = ea; EID[tk * 2 + 1] = eb; WGT[tk * 2] = gwt * w1; WGT[tk * 2 + 1] = gwt * w2; eA = ea; eB = eb; tkk = tk;
        }
        __syncthreads();
        if (tid < 32) cnt[32 + t9] = __hip_atomic_fetch_add(GCNT + tid, cnt[t9], __ATOMIC_RELAXED, __HIP_MEMORY_SCOPE_AGENT);
        __syncthreads();
        if (tid < 256) { const int pa = (int)(cnt[32 + eA] + ra), pb = (int)(cnt[32 + eB] + rb);
            POS[tkk * 2] = pa; POS[tkk * 2 + 1] = pb; ELIST[(size_t)eA * NASSIGN + pa] = tkk; ELIST[(size_t)eB * NASSIGN + pb] = tkk; }
        __syncthreads();
    }
    SEAM(9);

    if (IN(11) || IN(12)) {
        LAS int* tp = (LAS int*)(lds + SCHED_OFF); LAS int* rowst = tp + 40;
        LAS int* ecnt = tp + 80;
        if (tid == 0) { int run = 0; for (int e = 0; e < 32; ++e) { const int c = (int)__hip_atomic_load(GCNT + e, __ATOMIC_RELAXED, __HIP_MEMORY_SCOPE_AGENT); ecnt[e] = c; tp[e] = run; rowst[e] = run * 256; run += (c + 255) >> 8; } tp[32] = run; }
        __syncthreads();
        const int ntile = tp[32];
        for (int rep_ = 0; rep_ < 1 + ((PROBE_REP >> 11) & 1); ++rep_) if (IN(11)) {
            pg8::USched S{}; S.nM = ntile; S.nN = 4; S.G = G; S.c = bx; S.pair = 0; S.K = 512  ; S.nseg = 32; S.A0 = (const char*)H2F8; S.A1 = S.A0; S.B0 = (const char*)W13_t; S.B1 = S.B0; S.segB = (size_t)1024 * 1024; S.tp = tp; S.rowst = rowst; S.direct = -1;
            LAS int* gidx = (LAS int*)(lds + LDSCTL_OFF + 2048);
            S.gidx = gidx;
            { pg8::Unit u; for (int i = 0; i < 12 && S.next(i, u); ++i) if (tid < 256) { const int r = u.row0 - rowst[u.seg] + tid;
                  gidx[i * 256 + tid] = (r < ecnt[u.seg]) ? ELIST[(size_t)u.seg * NASSIGN + r] : 0; } }
            __syncthreads();
            UEpi E{}; E.mode = 5; E.hh = HH8;
            pg8::gemm_phase<UEpi, pg8::USched, true>(lds, 512, S, E);
        }
        SEAM(11);
        for (int rep_ = 0; rep_ < 1 + ((PROBE_REP >> 12) & 1); ++rep_) if (IN(12)) {
            pg8::USched S{}; S.nM = ntile; S.nN = 4; S.G = G; S.c = bx; S.pair = 0; S.K = 256  ; S.nseg = 32; S.A0 = (const char*)HH8; S.A1 = S.A0; S.B0 = (const char*)W2_t; S.B1 = S.B0; S.segB = (size_t)1024 * 512; S.tp = tp; S.rowst = rowst; S.direct = -1; S.gidx = nullptr;
            UEpi E{}; E.mode = 6; E.y = (unsigned char*)YB;
            pg8::gemm_phase<UEpi, pg8::USched, true>(lds, 256, S, E);
        }
    }
    SEAM(12);

    if (IN(13)) {
        LAS int* pst = (LAS int*)(lds + SCHED_OFF);
        if (tid == 0) { int run = 0; for (int e = 0; e < 32; ++e) { pst[e] = run; run += (((int)__hip_atomic_load(GCNT + e, __ATOMIC_RELAXED, __HIP_MEMORY_SCOPE_AGENT) + 255) >> 8) << 8; } }
        __syncthreads();
        for (int row = gw; row < NTOK; row += NGW) {
            const int b = row >> 12; const float* gt = mod + (size_t)b * 6144 + 5120;
            const int p0 = pst[EID[row * 2]] + POS[row * 2], p1 = pst[EID[row * 2 + 1]] + POS[row * 2 + 1]; const float w0 = WGT[row * 2], w1 = WGT[row * 2 + 1];
            float* orow = args.out + (size_t)row * 1024;
#pragma unroll
            for (int j = 0; j < 2; ++j) { const int k = 512 * j + 8 * lane;
                const u32x2 a = *(const u32x2*)((const unsigned char*)YB + (size_t)p0 * 1024 + k), c = *(const u32x2*)((const unsigned char*)YB + (size_t)p1 * 1024 + k);
                const u32x4 xw = *(const u32x4*)(X1B + (size_t)row * 1024 + k); const f32x4 g0 = *(const f32x4*)(gt + k), g1 = *(const f32x4*)(gt + k + 4);
                f32x4 x0, x1v; x0[0] = bf2f(xw.x & 0xffffu); x0[1] = bf2f(xw.x >> 16); x0[2] = bf2f(xw.y & 0xffffu); x0[3] = bf2f(xw.y >> 16); x1v[0] = bf2f(xw.z & 0xffffu); x1v[1] = bf2f(xw.z >> 16); x1v[2] = bf2f(xw.w & 0xffffu); x1v[3] = bf2f(xw.w >> 16);
                const f32x2 a0 = __builtin_amdgcn_cvt_pk_f32_fp8((int)a.x, false), a1 = __builtin_amdgcn_cvt_pk_f32_fp8((int)a.x, true), a2 = __builtin_amdgcn_cvt_pk_f32_fp8((int)a.y, false), a3 = __builtin_amdgcn_cvt_pk_f32_fp8((int)a.y, true);
                const f32x2 c0 = __builtin_amdgcn_cvt_pk_f32_fp8((int)c.x, false), c1 = __builtin_amdgcn_cvt_pk_f32_fp8((int)c.x, true), c2 = __builtin_amdgcn_cvt_pk_f32_fp8((int)c.y, false), c3 = __builtin_amdgcn_cvt_pk_f32_fp8((int)c.y, true);
                const float w0s = w0 * (1.0f / Y8S), w1s = w1 * (1.0f / Y8S);
                f32x4 y0, y1;
                y0[0] = w0s * a0[0] + w1s * c0[0]; y0[1] = w0s * a0[1] + w1s * c0[1]; y0[2] = w0s * a1[0] + w1s * c1[0]; y0[3] = w0s * a1[1] + w1s * c1[1];
                y1[0] = w0s * a2[0] + w1s * c2[0]; y1[1] = w0s * a2[1] + w1s * c2[1]; y1[2] = w0s * a3[0] + w1s * c3[0]; y1[3] = w0s * a3[1] + w1s * c3[1];
                *(f32x4*)(orow + k) = x0 + g0 * y0; *(f32x4*)(orow + k + 4) = x1v + g1 * y1; }
        }
    }
#undef IN
#undef SEAM
}

extern "C" void kernel_launch(void* const* d_in, const int* in_sizes, int n_in, void* d_out, int out_size, void* d_ws, size_t ws_size, hipStream_t stream) {
    static int grid = 0;
    if (grid == 0) {
        if (n_in != 28 || in_sizes[0] != NTOK * DMODEL || out_size != NTOK * DMODEL || ws_size < WS_END) { fprintf(stderr, "kernel_launch: unexpected shapes (n_in %d, in0 %d, out %d, ws %zu)\n", n_in, n_in > 0 ? in_sizes[0] : -1, out_size, ws_size); grid = -1; return; }
        int dev = 0, cus = 0, per_cu = 0;
        if (hipGetDevice(&dev) != hipSuccess || hipDeviceGetAttribute(&cus, hipDeviceAttributeMultiprocessorCount, dev) != hipSuccess) { grid = -1; return; }
        if (hipFuncSetAttribute((const void*)fwd_kernel, hipFuncAttributeMaxDynamicSharedMemorySize, LDS_BYTES) != hipSuccess) { fprintf(stderr, "kernel_launch: hipFuncSetAttribute failed\n"); grid = -1; return; }
        if (hipOccupancyMaxActiveBlocksPerMultiprocessor(&per_cu, (const void*)fwd_kernel, NTHREADS, LDS_BYTES) != hipSuccess || per_cu < 1) { fprintf(stderr, "kernel_launch: occupancy query says %d blocks per CU\n", per_cu); per_cu = 1; }
        (void)hipGetLastError();
        grid = cus * 1;
        if (grid != 256) fprintf(stderr, "kernel_launch: %d CUs; this kernel is laid out for 256\n", grid);
    }
    if (grid < 0) return;
    (void)hipMemsetAsync((char*)d_ws + WS_CTL, 0, CTL_ZERO_BYTES, stream);
    Args a{};
    for (int i = 0; i < 28; ++i) a.in[i] = (const float*)d_in[i];
    a.out = (float*)d_out; a.ws = (unsigned char*)d_ws;
    constexpr int NPH = 14;
    if (MK_N_LAUNCHES == 1) { a.ph_lo = 0; a.ph_hi = NPH; a.li = 0; hipLaunchKernelGGL(fwd_kernel, dim3(grid), dim3(NTHREADS), LDS_BYTES, stream, a); }
    else { for (int p = 0; p < NPH; ++p) { a.ph_lo = p; a.ph_hi = p + 1; a.li = p; hipLaunchKernelGGL(fwd_kernel, dim3(grid), dim3(NTHREADS), LDS_BYTES, stream, a); } }
}
```
